# Optimizing an MI355X kernel written in HIP

```python
import jax
import jax.numpy as jnp
from jax import lax
import numpy as np

D_MODEL = 2048
BATCH = 4
SEQ = 4096
DEPTH = 2

F32 = jnp.float32
RMS_EPS = 1e-6
MASK_VALUE = -1e30
LB_FLOOR = 1e-30
GRID_W = 64
MEM_TOKENS = 256

NA_HEADS = 8
NA_HEAD_DIM = 64
NA_WIDTH = NA_HEADS * NA_HEAD_DIM
NA_WIN_ROWS = 8
NA_WIN_COLS = 16

GLA_HEADS = 4
GLA_HEAD_K = 64
GLA_HEAD_V = 128
GLA_KEY_WIDTH = GLA_HEADS * GLA_HEAD_K
GLA_VAL_WIDTH = GLA_HEADS * GLA_HEAD_V
GLA_GATE_RANK = 16
GLA_GATE_NORMALIZER = 16.0

GDN_HEADS = 4
GDN_HEAD_K = 128
GDN_HEAD_V = 128
GDN_KEY_WIDTH = GDN_HEADS * GDN_HEAD_K
GDN_VAL_WIDTH = GDN_HEADS * GDN_HEAD_V
GDN_CONV = 5
GDN_CHUNK = 64

HGRN_HEADS = 4
HGRN_HEAD_K = 128
HGRN_HEAD_V = 128
HGRN_KEY_WIDTH = HGRN_HEADS * HGRN_HEAD_K
HGRN_VAL_WIDTH = HGRN_HEADS * HGRN_HEAD_V

LIN_CHUNK = 32

MEM_HEADS = 4
MEM_HEAD_DIM = 128
MEM_WIDTH = MEM_HEADS * MEM_HEAD_DIM

N_BRANCH = 5
BRANCH_WIDTH = 512

D_FF = 5632
N_EXPERTS = 8
MOE_TOP_K = 2
D_FF_EXPERT = 7168
MOE_BLOCK = 256
N_DENSE = (DEPTH + 1) // 2
N_MOE = DEPTH // 2

IN_WIDTHS = (
    NA_WIDTH, NA_WIDTH, NA_WIDTH,
    GLA_KEY_WIDTH, GLA_KEY_WIDTH, GLA_VAL_WIDTH,
    2 * GLA_GATE_RANK, GLA_VAL_WIDTH,
    2 * GDN_KEY_WIDTH + GDN_VAL_WIDTH,
    2 * GDN_HEADS, 2 * GDN_HEADS, GDN_VAL_WIDTH,
    HGRN_KEY_WIDTH, 2 * HGRN_KEY_WIDTH, HGRN_VAL_WIDTH, HGRN_VAL_WIDTH,
    MEM_WIDTH,
    N_BRANCH * D_MODEL,
)
P_IN = sum(IN_WIDTHS)

kernel_name = "hybrid_bidir_na_gla_gdn_hgrn2_mem_moe"


def rms_norm(x, gain, eps=RMS_EPS):
    xf = x.astype(F32)
    y = xf * lax.rsqrt(jnp.mean(xf * xf, axis=-1, keepdims=True) + eps)
    return (y * gain.astype(F32)).astype(x.dtype)


def l2_norm(x, eps=1e-6):
    xf = x.astype(F32)
    return xf * lax.rsqrt(jnp.sum(xf * xf, axis=-1, keepdims=True) + eps)


def _rev(t):
    return jnp.flip(t, axis=1)


def centred_depthwise_conv(x, w):
    width = w.shape[0]
    return lax.conv_general_dilated(
        x, w[:, None, :], window_strides=(1,), padding=[(width // 2, width // 2)],
        dimension_numbers=("NWC", "WIO", "NWC"), feature_group_count=x.shape[-1])


def chunk_gated_linear_attention(q, k, v, log_g):
    B, S, H, K = q.shape
    V = v.shape[-1]
    C = LIN_CHUNK
    n = S // C

    def chunks(t):
        return t.reshape(B, n, C, H, t.shape[-1]).transpose(1, 0, 3, 2, 4)

    q, k, v, log_g = chunks(q), chunks(k), chunks(v), chunks(log_g)
    b = jnp.cumsum(log_g, axis=-2)
    b_ref = b[..., C // 2:C // 2 + 1, :]
    incl = jnp.tril(jnp.ones((C, C), dtype=bool))
    scores = jnp.einsum("nbhik,nbhjk->nbhij", q * jnp.exp(b - b_ref), k * jnp.exp(b_ref - b))
    o_intra = jnp.einsum("nbhij,nbhjv->nbhiv", jnp.where(incl, scores, 0.0), v)
    q_dec = q * jnp.exp(b)
    k_dec = k * jnp.exp(b[..., -1:, :] - b)
    g_tot = jnp.exp(b[..., -1, :])

    def step(state, xs):
        q_c, k_c, v_c, g_c = xs
        o_c = jnp.einsum("bhik,bhkv->bhiv", q_c, state)
        state = state * g_c[..., None] + jnp.einsum("bhjk,bhjv->bhkv", k_c, v_c)
        return state, o_c

    _, o_inter = lax.scan(step, jnp.zeros((B, H, K, V), F32), (q_dec, k_dec, v, g_tot))
    o = o_intra + o_inter
    return o.transpose(1, 0, 3, 2, 4).reshape(B, S, H, V)


def chunk_gated_delta_rule(q, k, v, log_alpha, beta):
    B, S, H, K = q.shape
    V = v.shape[-1]
    C = GDN_CHUNK
    n = S // C

    def chunks(t):
        return t.reshape(B, n, C, H, t.shape[-1]).transpose(1, 0, 3, 2, 4)

    q, k, v = chunks(q), chunks(k), chunks(v)
    g = jnp.cumsum(chunks(log_alpha[..., None])[..., 0], axis=-1)
    beta = chunks(beta[..., None])
    incl = jnp.tril(jnp.ones((C, C), dtype=bool))
    strict = jnp.tril(jnp.ones((C, C), dtype=bool), -1)
    diff = g[..., :, None] - g[..., None, :]
    decay = jnp.where(incl, jnp.exp(jnp.where(incl, diff, 0.0)), 0.0)
    k_beta = k * beta
    a = jnp.where(strict, jnp.einsum("nbhik,nbhjk->nbhij", k_beta, k) * decay, 0.0)
    rhs = jnp.concatenate([v * beta, k_beta * jnp.exp(g)[..., None]], axis=-1)
    sol = lax.linalg.triangular_solve(a + jnp.eye(C, dtype=F32), rhs, left_side=True, lower=True)
    u, w = sol[..., :V], sol[..., V:]
    attn = jnp.einsum("nbhik,nbhjk->nbhij", q, k) * decay
    q_dec = q * jnp.exp(g)[..., None]
    k_dec = k * jnp.exp(g[..., -1:] - g)[..., None]
    g_tot = jnp.exp(g[..., -1])

    def step(state, xs):
        u_c, w_c, attn_c, q_c, k_c, g_c = xs
        v_new = u_c - jnp.einsum("bhck,bhkv->bhcv", w_c, state)
        o_c = jnp.einsum("bhck,bhkv->bhcv", q_c, state) + jnp.einsum("bhij,bhjv->bhiv", attn_c, v_new)
        state = state * g_c[..., None, None] + jnp.einsum("bhck,bhcv->bhkv", k_c, v_new)
        return state, o_c

    _, o = lax.scan(step, jnp.zeros((B, H, K, V), F32), (u, w, attn, q_dec, k_dec, g_tot))
    return o.transpose(1, 0, 3, 2, 4).reshape(B, S, H, V)


def neighbourhood_attention(q, k, v, q_gain, k_gain, rel_bias):
    B, S, _ = q.shape
    rows = S // GRID_W
    win_rows = min(NA_WIN_ROWS, rows)

    def grid(t):
        return t.reshape(B, rows, GRID_W, NA_HEADS, NA_HEAD_DIM)

    q = rms_norm(grid(q), q_gain).astype(F32) * (NA_HEAD_DIM ** -0.5)
    k = rms_norm(grid(k), k_gain).astype(F32)
    v = grid(v).astype(F32)
    r = jnp.arange(rows)
    c = jnp.arange(GRID_W)
    row_idx = jnp.clip(r - win_rows // 2, 0, rows - win_rows)[:, None] + jnp.arange(win_rows)[None, :]
    col_start = jnp.clip(c - NA_WIN_COLS // 2, 0, GRID_W - NA_WIN_COLS)
    col_in = (c[None, :] >= col_start[:, None]) & (c[None, :] < col_start[:, None] + NA_WIN_COLS)
    k_band = k[:, row_idx]
    v_band = v[:, row_idx]
    s = jnp.einsum("brqhd,brikhd->bhrqik", q, k_band)
    dr = row_idx - r[:, None] + (NA_WIN_ROWS - 1)
    dc = jnp.clip(c[None, :] - c[:, None], 1 - NA_WIN_COLS, NA_WIN_COLS - 1) + (NA_WIN_COLS - 1)
    bias = rel_bias.astype(F32)[:, dr[:, None, :, None], dc[None, :, None, :]]
    s = jnp.where(col_in[:, None, :], s + bias[None], MASK_VALUE)
    p = jax.nn.softmax(s, axis=(-2, -1))
    o = jnp.einsum("bhrqik,brikhd->brqhd", p, v_band)
    return o.reshape(B, S, NA_WIDTH)


def gla_branch(q, k, v, gate_lr, out_gate, w_gate_up, b_gate, norm_gain):
    B, S, _ = q.shape
    q = q.astype(F32).reshape(B, S, GLA_HEADS, GLA_HEAD_K) * (GLA_HEAD_K ** -0.5)
    k = k.astype(F32).reshape(B, S, GLA_HEADS, GLA_HEAD_K)
    v = v.astype(F32).reshape(B, S, GLA_HEADS, GLA_HEAD_V)
    lr = gate_lr.astype(F32).reshape(B, S, 2, GLA_GATE_RANK)
    gk = jnp.einsum("bsdr,drk->bsdk", lr, w_gate_up.astype(F32)) + b_gate.astype(F32)
    log_g = (jax.nn.log_sigmoid(gk) / GLA_GATE_NORMALIZER).reshape(B, S, 2, GLA_HEADS, GLA_HEAD_K)
    o = (chunk_gated_linear_attention(q, k, v, log_g[:, :, 0])
         + _rev(chunk_gated_linear_attention(_rev(q), _rev(k), _rev(v), _rev(log_g[:, :, 1]))))
    o = rms_norm(o, norm_gain) * jax.nn.silu(out_gate.astype(F32)).reshape(B, S, GLA_HEADS, GLA_HEAD_V)
    return o.reshape(B, S, GLA_VAL_WIDTH)


def gated_deltanet_branch(qkv, a, b, out_gate, conv_w, a_log, dt_bias, norm_gain):
    B, S, _ = qkv.shape
    qkv = jax.nn.silu(centred_depthwise_conv(qkv.astype(F32), conv_w.astype(F32)))
    q, k, v = jnp.split(qkv, [GDN_KEY_WIDTH, 2 * GDN_KEY_WIDTH], axis=-1)
    q = l2_norm(q.reshape(B, S, GDN_HEADS, GDN_HEAD_K)) * (GDN_HEAD_K ** -0.5)
    k = l2_norm(k.reshape(B, S, GDN_HEADS, GDN_HEAD_K))
    v = v.reshape(B, S, GDN_HEADS, GDN_HEAD_V)
    a = a.astype(F32).reshape(B, S, 2, GDN_HEADS)
    b = b.astype(F32).reshape(B, S, 2, GDN_HEADS)
    log_alpha = -jnp.exp(a_log.astype(F32)) * jax.nn.softplus(a + dt_bias.astype(F32))
    beta = jax.nn.sigmoid(b)
    o = (chunk_gated_delta_rule(q, k, v, log_alpha[:, :, 0], beta[:, :, 0])
         + _rev(chunk_gated_delta_rule(_rev(q), _rev(k), _rev(v), _rev(log_alpha[:, :, 1]), _rev(beta[:, :, 1]))))
    o = rms_norm(o, norm_gain) * jax.nn.silu(out_gate.astype(F32)).reshape(B, S, GDN_HEADS, GDN_HEAD_V)
    return o.reshape(B, S, GDN_VAL_WIDTH)


def hgrn2_branch(q, f_pre, i, out_gate, lower_bound, norm_gain):
    B, S, _ = q.shape
    q = jax.nn.silu(q.astype(F32)).reshape(B, S, HGRN_HEADS, HGRN_HEAD_K)
    z = f_pre.astype(F32).reshape(B, S, 2, HGRN_KEY_WIDTH)
    lb = lower_bound.astype(F32)
    log_f = jnp.logaddexp(jnp.log(jnp.maximum(lb, LB_FLOOR)), jnp.log1p(-lb) + jax.nn.log_sigmoid(z))
    k_in = (1.0 - lb) * jax.nn.sigmoid(-z)
    log_f = log_f.reshape(B, S, 2, HGRN_HEADS, HGRN_HEAD_K)
    k_in = k_in.reshape(B, S, 2, HGRN_HEADS, HGRN_HEAD_K)
    v = i.astype(F32).reshape(B, S, HGRN_HEADS, HGRN_HEAD_V)
    o = (chunk_gated_linear_attention(q, k_in[:, :, 0], v, log_f[:, :, 0])
         + _rev(chunk_gated_linear_attention(_rev(q), _rev(k_in[:, :, 1]), _rev(v), _rev(log_f[:, :, 1]))))
    o = rms_norm(o, norm_gain) * jax.nn.sigmoid(out_gate.astype(F32)).reshape(B, S, HGRN_HEADS, HGRN_HEAD_V)
    return o.reshape(B, S, HGRN_VAL_WIDTH)


def memory_cross_attention(q, mem, g_mem, w_mem_kv, q_gain, k_gain):
    B, S, _ = q.shape
    M = mem.shape[1]
    q = rms_norm(q.reshape(B, S, MEM_HEADS, MEM_HEAD_DIM), q_gain).astype(F32)
    kv = rms_norm(mem, g_mem) @ w_mem_kv
    k, v = jnp.split(kv, 2, axis=-1)
    k = rms_norm(k.reshape(B, M, MEM_HEADS, MEM_HEAD_DIM), k_gain).astype(F32)
    v = v.reshape(B, M, MEM_HEADS, MEM_HEAD_DIM).astype(F32)
    s = jnp.einsum("bshd,bmhd->bhsm", q, k) * (MEM_HEAD_DIM ** -0.5)
    p = jax.nn.softmax(s, axis=-1)
    o = jnp.einsum("bhsm,bmhd->bshd", p, v)
    return o.reshape(B, S, MEM_WIDTH)


def swiglu(h, w_gate, w_up, w_down):
    return (jax.nn.silu(h @ w_gate) * (h @ w_up)) @ w_down


def moe_swiglu(h, w_router, b_router, w_gate, w_up, w_down):
    N, D = h.shape
    E = w_router.shape[-1]
    logits = h.astype(F32) @ w_router.astype(F32) + b_router.astype(F32)
    top_logits, top_e = lax.top_k(logits, MOE_TOP_K)
    top_w = jax.nn.softmax(top_logits, axis=-1)
    nk = N * MOE_TOP_K
    n_blocks = -(-nk // MOE_BLOCK) + E
    flat_e = top_e.reshape(nk).astype(jnp.int32)
    flat_tok = jnp.repeat(jnp.arange(N, dtype=jnp.int32), MOE_TOP_K)
    order = jnp.argsort(flat_e)
    sorted_e = flat_e[order]
    counts = jnp.bincount(flat_e, length=E).astype(jnp.int32)
    padded = (counts + MOE_BLOCK - 1) // MOE_BLOCK * MOE_BLOCK
    start = jnp.cumsum(counts) - counts
    pad_end = jnp.cumsum(padded)
    pad_start = pad_end - padded
    slot_sorted = (pad_start[sorted_e] + jnp.arange(nk, dtype=jnp.int32) - start[sorted_e]).astype(jnp.int32)
    slot = jnp.zeros((nk,), jnp.int32).at[order].set(slot_sorted)
    slot_tok = jnp.full((n_blocks * MOE_BLOCK,), N, jnp.int32).at[slot].set(flat_tok)
    block_e = jnp.minimum(jnp.searchsorted(pad_end, jnp.arange(n_blocks, dtype=jnp.int32) * MOE_BLOCK, side="right"), E - 1)
    h_pad = jnp.concatenate([h, jnp.zeros((1, D), h.dtype)], axis=0)
    xb = h_pad[slot_tok].reshape(n_blocks, MOE_BLOCK, D)

    def expert_block(args):
        xs, e = args
        return (jax.nn.silu(xs @ w_gate[e]) * (xs @ w_up[e])) @ w_down[e]

    yb = lax.map(expert_block, (xb, block_e)).reshape(n_blocks * MOE_BLOCK, D)
    y = yb[slot].reshape(N, MOE_TOP_K, D)
    return jnp.einsum("nkd,nk->nd", y, top_w.astype(y.dtype))


def setup_inputs(seed: int = 0) -> dict:
    key = jax.random.key(seed)
    ks = jax.random.split(key, 32)

    def w(i, shape, fan_in):
        return jax.random.normal(ks[i], shape, F32) * (fan_in ** -0.5)

    def gain(i, shape):
        return 1.0 + 0.05 * jax.random.normal(ks[i], shape, F32)

    a_log = jnp.log(jax.random.uniform(ks[12], (DEPTH, 2, GDN_HEADS), F32, 1.0, 16.0))
    dt = jnp.exp(jax.random.uniform(ks[13], (DEPTH, 2, GDN_HEADS), F32, float(np.log(1e-3)), float(np.log(1e-1))))
    dt_bias = dt + jnp.log(-jnp.expm1(-dt))
    return {
        "x": jax.random.normal(ks[0], (BATCH, SEQ, D_MODEL), F32),
        "mem": jax.random.normal(ks[1], (BATCH, MEM_TOKENS, D_MODEL), F32),
        "g_mix": gain(2, (DEPTH, D_MODEL)),
        "w_in": w(3, (DEPTH, D_MODEL, P_IN), D_MODEL),
        "na_q_gain": gain(4, (DEPTH, NA_HEAD_DIM)),
        "na_k_gain": gain(5, (DEPTH, NA_HEAD_DIM)),
        "na_rel_bias": 0.1 * jax.random.normal(ks[6], (DEPTH, NA_HEADS, 2 * NA_WIN_ROWS - 1, 2 * NA_WIN_COLS - 1), F32),
        "gla_w_gate_up": w(7, (DEPTH, 2, GLA_GATE_RANK, GLA_KEY_WIDTH), GLA_GATE_RANK),
        "gla_b_gate": 0.1 * jax.random.normal(ks[8], (DEPTH, 2, GLA_KEY_WIDTH), F32),
        "gla_norm_gain": gain(9, (DEPTH, GLA_HEAD_V)),
        "gdn_conv_w": w(10, (DEPTH, GDN_CONV, 2 * GDN_KEY_WIDTH + GDN_VAL_WIDTH), GDN_CONV),
        "gdn_a_log": a_log,
        "gdn_dt_bias": dt_bias,
        "gdn_norm_gain": gain(11, (DEPTH, GDN_HEAD_V)),
        "hgrn_lb_raw": jax.random.normal(ks[14], (DEPTH, 2, HGRN_KEY_WIDTH), F32),
        "hgrn_norm_gain": gain(15, (DEPTH, HGRN_HEAD_V)),
        "g_mem": gain(16, (DEPTH, D_MODEL)),
        "w_mem_kv": w(17, (DEPTH, D_MODEL, 2 * MEM_WIDTH), D_MODEL),
        "mem_q_gain": gain(18, (DEPTH, MEM_HEAD_DIM)),
        "mem_k_gain": gain(19, (DEPTH, MEM_HEAD_DIM)),
        "w_branch": w(20, (DEPTH, N_BRANCH, BRANCH_WIDTH, D_MODEL), BRANCH_WIDTH),
        "w_out": w(21, (DEPTH, D_MODEL, D_MODEL), D_MODEL),
        "g_ffn": gain(22, (DEPTH, D_MODEL)),
        "ffn_w_gate": w(23, (N_DENSE, D_MODEL, D_FF), D_MODEL),
        "ffn_w_up": w(24, (N_DENSE, D_MODEL, D_FF), D_MODEL),
        "ffn_w_down": w(25, (N_DENSE, D_FF, D_MODEL), D_FF),
        "moe_w_router": w(26, (N_MOE, D_MODEL, N_EXPERTS), D_MODEL),
        "moe_b_router": 0.01 * jax.random.normal(ks[27], (N_MOE, N_EXPERTS), F32),
        "moe_w_gate": w(28, (N_MOE, N_EXPERTS, D_MODEL, D_FF_EXPERT), D_MODEL),
        "moe_w_up": w(29, (N_MOE, N_EXPERTS, D_MODEL, D_FF_EXPERT), D_MODEL),
        "moe_w_down": w(30, (N_MOE, N_EXPERTS, D_FF_EXPERT, D_MODEL), D_FF_EXPERT),
    }


def reference(x, mem, g_mix, w_in, na_q_gain, na_k_gain, na_rel_bias, gla_w_gate_up, gla_b_gate,
              gla_norm_gain, gdn_conv_w, gdn_a_log, gdn_dt_bias, gdn_norm_gain, hgrn_lb_raw,
              hgrn_norm_gain, g_mem, w_mem_kv, mem_q_gain, mem_k_gain, w_branch, w_out, g_ffn,
              ffn_w_gate, ffn_w_up, ffn_w_down, moe_w_router, moe_b_router, moe_w_gate, moe_w_up,
              moe_w_down):
    B, S, D = x.shape
    split_at = np.cumsum(IN_WIDTHS)[:-1].tolist()
    lb_w = jax.nn.softmax(hgrn_lb_raw.astype(F32), axis=0)
    hgrn_lb = jnp.cumsum(lb_w, axis=0) - lb_w[0:1]
    for layer in range(DEPTH):
        h = rms_norm(x, g_mix[layer])
        (na_q, na_k, na_v, gla_q, gla_k, gla_v, gla_lr, gla_og, gdn_qkv, gdn_a, gdn_b, gdn_og,
         hg_q, hg_f, hg_i, hg_og, mem_q, gate_logits) = jnp.split(h @ w_in[layer], split_at, axis=-1)
        branches = (
            neighbourhood_attention(na_q, na_k, na_v, na_q_gain[layer], na_k_gain[layer], na_rel_bias[layer]),
            gla_branch(gla_q, gla_k, gla_v, gla_lr, gla_og, gla_w_gate_up[layer], gla_b_gate[layer], gla_norm_gain[layer]),
            gated_deltanet_branch(gdn_qkv, gdn_a, gdn_b, gdn_og, gdn_conv_w[layer], gdn_a_log[layer],
                                  gdn_dt_bias[layer], gdn_norm_gain[layer]),
            hgrn2_branch(hg_q, hg_f, hg_i, hg_og, hgrn_lb[layer], hgrn_norm_gain[layer]),
            memory_cross_attention(mem_q, mem, g_mem[layer], w_mem_kv[layer], mem_q_gain[layer], mem_k_gain[layer]),
        )
        gates = jax.nn.sigmoid(gate_logits.astype(F32)).reshape(B, S, N_BRANCH, D).astype(x.dtype)
        merged = jnp.zeros_like(x)
        for n in range(N_BRANCH):
            merged = merged + gates[:, :, n] * (branches[n].astype(x.dtype) @ w_branch[layer, n])
        x = x + merged @ w_out[layer]

        h = rms_norm(x, g_ffn[layer])
        if layer % 2 == 0:
            j = layer // 2
            f = swiglu(h, ffn_w_gate[j], ffn_w_up[j], ffn_w_down[j])
        else:
            j = layer // 2
            f = moe_swiglu(h.reshape(B * S, D), moe_w_router[j], moe_b_router[j], moe_w_gate[j],
                           moe_w_up[j], moe_w_down[j]).reshape(B, S, D)
        x = x + f
    return x
```

```cpp
#include <hip/hip_runtime.h>
#include <cstdio>
#include <cstdint>
namespace pg8 {
#define PG8_LAS __attribute__((address_space(3)))
typedef unsigned short bf16_t;
typedef short bf16x8 __attribute__((ext_vector_type(8)));
typedef float f32x4 __attribute__((ext_vector_type(4)));
typedef unsigned u32x4 __attribute__((ext_vector_type(4)));
constexpr int BM = 256, BK = 64, HALF = 128, HTB = HALF * BK * 2  , STAGE_BYTES = 8 * HTB, NXCD = 8, WGM = 8;

__host__ __device__ __forceinline__ int lds_byte(int r, int c) { const int st = (r >> 4) * 2 + (c >> 5), rr = r & 15, cc = c & 31, ob = rr * 64 + cc * 2; return st * 1024 + (ob ^ (((ob >> 9) & 1) << 5)); }
__host__ __device__ __forceinline__ void stage_rc(int b, int& R, int& C) { const int st = b / 1024, sb = b % 1024, swz = sb ^ (((sb >> 9) & 1) << 5); R = (st >> 1) * 16 + swz / 64; C = (st & 1) * 32 + (swz % 64) / 2; }
__host__ __device__ __forceinline__ int perm32(int rho) { const int n = rho >> 4, i = rho & 15; return 8 * (i >> 2) + 4 * n + (i & 3); }

struct Unit { int pm, pn; };
struct Gemm { const bf16_t* A; const bf16_t* Bt; int M, N, K; };

struct StaticOrder {
    int nM, nN, nwg, G, c;
    __host__ __device__ void init(int M, int N, int G_, int c_) { nM = M / BM; nN = N / BM; nwg = nM * nN; G = G_; c = c_; }
    __host__ __device__ bool next(int i, Unit& u) const {
        const long L = (long)i * G + c; if (L >= nwg) return false;
        int wgid = (int)L; { const int q = nwg / NXCD, r = nwg % NXCD, xcd = wgid % NXCD, off = wgid / NXCD; wgid = (xcd < r ? xcd * (q + 1) : r * (q + 1) + (xcd - r) * q) + off; }
        const int nig = WGM * nN, gid = wgid / nig, fm = gid * WGM, gsz = (nM - fm) < WGM ? (nM - fm) : WGM;
        u.pm = fm + ((wgid % nig) % gsz); u.pn = (wgid % nig) / gsz; return true;
    }
    __device__ __forceinline__ void a_ready(const Unit&) const {}
    __device__ __forceinline__ void done(const Unit&) const {}
};
__device__ __forceinline__ unsigned cvt_pk_bf16(float lo, float hi) { unsigned r; asm volatile("v_cvt_pk_bf16_f32 %0, %1, %2" : "=v"(r) : "v"(lo), "v"(hi)); return r; }
typedef float f32x2 __attribute__((ext_vector_type(2)));
__device__ __forceinline__ float sigm(float x) { return __builtin_amdgcn_rcpf(1.0f + __expf(-x)); }
struct EpiInProj {
    static constexpr bool PERM = true, AFTER_DRAIN = false;
    bf16_t* P; bf16_t* G;
    __device__ __forceinline__ void operator()(const f32x4 (&acc)[2][2][4][2], const Unit& u, int wr, int wc, int fr, int fq) const {
        const int row0 = u.pm * BM + wr * 64 + fr; const bool isg = u.pn >= 33;
        bf16_t* base = isg ? G : P; const int ldc = isg ? 10240 : 8448; const int col0 = (isg ? (u.pn - 33) : u.pn) * BM + wc * 32 + 8 * fq;
#pragma unroll
        for (int ai = 0; ai < 2; ++ai)
#pragma unroll
            for (int m = 0; m < 4; ++m) { bf16_t* rowp = base + (size_t)(row0 + ai * HALF + m * 16) * ldc + col0;
#pragma unroll
                for (int bj = 0; bj < 2; ++bj) { f32x4 v0 = acc[ai][bj][m][0], v1 = acc[ai][bj][m][1];
                    if (isg) {
#pragma unroll
                        for (int j = 0; j < 4; ++j) { v0[j] = sigm(v0[j]); v1[j] = sigm(v1[j]); } }
                    u32x4 w; w.x = cvt_pk_bf16(v0[0], v0[1]); w.y = cvt_pk_bf16(v0[2], v0[3]); w.z = cvt_pk_bf16(v1[0], v1[1]); w.w = cvt_pk_bf16(v1[2], v1[3]);
                    *(u32x4*)(rowp + bj * HALF) = w; } }
    }
};
struct EpiBranch {
    static constexpr bool PERM = true, AFTER_DRAIN = false;
    bf16_t* G;
    __device__ __forceinline__ void operator()(const f32x4 (&acc)[2][2][4][2], const Unit& u, int wr, int wc, int fr, int fq) const {
        const int n = u.pn >> 3, j = u.pn & 7; const int row0 = (u.pm & 63) * BM + wr * 64 + fr, col0 = n * 2048 + j * BM + wc * 32 + 8 * fq;
#pragma unroll
        for (int ai = 0; ai < 2; ++ai)
#pragma unroll
            for (int m = 0; m < 4; ++m) { bf16_t* rowp = G + (size_t)(row0 + ai * HALF + m * 16) * 10240 + col0;
#pragma unroll
                for (int bj = 0; bj < 2; ++bj) { const u32x4 g = *(const u32x4*)(rowp + bj * HALF); const f32x4 v0 = acc[ai][bj][m][0], v1 = acc[ai][bj][m][1];
                    u32x4 w;
                    w.x = cvt_pk_bf16(v0[0] * __uint_as_float(g.x << 16), v0[1] * __uint_as_float(g.x & 0xffff0000u));
                    w.y = cvt_pk_bf16(v0[2] * __uint_as_float(g.y << 16), v0[3] * __uint_as_float(g.y & 0xffff0000u));
                    w.z = cvt_pk_bf16(v1[0] * __uint_as_float(g.z << 16), v1[1] * __uint_as_float(g.z & 0xffff0000u));
                    w.w = cvt_pk_bf16(v1[2] * __uint_as_float(g.w << 16), v1[3] * __uint_as_float(g.w & 0xffff0000u));
                    *(u32x4*)(rowp + bj * HALF) = w; } }
    }
};
struct EpiResF32 {
    static constexpr bool PERM = false, AFTER_DRAIN = false;
    const float* R; float* O; int ldc; int ntn;
    __device__ __forceinline__ void operator()(const f32x4 (&acc)[2][2][4][2], const Unit& u, int wr, int wc, int fr, int fq) const {
        const int row0 = u.pm * BM + wr * 64 + fr, col0 = (u.pn % ntn) * BM + wc * 32 + 4 * fq;
#pragma unroll
        for (int ai = 0; ai < 2; ++ai)
#pragma unroll
            for (int m = 0; m < 4; ++m) { const size_t off = (size_t)(row0 + ai * HALF + m * 16) * ldc + col0;
#pragma unroll
                for (int bj = 0; bj < 2; ++bj)
#pragma unroll
                    for (int n = 0; n < 2; ++n) { f32x4 o = acc[ai][bj][m][n]; if (R) o = o + *(const f32x4*)(R + off + bj * HALF + n * 16); *(f32x4*)(O + off + bj * HALF + n * 16) = o; }
                asm volatile("" ::: "memory"); }
    }
};
struct EpiSwiGLU {
    static constexpr bool PERM = true, AFTER_DRAIN = false;
    bf16_t* H; int ldh; int tpg;
    __device__ __forceinline__ void operator()(const f32x4 (&acc)[2][2][4][2], const Unit& u, int wr, int wc, int fr, int fq) const {
        const int row0 = u.pm * BM + wr * 64 + fr, col0 = (u.pn % tpg) * HALF + wc * 32 + 8 * fq;
#pragma unroll
        for (int ai = 0; ai < 2; ++ai)
#pragma unroll
            for (int m = 0; m < 4; ++m) { bf16_t* rowp = H + (size_t)(row0 + ai * HALF + m * 16) * ldh + col0;
                f32x4 h0, h1;
#pragma unroll
                for (int j = 0; j < 4; ++j) { const float g0 = acc[ai][0][m][0][j], g1 = acc[ai][0][m][1][j]; h0[j] = g0 * sigm(g0) * acc[ai][1][m][0][j]; h1[j] = g1 * sigm(g1) * acc[ai][1][m][1][j]; }
                u32x4 w; w.x = cvt_pk_bf16(h0[0], h0[1]); w.y = cvt_pk_bf16(h0[2], h0[3]); w.z = cvt_pk_bf16(h1[0], h1[1]); w.w = cvt_pk_bf16(h1[2], h1[3]);
                *(u32x4*)rowp = w; }
    }
};
struct BranchOrder {
    int G, c;
    __device__ bool next(int i, Unit& u) const {
        const long L = (long)i * G + c; if (L >= 2560) return false;
        int w = (int)L; { const int xcd = w % NXCD, off = w / NXCD; w = xcd * 320 + off; }
        const int n = w / 512, rem = w % 512, gid = rem / 64, r2 = rem % 64;
        u.pm = n * 64 + gid * 8 + (r2 % 8); u.pn = n * 8 + r2 / 8; return true;
    }
    __device__ __forceinline__ void a_ready(const Unit&) const {}
    __device__ __forceinline__ void done(const Unit&) const {}
};
struct KvOrder {
    int c, c0;
    __device__ bool next(int i, Unit& u) const { const int w = c - c0; if (i != 0 || w < 0 || w >= 32) return false; u.pm = w >> 2; u.pn = (w >> 4) * 4 + (w & 3); return true; }
    __device__ __forceinline__ void a_ready(const Unit&) const {}
    __device__ __forceinline__ void done(const Unit&) const {}
};
struct MoeOrder {
    int G, c, tpe, total; const PG8_LAS int* tb;
    __device__ bool next(int i, Unit& u) const {
        const long L = (long)i * G + c; if (L >= total) return false;
        int w = (int)L; { const int q = total / NXCD, r = total % NXCD, xcd = w % NXCD, off = w / NXCD; w = (xcd < r ? xcd * (q + 1) : r * (q + 1) + (xcd - r) * q) + off; }
        int e = 0;
#pragma unroll
        for (int k = 1; k < 8; ++k) if (w >= tb[16 + k]) e = k;
        const int loc = w - tb[16 + e], nb = tb[e];
        u.pm = tb[8 + e] + loc % nb; u.pn = e * tpe + loc / nb; return true;
    }
    __device__ __forceinline__ void a_ready(const Unit&) const {}
    __device__ __forceinline__ void done(const Unit&) const {}
};
template <class Epi, class Sched, bool ALIGN_EPI = false, bool SP2 = false>
__device__ __forceinline__ void gemm_phase(PG8_LAS unsigned char* lds, const Gemm g, const Sched& S, const Epi& E) {
    int tid = threadIdx.x; asm volatile("" : "+v"(tid));
    const int wid = __builtin_amdgcn_readfirstlane(tid >> 6), lane = tid & 63, wr = wid >> 2, wc = wid & 3, fr = lane & 15, fq = lane >> 4;
    const int K = g.K, nt = K / BK;
    unsigned voffA[2], voffB[2];
#pragma unroll
    for (int i = 0; i < 2; ++i) { int R, C; stage_rc(tid * 16 + i * 8192, R, C); const int Rb = Epi::PERM ? ((R & ~31) + perm32(R & 31)) : R;
        voffA[i] = (unsigned)(R * K + C) * 2u; voffB[i] = (unsigned)(Rb * K + C) * 2u; }
    const size_t kstep = (size_t)(BK * 2);
    const size_t hstep = (size_t)HALF * K * 2;
    const size_t tstep = 2 * hstep;
    const unsigned ldsw = (unsigned)wid * 1024u;
    const int aoff = lds_byte(wr * 64 + fr, fq * 8), boff = lds_byte(wc * 32 + fr, fq * 8);
#define PG8_SA(b, h) (((b) * 2 + (h)) * HTB)
#define PG8_SB(b, h) ((4 + (b) * 2 + (h)) * HTB)
#define PG8_STAGE(bufoff, gbase, voff) do { _Pragma("unroll") for (int _i = 0; _i < 2; ++_i) \
        __builtin_amdgcn_global_load_lds((const unsigned*)((const char*)(gbase) + (voff)[_i]), (PG8_LAS unsigned*)(lds + (bufoff) + ldsw + _i * 8192), 16, 0, 0); } while (0)
#define PG8_LDA(dst, b, h) do { _Pragma("unroll") for (int m = 0; m < 4; ++m) _Pragma("unroll") for (int k = 0; k < 2; ++k) dst[m][k] = *(const PG8_LAS bf16x8*)(lds + PG8_SA(b, h) + aoff + m * 2048 + k * 1024); } while (0)
#define PG8_LDB(dst, b, h) do { _Pragma("unroll") for (int n = 0; n < 2; ++n) _Pragma("unroll") for (int k = 0; k < 2; ++k) dst[n][k] = *(const PG8_LAS bf16x8*)(lds + PG8_SB(b, h) + boff + n * 2048 + k * 1024); } while (0)
#define PG8_MMA(ai, bj, At, Bt) do { __builtin_amdgcn_s_setprio(1); _Pragma("unroll") for (int m = 0; m < 4; ++m) _Pragma("unroll") for (int n = 0; n < 2; ++n) _Pragma("unroll") for (int k = 0; k < 2; ++k) \
        acc[ai][bj][m][n] = __builtin_amdgcn_mfma_f32_16x16x32_bf16(Bt[n][k], At[m][k], acc[ai][bj][m][n], 0, 0, 0); __builtin_amdgcn_s_setprio(0); } while (0)
#define PG8_WAIT_V(n) asm volatile("s_waitcnt vmcnt(" #n ")" ::: "memory")
#define PG8_WAIT_L(n) asm volatile("s_waitcnt lgkmcnt(" #n ")" ::: "memory")
#define PG8_BAR __builtin_amdgcn_s_barrier()
#define PG8_SCHED __builtin_amdgcn_sched_barrier(0)
    Unit cur, nxt; int ui = 0;
    if (!S.next(0, cur)) return;
    f32x4 acc[2][2][4][2];
#pragma unroll
    for (int a = 0; a < 2; ++a)
#pragma unroll
        for (int b = 0; b < 2; ++b)
#pragma unroll
            for (int m = 0; m < 4; ++m)
#pragma unroll
                for (int n = 0; n < 2; ++n) acc[a][b][m][n] = (f32x4){0.f, 0.f, 0.f, 0.f};
    bf16x8 At[4][2], B0[2][2], B1[2][2];
    const char* cA = (const char*)g.A + (size_t)cur.pm * tstep; const char* cB = (const char*)g.Bt + (size_t)cur.pn * tstep;
    S.a_ready(cur);
    if constexpr (SP2) {
        PG8_STAGE(PG8_SB(0, 0), cB, voffB); PG8_STAGE(PG8_SB(0, 1), cB + hstep, voffB); PG8_STAGE(PG8_SA(0, 0), cA, voffA); PG8_STAGE(PG8_SA(0, 1), cA + hstep, voffA);
        if (wr == 1) PG8_BAR;
        PG8_WAIT_V(2); PG8_BAR;
        PG8_STAGE(PG8_SB(1, 0), cB + kstep, voffB); PG8_STAGE(PG8_SA(1, 0), cA + kstep, voffA); PG8_STAGE(PG8_SB(1, 1), cB + hstep + kstep, voffB);
        PG8_WAIT_V(6); PG8_BAR;
    } else {
        PG8_STAGE(PG8_SB(0, 0), cB, voffB); PG8_STAGE(PG8_SA(0, 0), cA, voffA); PG8_STAGE(PG8_SB(0, 1), cB + hstep, voffB); PG8_STAGE(PG8_SA(0, 1), cA + hstep, voffA);
        if (wr == 1) PG8_BAR;
        PG8_WAIT_V(4); PG8_BAR;
        PG8_STAGE(PG8_SB(1, 0), cB + kstep, voffB); PG8_STAGE(PG8_SA(1, 0), cA + kstep, voffA); PG8_STAGE(PG8_SB(1, 1), cB + hstep + kstep, voffB);
        PG8_WAIT_V(6); PG8_BAR;
    }
    for (;;) {
        const bool has_next = S.next(ui + 1, nxt);
        const char* nA = has_next ? (const char*)g.A + (size_t)nxt.pm * tstep : cA; const char* nB = has_next ? (const char*)g.Bt + (size_t)nxt.pn * tstep : cB;
        for (int t = 0; t < nt; t += 2) {
            const bool last = (t == nt - 2);
            const char* a1 = cA + (size_t)(t + 1) * kstep;
            const char* a2 = last ? nA : cA + (size_t)(t + 2) * kstep; const char* b2 = last ? nB : cB + (size_t)(t + 2) * kstep;
            const char* a3 = a2 + kstep; const char* b3 = b2 + kstep;
            if (last && has_next) S.a_ready(nxt);
            if constexpr (SP2) {
            PG8_LDB(B0, 0, 0); PG8_LDB(B1, 0, 1); PG8_SCHED; PG8_LDA(At, 0, 0); PG8_STAGE(PG8_SA(1, 1), a1 + hstep, voffA);
            PG8_WAIT_V(8); PG8_WAIT_L(0); PG8_BAR; PG8_MMA(0, 0, At, B0); PG8_MMA(0, 1, At, B1); PG8_BAR; PG8_SCHED;
            PG8_LDA(At, 0, 1); PG8_STAGE(PG8_SB(0, 0), b2, voffB); PG8_STAGE(PG8_SB(0, 1), b2 + hstep, voffB); PG8_STAGE(PG8_SA(0, 0), a2, voffA);
            PG8_WAIT_V(8); PG8_WAIT_L(0); PG8_BAR; PG8_MMA(1, 0, At, B0); PG8_MMA(1, 1, At, B1); PG8_BAR; PG8_SCHED;
            PG8_LDB(B0, 1, 0); PG8_LDB(B1, 1, 1); PG8_SCHED; PG8_LDA(At, 1, 0); PG8_STAGE(PG8_SA(0, 1), a2 + hstep, voffA);
            PG8_WAIT_V(8); PG8_WAIT_L(0); PG8_BAR; PG8_MMA(0, 0, At, B0); PG8_MMA(0, 1, At, B1); PG8_BAR; PG8_SCHED;
            PG8_LDA(At, 1, 1); PG8_STAGE(PG8_SB(1, 0), b3, voffB); PG8_STAGE(PG8_SB(1, 1), b3 + hstep, voffB); PG8_STAGE(PG8_SA(1, 0), a3, voffA);
            PG8_WAIT_V(8); PG8_WAIT_L(0); PG8_BAR; PG8_MMA(1, 0, At, B0); PG8_MMA(1, 1, At, B1); PG8_BAR; PG8_SCHED;
            } else {
            PG8_LDB(B0, 0, 0); PG8_SCHED; PG8_LDA(At, 0, 0); PG8_STAGE(PG8_SA(1, 1), a1 + hstep, voffA);
            PG8_WAIT_L(8); PG8_BAR; PG8_WAIT_L(0); PG8_MMA(0, 0, At, B0); PG8_BAR; PG8_SCHED;
            PG8_LDB(B1, 0, 1); PG8_STAGE(PG8_SB(0, 0), b2, voffB);
            PG8_BAR; PG8_WAIT_L(0); PG8_MMA(0, 1, At, B1); PG8_BAR;
            PG8_LDA(At, 0, 1); PG8_STAGE(PG8_SA(0, 0), a2, voffA);
            PG8_BAR; PG8_WAIT_L(0); PG8_MMA(1, 0, At, B0); PG8_BAR; PG8_SCHED;
            PG8_STAGE(PG8_SB(0, 1), b2 + hstep, voffB);
            PG8_WAIT_V(6); PG8_BAR; PG8_MMA(1, 1, At, B1); PG8_BAR;
            PG8_LDB(B0, 1, 0); PG8_SCHED; PG8_LDA(At, 1, 0); PG8_STAGE(PG8_SA(0, 1), a2 + hstep, voffA);
            PG8_WAIT_L(8); PG8_BAR; PG8_WAIT_L(0); PG8_MMA(0, 0, At, B0); PG8_BAR; PG8_SCHED;
            PG8_LDB(B1, 1, 1); PG8_STAGE(PG8_SB(1, 0), b3, voffB);
            PG8_BAR; PG8_WAIT_L(0); PG8_MMA(0, 1, At, B1); PG8_BAR;
            PG8_LDA(At, 1, 1); PG8_STAGE(PG8_SA(1, 0), a3, voffA);
            PG8_BAR; PG8_WAIT_L(0); PG8_MMA(1, 0, At, B0); PG8_BAR; PG8_SCHED;
            PG8_STAGE(PG8_SB(1, 1), b3 + hstep, voffB);
            PG8_WAIT_V(6); PG8_BAR; PG8_MMA(1, 1, At, B1); PG8_BAR;
            }
        }
        if constexpr (ALIGN_EPI) { if (wr == 0) PG8_BAR; }
        if constexpr (!Epi::AFTER_DRAIN) { E(acc, cur, wr, wc, fr, fq); S.done(cur); }
        if (!has_next) break;
#pragma unroll
        for (int a = 0; a < 2; ++a)
#pragma unroll
            for (int b = 0; b < 2; ++b)
#pragma unroll
                for (int m = 0; m < 4; ++m)
#pragma unroll
                    for (int n = 0; n < 2; ++n) acc[a][b][m][n] = (f32x4){0.f, 0.f, 0.f, 0.f};
        cur = nxt; cA = nA; cB = nB; ++ui;
        if constexpr (ALIGN_EPI) { if (wr == 1) PG8_BAR; }
    }
    PG8_WAIT_V(0);
    if constexpr (!ALIGN_EPI) { if (wr == 0) PG8_BAR; }
    PG8_BAR;
    if constexpr (Epi::AFTER_DRAIN) { E.fused(acc, cur, wr, wc, fr, fq, lds, wid, lane); S.done(cur); }
#undef PG8_SA
#undef PG8_SB
#undef PG8_STAGE
#undef PG8_LDA
#undef PG8_LDB
#undef PG8_MMA
#undef PG8_WAIT_V
#undef PG8_WAIT_L
#undef PG8_BAR
#undef PG8_SCHED
}
}
constexpr int NT = 16384, DM = 2048, SEQ = 4096, NBATCH = 4, NLAYER = 2;
constexpr int LDP = 8448, NGATE = 10240, NIN = 18688, PIN = 18480;
constexpr int C_NAQ = 0, C_NAK = 512, C_NAV = 1024, C_GLQ = 1536, C_GLK = 1792, C_GLV = 2048, C_GLLR = 2560, C_GLOG = 2592, C_GDQKV = 3104, C_GDA = 4640, C_GDB = 4648,
              C_GDOG = 4656, C_HGQ = 5168, C_HGF = 5680, C_HGI = 6704, C_HGOG = 7216, C_MQ = 7728, C_PEND = 8240;
constexpr int DFF = 5632, DFFE = 7168, NEXP = 8, MAXSLOT = 34816;
constexpr float RMS_EPS = 1e-6f;
constexpr size_t MiB = 1u << 20;
constexpr size_t WS_CTL = 0, CTL_ZERO_BYTES = 1 * MiB;
constexpr size_t WS_ROUTE = 1 * MiB;
constexpr size_t WS_MK = 2 * MiB;
constexpr size_t WS_MVT = 4 * MiB;
constexpr size_t WS_KVRAW = 6 * MiB;
constexpr size_t WS_MEMN = 14 * MiB;
constexpr size_t WS_WIN = 24 * MiB;
constexpr size_t WS_WBR = WS_WIN + 146 * MiB;
constexpr size_t WS_WOUT = WS_WBR + 20 * MiB;
constexpr size_t WS_WMKV = WS_WOUT + 16 * MiB;
constexpr size_t WS_WGU = WS_WMKV + 8 * MiB;
constexpr size_t WS_WDN = WS_WGU + 44 * MiB;
constexpr size_t WS_MOE1 = WS_WDN + 22 * MiB;
constexpr size_t WS_MOE2 = WS_MOE1 + 448 * MiB;
constexpr size_t WS_HM = WS_MOE2 + 224 * MiB;
constexpr size_t WS_P = WS_HM + 64 * MiB;
constexpr size_t WS_G = WS_P + 264 * MiB;
constexpr size_t WS_GLG = WS_G + 320 * MiB;
constexpr size_t WS_GQ = WS_GLG + 32 * MiB;
constexpr size_t WS_GAB = WS_GQ + 48 * MiB;
constexpr size_t WS_HQ = WS_GAB + 1 * MiB;
constexpr size_t WS_HF = WS_HQ + 16 * MiB;
constexpr size_t WS_NAVT = WS_HF + 64 * MiB;
constexpr size_t WS_SOUT = WS_NAVT + 16 * MiB;
constexpr size_t WS_BR = WS_SOUT + 96 * MiB;
constexpr size_t WS_END = WS_BR + 80 * MiB;
constexpr size_t WS_HID = WS_P;
constexpr size_t WS_XB = WS_P;
constexpr size_t WS_HIDM = WS_XB + 136 * MiB;
constexpr size_t WS_YB = WS_HIDM + 476 * MiB;
static_assert(WS_YB + 272 * MiB <= WS_END, "MoE overlay fits");
static_assert(WS_END <= 2085645600ull, "workspace map fits sum(inputs)");
constexpr int CW_TMO = 0, CW_CODE = 1, CW_BAR = 4096, CW_WQ = 8192, CW_CNT = 8192 + 1024;
constexpr int RING_OFF = 0, RING_BYTES = 131072, LDSCTL_OFF = RING_BYTES, MISC_OFF = LDSCTL_OFF + 320, TAB_OFF = LDSCTL_OFF + 512, LDS_BYTES = 147456;
constexpr int NWAVES = 8;
#ifndef MK_SPLIT
#define MK_SPLIT 1
#endif
#define GAS __attribute__((address_space(1)))
#define LAS __attribute__((address_space(3)))
typedef unsigned short bf16;
typedef unsigned v4u __attribute__((ext_vector_type(4)));
typedef float f32x4 __attribute__((ext_vector_type(4)));
typedef short bf16x8 __attribute__((ext_vector_type(8)));
typedef GAS unsigned gu32;
typedef GAS unsigned long long gu64;
#define RLX_AGENT __ATOMIC_RELAXED, __HIP_MEMORY_SCOPE_AGENT
#define LDS_WAIT() asm volatile("s_waitcnt lgkmcnt(0)" ::: "memory")
#define VM_WAIT() asm volatile("s_waitcnt vmcnt(0)" ::: "memory")
__device__ __forceinline__ unsigned long long rt() { return __builtin_amdgcn_s_memrealtime(); }
__device__ __forceinline__ unsigned f2bf(float f) { unsigned u = __builtin_bit_cast(unsigned, f); return (u + 0x7fffu + ((u >> 16) & 1u)) >> 16; }
__device__ __forceinline__ unsigned pk2(float lo, float hi) { return f2bf(lo) | (f2bf(hi) << 16); }
#define XB_TMO      128
#define XB_XCNT(j)  (256  + 64 * (j))
#define XB_XSUB(j)  (1280 + 64 * (j))
#define XB_XGEN(j)  (2304 + 64 * (j))
#define XB_TOP      3328
#define XB_TOPGEN   3392
#define XCD_BAR_WORDS 3456
#define XB_SPIN_CAP (1u << 22)

__device__ __forceinline__ unsigned xb_ld(unsigned* p)              { return __hip_atomic_load(p, __ATOMIC_RELAXED, __HIP_MEMORY_SCOPE_AGENT); }
__device__ __forceinline__ unsigned xb_add(unsigned* p, unsigned v) { return __hip_atomic_fetch_add(p, v, __ATOMIC_RELAXED, __HIP_MEMORY_SCOPE_AGENT); }
__device__ __forceinline__ unsigned xb_xcc_id() { return (unsigned)__builtin_amdgcn_s_getreg((3 << 11) | 20) & 0xFu; }
#define XB_SPIN(cond, bar) do { unsigned _sp = 0; while (cond) { __builtin_amdgcn_s_sleep(1); \
    if ((++_sp & 255u) == 0u) { if (xb_ld(&(bar)[XB_TMO])) break; if (_sp > XB_SPIN_CAP) { atomicAdd(&(bar)[XB_TMO], 1u); break; } } } } while (0)

struct XcdBarrier {
    unsigned* bar; unsigned x;
    volatile LAS unsigned* st;
};

__device__ __forceinline__ XcdBarrier xcd_barrier_post(unsigned* bar, volatile LAS unsigned* st) {
    XcdBarrier b; b.bar = bar; b.x = xb_xcc_id(); b.st = st;
    if (threadIdx.x == 0) (void)xb_add(&bar[XB_XCNT(b.x)], 1u);
    return b;
}
__device__ __forceinline__ void xcd_barrier_complete(unsigned* bar, unsigned x, unsigned& nloc, unsigned& nx) {
    const unsigned G = gridDim.x * gridDim.y * gridDim.z;
    unsigned sum, cnt, mine, sp = 0u;
    for (;;) {
        sum = 0u; cnt = 0u; mine = 0u;
#pragma unroll
        for (unsigned j = 0; j < 16; ++j) { const unsigned c = xb_ld(&bar[XB_XCNT(j)]); sum += c; cnt += (c > 0u) ? 1u : 0u; mine = (j == x) ? c : mine; }
        if (sum == G) break;
        __builtin_amdgcn_s_sleep(1);
        if ((++sp & 255u) == 0u) { if (xb_ld(&bar[XB_TMO])) break; if (sp > XB_SPIN_CAP) { atomicAdd(&bar[XB_TMO], 1u); break; } }
    }
    nloc = mine > 0u ? mine : 1u; nx = cnt > 0u ? cnt : 1u;
}

__device__ __forceinline__ void xcd_barrier(const XcdBarrier& b) {
    asm volatile("s_waitcnt vmcnt(0)" ::: "memory");
    __syncthreads();
    if (threadIdx.x == 0) {
        unsigned* bar = b.bar;
        __builtin_amdgcn_s_waitcnt(0);
        unsigned nloc = b.st[0], nx = b.st[1];
        if (nloc == 0u) { xcd_barrier_complete(bar, b.x, nloc, nx); b.st[0] = nloc; b.st[1] = nx; }
        const unsigned old = xb_add(&bar[XB_XSUB(b.x)], 1u);
        const unsigned gen = old / nloc;
        if (old + 1u == (gen + 1u) * nloc) {
            __builtin_amdgcn_fence(__ATOMIC_RELEASE, "agent");
            asm volatile("s_waitcnt vmcnt(0)" ::: "memory");
            const unsigned og = xb_add(&bar[XB_TOP], 1u);
            const unsigned tg = og / nx;
            if (og + 1u == (tg + 1u) * nx) xb_add(&bar[XB_TOPGEN], 1u);
            else XB_SPIN(xb_ld(&bar[XB_TOPGEN]) == tg, bar);
            __builtin_amdgcn_fence(__ATOMIC_ACQUIRE, "agent");
            xb_add(&bar[XB_XGEN(b.x)], 1u);
            asm volatile("s_waitcnt vmcnt(0)" ::: "memory");
        } else {
            XB_SPIN(xb_ld(&bar[XB_XGEN(b.x)]) == gen, bar);
            __builtin_amdgcn_fence(__ATOMIC_ACQUIRE, "agent");
            asm volatile("s_waitcnt vmcnt(0)" ::: "memory");
        }
    }
    __syncthreads();
}
typedef unsigned v2u __attribute__((ext_vector_type(2)));
typedef float f32x2v __attribute__((ext_vector_type(2)));
__device__ __forceinline__ float bflo(unsigned w) { return __uint_as_float(w << 16); }
__device__ __forceinline__ float bfhi(unsigned w) { return __uint_as_float(w & 0xffff0000u); }
__device__ __forceinline__ float bf1(bf16 h) { return __uint_as_float(((unsigned)h) << 16); }
__device__ __forceinline__ unsigned pkbf(float lo, float hi) { return pg8::cvt_pk_bf16(lo, hi); }
__device__ __forceinline__ void unpack8(const v4u w, float (&f)[8]) { f[0] = bflo(w.x); f[1] = bfhi(w.x); f[2] = bflo(w.y); f[3] = bfhi(w.y); f[4] = bflo(w.z); f[5] = bfhi(w.z); f[6] = bflo(w.w); f[7] = bfhi(w.w); }
__device__ __forceinline__ v4u pack8(const float (&f)[8]) { v4u w; w.x = pkbf(f[0], f[1]); w.y = pkbf(f[2], f[3]); w.z = pkbf(f[4], f[5]); w.w = pkbf(f[6], f[7]); return w; }
__device__ __forceinline__ float sigmf(float x) { return 1.0f / (1.0f + __expf(-x)); }
__device__ __forceinline__ float siluf(float x) { return x / (1.0f + __expf(-x)); }
__device__ __forceinline__ float softplusf(float x) { return fmaxf(x, 0.f) + log1pf(__expf(-fabsf(x))); }
__device__ __forceinline__ float wave_sum(float v) {
#pragma unroll
    for (int o = 1; o < 64; o <<= 1) v += __shfl_xor(v, o);
    return v;
}
template <int N> __device__ __forceinline__ float group_sum(float v) {
#pragma unroll
    for (int o = 1; o < N; o <<= 1) v += __shfl_xor(v, o);
    return v;
}
#define DPP_ADD(v, ctrl) ((v) + __int_as_float(__builtin_amdgcn_update_dpp(0, __float_as_int(v), (ctrl), 0xF, 0xF, true)))
template <int KL> __device__ __forceinline__ float kl_sum(float v) {
    v = DPP_ADD(v, 0xB1); v = DPP_ADD(v, 0x4E); v = DPP_ADD(v, 0x141);
    if (KL == 16) v = DPP_ADD(v, 0x140);
    return v;
}
__device__ __forceinline__ void rms_row(const float* xrow, const float* gain, bf16* orow, int lane, f32x4 (&v)[8]) {
    const f32x4* xr = (const f32x4*)xrow + lane; float s = 0.f;
#pragma unroll
    for (int j = 0; j < 8; ++j) { v[j] = xr[64 * j]; s += (v[j].x * v[j].x + v[j].y * v[j].y) + (v[j].z * v[j].z + v[j].w * v[j].w); }
    const float sc = rsqrtf(wave_sum(s) * (1.0f / DM) + RMS_EPS);
    const f32x4* gr = (const f32x4*)gain + lane; v2u* o8 = (v2u*)orow + lane;
#pragma unroll
    for (int j = 0; j < 8; ++j) { v[j] = v[j] * sc * gr[64 * j]; v2u w; w.x = pkbf(v[j].x, v[j].y); w.y = pkbf(v[j].z, v[j].w); o8[64 * j] = w; }
}
template <class RowMap> __device__ __forceinline__ void transpose_item(const float* W, int K, int N, int nend, bf16* WT, LAS float* scr, int k0, int n0, int lane, const RowMap& rm) {
    const int nl = n0 + (lane & 31); const bool okr = nl < nend;
#pragma unroll 8
    for (int i = 0; i < 32; ++i) { const int kk = 2 * i + (lane >> 5); scr[kk * 33 + (lane & 31)] = okr ? W[(size_t)(k0 + kk) * N + nl] : 0.f; }
    LDS_WAIT(); asm volatile("" ::: "memory");
    const int c = lane & 7;
#pragma unroll
    for (int j = 0; j < 4; ++j) { const int n = (lane >> 3) + 8 * j; const LAS float* s = scr + (8 * c) * 33 + n;
        v4u o; o.x = pkbf(s[0 * 33], s[1 * 33]); o.y = pkbf(s[2 * 33], s[3 * 33]); o.z = pkbf(s[4 * 33], s[5 * 33]); o.w = pkbf(s[6 * 33], s[7 * 33]);
        if (n0 + n < nend) *(GAS v4u*)(WT + (size_t)rm(n0 + n) * K + k0 + 8 * c) = o; }
    LDS_WAIT(); asm volatile("" ::: "memory");
}
struct RmOff { int off; __device__ __forceinline__ int operator()(int n) const { return n + off; } };
struct RmWin { __device__ __forceinline__ int operator()(int n) const { return n < C_PEND ? n : n + (LDP - C_PEND); } };
struct RmGU { int up; __device__ __forceinline__ int operator()(int n) const { return (n >> 7) * 256 + (n & 127) + up * 128; } };
template <class RowMap> __device__ __forceinline__ void transpose_job(const float* W, int K, int N, bf16* WT, LAS float* scr, int gw, int NGW, int lane, const RowMap& rm) {
    const int nblk = (N + 31) / 32, nit = (K / 64) * nblk;
    for (int it = gw; it < nit; it += NGW) { const int kb = it / nblk, nb = it % nblk; transpose_item(W, K, N, N, WT, scr, 64 * kb, 32 * nb, lane, rm); }
}
struct LayerPtrs {
    const float *g_mix, *na_q_gain, *na_k_gain, *na_rel_bias, *gla_w_up, *gla_b, *gla_norm, *conv_w, *a_log, *dt_bias, *gdn_norm, *lb_raw0, *lb_raw1, *hg_norm, *mem_q_gain, *g_ffn;
};
__device__ __forceinline__ void prep_unit(int L, const LayerPtrs& lp, bf16* P, float* GLG, bf16* GQ, float* GAB, bf16* HQ, float* HF, bf16* NAVT, int t0, int lane) {
    const int b = t0 >> 12, s0 = t0 & 4095;
#pragma unroll 1
    for (int tt = 0; tt < 8; ++tt) { bf16* pr = P + (size_t)(t0 + tt) * LDP;
#pragma unroll
        for (int qk = 0; qk < 2; ++qk) { bf16* p = pr + (qk ? C_NAK : C_NAQ) + lane * 8; float f[8]; unpack8(*(const v4u*)p, f);
            float ss = 0.f;
#pragma unroll
            for (int i = 0; i < 8; ++i) ss += f[i] * f[i];
            ss = group_sum<8>(ss); const float sc = rsqrtf(ss * (1.0f / 64.0f) + RMS_EPS) * (qk ? 1.0f : 0.125f);
            const float* gn = (qk ? lp.na_k_gain : lp.na_q_gain) + (lane & 7) * 8;
#pragma unroll
            for (int i = 0; i < 8; ++i) f[i] = f[i] * sc * gn[i];
            *(v4u*)p = pack8(f); }
        { bf16* p = pr + C_MQ + lane * 8; float f[8]; unpack8(*(const v4u*)p, f); float ss = 0.f;
#pragma unroll
            for (int i = 0; i < 8; ++i) ss += f[i] * f[i];
            ss = group_sum<16>(ss); const float sc = rsqrtf(ss * (1.0f / 128.0f) + RMS_EPS) * 0.08838834764831845f; const float* gn = lp.mem_q_gain + (lane & 15) * 8;
#pragma unroll
            for (int i = 0; i < 8; ++i) f[i] = f[i] * sc * gn[i];
            *(v4u*)p = pack8(f); }
        { float f[8]; unpack8(*(const v4u*)(pr + C_HGQ + lane * 8), f);
#pragma unroll
            for (int i = 0; i < 8; ++i) f[i] = siluf(f[i]);
            *(v4u*)(HQ + (size_t)(t0 + tt) * 512 + lane * 8) = pack8(f);
#pragma unroll
            for (int d = 0; d < 2; ++d) { float z[8]; unpack8(*(const v4u*)(pr + C_HGF + d * 512 + lane * 8), z); float o[8];
#pragma unroll
                for (int i = 0; i < 8; ++i) { const int c = d * 512 + lane * 8 + i; const float lb = L ? sigmf(lp.lb_raw1[c] - lp.lb_raw0[c]) : 0.f; o[i] = lb + (1.0f - lb) * sigmf(z[i]); }
                float* hf = HF + (size_t)(t0 + tt) * 1024 + d * 512 + lane * 8;
                *(f32x4*)hf = (f32x4){o[0], o[1], o[2], o[3]}; *(f32x4*)(hf + 4) = (f32x4){o[4], o[5], o[6], o[7]}; } }
        { const int dir = lane >> 5, c8 = (lane & 31) * 8; float lr[16];
            { float t8[8]; unpack8(*(const v4u*)(pr + C_GLLR + dir * 16), t8);
#pragma unroll
              for (int i = 0; i < 8; ++i) lr[i] = t8[i];
              unpack8(*(const v4u*)(pr + C_GLLR + dir * 16 + 8), t8);
#pragma unroll
              for (int i = 0; i < 8; ++i) lr[8 + i] = t8[i]; }
            const float* bb = lp.gla_b + dir * 256 + c8; f32x4 a0 = *(const f32x4*)bb, a1 = *(const f32x4*)(bb + 4);
#pragma unroll
            for (int r = 0; r < 16; ++r) { const float* wp = lp.gla_w_up + (size_t)(dir * 16 + r) * 256 + c8; a0 = a0 + lr[r] * *(const f32x4*)wp; a1 = a1 + lr[r] * *(const f32x4*)(wp + 4); }
            f32x4 g0, g1;
#pragma unroll
            for (int i = 0; i < 4; ++i) { g0[i] = __expf(-softplusf(-a0[i]) * 0.0625f); g1[i] = __expf(-softplusf(-a1[i]) * 0.0625f); }
            float* gp = GLG + (size_t)(t0 + tt) * 512 + dir * 256 + c8; *(f32x4*)gp = g0; *(f32x4*)(gp + 4) = g1; }
        if (lane < 16) { const float val = bf1(pr[C_GDA + lane]); float o;
            if (lane < 8) { const float la = -__expf(lp.a_log[lane]) * softplusf(val + lp.dt_bias[lane]); o = __expf(la); } else o = sigmf(val);
            GAB[(size_t)(t0 + tt) * 16 + lane] = o; }
    }
#pragma unroll 1
    for (int j = 0; j < 3; ++j) { const int col = j * 512 + lane * 8; float w[5][8];
#pragma unroll
        for (int tap = 0; tap < 5; ++tap) { const float* wp = lp.conv_w + tap * 1536 + col; const f32x4 w0 = *(const f32x4*)wp, w1 = *(const f32x4*)(wp + 4);
            w[tap][0] = w0[0]; w[tap][1] = w0[1]; w[tap][2] = w0[2]; w[tap][3] = w0[3]; w[tap][4] = w1[0]; w[tap][5] = w1[1]; w[tap][6] = w1[2]; w[tap][7] = w1[3]; }
#pragma unroll 1
        for (int tt = 0; tt < 8; ++tt) { float acc[8];
#pragma unroll
            for (int i = 0; i < 8; ++i) acc[i] = 0.f;
#pragma unroll
            for (int tap = 0; tap < 5; ++tap) { const int s = s0 + tt + tap - 2; if (s >= 0 && s < SEQ) { float x[8]; unpack8(*(const v4u*)(P + (size_t)((b << 12) + s) * LDP + C_GDQKV + col), x);
#pragma unroll
                for (int i = 0; i < 8; ++i) acc[i] += w[tap][i] * x[i]; } }
#pragma unroll
            for (int i = 0; i < 8; ++i) acc[i] = siluf(acc[i]);
            if (j < 2) { float ss = 0.f;
#pragma unroll
                for (int i = 0; i < 8; ++i) ss += acc[i] * acc[i];
                ss = group_sum<16>(ss); const float sc = rsqrtf(ss + 1e-6f) * (j == 0 ? 0.08838834764831845f : 1.0f);
#pragma unroll
                for (int i = 0; i < 8; ++i) acc[i] *= sc; }
            *(v4u*)(GQ + (size_t)(t0 + tt) * 1536 + col) = pack8(acc); } }
    { unsigned vw[8][4];
#pragma unroll
        for (int tt = 0; tt < 8; ++tt) { const v4u x = *(const v4u*)(P + (size_t)(t0 + tt) * LDP + C_NAV + lane * 8); vw[tt][0] = x.x; vw[tt][1] = x.y; vw[tt][2] = x.z; vw[tt][3] = x.w; }
#pragma unroll
        for (int i = 0; i < 8; ++i) { unsigned e[8];
#pragma unroll
            for (int tt = 0; tt < 8; ++tt) e[tt] = (i & 1) ? (vw[tt][i >> 1] >> 16) : (vw[tt][i >> 1] & 0xffffu);
            v4u o; o.x = e[0] | (e[1] << 16); o.y = e[2] | (e[3] << 16); o.z = e[4] | (e[5] << 16); o.w = e[6] | (e[7] << 16);
            *(v4u*)(NAVT + ((size_t)((b * 8 + (lane >> 3)) * 64 + (lane & 7) * 8 + i)) * SEQ + s0) = o; } }
}
__device__ __forceinline__ void post_token(const LayerPtrs& lp, const bf16* P, const bf16* SOUT, bf16* BR, int t, int lane) {
    const bf16* pr = P + (size_t)t * LDP;
#pragma unroll
    for (int br = 0; br < 3; ++br) {
        float a[8], c[8], og[8];
        unpack8(*(const v4u*)(SOUT + ((size_t)(br * 2 + 0) * NT + t) * 512 + lane * 8), a);
        unpack8(*(const v4u*)(SOUT + ((size_t)(br * 2 + 1) * NT + t) * 512 + lane * 8), c);
        unpack8(*(const v4u*)(pr + (br == 0 ? C_GLOG : br == 1 ? C_GDOG : C_HGOG) + lane * 8), og);
        const float qs = br == 0 ? 0.125f : 1.0f; float ss = 0.f;
#pragma unroll
        for (int i = 0; i < 8; ++i) { a[i] = (a[i] + c[i]) * qs; ss += a[i] * a[i]; }
        ss = group_sum<16>(ss); const float sc = rsqrtf(ss * (1.0f / 128.0f) + RMS_EPS);
        const float* gn = (br == 0 ? lp.gla_norm : br == 1 ? lp.gdn_norm : lp.hg_norm) + (lane & 15) * 8;
#pragma unroll
        for (int i = 0; i < 8; ++i) a[i] = a[i] * sc * gn[i] * (br == 2 ? sigmf(og[i]) : siluf(og[i]));
        *(v4u*)(BR + ((size_t)(1 + br) * NT + t) * 512 + lane * 8) = pack8(a);
    }
}
struct ScanSrc { const bf16* q; int qp; const bf16* k; int kp; const float* g; int gp; const bf16* v; int vp; const float* ab; bf16* o; int op; };
template <int K, int KL, int MODE> __device__ __forceinline__ void scan_item(LAS unsigned char* lds, const ScanSrc& S, int dir, int tid) {
    constexpr int VPW = 64 / KL, VPB = 8 * VPW, KPL = K / KL;
    constexpr int NQC = 64 * K / 8 / 512;
    constexpr int NGC = 64 * K / 4 / 512;
    constexpr int NVC = 64 * VPB / 8;
    LAS float* Q = (LAS float*)lds; LAS float* KK = Q + 64 * K; LAS float* GG = (MODE == 0) ? KK + 64 * K : KK; LAS float* V = (MODE == 0) ? GG + 64 * K : KK + 64 * K; LAS float* O = V + 64 * VPB; LAS float* AB = O + 64 * VPB;
    static_assert((64 * K * (MODE == 0 ? 3 : 2) + 2 * 64 * VPB + 128) * 4 <= RING_BYTES, "scan LDS");
    const int lane = tid & 63, wave = tid >> 6, kl = lane % KL, vc = wave * VPW + lane / KL;
    float s[KPL];
#pragma unroll
    for (int i = 0; i < KPL; ++i) s[i] = 0.f;
    v4u rq[NQC], rk[NQC]; f32x4 rg[NGC]; v4u rv; float rab = 0.f;
#define SCAN_TOK(blk, r) (dir ? (SEQ - 1 - ((blk) * 64 + (r))) : ((blk) * 64 + (r)))
#define SCAN_LOAD(blk) do { \
        _Pragma("unroll") for (int c = 0; c < NQC; ++c) { const int ch = tid + c * 512, r = ch / (K / 8), cc = ch % (K / 8); const size_t tok = SCAN_TOK(blk, r); \
            rq[c] = *(const v4u*)(S.q + tok * S.qp + cc * 8); if (MODE != 1) rk[c] = *(const v4u*)(S.k + tok * S.kp + cc * 8); } \
        if (MODE != 2) { _Pragma("unroll") for (int c = 0; c < NGC; ++c) { const int ch = tid + c * 512, r = ch / (K / 4), cc = ch % (K / 4); const size_t tok = SCAN_TOK(blk, r); rg[c] = *(const f32x4*)(S.g + tok * S.gp + cc * 4); } } \
        if (tid < NVC) { const int r = tid / (VPB / 8), cc = tid % (VPB / 8); const size_t tok = SCAN_TOK(blk, r); rv = *(const v4u*)(S.v + tok * S.vp + cc * 8); } \
        if (MODE == 2 && tid >= 384) { const int r = (tid - 384) >> 1, w = (tid - 384) & 1; const size_t tok = SCAN_TOK(blk, r); rab = S.ab[tok * 16 + w * 8]; } } while (0)
    SCAN_LOAD(0);
#pragma unroll 1
    for (int blk = 0; blk < SEQ / 64; ++blk) {
        __syncthreads();
        if (blk > 0 && tid < NVC) {
            const int r = tid / (VPB / 8), cc = tid % (VPB / 8); const size_t tok = SCAN_TOK(blk - 1, r); const LAS float* op = O + r * VPB + cc * 8;
            v4u w; w.x = pkbf(op[0], op[1]); w.y = pkbf(op[2], op[3]); w.z = pkbf(op[4], op[5]); w.w = pkbf(op[6], op[7]); *(v4u*)(S.o + tok * S.op + cc * 8) = w; }
#pragma unroll
        for (int c = 0; c < NQC; ++c) { const int ch = tid + c * 512, r = ch / (K / 8), cc = ch % (K / 8); float f[8];
            unpack8(rq[c], f); LAS float* d = Q + r * K + cc * 8; *(LAS f32x4*)d = (f32x4){f[0], f[1], f[2], f[3]}; *(LAS f32x4*)(d + 4) = (f32x4){f[4], f[5], f[6], f[7]};
            if (MODE != 1) { unpack8(rk[c], f); LAS float* e = KK + r * K + cc * 8; *(LAS f32x4*)e = (f32x4){f[0], f[1], f[2], f[3]}; *(LAS f32x4*)(e + 4) = (f32x4){f[4], f[5], f[6], f[7]}; } }
        if (MODE != 2) {
#pragma unroll
            for (int c = 0; c < NGC; ++c) { const int ch = tid + c * 512, r = ch / (K / 4), cc = ch % (K / 4); *(LAS f32x4*)(GG + r * K + cc * 4) = rg[c]; } }
        if (tid < NVC) { const int r = tid / (VPB / 8), cc = tid % (VPB / 8); float f[8]; unpack8(rv, f); LAS float* d = V + r * VPB + cc * 8; *(LAS f32x4*)d = (f32x4){f[0], f[1], f[2], f[3]}; *(LAS f32x4*)(d + 4) = (f32x4){f[4], f[5], f[6], f[7]}; }
        if (MODE == 2 && tid >= 384) AB[tid - 384] = rab;
        __syncthreads();
        if (blk + 1 < SEQ / 64) SCAN_LOAD(blk + 1);
#pragma unroll 2
        for (int r = 0; r < 64; ++r) {
            float qq[KPL], kk[KPL];
            const LAS float* qp = Q + r * K + kl * KPL;
#pragma unroll
            for (int i = 0; i < KPL; i += 4) { const f32x4 t = *(const LAS f32x4*)(qp + i); qq[i] = t[0]; qq[i + 1] = t[1]; qq[i + 2] = t[2]; qq[i + 3] = t[3]; }
            const float vv = V[r * VPB + vc];
            if (MODE == 2) {
                const LAS float* kp = KK + r * K + kl * KPL;
#pragma unroll
                for (int i = 0; i < KPL; i += 4) { const f32x4 t = *(const LAS f32x4*)(kp + i); kk[i] = t[0]; kk[i + 1] = t[1]; kk[i + 2] = t[2]; kk[i + 3] = t[3]; }
                const float al = AB[2 * r], be = AB[2 * r + 1];
                float p0 = 0.f, p1 = 0.f;
#pragma unroll
                for (int i = 0; i < KPL; i += 2) { p0 += kk[i] * s[i]; p1 += kk[i + 1] * s[i + 1]; }
                const float p = kl_sum<KL>(p0 + p1);
                const float coef = be * (vv - al * p);
#pragma unroll
                for (int i = 0; i < KPL; ++i) s[i] = al * s[i] + coef * kk[i];
            } else {
                float gg[KPL]; const LAS float* gp = GG + r * K + kl * KPL;
#pragma unroll
                for (int i = 0; i < KPL; i += 4) { const f32x4 t = *(const LAS f32x4*)(gp + i); gg[i] = t[0]; gg[i + 1] = t[1]; gg[i + 2] = t[2]; gg[i + 3] = t[3]; }
                if (MODE == 0) { const LAS float* kp = KK + r * K + kl * KPL;
#pragma unroll
                    for (int i = 0; i < KPL; i += 4) { const f32x4 t = *(const LAS f32x4*)(kp + i); kk[i] = t[0]; kk[i + 1] = t[1]; kk[i + 2] = t[2]; kk[i + 3] = t[3]; }
                } else {
#pragma unroll
                    for (int i = 0; i < KPL; ++i) kk[i] = 1.0f - gg[i]; }
#pragma unroll
                for (int i = 0; i < KPL; ++i) s[i] = gg[i] * s[i] + kk[i] * vv;
            }
            float o0 = 0.f, o1 = 0.f;
#pragma unroll
            for (int i = 0; i < KPL; i += 2) { o0 += qq[i] * s[i]; o1 += qq[i + 1] * s[i + 1]; }
            const float o = kl_sum<KL>(o0 + o1);
            if (kl == 0) O[r * VPB + vc] = o;
        }
    }
    __syncthreads();
    if (tid < NVC) { const int r = tid / (VPB / 8), cc = tid % (VPB / 8); const size_t tok = SCAN_TOK(SEQ / 64 - 1, r); const LAS float* op = O + r * VPB + cc * 8;
        v4u w; w.x = pkbf(op[0], op[1]); w.y = pkbf(op[2], op[3]); w.z = pkbf(op[4], op[5]); w.w = pkbf(op[6], op[7]); *(v4u*)(S.o + tok * S.op + cc * 8) = w; }
    __syncthreads();
#undef SCAN_LOAD
#undef SCAN_TOK
}
typedef short bf16x8 __attribute__((ext_vector_type(8)));
__device__ __forceinline__ bf16x8 as_bf16x8(v4u w) { return __builtin_bit_cast(bf16x8, w); }
#define MFMA16(a, b, c) __builtin_amdgcn_mfma_f32_16x16x32_bf16((a), (b), (c), 0, 0, 0)
__device__ __forceinline__ void na_wave_unit(const bf16* P, const bf16* NAVT, const float* rel_bias, bf16* BR0, int b, int h, int r, int qc, int lane) {
    const int fr = lane & 15, g = lane >> 4; const int c = qc * 16 + fr;
    const int kc_lo = qc == 0 ? 0 : qc == 1 ? 8 : qc == 2 ? 24 : 32;
    const int cs = min(max(c - 8, 0), 48), rbase = min(max(r - 4, 0), 56);
    const size_t tq = (size_t)(b << 12) + r * 64 + c;
    bf16x8 qf[2];
#pragma unroll
    for (int ks = 0; ks < 2; ++ks) qf[ks] = as_bf16x8(*(const v4u*)(P + tq * LDP + C_NAQ + h * 64 + ks * 32 + g * 8));
    f32x4 s[8][2]; float mx = -3.0e38f;
#pragma unroll
    for (int i = 0; i < 8; ++i) { const size_t tk0 = (size_t)(b << 12) + (rbase + i) * 64 + kc_lo; const float* bp = rel_bias + (h * 15 + (rbase + i - r + 7)) * 31;
#pragma unroll
        for (int kt = 0; kt < 2; ++kt) { const bf16* kp = P + (tk0 + kt * 16 + fr) * LDP + C_NAK + h * 64 + g * 8;
            f32x4 a = {0.f, 0.f, 0.f, 0.f}; a = MFMA16(as_bf16x8(*(const v4u*)kp), qf[0], a); a = MFMA16(as_bf16x8(*(const v4u*)(kp + 32)), qf[1], a);
#pragma unroll
            for (int jj = 0; jj < 4; ++jj) { const int ck = kc_lo + kt * 16 + 4 * g + jj; const bool inw = (ck >= cs) && (ck < cs + 16); const int dc = min(max(ck - c + 15, 0), 30);
                a[jj] = inw ? a[jj] + bp[dc] : -1.0e30f; mx = fmaxf(mx, a[jj]); }
            s[i][kt] = a; } }
    mx = fmaxf(mx, __shfl_xor(mx, 16)); mx = fmaxf(mx, __shfl_xor(mx, 32));
    float l = 0.f;
#pragma unroll
    for (int i = 0; i < 8; ++i)
#pragma unroll
        for (int kt = 0; kt < 2; ++kt)
#pragma unroll
            for (int jj = 0; jj < 4; ++jj) { const float p = __expf(s[i][kt][jj] - mx); s[i][kt][jj] = p; l += p; }
    l += __shfl_xor(l, 16); l += __shfl_xor(l, 32);
    f32x4 o[4];
#pragma unroll
    for (int dt = 0; dt < 4; ++dt) o[dt] = (f32x4){0.f, 0.f, 0.f, 0.f};
#pragma unroll
    for (int i = 0; i < 8; ++i) { v4u pw; pw.x = pkbf(s[i][0][0], s[i][0][1]); pw.y = pkbf(s[i][0][2], s[i][0][3]); pw.z = pkbf(s[i][1][0], s[i][1][1]); pw.w = pkbf(s[i][1][2], s[i][1][3]);
        const bf16x8 pf = as_bf16x8(pw); const int tokoff = (rbase + i) * 64 + kc_lo + 4 * g;
#pragma unroll
        for (int dt = 0; dt < 4; ++dt) { const bf16* vp = NAVT + ((size_t)((b * 8 + h) * 64 + dt * 16 + fr)) * SEQ + tokoff;
            const v2u v0 = *(const v2u*)vp, v1 = *(const v2u*)(vp + 16); v4u vw; vw.x = v0.x; vw.y = v0.y; vw.z = v1.x; vw.w = v1.y;
            o[dt] = MFMA16(as_bf16x8(vw), pf, o[dt]); } }
    const float inv = 1.0f / l;
#pragma unroll
    for (int dt = 0; dt < 4; ++dt) { v2u w; w.x = pkbf(o[dt][0] * inv, o[dt][1] * inv); w.y = pkbf(o[dt][2] * inv, o[dt][3] * inv);
        *(v2u*)(BR0 + tq * 512 + h * 64 + dt * 16 + 4 * g) = w; }
}
__device__ __forceinline__ void mem_wave_unit(const bf16* P, const bf16* MK, const bf16* MVT, bf16* BR4, int t0, int h, int lane) {
    const int fr = lane & 15, g = lane >> 4, b = t0 >> 12; const size_t tq = (size_t)t0 + fr;
    bf16x8 qf[4];
#pragma unroll
    for (int ks = 0; ks < 4; ++ks) qf[ks] = as_bf16x8(*(const v4u*)(P + tq * LDP + C_MQ + h * 128 + ks * 32 + g * 8));
    f32x4 s[16]; float mx = -3.0e38f;
#pragma unroll
    for (int mt = 0; mt < 16; ++mt) { const bf16* kp = MK + ((size_t)(b * 256 + mt * 16 + fr)) * 512 + h * 128 + g * 8; f32x4 a = {0.f, 0.f, 0.f, 0.f};
#pragma unroll
        for (int ks = 0; ks < 4; ++ks) a = MFMA16(as_bf16x8(*(const v4u*)(kp + ks * 32)), qf[ks], a);
#pragma unroll
        for (int jj = 0; jj < 4; ++jj) mx = fmaxf(mx, a[jj]);
        s[mt] = a; }
    mx = fmaxf(mx, __shfl_xor(mx, 16)); mx = fmaxf(mx, __shfl_xor(mx, 32));
    float l = 0.f;
#pragma unroll
    for (int mt = 0; mt < 16; ++mt)
#pragma unroll
        for (int jj = 0; jj < 4; ++jj) { const float p = __expf(s[mt][jj] - mx); s[mt][jj] = p; l += p; }
    l += __shfl_xor(l, 16); l += __shfl_xor(l, 32);
    f32x4 o[8];
#pragma unroll
    for (int dt = 0; dt < 8; ++dt) o[dt] = (f32x4){0.f, 0.f, 0.f, 0.f};
#pragma unroll
    for (int kb = 0; kb < 8; ++kb) { v4u pw; pw.x = pkbf(s[2 * kb][0], s[2 * kb][1]); pw.y = pkbf(s[2 * kb][2], s[2 * kb][3]); pw.z = pkbf(s[2 * kb + 1][0], s[2 * kb + 1][1]); pw.w = pkbf(s[2 * kb + 1][2], s[2 * kb + 1][3]);
        const bf16x8 pf = as_bf16x8(pw);
#pragma unroll
        for (int dt = 0; dt < 8; ++dt) { const bf16* vp = MVT + ((size_t)((b * 4 + h) * 128 + dt * 16 + fr)) * 256 + kb * 32 + 4 * g;
            const v2u v0 = *(const v2u*)vp, v1 = *(const v2u*)(vp + 16); v4u vw; vw.x = v0.x; vw.y = v0.y; vw.z = v1.x; vw.w = v1.y;
            o[dt] = MFMA16(as_bf16x8(vw), pf, o[dt]); } }
    const float inv = 1.0f / l;
#pragma unroll
    for (int dt = 0; dt < 8; ++dt) { v2u w; w.x = pkbf(o[dt][0] * inv, o[dt][1] * inv); w.y = pkbf(o[dt][2] * inv, o[dt][3] * inv);
        *(v2u*)(BR4 + tq * 512 + h * 128 + dt * 16 + 4 * g) = w; }
}
struct Args { const float* in[31]; float* out; unsigned char* ws; int ph_lo, ph_hi; };
static_assert(sizeof(Args) == 31 * 8 + 8 + 8 + 8, "Args has no padding");
typedef const __attribute__((address_space(4))) unsigned char* kptr_t;
typedef const float* cfptr_t; typedef float* fptr_t; typedef unsigned char* ucptr_t;
__device__ __forceinline__ kptr_t kargs() { kptr_t p = (kptr_t)__builtin_amdgcn_kernarg_segment_ptr(); asm volatile("" : "+s"(p)); return p; }
#define KIN(p, i) (*(const __attribute__((address_space(4))) cfptr_t*)((p) + 8 * (i)))
#define KOUT(p) (*(const __attribute__((address_space(4))) fptr_t*)((p) + 248))
#define KWS(p) (*(const __attribute__((address_space(4))) ucptr_t*)((p) + 256))

#ifndef EN_MASK
#define EN_MASK 0xffffffffu
#endif
#define EN_PH(k) ((EN_MASK >> (k)) & 1u)
__global__ void __launch_bounds__(NWAVES * 64, 2) mega_fwd(Args args) {
    extern __shared__ __attribute__((aligned(16))) unsigned char lds_raw[];
    LAS unsigned char* lds = (LAS unsigned char*)lds_raw;
    volatile LAS unsigned* MISC = (volatile LAS unsigned*)(lds + MISC_OFF);
    LAS int* TAB = (LAS int*)(lds + TAB_OFF);
    for (int u = threadIdx.x; u < (LDS_BYTES - LDSCTL_OFF) / 4; u += NWAVES * 64) ((LAS unsigned*)(lds + LDSCTL_OFF))[u] = 0u;
    __syncthreads();
    XcdBarrier bar; bar.bar = (unsigned*)(args.ws + WS_CTL) + CW_BAR; bar.x = 0; bar.st = nullptr;
    if (!MK_SPLIT) bar = xcd_barrier_post((unsigned*)(args.ws + WS_CTL) + CW_BAR, MISC + 8);
    const int lo = args.ph_lo, hi = args.ph_hi;
#define IN(k) (lo <= (k) && (k) < hi)
#define SEAM(k) do { if ((k) + 1 < hi) { if (MK_SPLIT) { if (threadIdx.x == 0) __hip_atomic_store((gu32*)(args.ws + WS_CTL) + CW_TMO, 0xBADBA0u, RLX_AGENT); } else xcd_barrier(bar); } } while (0)
#define PHASE_VARS \
    const kptr_t kp = kargs(); unsigned char* const ws = KWS(kp); float* const out = KOUT(kp); (void)out; \
    int tid_ = threadIdx.x; asm volatile("" : "+v"(tid_)); const int tid = tid_, lane = tid & 63, wave = __builtin_amdgcn_readfirstlane(tid >> 6); (void)lane; (void)wave; \
    int G_ = gridDim.x, bx_ = blockIdx.x; asm volatile("" : "+s"(G_), "+s"(bx_)); const int G = G_, bx = bx_; const int vcu = (G % 8 == 0) ? (bx % 8) * (G / 8) + bx / 8 : bx; const int gw = vcu * NWAVES + wave, NGW = G * NWAVES; (void)gw; (void)NGW; \
    gu32* const ctl = (gu32*)(ws + WS_CTL); (void)ctl
#define LAYER_PTRS(lp) LayerPtrs lp; \
        lp.g_mix = KIN(kp, 2) + L * DM; lp.na_q_gain = KIN(kp, 4) + L * 64; lp.na_k_gain = KIN(kp, 5) + L * 64; lp.na_rel_bias = KIN(kp, 6) + L * 8 * 15 * 31; \
        lp.gla_w_up = KIN(kp, 7) + L * 2 * 16 * 256; lp.gla_b = KIN(kp, 8) + L * 512; lp.gla_norm = KIN(kp, 9) + L * 128; lp.conv_w = KIN(kp, 10) + L * 5 * 1536; \
        lp.a_log = KIN(kp, 11) + L * 8; lp.dt_bias = KIN(kp, 12) + L * 8; lp.gdn_norm = KIN(kp, 13) + L * 128; lp.lb_raw0 = KIN(kp, 14); lp.lb_raw1 = KIN(kp, 14) + 1024; \
        lp.hg_norm = KIN(kp, 15) + L * 128; lp.mem_q_gain = KIN(kp, 18) + L * 128; lp.g_ffn = KIN(kp, 22) + L * DM
#define WSP(T, off) ((T*)(ws + (off)))

    if (EN_PH(31) && IN(0)) { PHASE_VARS;
        bf16* WIN = WSP(bf16, WS_WIN); bf16* WBR = WSP(bf16, WS_WBR); bf16* WOUT = WSP(bf16, WS_WOUT); bf16* WMKV = WSP(bf16, WS_WMKV);
        bf16* WGU = WSP(bf16, WS_WGU); bf16* WDN = WSP(bf16, WS_WDN); bf16* MOE1 = WSP(bf16, WS_MOE1); bf16* MOE2 = WSP(bf16, WS_MOE2);
        LAS float* scr = (LAS float*)(lds + RING_OFF + wave * 16384);
#pragma unroll 1
        for (int L = 0; L < 2; ++L) {
            transpose_job(KIN(kp, 3) + (size_t)L * DM * PIN, DM, PIN, WIN + (size_t)L * NIN * DM, scr, gw, NGW, lane, RmWin{});
#pragma unroll 1
            for (int n = 0; n < 5; ++n) transpose_job(KIN(kp, 20) + (size_t)(L * 5 + n) * 512 * DM, 512, DM, WBR + (size_t)(L * 5 + n) * DM * 512, scr, gw, NGW, lane, RmOff{0});
            transpose_job(KIN(kp, 21) + (size_t)L * DM * DM, DM, DM, WOUT + (size_t)L * DM * DM, scr, gw, NGW, lane, RmOff{0});
            transpose_job(KIN(kp, 17) + (size_t)L * DM * 1024, DM, 1024, WMKV + (size_t)L * 1024 * DM, scr, gw, NGW, lane, RmOff{0});
        }
#pragma unroll 1
        for (int up = 0; up < 2; ++up) transpose_job(KIN(kp, 23 + up), DM, DFF, WGU, scr, gw, NGW, lane, RmGU{up});
        transpose_job(KIN(kp, 25), DFF, DM, WDN, scr, gw, NGW, lane, RmOff{0});
#pragma unroll 1
        for (int e = 0; e < NEXP; ++e) {
#pragma unroll 1
            for (int up = 0; up < 2; ++up) transpose_job(KIN(kp, 28 + up) + (size_t)e * DM * DFFE, DM, DFFE, MOE1 + (size_t)e * 2 * DFFE * DM, scr, gw, NGW, lane, RmGU{up});
            transpose_job(KIN(kp, 30) + (size_t)e * DFFE * DM, DFFE, DM, MOE2 + (size_t)e * DM * DFFE, scr, gw, NGW, lane, RmOff{0});
        }
        for (int i = gw * 64 + lane; i < 2 * (LDP - C_PEND) * DM / 8; i += NGW * 64) { const int L = i / ((LDP - C_PEND) * DM / 8), r = i % ((LDP - C_PEND) * DM / 8);
            *(v4u*)(WIN + ((size_t)L * NIN + C_PEND) * DM + (size_t)r * 8) = (v4u){0u, 0u, 0u, 0u}; }
        const float* mem = KIN(kp, 1); bf16* MEMN = WSP(bf16, WS_MEMN);
        for (int row = gw; row < 2 * 1024; row += NGW) { const int L = row >> 10, m = row & 1023; f32x4 v[8]; rms_row(mem + (size_t)m * DM, KIN(kp, 16) + L * DM, MEMN + (size_t)row * DM, lane, v); }
    }
    SEAM(0);

#pragma unroll 1
    for (int L = 0; L < NLAYER; ++L) {
        const int pb = 1 + 16 * L;
        if (EN_PH(0) && IN(pb + 0)) { PHASE_VARS; const float* xres = L ? (const float*)out : KIN(kp, 0); const float* gm = KIN(kp, 2) + L * DM; bf16* HM = WSP(bf16, WS_HM);
            for (int t = gw; t < NT; t += NGW) { f32x4 v[8]; rms_row(xres + (size_t)t * DM, gm, HM + (size_t)t * DM, lane, v); } }
        SEAM(pb + 0);
        if (EN_PH(1) && IN(pb + 1)) {
            { PHASE_VARS; pg8::Gemm g{WSP(bf16, WS_HM), WSP(bf16, WS_WIN) + (size_t)L * NIN * DM, NT, NIN, DM}; pg8::StaticOrder S; S.init(NT, NIN, G, bx); pg8::EpiInProj E{WSP(bf16, WS_P), WSP(bf16, WS_G)};
              pg8::gemm_phase<pg8::EpiInProj, pg8::StaticOrder, true, true>(lds + RING_OFF, g, S, E); }
            if (L == 0) { PHASE_VARS; pg8::Gemm g{WSP(bf16, WS_MEMN), WSP(bf16, WS_WMKV), 2048, 2048, DM}; pg8::KvOrder S{bx, G >= 96 ? 64 : 0}; pg8::EpiResF32 E{nullptr, WSP(float, WS_KVRAW), 1024, 4};
              pg8::gemm_phase<pg8::EpiResF32, pg8::KvOrder, false, true>(lds + RING_OFF, g, S, E); }
        }
        SEAM(pb + 1);
        if (EN_PH(2) && IN(pb + 2)) { PHASE_VARS; LAYER_PTRS(lp);
            for (int u = gw; u < NT / 8; u += NGW) prep_unit(L, lp, WSP(bf16, WS_P), WSP(float, WS_GLG), WSP(bf16, WS_GQ), WSP(float, WS_GAB), WSP(bf16, WS_HQ), WSP(float, WS_HF), WSP(bf16, WS_NAVT), u * 8, lane);
            if (L == 0) { const float* KVRAW = WSP(float, WS_KVRAW); bf16* MK = WSP(bf16, WS_MK); bf16* MVT = WSP(bf16, WS_MVT); const float* mkg = KIN(kp, 19);
                for (int row = gw; row < 2048; row += NGW) {
                    const int LL = row >> 10; const float* kr = KVRAW + (size_t)row * 1024;
                    const f32x4 k0 = *(const f32x4*)(kr + lane * 8), k1 = *(const f32x4*)(kr + lane * 8 + 4);
                    float f[8] = {k0[0], k0[1], k0[2], k0[3], k1[0], k1[1], k1[2], k1[3]}; float ss = 0.f;
#pragma unroll
                    for (int i = 0; i < 8; ++i) ss += f[i] * f[i];
                    ss = group_sum<16>(ss); const float sc = rsqrtf(ss * (1.0f / 128.0f) + RMS_EPS); const float* gn = mkg + LL * 128 + (lane & 15) * 8;
#pragma unroll
                    for (int i = 0; i < 8; ++i) f[i] = f[i] * sc * gn[i];
                    *(v4u*)(MK + (size_t)row * 512 + lane * 8) = pack8(f);
                    const int b = (row >> 8) & 3, m = row & 255; const float* vr = kr + 512;
#pragma unroll
                    for (int i = 0; i < 8; ++i) { const int cidx = lane * 8 + i; const int h = cidx >> 7, d = cidx & 127;
                        MVT[((size_t)((LL * 4 + b) * 4 + h) * 128 + d) * 256 + m] = (bf16)(pkbf(vr[cidx], 0.f) & 0xffffu); }
                }
            }
        }
        SEAM(pb + 2);
        if (EN_PH(3) && IN(pb + 3)) { PHASE_VARS;
            gu32* wq = ctl + CW_WQ + 64 * L;
            bf16* P = WSP(bf16, WS_P); bf16* SOUT = WSP(bf16, WS_SOUT); bf16* BR = WSP(bf16, WS_BR);
            for (;;) {
                __syncthreads();
                if (tid == 0) MISC[16] = __hip_atomic_fetch_add(wq, 1u, RLX_AGENT);
                __syncthreads();
                const int it = (int)MISC[16];
                if (it >= 1792) break;
                if (it < 128) {
                    const int seq = it >> 2, vq = it & 3, b = seq >> 3, h = (seq >> 1) & 3, dir = seq & 1; const size_t r0 = (size_t)b << 12;
                    bf16* GQ = WSP(bf16, WS_GQ);
                    ScanSrc S; S.q = GQ + r0 * 1536 + h * 128; S.qp = 1536; S.k = GQ + r0 * 1536 + 512 + h * 128; S.kp = 1536; S.g = nullptr; S.gp = 0;
                    S.v = GQ + r0 * 1536 + 1024 + h * 128 + vq * 32; S.vp = 1536; S.ab = WSP(float, WS_GAB) + r0 * 16 + dir * 4 + h;
                    S.o = SOUT + ((size_t)(1 * 2 + dir) * NT + r0) * 512 + h * 128 + vq * 32; S.op = 512;
                    scan_item<128, 16, 2>(lds + RING_OFF, S, dir, tid);
                } else if (it < 192) {
                    const int i2 = it - 128, seq = i2 >> 1, vh = i2 & 1, b = seq >> 3, h = (seq >> 1) & 3, dir = seq & 1; const size_t r0 = (size_t)b << 12;
                    ScanSrc S; S.q = WSP(bf16, WS_HQ) + r0 * 512 + h * 128; S.qp = 512; S.k = nullptr; S.kp = 0; S.g = WSP(float, WS_HF) + r0 * 1024 + dir * 512 + h * 128; S.gp = 1024;
                    S.v = P + r0 * LDP + C_HGI + h * 128 + vh * 64; S.vp = LDP; S.ab = nullptr;
                    S.o = SOUT + ((size_t)(2 * 2 + dir) * NT + r0) * 512 + h * 128 + vh * 64; S.op = 512;
                    scan_item<128, 8, 1>(lds + RING_OFF, S, dir, tid);
                } else if (it < 256) {
                    const int i2 = it - 192, seq = i2 >> 1, vh = i2 & 1, b = seq >> 3, h = (seq >> 1) & 3, dir = seq & 1; const size_t r0 = (size_t)b << 12;
                    ScanSrc S; S.q = P + r0 * LDP + C_GLQ + h * 64; S.qp = LDP; S.k = P + r0 * LDP + C_GLK + h * 64; S.kp = LDP; S.g = WSP(float, WS_GLG) + r0 * 512 + dir * 256 + h * 64; S.gp = 512;
                    S.v = P + r0 * LDP + C_GLV + h * 128 + vh * 64; S.vp = LDP; S.ab = nullptr;
                    S.o = SOUT + ((size_t)(0 * 2 + dir) * NT + r0) * 512 + h * 128 + vh * 64; S.op = 512;
                    scan_item<64, 8, 0>(lds + RING_OFF, S, dir, tid);
                } else if (it < 1280) {
                    const int i2 = it - 256, b = i2 >> 8, h = (i2 >> 5) & 7, rp = i2 & 31;
                    na_wave_unit(P, WSP(bf16, WS_NAVT), KIN(kp, 6) + L * 8 * 15 * 31, BR, b, h, 2 * rp + (wave >> 2), wave & 3, lane);
                } else {
                    const int i2 = it - 1280, tb = i2 >> 2, h = i2 & 3;
                    mem_wave_unit(P, WSP(bf16, WS_MK) + (size_t)L * 1024 * 512, WSP(bf16, WS_MVT) + (size_t)L * 4 * 4 * 128 * 256, BR + (size_t)4 * NT * 512, tb * 128 + wave * 16, h, lane);
                }
            }
        }
        SEAM(pb + 3);
        if (EN_PH(4) && IN(pb + 4)) { PHASE_VARS; LAYER_PTRS(lp); for (int t = gw; t < NT; t += NGW) post_token(lp, WSP(bf16, WS_P), WSP(bf16, WS_SOUT), WSP(bf16, WS_BR), t, lane); }
        SEAM(pb + 4);
        if (EN_PH(5) && IN(pb + 5)) { PHASE_VARS; pg8::Gemm g{WSP(bf16, WS_BR), WSP(bf16, WS_WBR) + (size_t)L * 5 * DM * 512, 5 * NT, 5 * DM, 512}; pg8::BranchOrder S{G, bx}; pg8::EpiBranch E{WSP(bf16, WS_G)};
            pg8::gemm_phase<pg8::EpiBranch, pg8::BranchOrder, true, true>(lds + RING_OFF, g, S, E); }
        SEAM(pb + 5);
        if (EN_PH(6) && IN(pb + 6)) { PHASE_VARS; const bf16* GZ = WSP(bf16, WS_G); bf16* HM = WSP(bf16, WS_HM);
            for (size_t i = (size_t)bx * 512 + tid; i < (size_t)NT * DM / 8; i += (size_t)G * 512) { const size_t t = i >> 8, c = (i & 255) * 8; float a[8], f[8];
#pragma unroll
                for (int k = 0; k < 8; ++k) a[k] = 0.f;
#pragma unroll
                for (int n = 0; n < 5; ++n) { unpack8(*(const v4u*)(GZ + t * NGATE + n * DM + c), f);
#pragma unroll
                    for (int k = 0; k < 8; ++k) a[k] += f[k]; }
                *(v4u*)(HM + t * DM + c) = pack8(a); } }
        SEAM(pb + 6);
        if (EN_PH(7) && IN(pb + 7)) { PHASE_VARS; const float* xres = L ? (const float*)out : KIN(kp, 0);
            pg8::Gemm g{WSP(bf16, WS_HM), WSP(bf16, WS_WOUT) + (size_t)L * DM * DM, NT, DM, DM}; pg8::StaticOrder S; S.init(NT, DM, G, bx); pg8::EpiResF32 E{xres, out, DM, 1 << 20};
            pg8::gemm_phase<pg8::EpiResF32, pg8::StaticOrder, true, true>(lds + RING_OFF, g, S, E); }
        SEAM(pb + 7);
        if (L == 0) {
            if (EN_PH(8) && IN(pb + 8)) { PHASE_VARS; const float* gf = KIN(kp, 22) + L * DM; bf16* HM = WSP(bf16, WS_HM);
                for (int t = gw; t < NT; t += NGW) { f32x4 v[8]; rms_row(out + (size_t)t * DM, gf, HM + (size_t)t * DM, lane, v); } }
            SEAM(pb + 8);
            if (EN_PH(9) && IN(pb + 9)) { PHASE_VARS; pg8::Gemm g{WSP(bf16, WS_HM), WSP(bf16, WS_WGU), NT, 2 * DFF, DM}; pg8::StaticOrder S; S.init(NT, 2 * DFF, G, bx); pg8::EpiSwiGLU E{WSP(bf16, WS_HID), DFF, 1 << 20};
                pg8::gemm_phase<pg8::EpiSwiGLU, pg8::StaticOrder, true, true>(lds + RING_OFF, g, S, E); }
            SEAM(pb + 9);
            if (EN_PH(10) && IN(pb + 10)) { PHASE_VARS; pg8::Gemm g{WSP(bf16, WS_HID), WSP(bf16, WS_WDN), NT, DM, DFF}; pg8::StaticOrder S; S.init(NT, DM, G, bx); pg8::EpiResF32 E{out, out, DM, 1 << 20};
                pg8::gemm_phase<pg8::EpiResF32, pg8::StaticOrder, true, true>(lds + RING_OFF, g, S, E); }
            SEAM(pb + 10);
        } else {
            if (EN_PH(8) && IN(pb + 8)) { PHASE_VARS; gu32* cnt = ctl + CW_CNT; unsigned* ROUTE = WSP(unsigned, WS_ROUTE); bf16* HM = WSP(bf16, WS_HM);
                const float* wr = KIN(kp, 26); const float* brt = KIN(kp, 27); const float* gf = KIN(kp, 22) + L * DM;
                LAS unsigned* lcnt = (LAS unsigned*)(lds + RING_OFF); LAS unsigned* gbase = lcnt + 8;
                for (int blk = bx; blk < NT / 64; blk += G) {
                    __syncthreads(); if (tid < 8) lcnt[tid] = 0u; __syncthreads();
                    unsigned re0 = 0, re1 = 0, rp0 = 0, rp1 = 0; float rw0 = 0.f, rw1 = 0.f;
#pragma unroll 1
                    for (int tt = 0; tt < 8; ++tt) { const int t = blk * 64 + wave * 8 + tt; f32x4 v[8]; rms_row(out + (size_t)t * DM, gf, HM + (size_t)t * DM, lane, v);
                        float lg[8];
#pragma unroll
                        for (int e = 0; e < 8; ++e) lg[e] = 0.f;
#pragma unroll
                        for (int j = 0; j < 8; ++j)
#pragma unroll
                            for (int q = 0; q < 4; ++q) { const float* wp = wr + (size_t)(4 * (lane + 64 * j) + q) * 8; const f32x4 w0 = *(const f32x4*)wp, w1 = *(const f32x4*)(wp + 4); const float hv = v[j][q];
                                lg[0] += hv * w0[0]; lg[1] += hv * w0[1]; lg[2] += hv * w0[2]; lg[3] += hv * w0[3]; lg[4] += hv * w1[0]; lg[5] += hv * w1[1]; lg[6] += hv * w1[2]; lg[7] += hv * w1[3]; }
#pragma unroll
                        for (int e = 0; e < 8; ++e) lg[e] = wave_sum(lg[e]) + brt[e];
                        int e0 = 0; float m0 = lg[0];
#pragma unroll
                        for (int e = 1; e < 8; ++e) if (lg[e] > m0) { m0 = lg[e]; e0 = e; }
                        int e1 = 0; float m1 = -3.0e38f;
#pragma unroll
                        for (int e = 0; e < 8; ++e) if (e != e0 && lg[e] > m1) { m1 = lg[e]; e1 = e; }
                        const float w0 = 1.0f / (1.0f + __expf(m1 - m0));
                        if (lane == tt) { re0 = e0; re1 = e1; rw0 = w0; rw1 = 1.0f - w0;
                            rp0 = __hip_atomic_fetch_add(&lcnt[e0], 1u, __ATOMIC_RELAXED, __HIP_MEMORY_SCOPE_WORKGROUP); rp1 = __hip_atomic_fetch_add(&lcnt[e1], 1u, __ATOMIC_RELAXED, __HIP_MEMORY_SCOPE_WORKGROUP); }
                    }
                    __syncthreads();
                    if (tid < 8) gbase[tid] = __hip_atomic_fetch_add(cnt + 64 * tid, lcnt[tid], RLX_AGENT);
                    __syncthreads();
                    if (lane < 8) { const int t = blk * 64 + wave * 8 + lane; unsigned* rr = ROUTE + (size_t)t * 8;
                        rr[0] = re0; rr[1] = re1; rr[2] = gbase[re0] + rp0; rr[3] = gbase[re1] + rp1; rr[4] = __float_as_uint(rw0); rr[5] = __float_as_uint(rw1); }
                }
            }
            SEAM(pb + 8);
            if (hi > pb + 9) { PHASE_VARS; gu32* cnt = ctl + CW_CNT;
                __syncthreads();
                if (tid == 0) { int acc = 0; for (int e = 0; e < 8; ++e) { const int c = (int)__hip_atomic_load(cnt + 64 * e, RLX_AGENT); const int nb = (c + 255) >> 8; TAB[e] = nb; TAB[8 + e] = acc; TAB[32 + e] = acc * 256; acc += nb; } TAB[40] = acc; }
                __syncthreads();
            }
            if (EN_PH(9) && IN(pb + 9)) { PHASE_VARS; bf16* XB = WSP(bf16, WS_XB); unsigned* ROUTE = WSP(unsigned, WS_ROUTE); const bf16* HM = WSP(bf16, WS_HM);
                for (int t = gw; t < NT; t += NGW) { unsigned* rr = ROUTE + (size_t)t * 8; const unsigned e0 = rr[0], e1 = rr[1]; const unsigned s0 = (unsigned)TAB[32 + e0] + rr[2], s1 = (unsigned)TAB[32 + e1] + rr[3];
                    if (lane == 0) { rr[6] = s0; rr[7] = s1; }
                    const v4u* src = (const v4u*)(HM + (size_t)t * DM) + lane; v4u* d0 = (v4u*)(XB + (size_t)s0 * DM) + lane; v4u* d1 = (v4u*)(XB + (size_t)s1 * DM) + lane;
#pragma unroll
                    for (int j = 0; j < 4; ++j) { const v4u x = src[64 * j]; d0[64 * j] = x; d1[64 * j] = x; } } }
            SEAM(pb + 9);
            if (EN_PH(10) && IN(pb + 10)) { PHASE_VARS; __syncthreads(); if (tid == 0) { for (int e = 0; e <= 8; ++e) TAB[16 + e] = (e < 8 ? TAB[8 + e] : TAB[40]) * 56; } __syncthreads();
                pg8::Gemm g{WSP(bf16, WS_XB), WSP(bf16, WS_MOE1), MAXSLOT, 8 * 2 * DFFE, DM}; pg8::MoeOrder S{G, bx, 56, TAB[40] * 56, TAB}; pg8::EpiSwiGLU E{WSP(bf16, WS_HIDM), DFFE, 56};
                pg8::gemm_phase<pg8::EpiSwiGLU, pg8::MoeOrder, true, true>(lds + RING_OFF, g, S, E); }
            SEAM(pb + 10);
            if (EN_PH(11) && IN(pb + 11)) { PHASE_VARS; __syncthreads(); if (tid == 0) { for (int e = 0; e <= 8; ++e) TAB[16 + e] = (e < 8 ? TAB[8 + e] : TAB[40]) * 8; } __syncthreads();
                pg8::Gemm g{WSP(bf16, WS_HIDM), WSP(bf16, WS_MOE2), MAXSLOT, 8 * DM, DFFE}; pg8::MoeOrder S{G, bx, 8, TAB[40] * 8, TAB}; pg8::EpiResF32 E{nullptr, WSP(float, WS_YB), DM, 8};
                pg8::gemm_phase<pg8::EpiResF32, pg8::MoeOrder, true, true>(lds + RING_OFF, g, S, E); }
            SEAM(pb + 11);
            if (EN_PH(12) && IN(pb + 12)) { PHASE_VARS; const float* YB = WSP(float, WS_YB); const unsigned* ROUTE = WSP(unsigned, WS_ROUTE);
                for (int t = gw; t < NT; t += NGW) { const unsigned* rr = ROUTE + (size_t)t * 8; const float w0 = __uint_as_float(rr[4]), w1 = __uint_as_float(rr[5]); const size_t s0 = rr[6], s1 = rr[7];
                    f32x4* o = (f32x4*)(out + (size_t)t * DM) + lane; const f32x4* y0 = (const f32x4*)(YB + s0 * DM) + lane; const f32x4* y1 = (const f32x4*)(YB + s1 * DM) + lane;
#pragma unroll
                    for (int j = 0; j < 8; ++j) o[64 * j] = o[64 * j] + w0 * y0[64 * j] + w1 * y1[64 * j]; } }
            SEAM(pb + 12);
        }
    }
#undef IN
#undef SEAM
}
extern "C" void kernel_launch(void* const* d_in, const int* in_sizes, int n_in, void* d_out, int out_size, void* d_ws, size_t ws_size, hipStream_t stream) {
    static int grid = 0;
    if (grid == 0) {
        if (n_in != 31 || in_sizes[0] != NT * DM || out_size != NT * DM || ws_size < WS_END) { fprintf(stderr, "kernel_launch: unexpected shapes (n_in %d, in0 %d, out %d, ws %zu < %zu); nothing launched\n", n_in, n_in > 0 ? in_sizes[0] : -1, out_size, ws_size, (size_t)WS_END); grid = -1; return; }
        int dev = 0, cus = 0, per_cu = 0;
        if (hipGetDevice(&dev) != hipSuccess || hipDeviceGetAttribute(&cus, hipDeviceAttributeMultiprocessorCount, dev) != hipSuccess) { grid = -1; return; }
        if (hipFuncSetAttribute((const void*)mega_fwd, hipFuncAttributeMaxDynamicSharedMemorySize, LDS_BYTES) != hipSuccess) { fprintf(stderr, "kernel_launch: hipFuncSetAttribute failed\n"); grid = -1; return; }
        if (hipOccupancyMaxActiveBlocksPerMultiprocessor(&per_cu, (const void*)mega_fwd, NWAVES * 64, LDS_BYTES) != hipSuccess || per_cu < 1) fprintf(stderr, "kernel_launch: occupancy query reports %d\n", per_cu);
        (void)hipGetLastError();
        grid = cus;
    }
    if (grid < 0) return;
    if (hipMemsetAsync((char*)d_ws + WS_CTL, 0, CTL_ZERO_BYTES, stream) != hipSuccess) return;
    Args a{};
    for (int i = 0; i < 31; ++i) a.in[i] = (const float*)d_in[i];
    a.out = (float*)d_out; a.ws = (unsigned char*)d_ws;
#if MK_SPLIT
    int ids[40]; int n = 0; ids[n++] = 0;
    for (int L = 0; L < 2; ++L) for (int k = 0; k < (L ? 13 : 11); ++k) ids[n++] = 1 + 16 * L + k;
    for (int i = 0; i < n; ++i) { a.ph_lo = ids[i]; a.ph_hi = ids[i] + 1; hipLaunchKernelGGL(mega_fwd, dim3(grid), dim3(NWAVES * 64), LDS_BYTES, stream, a); }
#else
    a.ph_lo = 0; a.ph_hi = 64;
    hipLaunchKernelGGL(mega_fwd, dim3(grid), dim3(NWAVES * 64), LDS_BYTES, stream, a);
#endif
    const hipError_t le = hipPeekAtLastError();
    if (le != hipSuccess) fprintf(stderr, "kernel_launch: launch failed: %s\n", hipGetErrorName(le));
}
```

```cpp
#include <hip/hip_runtime.h>
#include <cstdio>
#include <cstdint>
__device__ __forceinline__ int pg8_tid();
namespace pg8 {
#define PG8_LAS __attribute__((address_space(3)))
typedef unsigned short bf16_t;
typedef short bf16x8 __attribute__((ext_vector_type(8)));
typedef float f32x4 __attribute__((ext_vector_type(4)));
typedef unsigned u32x4 __attribute__((ext_vector_type(4)));
constexpr int BM = 256, BK = 64, HALF = 128, HTB = HALF * BK * 2  , STAGE_BYTES = 8 * HTB, NXCD = 8, WGM = 8;

__host__ __device__ __forceinline__ int lds_byte(int r, int c) { const int st = (r >> 4) * 2 + (c >> 5), rr = r & 15, cc = c & 31, ob = rr * 64 + cc * 2; return st * 1024 + (ob ^ (((ob >> 9) & 1) << 5)); }
__host__ __device__ __forceinline__ void stage_rc(int b, int& R, int& C) { const int st = b / 1024, sb = b % 1024, swz = sb ^ (((sb >> 9) & 1) << 5); R = (st >> 1) * 16 + swz / 64; C = (st & 1) * 32 + (swz % 64) / 2; }
__host__ __device__ __forceinline__ int perm32(int rho) { const int n = rho >> 4, i = rho & 15; return 8 * (i >> 2) + 4 * n + (i & 3); }

struct Unit { int pm, pn; };
struct Gemm { const bf16_t* A; const bf16_t* Bt; int M, N, K; };

struct StaticOrder {
    int nM, nN, nwg, G, c;
    __host__ __device__ void init(int M, int N, int G_, int c_) { nM = M / BM; nN = N / BM; nwg = nM * nN; G = G_; c = c_; }
    __host__ __device__ bool next(int i, Unit& u) const {
        const long L = (long)i * G + c; if (L >= nwg) return false;
        int wgid = (int)L; { const int q = nwg / NXCD, r = nwg % NXCD, xcd = wgid % NXCD, off = wgid / NXCD; wgid = (xcd < r ? xcd * (q + 1) : r * (q + 1) + (xcd - r) * q) + off; }
        const int nig = WGM * nN, gid = wgid / nig, fm = gid * WGM, gsz = (nM - fm) < WGM ? (nM - fm) : WGM;
        u.pm = fm + ((wgid % nig) % gsz); u.pn = (wgid % nig) / gsz; return true;
    }
    __device__ __forceinline__ void a_ready(const Unit&) const {}
    __device__ __forceinline__ void done(const Unit&) const {}
};
__device__ __forceinline__ unsigned cvt_pk_bf16(float lo, float hi) { unsigned r; asm volatile("v_cvt_pk_bf16_f32 %0, %1, %2" : "=v"(r) : "v"(lo), "v"(hi)); return r; }
typedef float f32x2 __attribute__((ext_vector_type(2)));
__device__ __forceinline__ float sigm(float x) { return __builtin_amdgcn_rcpf(1.0f + __expf(-x)); }
struct EpiInProj {
    static constexpr bool PERM = true, AFTER_DRAIN = false, CARRY = false;
    bf16_t* P; bf16_t* G;
    __device__ __forceinline__ void operator()(const f32x4 (&acc)[2][2][4][2], const Unit& u, int wr, int wc, int fr, int fq) const {
        const int row0 = u.pm * BM + wr * 64 + fr; const bool isg = u.pn >= 33;
#if defined(SKIP_G)
        if (isg) return;
#endif
        bf16_t* base = isg ? G : P; const int ldc = isg ? 10240 : 8448; const int col0 = (isg ? (u.pn - 33) : u.pn) * BM + wc * 32 + 8 * fq;
#pragma unroll
        for (int ai = 0; ai < 2; ++ai)
#pragma unroll
            for (int m = 0; m < 4; ++m) { bf16_t* rowp = base + (size_t)(row0 + ai * HALF + m * 16) * ldc + col0;
#pragma unroll
                for (int bj = 0; bj < 2; ++bj) { f32x4 v0 = acc[ai][bj][m][0], v1 = acc[ai][bj][m][1];
                    if (isg) {
                        unsigned lo = 0u, hi = 0u;
#pragma unroll
                        for (int j = 0; j < 4; ++j) { lo = __builtin_amdgcn_cvt_pk_u8_f32(sigm(v0[j]) * 255.0f, j, lo); hi = __builtin_amdgcn_cvt_pk_u8_f32(sigm(v1[j]) * 255.0f, j, hi); }
                        typedef unsigned u32x2 __attribute__((ext_vector_type(2)));
                        *(u32x2*)((unsigned char*)G + (size_t)(row0 + ai * HALF + m * 16) * 10240 + col0 + bj * HALF) = (u32x2){lo, hi};
                    } else {
                    u32x4 w; w.x = cvt_pk_bf16(v0[0], v0[1]); w.y = cvt_pk_bf16(v0[2], v0[3]); w.z = cvt_pk_bf16(v1[0], v1[1]); w.w = cvt_pk_bf16(v1[2], v1[3]);
                    *(u32x4*)(rowp + bj * HALF) = w; } } }
    }
};
struct EpiGate {
    static constexpr bool PERM = true, AFTER_DRAIN = false, CARRY = false;
    bf16_t* G;
    __device__ __forceinline__ void operator()(const f32x4 (&acc)[2][2][4][2], const Unit& u, int wr, int wc, int fr, int fq) const {
        const int row0 = u.pm * BM + wr * 64 + fr, col0 = u.pn * BM + wc * 32 + 8 * fq;
#pragma unroll
        for (int ai = 0; ai < 2; ++ai)
#pragma unroll
            for (int m = 0; m < 4; ++m) { bf16_t* rowp = G + (size_t)(row0 + ai * HALF + m * 16) * 10240 + col0;
#pragma unroll
                for (int bj = 0; bj < 2; ++bj) { f32x4 v0 = acc[ai][bj][m][0], v1 = acc[ai][bj][m][1];
#pragma unroll
                    for (int j = 0; j < 4; ++j) { v0[j] = sigm(v0[j]); v1[j] = sigm(v1[j]); }
                    u32x4 w; w.x = cvt_pk_bf16(v0[0], v0[1]); w.y = cvt_pk_bf16(v0[2], v0[3]); w.z = cvt_pk_bf16(v1[0], v1[1]); w.w = cvt_pk_bf16(v1[2], v1[3]);
                    *(u32x4*)(rowp + bj * HALF) = w; } }
    }
};
struct EpiBranch {
    static constexpr bool PERM = true, AFTER_DRAIN = false, CARRY = false;
    bf16_t* G;
    __device__ __forceinline__ void operator()(const f32x4 (&acc)[2][2][4][2], const Unit& u, int wr, int wc, int fr, int fq) const {
        const int n = u.pn >> 3, j = u.pn & 7; const int row0 = (u.pm & 63) * BM + wr * 64 + fr, col0 = n * 2048 + j * BM + wc * 32 + 8 * fq;
#pragma unroll
        for (int ai = 0; ai < 2; ++ai)
#pragma unroll
            for (int m = 0; m < 4; ++m) { bf16_t* rowp = G + (size_t)(row0 + ai * HALF + m * 16) * 10240 + col0;
#pragma unroll
                for (int bj = 0; bj < 2; ++bj) { const u32x4 g = *(const u32x4*)(rowp + bj * HALF); const f32x4 v0 = acc[ai][bj][m][0], v1 = acc[ai][bj][m][1];
                    u32x4 w;
                    w.x = cvt_pk_bf16(v0[0] * __uint_as_float(g.x << 16), v0[1] * __uint_as_float(g.x & 0xffff0000u));
                    w.y = cvt_pk_bf16(v0[2] * __uint_as_float(g.y << 16), v0[3] * __uint_as_float(g.y & 0xffff0000u));
                    w.z = cvt_pk_bf16(v1[0] * __uint_as_float(g.z << 16), v1[1] * __uint_as_float(g.z & 0xffff0000u));
                    w.w = cvt_pk_bf16(v1[2] * __uint_as_float(g.w << 16), v1[3] * __uint_as_float(g.w & 0xffff0000u));
                    *(u32x4*)(rowp + bj * HALF) = w; } }
    }
};
struct EpiBranchAcc {
    static constexpr bool PERM = true, AFTER_DRAIN = false, CARRY = false;
    const bf16_t* G; bf16_t* Mg;
    __device__ __forceinline__ void operator()(const f32x4 (&acc)[2][2][4][2], const Unit& u, int wr, int wc, int fr, int fq) const {
        typedef unsigned u32x2 __attribute__((ext_vector_type(2)));
        const int n = u.pn >> 3, j = u.pn & 7; const int row0 = (u.pm & 63) * BM + wr * 64 + fr, gcol0 = n * 2048 + j * BM + wc * 32 + 8 * fq, mcol0 = j * BM + wc * 32 + 8 * fq;
#pragma unroll
        for (int ai = 0; ai < 2; ++ai) { u32x2 gg[4][2]; u32x4 ov[4][2];
#pragma unroll
            for (int m = 0; m < 4; ++m) { const unsigned char* gp = (const unsigned char*)G + (size_t)(row0 + ai * HALF + m * 16) * 10240 + gcol0; const bf16_t* mp = Mg + (size_t)(row0 + ai * HALF + m * 16) * 2048 + mcol0;
#pragma unroll
                for (int bj = 0; bj < 2; ++bj) { gg[m][bj] = *(const u32x2*)(gp + bj * HALF);
                    if (n) ov[m][bj] = *(const u32x4*)(mp + bj * HALF); } }
#pragma unroll
            for (int m = 0; m < 4; ++m) { bf16_t* mp = Mg + (size_t)(row0 + ai * HALF + m * 16) * 2048 + mcol0;
#pragma unroll
                for (int bj = 0; bj < 2; ++bj) { const u32x2 g = gg[m][bj]; const f32x4 v0 = acc[ai][bj][m][0] * (1.0f / 255.0f), v1 = acc[ai][bj][m][1] * (1.0f / 255.0f);
                    float z[8] = {v0[0] * (float)(g.x & 0xffu), v0[1] * (float)((g.x >> 8) & 0xffu), v0[2] * (float)((g.x >> 16) & 0xffu), v0[3] * (float)(g.x >> 24),
                                  v1[0] * (float)(g.y & 0xffu), v1[1] * (float)((g.y >> 8) & 0xffu), v1[2] * (float)((g.y >> 16) & 0xffu), v1[3] * (float)(g.y >> 24)};
                    if (n) { const unsigned w0 = ov[m][bj].x, w1 = ov[m][bj].y, w2 = ov[m][bj].z, w3 = ov[m][bj].w;
                        z[0] += __uint_as_float(w0 << 16); z[1] += __uint_as_float(w0 & 0xffff0000u); z[2] += __uint_as_float(w1 << 16); z[3] += __uint_as_float(w1 & 0xffff0000u);
                        z[4] += __uint_as_float(w2 << 16); z[5] += __uint_as_float(w2 & 0xffff0000u); z[6] += __uint_as_float(w3 << 16); z[7] += __uint_as_float(w3 & 0xffff0000u); }
                    u32x4 w; w.x = cvt_pk_bf16(z[0], z[1]); w.y = cvt_pk_bf16(z[2], z[3]); w.z = cvt_pk_bf16(z[4], z[5]); w.w = cvt_pk_bf16(z[6], z[7]);
                    *(u32x4*)(mp + bj * HALF) = w; } }
            asm volatile("" ::: "memory"); }
    }
};
struct EpiResF32 {
    static constexpr bool PERM = false, AFTER_DRAIN = false, CARRY = false;
    const float* R; float* O; int ldc; int ntn;
    __device__ __forceinline__ void operator()(const f32x4 (&acc)[2][2][4][2], const Unit& u, int wr, int wc, int fr, int fq) const {
        const int row0 = u.pm * BM + wr * 64 + fr, col0 = (u.pn % ntn) * BM + wc * 32 + 4 * fq;
#pragma unroll
        for (int ai = 0; ai < 2; ++ai) { f32x4 r[4][2][2];
            if (R) {
#pragma unroll
                for (int m = 0; m < 4; ++m) { const size_t off = (size_t)(row0 + ai * HALF + m * 16) * ldc + col0;
#pragma unroll
                    for (int bj = 0; bj < 2; ++bj)
#pragma unroll
                        for (int n = 0; n < 2; ++n) r[m][bj][n] = *(const f32x4*)(R + off + bj * HALF + n * 16); } }
#pragma unroll
            for (int m = 0; m < 4; ++m) { const size_t off = (size_t)(row0 + ai * HALF + m * 16) * ldc + col0;
#pragma unroll
                for (int bj = 0; bj < 2; ++bj)
#pragma unroll
                    for (int n = 0; n < 2; ++n) { f32x4 o = acc[ai][bj][m][n]; if (R) o = o + r[m][bj][n]; *(f32x4*)(O + off + bj * HALF + n * 16) = o; } }
            asm volatile("" ::: "memory"); }
    }
};
struct EpiBf16Out {
    static constexpr bool PERM = false, AFTER_DRAIN = false, CARRY = false;
    bf16_t* O; int ldc; int ntn;
    __device__ __forceinline__ void operator()(const f32x4 (&acc)[2][2][4][2], const Unit& u, int wr, int wc, int fr, int fq) const {
        typedef unsigned u32x2 __attribute__((ext_vector_type(2)));
        const int row0 = u.pm * BM + wr * 64 + fr, col0 = (u.pn % ntn) * BM + wc * 32 + 4 * fq;
#pragma unroll
        for (int ai = 0; ai < 2; ++ai)
#pragma unroll
            for (int m = 0; m < 4; ++m) { bf16_t* rowp = O + (size_t)(row0 + ai * HALF + m * 16) * ldc + col0;
#pragma unroll
                for (int bj = 0; bj < 2; ++bj)
#pragma unroll
                    for (int n = 0; n < 2; ++n) { const f32x4 v = acc[ai][bj][m][n]; *(u32x2*)(rowp + bj * HALF + n * 16) = (u32x2){cvt_pk_bf16(v[0], v[1]), cvt_pk_bf16(v[2], v[3])}; } }
    }
};
struct EpiSwiGLU {
    static constexpr bool PERM = true, AFTER_DRAIN = false, CARRY = false;
    bf16_t* H; int ldh; int tpg;
    __device__ __forceinline__ void operator()(const f32x4 (&acc)[2][2][4][2], const Unit& u, int wr, int wc, int fr, int fq) const {
        const int row0 = u.pm * BM + wr * 64 + fr, col0 = (u.pn % tpg) * HALF + wc * 32 + 8 * fq;
#pragma unroll
        for (int ai = 0; ai < 2; ++ai)
#pragma unroll
            for (int m = 0; m < 4; ++m) { bf16_t* rowp = H + (size_t)(row0 + ai * HALF + m * 16) * ldh + col0;
                f32x4 h0, h1;
#pragma unroll
                for (int j = 0; j < 4; ++j) { const float g0 = acc[ai][0][m][0][j], g1 = acc[ai][0][m][1][j]; h0[j] = g0 * sigm(g0) * acc[ai][1][m][0][j]; h1[j] = g1 * sigm(g1) * acc[ai][1][m][1][j]; }
                u32x4 w; w.x = cvt_pk_bf16(h0[0], h0[1]); w.y = cvt_pk_bf16(h0[2], h0[3]); w.z = cvt_pk_bf16(h1[0], h1[1]); w.w = cvt_pk_bf16(h1[2], h1[3]);
                *(u32x4*)rowp = w; }
    }
};
struct EpiNull {
    static constexpr bool PERM = true, AFTER_DRAIN = false, CARRY = false;
    __device__ __forceinline__ void operator()(const f32x4 (&acc)[2][2][4][2], const Unit&, int, int, int, int) const {
#pragma unroll
        for (int a = 0; a < 2; ++a)
#pragma unroll
            for (int b = 0; b < 2; ++b)
#pragma unroll
                for (int m = 0; m < 4; ++m)
#pragma unroll
                    for (int n = 0; n < 2; ++n) asm volatile("" :: "v"(acc[a][b][m][n]));
    }
};
struct EpiSwiGLU8 {
    static constexpr bool PERM = true, AFTER_DRAIN = false, CARRY = false;
    unsigned char* H; int ldh; int tpg;
    __device__ __forceinline__ void operator()(const f32x4 (&acc)[2][2][4][2], const Unit& u, int wr, int wc, int fr, int fq) const {
        const int row0 = u.pm * BM + wr * 64 + fr, col0 = (u.pn % tpg) * HALF + wc * 32 + 8 * fq;
#pragma unroll
        for (int ai = 0; ai < 2; ++ai)
#pragma unroll
            for (int m = 0; m < 4; ++m) { unsigned char* rowp = H + (size_t)(row0 + ai * HALF + m * 16) * ldh + col0;
                f32x4 h0, h1;
#pragma unroll
                for (int j = 0; j < 4; ++j) { const float g0 = acc[ai][0][m][0][j], g1 = acc[ai][0][m][1][j]; h0[j] = g0 * sigm(g0) * acc[ai][1][m][0][j]; h1[j] = g1 * sigm(g1) * acc[ai][1][m][1][j]; }
                int w0 = __builtin_amdgcn_cvt_pk_fp8_f32(h0[0], h0[1], 0, false); w0 = __builtin_amdgcn_cvt_pk_fp8_f32(h0[2], h0[3], w0, true);
                int w1 = __builtin_amdgcn_cvt_pk_fp8_f32(h1[0], h1[1], 0, false); w1 = __builtin_amdgcn_cvt_pk_fp8_f32(h1[2], h1[3], w1, true);
                typedef unsigned u32x2 __attribute__((ext_vector_type(2))); *(u32x2*)rowp = (u32x2){(unsigned)w0, (unsigned)w1}; }
    }
};
struct BranchOrder {
    int G, c;
    __device__ bool next(int i, Unit& u) const {
        const long L = (long)i * G + c; if (L >= 2560) return false;
        int w = (int)L; { const int xcd = w % NXCD, off = w / NXCD; w = xcd * 320 + off; }
        const int n = w / 512, rem = w % 512, gid = rem / 64, r2 = rem % 64;
        u.pm = n * 64 + gid * 8 + (r2 % 8); u.pn = n * 8 + r2 / 8; return true;
    }
    __device__ __forceinline__ void a_ready(const Unit&) const {}
    __device__ __forceinline__ void done(const Unit&) const {}
};
struct BranchOrder5 {
    int G, c;
    __device__ bool next(int i, Unit& u) const {
        const int tt = (i / 5) * G + c; if (tt >= 512) return false; const int n = i % 5;
        const int w = (tt % NXCD) * 64 + tt / NXCD, gid = w / 64, r2 = w % 64;
        u.pm = n * 64 + gid * 8 + (r2 % 8); u.pn = n * 8 + r2 / 8; return true;
    }
    __device__ __forceinline__ void a_ready(const Unit&) const {}
    __device__ __forceinline__ void done(const Unit&) const {}
};
struct GateOrder : StaticOrder {
    __device__ bool next(int i, Unit& u) const { if (!StaticOrder::next(i, u)) return false; u.pn += 33; return true; }
};
struct GateBatchOrder {
    int grp, base, n;
    __device__ bool next(int i, Unit& u) const { if (i >= n) return false; const int r = base + i; u.pm = grp * 8 + (r & 7); u.pn = 33 + (r >> 3); return true; }
    __device__ __forceinline__ void a_ready(const Unit&) const {}
    __device__ __forceinline__ void done(const Unit&) const {}
};
struct KvOrder {
    int c, c0;
    __device__ bool next(int i, Unit& u) const { const int w = c - c0; if (i != 0 || w < 0 || w >= 32) return false; u.pm = w >> 2; u.pn = (w >> 4) * 4 + (w & 3); return true; }
    __device__ __forceinline__ void a_ready(const Unit&) const {}
    __device__ __forceinline__ void done(const Unit&) const {}
};
struct MoeOrder {
    int G, c, tpe, total; const PG8_LAS int* tb;
    __device__ bool next(int i, Unit& u) const {
        const long L = (long)i * G + c; if (L >= total) return false;
        int w = (int)L; { const int q = total / NXCD, r = total % NXCD, xcd = w % NXCD, off = w / NXCD; w = (xcd < r ? xcd * (q + 1) : r * (q + 1) + (xcd - r) * q) + off; }
        int e = 0;
#pragma unroll
        for (int k = 1; k < 8; ++k) if (w >= tb[16 + k]) e = k;
        const int loc = w - tb[16 + e], nb = tb[e];
        u.pm = tb[8 + e] + loc % nb; u.pn = e * tpe + loc / nb; return true;
    }
    __device__ __forceinline__ void a_ready(const Unit&) const {}
    __device__ __forceinline__ void done(const Unit&) const {}
};
template <class Epi, class Sched, bool ALIGN_EPI = false, bool SP2 = false>
__device__ __forceinline__ void gemm_phase(PG8_LAS unsigned char* lds, const Gemm g, const Sched& S, const Epi& E) {
    int tid = pg8_tid(); asm volatile("" : "+v"(tid));
    const int wid = __builtin_amdgcn_readfirstlane(tid >> 6), lane = tid & 63, wr = wid >> 2, wc = wid & 3, fr = lane & 15, fq = lane >> 4;
    const int K = g.K, nt = K / BK;
    unsigned voffA[2], voffB[2];
#pragma unroll
    for (int i = 0; i < 2; ++i) { int R, C; stage_rc(tid * 16 + i * 8192, R, C); const int Rb = Epi::PERM ? ((R & ~31) + perm32(R & 31)) : R;
        voffA[i] = (unsigned)(R * K + C) * 2u; voffB[i] = (unsigned)(Rb * K + C) * 2u; }
    const size_t kstep = (size_t)(BK * 2);
    const size_t hstep = (size_t)HALF * K * 2;
    const size_t tstep = 2 * hstep;
    const unsigned ldsw = (unsigned)wid * 1024u;
    const int aoff = lds_byte(wr * 64 + fr, fq * 8), boff = lds_byte(wc * 32 + fr, fq * 8);
#define PG8_SA(b, h) (((b) * 2 + (h)) * HTB)
#define PG8_SB(b, h) ((4 + (b) * 2 + (h)) * HTB)
#define PG8_STAGE(bufoff, gbase, voff) do { _Pragma("unroll") for (int _i = 0; _i < 2; ++_i) \
        __builtin_amdgcn_global_load_lds((const unsigned*)((const char*)(gbase) + (voff)[_i]), (PG8_LAS unsigned*)(lds + (bufoff) + ldsw + _i * 8192), 16, 0, 0); } while (0)
#define PG8_LDA(dst, b, h) do { _Pragma("unroll") for (int m = 0; m < 4; ++m) _Pragma("unroll") for (int k = 0; k < 2; ++k) dst[m][k] = *(const PG8_LAS bf16x8*)(lds + PG8_SA(b, h) + aoff + m * 2048 + k * 1024); } while (0)
#define PG8_LDB(dst, b, h) do { _Pragma("unroll") for (int n = 0; n < 2; ++n) _Pragma("unroll") for (int k = 0; k < 2; ++k) dst[n][k] = *(const PG8_LAS bf16x8*)(lds + PG8_SB(b, h) + boff + n * 2048 + k * 1024); } while (0)
#define PG8_MMA(ai, bj, At, Bt) do { __builtin_amdgcn_s_setprio(1); _Pragma("unroll") for (int m = 0; m < 4; ++m) _Pragma("unroll") for (int n = 0; n < 2; ++n) _Pragma("unroll") for (int k = 0; k < 2; ++k) \
        acc[ai][bj][m][n] = __builtin_amdgcn_mfma_f32_16x16x32_bf16(Bt[n][k], At[m][k], acc[ai][bj][m][n], 0, 0, 0); __builtin_amdgcn_s_setprio(0); } while (0)
#define PG8_WAIT_V(n) asm volatile("s_waitcnt vmcnt(" #n ")" ::: "memory")
#define PG8_WAIT_L(n) asm volatile("s_waitcnt lgkmcnt(" #n ")" ::: "memory")
#define PG8_BAR __builtin_amdgcn_s_barrier()
#define PG8_SCHED __builtin_amdgcn_sched_barrier(0)
    Unit cur, nxt; int ui = 0;
    if (!S.next(0, cur)) return;
    f32x4 acc[2][2][4][2];
#pragma unroll
    for (int a = 0; a < 2; ++a)
#pragma unroll
        for (int b = 0; b < 2; ++b)
#pragma unroll
            for (int m = 0; m < 4; ++m)
#pragma unroll
                for (int n = 0; n < 2; ++n) acc[a][b][m][n] = (f32x4){0.f, 0.f, 0.f, 0.f};
    bf16x8 At[4][2], B0[2][2], B1[2][2];
    const char* cA = (const char*)g.A + (size_t)cur.pm * tstep; const char* cB = (const char*)g.Bt + (size_t)cur.pn * tstep;
    S.a_ready(cur);
    if constexpr (SP2) {
        PG8_STAGE(PG8_SB(0, 0), cB, voffB); PG8_STAGE(PG8_SB(0, 1), cB + hstep, voffB); PG8_STAGE(PG8_SA(0, 0), cA, voffA); PG8_STAGE(PG8_SA(0, 1), cA + hstep, voffA);
        if (wr == 1) PG8_BAR;
        PG8_WAIT_V(2); PG8_BAR;
        PG8_STAGE(PG8_SB(1, 0), cB + kstep, voffB); PG8_STAGE(PG8_SA(1, 0), cA + kstep, voffA); PG8_STAGE(PG8_SB(1, 1), cB + hstep + kstep, voffB);
        PG8_WAIT_V(6); PG8_BAR;
    } else {
        PG8_STAGE(PG8_SB(0, 0), cB, voffB); PG8_STAGE(PG8_SA(0, 0), cA, voffA); PG8_STAGE(PG8_SB(0, 1), cB + hstep, voffB); PG8_STAGE(PG8_SA(0, 1), cA + hstep, voffA);
        if (wr == 1) PG8_BAR;
        PG8_WAIT_V(4); PG8_BAR;
        PG8_STAGE(PG8_SB(1, 0), cB + kstep, voffB); PG8_STAGE(PG8_SA(1, 0), cA + kstep, voffA); PG8_STAGE(PG8_SB(1, 1), cB + hstep + kstep, voffB);
        PG8_WAIT_V(6); PG8_BAR;
    }
    for (;;) {
        const bool has_next = S.next(ui + 1, nxt);
        const char* nA = has_next ? (const char*)g.A + (size_t)nxt.pm * tstep : cA; const char* nB = has_next ? (const char*)g.Bt + (size_t)nxt.pn * tstep : cB;
        for (int t = 0; t < nt; t += 2) {
            const bool last = (t == nt - 2);
            const char* a1 = cA + (size_t)(t + 1) * kstep;
            const char* a2 = last ? nA : cA + (size_t)(t + 2) * kstep; const char* b2 = last ? nB : cB + (size_t)(t + 2) * kstep;
            const char* a3 = a2 + kstep; const char* b3 = b2 + kstep;
            if (last && has_next) S.a_ready(nxt);
            if constexpr (SP2) {
            PG8_LDB(B0, 0, 0); PG8_LDB(B1, 0, 1); PG8_SCHED; PG8_LDA(At, 0, 0); PG8_STAGE(PG8_SA(1, 1), a1 + hstep, voffA);
            PG8_WAIT_V(8); PG8_WAIT_L(0); PG8_BAR; PG8_MMA(0, 0, At, B0); PG8_MMA(0, 1, At, B1); PG8_BAR; PG8_SCHED;
            PG8_LDA(At, 0, 1); PG8_STAGE(PG8_SB(0, 0), b2, voffB); PG8_STAGE(PG8_SB(0, 1), b2 + hstep, voffB); PG8_STAGE(PG8_SA(0, 0), a2, voffA);
            PG8_WAIT_V(8); PG8_WAIT_L(0); PG8_BAR; PG8_MMA(1, 0, At, B0); PG8_MMA(1, 1, At, B1); PG8_BAR; PG8_SCHED;
            PG8_LDB(B0, 1, 0); PG8_LDB(B1, 1, 1); PG8_SCHED; PG8_LDA(At, 1, 0); PG8_STAGE(PG8_SA(0, 1), a2 + hstep, voffA);
            PG8_WAIT_V(8); PG8_WAIT_L(0); PG8_BAR; PG8_MMA(0, 0, At, B0); PG8_MMA(0, 1, At, B1); PG8_BAR; PG8_SCHED;
            PG8_LDA(At, 1, 1); PG8_STAGE(PG8_SB(1, 0), b3, voffB); PG8_STAGE(PG8_SB(1, 1), b3 + hstep, voffB); PG8_STAGE(PG8_SA(1, 0), a3, voffA);
            PG8_WAIT_V(8); PG8_WAIT_L(0); PG8_BAR; PG8_MMA(1, 0, At, B0); PG8_MMA(1, 1, At, B1); PG8_BAR; PG8_SCHED;
            } else {
            PG8_LDB(B0, 0, 0); PG8_SCHED; PG8_LDA(At, 0, 0); PG8_STAGE(PG8_SA(1, 1), a1 + hstep, voffA);
            PG8_WAIT_L(8); PG8_BAR; PG8_WAIT_L(0); PG8_MMA(0, 0, At, B0); PG8_BAR; PG8_SCHED;
            PG8_LDB(B1, 0, 1); PG8_STAGE(PG8_SB(0, 0), b2, voffB);
            PG8_BAR; PG8_WAIT_L(0); PG8_MMA(0, 1, At, B1); PG8_BAR;
            PG8_LDA(At, 0, 1); PG8_STAGE(PG8_SA(0, 0), a2, voffA);
            PG8_BAR; PG8_WAIT_L(0); PG8_MMA(1, 0, At, B0); PG8_BAR; PG8_SCHED;
            PG8_STAGE(PG8_SB(0, 1), b2 + hstep, voffB);
            PG8_WAIT_V(6); PG8_BAR; PG8_MMA(1, 1, At, B1); PG8_BAR;
            PG8_LDB(B0, 1, 0); PG8_SCHED; PG8_LDA(At, 1, 0); PG8_STAGE(PG8_SA(0, 1), a2 + hstep, voffA);
            PG8_WAIT_L(8); PG8_BAR; PG8_WAIT_L(0); PG8_MMA(0, 0, At, B0); PG8_BAR; PG8_SCHED;
            PG8_LDB(B1, 1, 1); PG8_STAGE(PG8_SB(1, 0), b3, voffB);
            PG8_BAR; PG8_WAIT_L(0); PG8_MMA(0, 1, At, B1); PG8_BAR;
            PG8_LDA(At, 1, 1); PG8_STAGE(PG8_SA(1, 0), a3, voffA);
            PG8_BAR; PG8_WAIT_L(0); PG8_MMA(1, 0, At, B0); PG8_BAR; PG8_SCHED;
            PG8_STAGE(PG8_SB(1, 1), b3 + hstep, voffB);
            PG8_WAIT_V(6); PG8_BAR; PG8_MMA(1, 1, At, B1); PG8_BAR;
            }
        }
        if constexpr (ALIGN_EPI) { if (wr == 0) PG8_BAR; }
        if constexpr (Epi::CARRY) { int fr_ = fr, fq_ = fq; asm volatile("" : "+v"(fr_), "+v"(fq_)); E.carry(acc, cur, wr, wc, fr_, fq_); S.done(cur); }
        else if constexpr (!Epi::AFTER_DRAIN) { E(acc, cur, wr, wc, fr, fq); S.done(cur); }
        if (!has_next) break;
        if constexpr (!Epi::CARRY)
#pragma unroll
        for (int a = 0; a < 2; ++a)
#pragma unroll
            for (int b = 0; b < 2; ++b)
#pragma unroll
                for (int m = 0; m < 4; ++m)
#pragma unroll
                    for (int n = 0; n < 2; ++n) acc[a][b][m][n] = (f32x4){0.f, 0.f, 0.f, 0.f};
        cur = nxt; cA = nA; cB = nB; ++ui;
        if constexpr (ALIGN_EPI) { if (wr == 1) PG8_BAR; }
    }
    PG8_WAIT_V(0);
    if constexpr (!ALIGN_EPI) { if (wr == 0) PG8_BAR; }
    PG8_BAR;
    if constexpr (Epi::AFTER_DRAIN) { E.fused(acc, cur, wr, wc, fr, fq, lds, wid, lane); S.done(cur); }
#undef PG8_SA
#undef PG8_SB
#undef PG8_STAGE
#undef PG8_LDA
#undef PG8_LDB
#undef PG8_MMA
#undef PG8_WAIT_V
#undef PG8_WAIT_L
#undef PG8_BAR
#undef PG8_SCHED
}
typedef int i32x8 __attribute__((ext_vector_type(8)));
typedef int i32x8a __attribute__((ext_vector_type(8), aligned(16)));
template <class Epi, class Sched, bool ALIGN_EPI = false, bool SP2 = true>
__device__ __forceinline__ void gemm_phase_f8(PG8_LAS unsigned char* lds, const Gemm g, const Sched& S, const Epi& E) {
    int tid = pg8_tid(); asm volatile("" : "+v"(tid));
    const int wid = __builtin_amdgcn_readfirstlane(tid >> 6), lane = tid & 63, wr = wid >> 2, wc = wid & 3, fr = lane & 15, fq = lane >> 4;
    const int K = g.K, nt = K / BK;
    unsigned voffA[2], voffB[2];
#pragma unroll
    for (int i = 0; i < 2; ++i) { int R, C; stage_rc(tid * 16 + i * 8192, R, C); const int Rb = Epi::PERM ? ((R & ~31) + perm32(R & 31)) : R;
        voffA[i] = (unsigned)(R * K + C) * 2u; voffB[i] = (unsigned)(Rb * K + C) * 2u; }
    const size_t kstep = (size_t)(BK * 2);
    const size_t hstep = (size_t)HALF * K * 2;
    const size_t tstep = 2 * hstep;
    const unsigned ldsw = (unsigned)wid * 1024u;
    const int aoff = lds_byte(wr * 64 + fr, fq * 8), boff = lds_byte(wc * 32 + fr, fq * 8);
#define PG8_SA(b, h) (((b) * 2 + (h)) * HTB)
#define PG8_SB(b, h) ((4 + (b) * 2 + (h)) * HTB)
#define PG8_STAGE(bufoff, gbase, voff) do { _Pragma("unroll") for (int _i = 0; _i < 2; ++_i) \
        __builtin_amdgcn_global_load_lds((const unsigned*)((const char*)(gbase) + (voff)[_i]), (PG8_LAS unsigned*)(lds + (bufoff) + ldsw + _i * 8192), 16, 0, 0); } while (0)
#define PG8_LDA(dst, b, h) do { _Pragma("unroll") for (int m = 0; m < 4; ++m) { const u32x4 lo_ = *(const PG8_LAS u32x4*)(lds + PG8_SA(b, h) + aoff + m * 2048), hi_ = *(const PG8_LAS u32x4*)(lds + PG8_SA(b, h) + aoff + m * 2048 + 1024); dst[m] = (i32x8){(int)lo_.x, (int)lo_.y, (int)lo_.z, (int)lo_.w, (int)hi_.x, (int)hi_.y, (int)hi_.z, (int)hi_.w}; } } while (0)
#define PG8_LDB(dst, b, h) do { _Pragma("unroll") for (int n = 0; n < 2; ++n) { const u32x4 lo_ = *(const PG8_LAS u32x4*)(lds + PG8_SB(b, h) + boff + n * 2048), hi_ = *(const PG8_LAS u32x4*)(lds + PG8_SB(b, h) + boff + n * 2048 + 1024); dst[n] = (i32x8){(int)lo_.x, (int)lo_.y, (int)lo_.z, (int)lo_.w, (int)hi_.x, (int)hi_.y, (int)hi_.z, (int)hi_.w}; } } while (0)
#define PG8_MMA(ai, bj, At, Bt) do { __builtin_amdgcn_s_setprio(1); _Pragma("unroll") for (int m = 0; m < 4; ++m) _Pragma("unroll") for (int n = 0; n < 2; ++n) \
        asm volatile("s_nop 1\n\tv_mfma_scale_f32_16x16x128_f8f6f4 %0, %1, %2, %0, %3, %4 op_sel_hi:[0,0,0]" : "+v"(acc[ai][bj][m][n]) : "v"(Bt[n]), "v"(At[m]), "v"(sc_w), "v"(sc_a)); __builtin_amdgcn_s_setprio(0); } while (0)
#define PG8_WAIT_V(n) asm volatile("s_waitcnt vmcnt(" #n ")" ::: "memory")
#define PG8_WAIT_L(n) asm volatile("s_waitcnt lgkmcnt(" #n ")" ::: "memory")
#define PG8_BAR __builtin_amdgcn_s_barrier()
#define PG8_SCHED __builtin_amdgcn_sched_barrier(0)
    Unit cur, nxt; int ui = 0;
    if (!S.next(0, cur)) return;
    f32x4 acc[2][2][4][2];
#pragma unroll
    for (int a = 0; a < 2; ++a)
#pragma unroll
        for (int b = 0; b < 2; ++b)
#pragma unroll
            for (int m = 0; m < 4; ++m)
#pragma unroll
                for (int n = 0; n < 2; ++n) acc[a][b][m][n] = (f32x4){0.f, 0.f, 0.f, 0.f};
    i32x8 At[4], B0[2], B1[2];
    int sc_w = 0x79797979, sc_a = 0x7F7F7F7F;
    asm volatile("" : "+v"(sc_w), "+v"(sc_a));
    const char* cA = (const char*)g.A + (size_t)cur.pm * tstep; const char* cB = (const char*)g.Bt + (size_t)cur.pn * tstep;
    S.a_ready(cur);
    if constexpr (SP2) {
        PG8_STAGE(PG8_SB(0, 0), cB, voffB); PG8_STAGE(PG8_SB(0, 1), cB + hstep, voffB); PG8_STAGE(PG8_SA(0, 0), cA, voffA); PG8_STAGE(PG8_SA(0, 1), cA + hstep, voffA);
        if (wr == 1) PG8_BAR;
        PG8_WAIT_V(2); PG8_BAR;
        PG8_STAGE(PG8_SB(1, 0), cB + kstep, voffB); PG8_STAGE(PG8_SA(1, 0), cA + kstep, voffA); PG8_STAGE(PG8_SB(1, 1), cB + hstep + kstep, voffB);
        PG8_WAIT_V(6); PG8_BAR;
    } else {
        PG8_STAGE(PG8_SB(0, 0), cB, voffB); PG8_STAGE(PG8_SA(0, 0), cA, voffA); PG8_STAGE(PG8_SB(0, 1), cB + hstep, voffB); PG8_STAGE(PG8_SA(0, 1), cA + hstep, voffA);
        if (wr == 1) PG8_BAR;
        PG8_WAIT_V(4); PG8_BAR;
        PG8_STAGE(PG8_SB(1, 0), cB + kstep, voffB); PG8_STAGE(PG8_SA(1, 0), cA + kstep, voffA); PG8_STAGE(PG8_SB(1, 1), cB + hstep + kstep, voffB);
        PG8_WAIT_V(6); PG8_BAR;
    }
    for (;;) {
        const bool has_next = S.next(ui + 1, nxt);
        const char* nA = has_next ? (const char*)g.A + (size_t)nxt.pm * tstep : cA; const char* nB = has_next ? (const char*)g.Bt + (size_t)nxt.pn * tstep : cB;
        for (int t = 0; t < nt; t += 2) {
            const bool last = (t == nt - 2);
            const char* a1 = cA + (size_t)(t + 1) * kstep;
            const char* a2 = last ? nA : cA + (size_t)(t + 2) * kstep; const char* b2 = last ? nB : cB + (size_t)(t + 2) * kstep;
            const char* a3 = a2 + kstep; const char* b3 = b2 + kstep;
            if (last && has_next) S.a_ready(nxt);
            if constexpr (SP2) {
            PG8_LDB(B0, 0, 0); PG8_LDB(B1, 0, 1); PG8_SCHED; PG8_LDA(At, 0, 0); PG8_STAGE(PG8_SA(1, 1), a1 + hstep, voffA);
            PG8_WAIT_V(8); PG8_WAIT_L(0); PG8_BAR; PG8_MMA(0, 0, At, B0); PG8_MMA(0, 1, At, B1); PG8_BAR; PG8_SCHED;
            PG8_LDA(At, 0, 1); PG8_STAGE(PG8_SB(0, 0), b2, voffB); PG8_STAGE(PG8_SB(0, 1), b2 + hstep, voffB); PG8_STAGE(PG8_SA(0, 0), a2, voffA);
            PG8_WAIT_V(8); PG8_WAIT_L(0); PG8_BAR; PG8_MMA(1, 0, At, B0); PG8_MMA(1, 1, At, B1); PG8_BAR; PG8_SCHED;
            PG8_LDB(B0, 1, 0); PG8_LDB(B1, 1, 1); PG8_SCHED; PG8_LDA(At, 1, 0); PG8_STAGE(PG8_SA(0, 1), a2 + hstep, voffA);
            PG8_WAIT_V(8); PG8_WAIT_L(0); PG8_BAR; PG8_MMA(0, 0, At, B0); PG8_MMA(0, 1, At, B1); PG8_BAR; PG8_SCHED;
            PG8_LDA(At, 1, 1); PG8_STAGE(PG8_SB(1, 0), b3, voffB); PG8_STAGE(PG8_SB(1, 1), b3 + hstep, voffB); PG8_STAGE(PG8_SA(1, 0), a3, voffA);
            PG8_WAIT_V(8); PG8_WAIT_L(0); PG8_BAR; PG8_MMA(1, 0, At, B0); PG8_MMA(1, 1, At, B1); PG8_BAR; PG8_SCHED;
            } else {
            PG8_LDB(B0, 0, 0); PG8_SCHED; PG8_LDA(At, 0, 0); PG8_STAGE(PG8_SA(1, 1), a1 + hstep, voffA);
            PG8_WAIT_L(8); PG8_BAR; PG8_WAIT_L(0); PG8_MMA(0, 0, At, B0); PG8_BAR; PG8_SCHED;
            PG8_LDB(B1, 0, 1); PG8_STAGE(PG8_SB(0, 0), b2, voffB);
            PG8_BAR; PG8_WAIT_L(0); PG8_MMA(0, 1, At, B1); PG8_BAR;
            PG8_LDA(At, 0, 1); PG8_STAGE(PG8_SA(0, 0), a2, voffA);
            PG8_BAR; PG8_WAIT_L(0); PG8_MMA(1, 0, At, B0); PG8_BAR; PG8_SCHED;
            PG8_STAGE(PG8_SB(0, 1), b2 + hstep, voffB);
            PG8_WAIT_V(6); PG8_BAR; PG8_MMA(1, 1, At, B1); PG8_BAR;
            PG8_LDB(B0, 1, 0); PG8_SCHED; PG8_LDA(At, 1, 0); PG8_STAGE(PG8_SA(0, 1), a2 + hstep, voffA);
            PG8_WAIT_L(8); PG8_BAR; PG8_WAIT_L(0); PG8_MMA(0, 0, At, B0); PG8_BAR; PG8_SCHED;
            PG8_LDB(B1, 1, 1); PG8_STAGE(PG8_SB(1, 0), b3, voffB);
            PG8_BAR; PG8_WAIT_L(0); PG8_MMA(0, 1, At, B1); PG8_BAR;
            PG8_LDA(At, 1, 1); PG8_STAGE(PG8_SA(1, 0), a3, voffA);
            PG8_BAR; PG8_WAIT_L(0); PG8_MMA(1, 0, At, B0); PG8_BAR; PG8_SCHED;
            PG8_STAGE(PG8_SB(1, 1), b3 + hstep, voffB);
            PG8_WAIT_V(6); PG8_BAR; PG8_MMA(1, 1, At, B1); PG8_BAR;
            }
        }
        if constexpr (ALIGN_EPI) { if (wr == 0) PG8_BAR; }
#pragma unroll
        for (int a_ = 0; a_ < 2; ++a_)
#pragma unroll
            for (int b_ = 0; b_ < 2; ++b_) asm volatile("s_nop 15\n\ts_nop 15" : "+v"(acc[a_][b_][0][0]), "+v"(acc[a_][b_][0][1]), "+v"(acc[a_][b_][1][0]), "+v"(acc[a_][b_][1][1]), "+v"(acc[a_][b_][2][0]), "+v"(acc[a_][b_][2][1]), "+v"(acc[a_][b_][3][0]), "+v"(acc[a_][b_][3][1]));
        if constexpr (!Epi::AFTER_DRAIN) { int fr_ = fr, fq_ = fq; asm volatile("" : "+v"(fr_), "+v"(fq_));
            E(acc, cur, wr, wc, fr_, fq_); S.done(cur); }
        if (!has_next) break;
#pragma unroll
        for (int a = 0; a < 2; ++a)
#pragma unroll
            for (int b = 0; b < 2; ++b)
#pragma unroll
                for (int m = 0; m < 4; ++m)
#pragma unroll
                    for (int n = 0; n < 2; ++n) acc[a][b][m][n] = (f32x4){0.f, 0.f, 0.f, 0.f};
        cur = nxt; cA = nA; cB = nB; ++ui;
        if constexpr (ALIGN_EPI) { if (wr == 1) PG8_BAR; }
    }
    PG8_WAIT_V(0);
    if constexpr (!ALIGN_EPI) { if (wr == 0) PG8_BAR; }
    PG8_BAR;
    if constexpr (Epi::AFTER_DRAIN) { E.fused(acc, cur, wr, wc, fr, fq, lds, wid, lane); S.done(cur); }
#undef PG8_SA
#undef PG8_SB
#undef PG8_STAGE
#undef PG8_LDA
#undef PG8_LDB
#undef PG8_MMA
#undef PG8_WAIT_V
#undef PG8_WAIT_L
#undef PG8_BAR
#undef PG8_SCHED
}
}
constexpr int NT = 16384, DM = 2048, SEQ = 4096, NBATCH = 4, NLAYER = 2;
constexpr int LDP = 8448, NGATE = 10240, NIN = 18688, PIN = 18480;
constexpr int C_NAQ = 0, C_NAK = 512, C_NAV = 1024, C_GLQ = 1536, C_GLK = 1792, C_GLV = 2048, C_GLLR = 2560, C_GLOG = 2592, C_GDQKV = 3104, C_GDA = 4640, C_GDB = 4648,
              C_GDOG = 4656, C_HGQ = 5168, C_HGF = 5680, C_HGI = 6704, C_HGOG = 7216, C_MQ = 7728, C_PEND = 8240;
constexpr int DFF = 5632, DFFE = 7168, NEXP = 8, MAXSLOT = 34816;
constexpr float RMS_EPS = 1e-6f;
constexpr size_t MiB = 1u << 20;
constexpr size_t WS_CTL = 0, CTL_ZERO_BYTES = 1 * MiB;
constexpr size_t WS_ROUTE = 1 * MiB;
constexpr size_t WS_MK = 2 * MiB;
constexpr size_t WS_MVT = 4 * MiB;
constexpr size_t WS_KVRAW = 6 * MiB;
constexpr size_t WS_MEMN = 14 * MiB;
constexpr size_t WS_WIN = 24 * MiB;
constexpr size_t WS_WBR = WS_WIN + 146 * MiB;
constexpr size_t WS_WOUT = WS_WBR + 20 * MiB;
constexpr size_t WS_WMKV = WS_WOUT + 16 * MiB;
constexpr size_t WS_WGU = WS_WMKV + 8 * MiB;
constexpr size_t WS_WDN = WS_WGU + 44 * MiB;
constexpr size_t WS_MOE1 = WS_WDN + 22 * MiB;
constexpr size_t WS_MOE2 = WS_MOE1 + 448 * MiB;
constexpr size_t WS_OA = WS_MOE1 + 224 * MiB, WS_MOE2F = WS_MOE2 + 112 * MiB;
constexpr size_t WS_HM = WS_MOE2 + 224 * MiB;
constexpr size_t WS_P = WS_HM + 64 * MiB;
constexpr size_t WS_G = WS_P + 264 * MiB;
constexpr size_t WS_GLG = WS_G + 320 * MiB;
constexpr size_t WS_GQ = WS_GLG + 32 * MiB;
constexpr size_t WS_GAB = WS_GQ + 48 * MiB;
constexpr size_t WS_HQ = WS_GAB + 1 * MiB;
constexpr size_t WS_HF = WS_HQ + 16 * MiB;
constexpr size_t WS_NAVT = WS_HF + 64 * MiB;
constexpr size_t WS_SOUT = WS_NAVT + 16 * MiB;
constexpr size_t WS_BR = WS_SOUT + 96 * MiB;
constexpr size_t WS_H8 = WS_BR + 80 * MiB;
constexpr size_t WS_END = WS_H8 + 32 * MiB;
constexpr size_t WS_HID = WS_P;
constexpr size_t WS_XB = WS_P;
constexpr size_t WS_HIDM = WS_XB + 136 * MiB;
constexpr size_t WS_YB = WS_HIDM + 476 * MiB;
static_assert(WS_YB + 272 * MiB <= WS_END, "MoE overlay fits");
static_assert(WS_END <= 2085645600ull, "workspace map fits sum(inputs)");
constexpr int CW_TMO = 0, CW_CODE = 1, CW_BAR = 4096, CW_WQ = 8192, CW_CNT = 8192 + 1024, CW_CONVQ = 8192 + 2048, CW_S2DONE = 8192 + 2048 + 64, CW_GQ = 16384;
constexpr int RING_OFF = 0, RING_BYTES = 131072, LDSCTL_OFF = RING_BYTES, MISC_OFF = LDSCTL_OFF + 320, TAB_OFF = LDSCTL_OFF + 512, LDS_BYTES = 147456;
constexpr int NWAVES = 8;
#ifndef MK_SPLIT
#define MK_SPLIT 0
#endif
#define GAS __attribute__((address_space(1)))
#define LAS __attribute__((address_space(3)))
typedef unsigned short bf16;
typedef unsigned v4u __attribute__((ext_vector_type(4)));
typedef float f32x4 __attribute__((ext_vector_type(4)));
typedef short bf16x8 __attribute__((ext_vector_type(8)));
typedef GAS unsigned gu32;
typedef GAS unsigned long long gu64;
#define RLX_AGENT __ATOMIC_RELAXED, __HIP_MEMORY_SCOPE_AGENT
#define LDS_WAIT() asm volatile("s_waitcnt lgkmcnt(0)" ::: "memory")
#define VM_WAIT() asm volatile("s_waitcnt vmcnt(0)" ::: "memory")
__device__ __forceinline__ unsigned long long rt() { return __builtin_amdgcn_s_memrealtime(); }
__device__ __forceinline__ unsigned f2bf(float f) { unsigned u = __builtin_bit_cast(unsigned, f); return (u + 0x7fffu + ((u >> 16) & 1u)) >> 16; }
__device__ __forceinline__ unsigned pk2(float lo, float hi) { return f2bf(lo) | (f2bf(hi) << 16); }
constexpr int WAVETAB_OFF = 131072 + 1024;
__device__ __forceinline__ unsigned hw_slot() { return (unsigned)__builtin_amdgcn_s_getreg((5 << 11) | 4) & 63u; }
__device__ __forceinline__ int mk_lane() { return (int)__builtin_amdgcn_mbcnt_hi(~0u, __builtin_amdgcn_mbcnt_lo(~0u, 0u)); }
__device__ __forceinline__ int mk_wave() { extern __shared__ __attribute__((aligned(16))) unsigned char lds_raw_[]; const volatile LAS int* tab = (const volatile LAS int*)((LAS unsigned char*)lds_raw_ + WAVETAB_OFF); return __builtin_amdgcn_readfirstlane(tab[hw_slot()]); }
__device__ __forceinline__ int mk_tid() { return mk_wave() * 64 + mk_lane(); }
__device__ __forceinline__ int pg8_tid() { return mk_tid(); }
#define XB_TMO      128
#define XB_XCNT(j)  (256  + 64 * (j))
#define XB_XSUB(j)  (1280 + 64 * (j))
#define XB_XGEN(j)  (2304 + 64 * (j))
#define XB_TOP      3328
#define XB_TOPGEN   3392
#define XCD_BAR_WORDS 3456
#define XB_SPIN_CAP (1u << 22)

__device__ __forceinline__ unsigned xb_ld(unsigned* p)              { return __hip_atomic_load(p, __ATOMIC_RELAXED, __HIP_MEMORY_SCOPE_AGENT); }
__device__ __forceinline__ unsigned xb_add(unsigned* p, unsigned v) { return __hip_atomic_fetch_add(p, v, __ATOMIC_RELAXED, __HIP_MEMORY_SCOPE_AGENT); }
__device__ __forceinline__ unsigned xb_xcc_id() { return (unsigned)__builtin_amdgcn_s_getreg((3 << 11) | 20) & 0xFu; }
#define XB_SPIN(cond, bar) do { unsigned _sp = 0; while (cond) { __builtin_amdgcn_s_sleep(1); \
    if ((++_sp & 255u) == 0u) { if (xb_ld(&(bar)[XB_TMO])) break; if (_sp > XB_SPIN_CAP) { atomicAdd(&(bar)[XB_TMO], 1u); break; } } } } while (0)

struct XcdBarrier {
    unsigned* bar; unsigned x;
    volatile LAS unsigned* st;
};

__device__ __forceinline__ XcdBarrier xcd_barrier_post(unsigned* bar, volatile LAS unsigned* st) {
    XcdBarrier b; b.bar = bar; b.x = xb_xcc_id(); b.st = st;
    if (mk_tid() == 0) (void)xb_add(&bar[XB_XCNT(b.x)], 1u);
    return b;
}
__device__ __forceinline__ void xcd_barrier_complete(unsigned* bar, unsigned x, unsigned& nloc, unsigned& nx) {
    const unsigned G = gridDim.x * gridDim.y * gridDim.z;
    unsigned sum, cnt, mine, sp = 0u;
    for (;;) {
        sum = 0u; cnt = 0u; mine = 0u;
#pragma unroll
        for (unsigned j = 0; j < 16; ++j) { const unsigned c = xb_ld(&bar[XB_XCNT(j)]); sum += c; cnt += (c > 0u) ? 1u : 0u; mine = (j == x) ? c : mine; }
        if (sum == G) break;
        __builtin_amdgcn_s_sleep(1);
        if ((++sp & 255u) == 0u) { if (xb_ld(&bar[XB_TMO])) break; if (sp > XB_SPIN_CAP) { atomicAdd(&bar[XB_TMO], 1u); break; } }
    }
    nloc = mine > 0u ? mine : 1u; nx = cnt > 0u ? cnt : 1u;
}

__device__ __forceinline__ void xcd_barrier(const XcdBarrier& b) {
    asm volatile("s_waitcnt vmcnt(0)" ::: "memory");
    __syncthreads();
    if (mk_tid() == 0) {
        unsigned* bar = b.bar;
        __builtin_amdgcn_s_waitcnt(0);
        unsigned nloc = b.st[0], nx = b.st[1];
        if (nloc == 0u) { xcd_barrier_complete(bar, b.x, nloc, nx); b.st[0] = nloc; b.st[1] = nx; }
        const unsigned old = xb_add(&bar[XB_XSUB(b.x)], 1u);
        const unsigned gen = old / nloc;
        if (old + 1u == (gen + 1u) * nloc) {
            __builtin_amdgcn_fence(__ATOMIC_RELEASE, "agent");
            asm volatile("s_waitcnt vmcnt(0)" ::: "memory");
            const unsigned og = xb_add(&bar[XB_TOP], 1u);
            const unsigned tg = og / nx;
            if (og + 1u == (tg + 1u) * nx) xb_add(&bar[XB_TOPGEN], 1u);
            else XB_SPIN(xb_ld(&bar[XB_TOPGEN]) == tg, bar);
            __builtin_amdgcn_fence(__ATOMIC_ACQUIRE, "agent");
            xb_add(&bar[XB_XGEN(b.x)], 1u);
            asm volatile("s_waitcnt vmcnt(0)" ::: "memory");
        } else {
            XB_SPIN(xb_ld(&bar[XB_XGEN(b.x)]) == gen, bar);
            __builtin_amdgcn_fence(__ATOMIC_ACQUIRE, "agent");
            asm volatile("s_waitcnt vmcnt(0)" ::: "memory");
        }
    }
    __syncthreads();
}
typedef unsigned v2u __attribute__((ext_vector_type(2)));
typedef float f32x2v __attribute__((ext_vector_type(2)));
__device__ __forceinline__ float bflo(unsigned w) { return __uint_as_float(w << 16); }
__device__ __forceinline__ float bfhi(unsigned w) { return __uint_as_float(w & 0xffff0000u); }
__device__ __forceinline__ float bf1(bf16 h) { return __uint_as_float(((unsigned)h) << 16); }
typedef __bf16 bf16x2_t __attribute__((ext_vector_type(2)));
__device__ __forceinline__ unsigned pkbf(float lo, float hi) { const f32x2v v = {lo, hi}; return __builtin_bit_cast(unsigned, __builtin_convertvector(v, bf16x2_t)); }
__device__ __forceinline__ void unpack8(const v4u w, float (&f)[8]) { f[0] = bflo(w.x); f[1] = bfhi(w.x); f[2] = bflo(w.y); f[3] = bfhi(w.y); f[4] = bflo(w.z); f[5] = bfhi(w.z); f[6] = bflo(w.w); f[7] = bfhi(w.w); }
__device__ __forceinline__ v4u pack8(const float (&f)[8]) { v4u w; w.x = pkbf(f[0], f[1]); w.y = pkbf(f[2], f[3]); w.z = pkbf(f[4], f[5]); w.w = pkbf(f[6], f[7]); return w; }
__device__ __forceinline__ float sigmf(float x) { return __builtin_amdgcn_rcpf(1.0f + __expf(-x)); }
__device__ __forceinline__ float siluf(float x) { return x * __builtin_amdgcn_rcpf(1.0f + __expf(-x)); }
__device__ __forceinline__ float softplusf(float x) { return fmaxf(x, 0.f) + __logf(1.0f + __expf(-fabsf(x))); }
#define DPP_ADD(v, ctrl) ((v) + __int_as_float(__builtin_amdgcn_update_dpp(0, __float_as_int(v), (ctrl), 0xF, 0xF, true)))
__device__ __forceinline__ float row16_sum(float v) { v = DPP_ADD(v, 0xB1); v = DPP_ADD(v, 0x4E); v = DPP_ADD(v, 0x141); v = DPP_ADD(v, 0x140); return v; }
__device__ __forceinline__ float wave_sum(float v) { v = row16_sum(v); v += __shfl_xor(v, 16); v += __shfl_xor(v, 32); return v; }
template <int N> __device__ __forceinline__ float group_sum(float v) {
    v = DPP_ADD(v, 0xB1); v = DPP_ADD(v, 0x4E); v = DPP_ADD(v, 0x141); if (N == 16) v = DPP_ADD(v, 0x140);
    return v;
}
template <int KL> __device__ __forceinline__ float kl_sum(float v) {
    v = DPP_ADD(v, 0xB1); v = DPP_ADD(v, 0x4E); v = DPP_ADD(v, 0x141);
    if (KL == 16) v = DPP_ADD(v, 0x140);
    return v;
}
__device__ __forceinline__ unsigned pk4_f8(float a, float b, float c, float d);
__device__ __forceinline__ void rms_row(const float* xrow, const float* gain, bf16* orow, int lane, f32x4 (&v)[8], unsigned char* o8row = nullptr) {
    const f32x4* xr = (const f32x4*)xrow + lane; float s = 0.f;
#pragma unroll
    for (int j = 0; j < 8; ++j) { v[j] = xr[64 * j]; s += (v[j].x * v[j].x + v[j].y * v[j].y) + (v[j].z * v[j].z + v[j].w * v[j].w); }
    const float sc = rsqrtf(wave_sum(s) * (1.0f / DM) + RMS_EPS);
    const f32x4* gr = (const f32x4*)gain + lane; v2u* o8 = (v2u*)orow + lane;
#pragma unroll
    for (int j = 0; j < 8; ++j) { v[j] = v[j] * sc * gr[64 * j]; v2u w; w.x = pkbf(v[j].x, v[j].y); w.y = pkbf(v[j].z, v[j].w); o8[64 * j] = w;
        if (o8row) ((unsigned*)o8row)[lane + 64 * j] = pk4_f8(v[j].x, v[j].y, v[j].z, v[j].w); }
}
__device__ __forceinline__ unsigned pk4_f8(float a, float b, float c, float d);
__device__ __forceinline__ void rms_row_f8(const float* xrow, const float* gain, unsigned char* orow, int lane, f32x4 (&v)[8]) {
    const f32x4* xr = (const f32x4*)xrow + lane; float s = 0.f;
#pragma unroll
    for (int j = 0; j < 8; ++j) { v[j] = xr[64 * j]; s += (v[j].x * v[j].x + v[j].y * v[j].y) + (v[j].z * v[j].z + v[j].w * v[j].w); }
    const float sc = rsqrtf(wave_sum(s) * (1.0f / DM) + RMS_EPS);
    const f32x4* gr = (const f32x4*)gain + lane; unsigned* o4 = (unsigned*)orow + lane;
#pragma unroll
    for (int j = 0; j < 8; ++j) { v[j] = v[j] * sc * gr[64 * j]; o4[64 * j] = pk4_f8(v[j].x, v[j].y, v[j].z, v[j].w); }
}
__device__ __forceinline__ unsigned pk4_f8(float a, float b, float c, float d) { int w = __builtin_amdgcn_cvt_pk_fp8_f32(a, b, 0, false); w = __builtin_amdgcn_cvt_pk_fp8_f32(c, d, w, true); return (unsigned)w; }
struct RmOff { int off; __device__ __forceinline__ int operator()(int n) const { return n + off; } };
struct RmWin { __device__ __forceinline__ int operator()(int n) const { return n < C_PEND ? n : n + (LDP - C_PEND); } };
struct RmGU { int up; __device__ __forceinline__ int operator()(int n) const { return (n >> 7) * 256 + (n & 127) + up * 128; } };
__device__ __forceinline__ void tr_load(float (&v)[64], const float* W, int ldw, int N, int nblk, int it, int lane) {
    const int kb = it / nblk, nb = it % nblk; const int n = 64 * nb + lane; const bool ok = n < N; const float* p = W + (size_t)(64 * kb) * ldw + (ok ? n : 0);
#pragma unroll
    for (int kk = 0; kk < 64; ++kk) v[kk] = p[(size_t)kk * ldw];
    if (!ok) {
#pragma unroll
        for (int kk = 0; kk < 64; ++kk) v[kk] = 0.f; }
}
template <class RowMap> __device__ __forceinline__ void tr_store(const float (&v)[64], int K, int N, int nblk, int it, bf16* WT, LAS unsigned* scr, int lane, const RowMap& rm) {
    const int kb = it / nblk, nb = it % nblk;
#pragma unroll
    for (int kp = 0; kp < 32; ++kp) scr[lane * 33 + kp] = pkbf(v[2 * kp], v[2 * kp + 1]);
    LDS_WAIT(); asm volatile("" ::: "memory");
    const int c = lane & 7;
#pragma unroll
    for (int j = 0; j < 8; ++j) { const int nl = (lane >> 3) + 8 * j; const LAS unsigned* s = scr + nl * 33 + 4 * c; v4u o; o.x = s[0]; o.y = s[1]; o.z = s[2]; o.w = s[3];
        const int n = 64 * nb + nl; if (n < N) *(GAS v4u*)(WT + (size_t)rm(n) * K + 64 * kb + 8 * c) = o; }
    LDS_WAIT(); asm volatile("" ::: "memory");
}
template <class RowMap> __device__ __forceinline__ void transpose_job(const float* W, int K, int N, bf16* WT, LAS float* scr_f, int gw, int NGW, int lane, const RowMap& rm, int ldw = 0) {
    if (!ldw) ldw = N;
    LAS unsigned* scr = (LAS unsigned*)scr_f; const int nblk = (N + 63) / 64, nit = (K / 64) * nblk;
    float va[64], vb[64]; int it = gw;
    if (it < nit) tr_load(va, W, ldw, N, nblk, it, lane);
#pragma unroll 1
    for (; it < nit; it += 2 * NGW) { const int it2 = it + NGW, it3 = it2 + NGW;
        if (it2 < nit) tr_load(vb, W, ldw, N, nblk, it2, lane);
        tr_store(va, K, N, nblk, it, WT, scr, lane, rm);
        if (it3 < nit) tr_load(va, W, ldw, N, nblk, it3, lane);
        if (it2 < nit) tr_store(vb, K, N, nblk, it2, WT, scr, lane, rm);
    }
}
template <class RowMap> __device__ __forceinline__ void tr_store_f8(const float (&v)[64], float scale, int K, int N, int nblk, int it, unsigned char* WT, LAS unsigned* scr, int lane, const RowMap& rm) {
    const int kb = it / nblk, nb = it % nblk;
#pragma unroll
    for (int q = 0; q < 16; ++q) scr[lane * 17 + q] = pk4_f8(v[4 * q] * scale, v[4 * q + 1] * scale, v[4 * q + 2] * scale, v[4 * q + 3] * scale);
    LDS_WAIT(); asm volatile("" ::: "memory");
    const int c = lane & 3;
#pragma unroll
    for (int j = 0; j < 4; ++j) { const int nl = (lane >> 2) + 16 * j; const LAS unsigned* s = scr + nl * 17 + 4 * c; v4u o; o.x = s[0]; o.y = s[1]; o.z = s[2]; o.w = s[3];
        const int n = 64 * nb + nl; if (n < N) *(GAS v4u*)(WT + (size_t)rm(n) * K + 64 * kb + 16 * c) = o; }
    LDS_WAIT(); asm volatile("" ::: "memory");
}
template <class RowMap> __device__ __forceinline__ void transpose_job_f8(const float* W, float scale, int K, int N, unsigned char* WT, LAS float* scr_f, int gw, int NGW, int lane, const RowMap& rm, int ldw = 0) {
    if (!ldw) ldw = N;
    LAS unsigned* scr = (LAS unsigned*)scr_f; const int nblk = (N + 63) / 64, nit = (K / 64) * nblk;
    float va[64], vb[64]; int it = gw;
    if (it < nit) tr_load(va, W, ldw, N, nblk, it, lane);
#pragma unroll 1
    for (; it < nit; it += 2 * NGW) { const int it2 = it + NGW, it3 = it2 + NGW;
        if (it2 < nit) tr_load(vb, W, ldw, N, nblk, it2, lane);
        tr_store_f8(va, scale, K, N, nblk, it, WT, scr, lane, rm);
        if (it3 < nit) tr_load(va, W, ldw, N, nblk, it3, lane);
        if (it2 < nit) tr_store_f8(vb, scale, K, N, nblk, it2, WT, scr, lane, rm);
    }
}
__device__ __forceinline__ void moe1_convert_all(const float* wg, const float* wu, unsigned char* MOE1, LAS float* scr_f, int gw, int NGW, int lane) {
    LAS unsigned* scr = (LAS unsigned*)scr_f; constexpr int NB = DFFE / 64, TPJ = (DM / 64) * NB, NIT = 16 * TPJ;
    float va[64], vb[64]; int it = gw;
#define M1_SRC(t) (((((t) / TPJ) & 1) ? wu : wg) + (size_t)(((t) / TPJ) >> 1) * DM * DFFE)
#define M1_DST(t) (MOE1 + (size_t)(((t) / TPJ) >> 1) * 2 * DFFE * DM)
    if (it < NIT) tr_load(va, M1_SRC(it), DFFE, DFFE, NB, it % TPJ, lane);
#pragma unroll 1
    for (; it < NIT; it += 2 * NGW) { const int it2 = it + NGW, it3 = it2 + NGW;
        if (it2 < NIT) tr_load(vb, M1_SRC(it2), DFFE, DFFE, NB, it2 % TPJ, lane);
        tr_store_f8(va, 64.0f, DM, DFFE, NB, it % TPJ, M1_DST(it), scr, lane, RmGU{(it / TPJ) & 1});
        if (it3 < NIT) tr_load(va, M1_SRC(it3), DFFE, DFFE, NB, it3 % TPJ, lane);
        if (it2 < NIT) tr_store_f8(vb, 64.0f, DM, DFFE, NB, it2 % TPJ, M1_DST(it2), scr, lane, RmGU{(it2 / TPJ) & 1});
    }
#undef M1_SRC
#undef M1_DST
}
struct RmGen { int kind, off; __device__ __forceinline__ int operator()(int n) const { return kind ? (n >> 7) * 256 + (n & 127) + off * 128 : n + off; } };
struct P0Job { const float* W; int ldw, N, K, nblk, loc, f8; unsigned char* WT; RmGen rm; };
__device__ __forceinline__ P0Job p0_job(int t, const float* w_in, const float* w_br, const float* w_out, const float* w_kv, const float* f_gate, const float* f_up, const float* f_down, unsigned char* ws) {
    P0Job j; j.f8 = 0; j.rm = RmGen{0, 0};
    constexpr int T_P = 32 * 129, T_G = 32 * 160, T_B = 8 * 32, T_O = 32 * 32, T_K = 32 * 16, T_L = T_P + T_G + 5 * T_B + T_O + T_K, T_D = 32 * 88;
    if (t < 2 * T_L) { const int L = t / T_L; int r = t % T_L;
        if (r < T_P) { j.W = w_in + (size_t)L * DM * PIN; j.ldw = PIN; j.N = C_PEND; j.K = DM; j.nblk = 129; j.loc = r; j.WT = ws + WS_WIN + (size_t)L * NIN * DM * 2; return j; } r -= T_P;
        if (r < T_G) { j.W = w_in + (size_t)L * DM * PIN + C_PEND; j.ldw = PIN; j.N = NGATE; j.K = DM; j.nblk = 160; j.loc = r; j.f8 = 1; j.WT = ws + WS_WIN + ((size_t)L * NIN + LDP) * DM * 2; return j; } r -= T_G;
        if (r < 5 * T_B) { const int n = r / T_B; j.W = w_br + (size_t)(L * 5 + n) * 512 * DM; j.ldw = DM; j.N = DM; j.K = 512; j.nblk = 32; j.loc = r % T_B; j.WT = ws + WS_WBR + (size_t)(L * 5 + n) * DM * 512 * 2; return j; } r -= 5 * T_B;
        if (r < T_O) { j.W = w_out + (size_t)L * DM * DM; j.ldw = DM; j.N = DM; j.K = DM; j.nblk = 32; j.loc = r; j.WT = ws + WS_WOUT + (size_t)L * DM * DM * 2; return j; } r -= T_O;
        j.W = w_kv + (size_t)L * DM * 1024; j.ldw = 1024; j.N = 1024; j.K = DM; j.nblk = 16; j.loc = r; j.WT = ws + WS_WMKV + (size_t)L * 1024 * DM * 2; return j; }
    int r = t - 2 * T_L;
    if (r < 2 * T_D) { const int up = r / T_D; j.W = up ? f_up : f_gate; j.ldw = DFF; j.N = DFF; j.K = DM; j.nblk = 88; j.loc = r % T_D; j.WT = ws + WS_WGU; j.rm = RmGen{1, up}; return j; } r -= 2 * T_D;
    j.W = f_down; j.ldw = DM; j.N = DM; j.K = DFF; j.nblk = 32; j.loc = r; j.WT = ws + WS_WDN; return j;
}
constexpr int P0_TILES = 2 * (32 * 129 + 32 * 160 + 5 * 8 * 32 + 32 * 32 + 32 * 16) + 3 * 32 * 88;
__device__ __forceinline__ void p0_store(const float (&v)[64], const P0Job& j, LAS unsigned* scr, int lane) {
    if (j.f8) tr_store_f8(v, 64.0f, j.K, j.N, j.nblk, j.loc, j.WT, scr, lane, j.rm); else tr_store(v, j.K, j.N, j.nblk, j.loc, (bf16*)j.WT, scr, lane, j.rm);
}
__device__ __forceinline__ void phase0_convert_all(const float* w_in, const float* w_br, const float* w_out, const float* w_kv, const float* f_gate, const float* f_up, const float* f_down, unsigned char* ws, LAS float* scr_f, int gw, int NGW, int lane) {
    LAS unsigned* scr = (LAS unsigned*)scr_f; float va[64], vb[64]; int it = gw;
    P0Job ja = p0_job(it < P0_TILES ? it : 0, w_in, w_br, w_out, w_kv, f_gate, f_up, f_down, ws), jb = ja;
    if (it < P0_TILES) tr_load(va, ja.W, ja.ldw, ja.N, ja.nblk, ja.loc, lane);
#pragma unroll 1
    for (; it < P0_TILES; it += 2 * NGW) { const int it2 = it + NGW, it3 = it2 + NGW;
        if (it2 < P0_TILES) { jb = p0_job(it2, w_in, w_br, w_out, w_kv, f_gate, f_up, f_down, ws); tr_load(vb, jb.W, jb.ldw, jb.N, jb.nblk, jb.loc, lane); }
        p0_store(va, ja, scr, lane);
        if (it3 < P0_TILES) { ja = p0_job(it3, w_in, w_br, w_out, w_kv, f_gate, f_up, f_down, ws); tr_load(va, ja.W, ja.ldw, ja.N, ja.nblk, ja.loc, lane); }
        if (it2 < P0_TILES) p0_store(vb, jb, scr, lane);
    }
}
constexpr int MQ_GU = 16 * 32 * 112, MQ_TILES = MQ_GU + 2 * 112 * 32, MQ_GRAB = 16;
__device__ __forceinline__ P0Job moe_job(int t, const float* wg, const float* wu, const float* wd, unsigned char* ws) {
    P0Job j; j.f8 = 1; constexpr int TPJ = 32 * 112;
    if (t < MQ_GU) { const int jb = t / TPJ, e = jb >> 1, up = jb & 1; j.W = (up ? wu : wg) + (size_t)e * DM * DFFE; j.ldw = DFFE; j.N = DFFE; j.K = DM; j.nblk = 112; j.loc = t % TPJ; j.WT = ws + WS_MOE1 + (size_t)e * 2 * DFFE * DM; j.rm = RmGen{1, up}; return j; }
    const int r = t - MQ_GU, e = 6 + r / TPJ; j.W = wd + (size_t)e * DFFE * DM; j.ldw = DM; j.N = DM; j.K = DFFE; j.nblk = 32; j.loc = r % TPJ; j.WT = ws + WS_MOE2F + (size_t)e * DM * DFFE; j.rm = RmGen{0, 0}; return j;
}
__device__ __forceinline__ unsigned mq_grab(gu32* q, const gu32* stop, unsigned stop_val) {
    if (stop && __hip_atomic_load(stop, RLX_AGENT) >= stop_val) return 0x7fffffffu;
    return __hip_atomic_fetch_add(q, (unsigned)MQ_GRAB, RLX_AGENT);
}
__device__ __forceinline__ void moe_drain(const float* wg, const float* wu, const float* wd, unsigned char* ws, gu32* q, const gu32* stop, unsigned stop_val, volatile LAS unsigned* slot, LAS float* scr_f, int wave, int lane, int tid) {
    LAS unsigned* scr = (LAS unsigned*)scr_f; float va[64], vb[64];
    __syncthreads();
    if (tid == 0) slot[0] = mq_grab(q, stop, stop_val);
    __syncthreads();
    unsigned t = slot[0]; int i = 0; P0Job ja, jb;
    if (t < (unsigned)MQ_TILES) { ja = moe_job((int)t + 2 * wave, wg, wu, wd, ws); tr_load(va, ja.W, ja.ldw, ja.N, ja.nblk, ja.loc, lane); jb = moe_job((int)t + 2 * wave + 1, wg, wu, wd, ws); tr_load(vb, jb.W, jb.ldw, jb.N, jb.nblk, jb.loc, lane); }
#pragma unroll 1
    while (t < (unsigned)MQ_TILES) {
        if (tid == 0) slot[(i + 1) & 1] = mq_grab(q, stop, stop_val);
        tr_store_f8(va, 64.0f, ja.K, ja.N, ja.nblk, ja.loc, ja.WT, scr, lane, ja.rm);
        __syncthreads();
        const unsigned tn = slot[(i + 1) & 1];
        if (tn < (unsigned)MQ_TILES) { ja = moe_job((int)tn + 2 * wave, wg, wu, wd, ws); tr_load(va, ja.W, ja.ldw, ja.N, ja.nblk, ja.loc, lane); }
        tr_store_f8(vb, 64.0f, jb.K, jb.N, jb.nblk, jb.loc, jb.WT, scr, lane, jb.rm);
        if (tn < (unsigned)MQ_TILES) { jb = moe_job((int)tn + 2 * wave + 1, wg, wu, wd, ws); tr_load(vb, jb.W, jb.ldw, jb.N, jb.nblk, jb.loc, lane); }
        t = tn; ++i;
    }
}
struct LayerPtrs {
    const float *g_mix, *na_q_gain, *na_k_gain, *na_rel_bias, *gla_w_up, *gla_b, *gla_norm, *conv_w, *a_log, *dt_bias, *gdn_norm, *lb_raw0, *lb_raw1, *hg_norm, *mem_q_gain, *g_ffn;
};
__device__ __forceinline__ void prep_unit(int L, const LayerPtrs& lp, bf16* P, float* GLG, bf16* GQ, float* GAB, bf16* HQ, float* HF, bf16* NAVT, int t0, int lane) {
    const int b = t0 >> 12, s0 = t0 & 4095;
    float lbv[2][8];
#pragma unroll
    for (int d = 0; d < 2; ++d)
#pragma unroll
        for (int i = 0; i < 8; ++i) { const int c = d * 512 + lane * 8 + i; lbv[d][i] = L ? sigmf(lp.lb_raw1[c] - lp.lb_raw0[c]) : 0.f; }
#pragma unroll 1
    for (int tt = 0; tt < 8; ++tt) { bf16* pr = P + (size_t)(t0 + tt) * LDP;
        const v4u rq = *(const v4u*)(pr + C_NAQ + lane * 8), rk = *(const v4u*)(pr + C_NAK + lane * 8), rm = *(const v4u*)(pr + C_MQ + lane * 8), rh = *(const v4u*)(pr + C_HGQ + lane * 8),
                  rf0 = *(const v4u*)(pr + C_HGF + lane * 8), rf1 = *(const v4u*)(pr + C_HGF + 512 + lane * 8), rl0 = *(const v4u*)(pr + C_GLLR + (lane >> 5) * 16), rl1 = *(const v4u*)(pr + C_GLLR + (lane >> 5) * 16 + 8);
        const bf16 ra = pr[C_GDA + (lane & 15)];
#pragma unroll
        for (int qk = 0; qk < 2; ++qk) { bf16* p = pr + (qk ? C_NAK : C_NAQ) + lane * 8; float f[8]; unpack8(qk ? rk : rq, f);
            float ss = 0.f;
#pragma unroll
            for (int i = 0; i < 8; ++i) ss += f[i] * f[i];
            ss = group_sum<8>(ss); const float sc = rsqrtf(ss * (1.0f / 64.0f) + RMS_EPS) * (qk ? 1.0f : 0.125f);
            const float* gn = (qk ? lp.na_k_gain : lp.na_q_gain) + (lane & 7) * 8;
#pragma unroll
            for (int i = 0; i < 8; ++i) f[i] = f[i] * sc * gn[i];
            *(v4u*)p = pack8(f); }
        { bf16* p = pr + C_MQ + lane * 8; float f[8]; unpack8(rm, f); float ss = 0.f;
#pragma unroll
            for (int i = 0; i < 8; ++i) ss += f[i] * f[i];
            ss = group_sum<16>(ss); const float sc = rsqrtf(ss * (1.0f / 128.0f) + RMS_EPS) * 0.08838834764831845f; const float* gn = lp.mem_q_gain + (lane & 15) * 8;
#pragma unroll
            for (int i = 0; i < 8; ++i) f[i] = f[i] * sc * gn[i];
            *(v4u*)p = pack8(f); }
        { float f[8]; unpack8(rh, f);
#pragma unroll
            for (int i = 0; i < 8; ++i) f[i] = siluf(f[i]);
            *(v4u*)(HQ + (size_t)(t0 + tt) * 512 + lane * 8) = pack8(f);
#pragma unroll
            for (int d = 0; d < 2; ++d) { float z[8]; unpack8(d ? rf1 : rf0, z); float o[8];
#pragma unroll
                for (int i = 0; i < 8; ++i) { if (L) { const float lb = lbv[d][i]; o[i] = __logf(lb + (1.0f - lb) * sigmf(z[i])); } else o[i] = -softplusf(-z[i]); }
                float* hf = HF + (size_t)(t0 + tt) * 1024 + d * 512 + lane * 8;
                *(f32x4*)hf = (f32x4){o[0], o[1], o[2], o[3]}; *(f32x4*)(hf + 4) = (f32x4){o[4], o[5], o[6], o[7]}; } }
        { const int dir = lane >> 5, c8 = (lane & 31) * 8; float lr[16];
            { float t8[8]; unpack8(rl0, t8);
#pragma unroll
              for (int i = 0; i < 8; ++i) lr[i] = t8[i];
              unpack8(rl1, t8);
#pragma unroll
              for (int i = 0; i < 8; ++i) lr[8 + i] = t8[i]; }
            const float* bb = lp.gla_b + dir * 256 + c8; f32x4 a0 = *(const f32x4*)bb, a1 = *(const f32x4*)(bb + 4);
#pragma unroll
            for (int r = 0; r < 16; ++r) { const float* wp = lp.gla_w_up + (size_t)(dir * 16 + r) * 256 + c8; a0 = a0 + lr[r] * *(const f32x4*)wp; a1 = a1 + lr[r] * *(const f32x4*)(wp + 4); }
            f32x4 g0, g1;
#pragma unroll
            for (int i = 0; i < 4; ++i) { g0[i] = -softplusf(-a0[i]) * 0.0625f; g1[i] = -softplusf(-a1[i]) * 0.0625f; }
            float* gp = GLG + (size_t)(t0 + tt) * 512 + dir * 256 + c8; *(f32x4*)gp = g0; *(f32x4*)(gp + 4) = g1; }
        if (lane < 16) { const float val = bf1(ra); float o;
            if (lane < 8) o = -__expf(lp.a_log[lane]) * softplusf(val + lp.dt_bias[lane]); else o = sigmf(val);
            GAB[(size_t)(t0 + tt) * 16 + lane] = o; }
    }
#pragma unroll 1
    for (int j = 0; j < 3; ++j) { const int col = j * 512 + lane * 8; float w[5][8];
#pragma unroll
        for (int tap = 0; tap < 5; ++tap) { const float* wp = lp.conv_w + tap * 1536 + col; const f32x4 w0 = *(const f32x4*)wp, w1 = *(const f32x4*)(wp + 4);
            w[tap][0] = w0[0]; w[tap][1] = w0[1]; w[tap][2] = w0[2]; w[tap][3] = w0[3]; w[tap][4] = w1[0]; w[tap][5] = w1[1]; w[tap][6] = w1[2]; w[tap][7] = w1[3]; }
#pragma unroll 1
        for (int hf = 0; hf < 2; ++hf) {
        v4u xr[8];
#pragma unroll
        for (int r = 0; r < 8; ++r) { const int s = s0 + hf * 4 + r - 2; xr[r] = (v4u){0u, 0u, 0u, 0u}; if (s >= 0 && s < SEQ) xr[r] = *(const v4u*)(P + (size_t)((b << 12) + s) * LDP + C_GDQKV + col); }
#pragma unroll
        for (int t4 = 0; t4 < 4; ++t4) { const int tt = hf * 4 + t4; float acc[8]; __builtin_amdgcn_sched_barrier(0);
#pragma unroll
            for (int i = 0; i < 8; ++i) acc[i] = 0.f;
#pragma unroll
            for (int tap = 0; tap < 5; ++tap) { float x[8]; unpack8(xr[t4 + tap], x);
#pragma unroll
                for (int i = 0; i < 8; ++i) acc[i] += w[tap][i] * x[i]; }
#pragma unroll
            for (int i = 0; i < 8; ++i) acc[i] = siluf(acc[i]);
            if (j < 2) { float ss = 0.f;
#pragma unroll
                for (int i = 0; i < 8; ++i) ss += acc[i] * acc[i];
                ss = group_sum<16>(ss); const float sc = rsqrtf(ss + 1e-6f) * (j == 0 ? 0.08838834764831845f : 1.0f);
#pragma unroll
                for (int i = 0; i < 8; ++i) acc[i] *= sc; }
            *(v4u*)(GQ + (size_t)(t0 + tt) * 1536 + col) = pack8(acc); } } }
    { unsigned vw[8][4];
#pragma unroll
        for (int tt = 0; tt < 8; ++tt) { const v4u x = *(const v4u*)(P + (size_t)(t0 + tt) * LDP + C_NAV + lane * 8); vw[tt][0] = x.x; vw[tt][1] = x.y; vw[tt][2] = x.z; vw[tt][3] = x.w; }
#pragma unroll
        for (int i = 0; i < 8; ++i) { unsigned e[8];
#pragma unroll
            for (int tt = 0; tt < 8; ++tt) e[tt] = (i & 1) ? (vw[tt][i >> 1] >> 16) : (vw[tt][i >> 1] & 0xffffu);
            v4u o; o.x = e[0] | (e[1] << 16); o.y = e[2] | (e[3] << 16); o.z = e[4] | (e[5] << 16); o.w = e[6] | (e[7] << 16);
            *(v4u*)(NAVT + ((size_t)((b * 8 + (lane >> 3)) * 64 + (lane & 7) * 8 + i)) * SEQ + s0) = o; } }
}
__device__ __forceinline__ void post_token(const LayerPtrs& lp, const bf16* P, const bf16* SOUT, bf16* BR, int t, int lane) {
    const bf16* pr = P + (size_t)t * LDP;
#pragma unroll
    for (int br = 0; br < 3; ++br) {
        float a[8], c[8], og[8];
        unpack8(*(const v4u*)(SOUT + ((size_t)(br * 2 + 0) * NT + t) * 512 + lane * 8), a);
        unpack8(*(const v4u*)(SOUT + ((size_t)(br * 2 + 1) * NT + t) * 512 + lane * 8), c);
        unpack8(*(const v4u*)(pr + (br == 0 ? C_GLOG : br == 1 ? C_GDOG : C_HGOG) + lane * 8), og);
        const float qs = br == 0 ? 0.125f : 1.0f; float ss = 0.f;
#pragma unroll
        for (int i = 0; i < 8; ++i) { a[i] = (a[i] + c[i]) * qs; ss += a[i] * a[i]; }
        ss = group_sum<16>(ss); const float sc = rsqrtf(ss * (1.0f / 128.0f) + RMS_EPS);
        const float* gn = (br == 0 ? lp.gla_norm : br == 1 ? lp.gdn_norm : lp.hg_norm) + (lane & 15) * 8;
#pragma unroll
        for (int i = 0; i < 8; ++i) a[i] = a[i] * sc * gn[i] * (br == 2 ? sigmf(og[i]) : siluf(og[i]));
        *(v4u*)(BR + ((size_t)(1 + br) * NT + t) * 512 + lane * 8) = pack8(a);
    }
}
typedef short bf16x8 __attribute__((ext_vector_type(8)));
__device__ __forceinline__ bf16x8 as_bf16x8(v4u w) { return __builtin_bit_cast(bf16x8, w); }
#define MFMA16(a, b, c) __builtin_amdgcn_mfma_f32_16x16x32_bf16((a), (b), (c), 0, 0, 0)
typedef short bf16x4 __attribute__((ext_vector_type(4)));
__device__ __forceinline__ bf16x4 as_bf16x4(v2u w) { return __builtin_bit_cast(bf16x4, w); }
#define MFMA16K16(a, b, c) __builtin_amdgcn_mfma_f32_16x16x16bf16_1k((a), (b), (c), 0, 0, 0)
__device__ __forceinline__ void na_wave_unit(const bf16* P, const bf16* NAVT, const float* rel_bias, bf16* BR0, int b, int h, int r, int qc, int lane) {
    const int fr = lane & 15, g = lane >> 4; const int c = qc * 16 + fr;
    const int kc_lo = qc == 0 ? 0 : qc == 1 ? 8 : qc == 2 ? 24 : 32;
    const int cs = min(max(c - 8, 0), 48), rbase = min(max(r - 4, 0), 56);
    const size_t tq = (size_t)(b << 12) + r * 64 + c;
    bf16x8 qf[2];
#pragma unroll
    for (int ks = 0; ks < 2; ++ks) qf[ks] = as_bf16x8(*(const v4u*)(P + tq * LDP + C_NAQ + h * 64 + ks * 32 + g * 8));
    f32x4 s[8][2]; float mx = -3.0e38f;
    v4u kf[8][2][2];
#pragma unroll
    for (int i = 0; i < 8; ++i)
#pragma unroll
        for (int kt = 0; kt < 2; ++kt) { const bf16* kp = P + ((size_t)(b << 12) + (rbase + i) * 64 + kc_lo + (fr >> 2) * 8 + kt * 4 + (fr & 3)) * LDP + C_NAK + h * 64 + g * 8; kf[i][kt][0] = *(const v4u*)kp; kf[i][kt][1] = *(const v4u*)(kp + 32); }
#pragma unroll
    for (int i = 0; i < 8; ++i) { const float* bp = rel_bias + (h * 15 + (rbase + i - r + 7)) * 31;
#pragma unroll
        for (int kt = 0; kt < 2; ++kt) {
            f32x4 a = {0.f, 0.f, 0.f, 0.f}; a = MFMA16(as_bf16x8(kf[i][kt][0]), qf[0], a); a = MFMA16(as_bf16x8(kf[i][kt][1]), qf[1], a);
            const int ck0 = kc_lo + 8 * g + 4 * kt, dc0 = ck0 - c + 15, dcl = min(max(dc0, 0), 27); const f32x4 b4 = *(const f32x4*)(bp + dcl);
#pragma unroll
            for (int jj = 0; jj < 4; ++jj) { const int ck = ck0 + jj; const bool inw = (ck >= cs) && (ck < cs + 16); const int sh = dc0 + jj - dcl;
                const float bv = sh == 0 ? b4[0] : sh == 1 ? b4[1] : sh == 2 ? b4[2] : b4[3];
                a[jj] = inw ? a[jj] + bv : -1.0e30f; mx = fmaxf(mx, a[jj]); }
            s[i][kt] = a; } }
    mx = fmaxf(mx, __shfl_xor(mx, 16)); mx = fmaxf(mx, __shfl_xor(mx, 32));
    float l = 0.f;
#pragma unroll
    for (int i = 0; i < 8; ++i)
#pragma unroll
        for (int kt = 0; kt < 2; ++kt)
#pragma unroll
            for (int jj = 0; jj < 4; ++jj) { const float p = __expf(s[i][kt][jj] - mx); s[i][kt][jj] = p; l += p; }
    l += __shfl_xor(l, 16); l += __shfl_xor(l, 32);
    f32x4 o[4];
#pragma unroll
    for (int dt = 0; dt < 4; ++dt) o[dt] = (f32x4){0.f, 0.f, 0.f, 0.f};
#pragma unroll
    for (int hh = 0; hh < 2; ++hh) { v4u vv[4][4];
#pragma unroll
        for (int i4 = 0; i4 < 4; ++i4)
#pragma unroll
            for (int dt = 0; dt < 4; ++dt) { const bf16* vp = NAVT + ((size_t)((b * 8 + h) * 64 + dt * 16 + fr)) * SEQ + (rbase + hh * 4 + i4) * 64 + kc_lo + 8 * g; vv[i4][dt] = *(const v4u*)vp; }
#pragma unroll
        for (int i4 = 0; i4 < 4; ++i4) { const int i = hh * 4 + i4; v4u pw; pw.x = pkbf(s[i][0][0], s[i][0][1]); pw.y = pkbf(s[i][0][2], s[i][0][3]); pw.z = pkbf(s[i][1][0], s[i][1][1]); pw.w = pkbf(s[i][1][2], s[i][1][3]);
            const bf16x8 pf = as_bf16x8(pw);
#pragma unroll
            for (int dt = 0; dt < 4; ++dt) o[dt] = MFMA16(as_bf16x8(vv[i4][dt]), pf, o[dt]); } }
    const float inv = 1.0f / l;
#pragma unroll
    for (int dt = 0; dt < 4; ++dt) { v2u w; w.x = pkbf(o[dt][0] * inv, o[dt][1] * inv); w.y = pkbf(o[dt][2] * inv, o[dt][3] * inv);
        *(v2u*)(BR0 + tq * 512 + h * 64 + dt * 16 + 4 * g) = w; }
}
__device__ __forceinline__ void mem_wave_unit(const bf16* P, const bf16* MK, const bf16* MVT, bf16* BR4, int t0, int h, int lane) {
    const int fr = lane & 15, g = lane >> 4, b = t0 >> 12; const size_t tq = (size_t)t0 + fr;
    bf16x8 qf[4];
#pragma unroll
    for (int ks = 0; ks < 4; ++ks) qf[ks] = as_bf16x8(*(const v4u*)(P + tq * LDP + C_MQ + h * 128 + ks * 32 + g * 8));
    f32x4 s[16]; float mx = -3.0e38f;
#pragma unroll
    for (int m4 = 0; m4 < 2; ++m4) { v4u kf[8][4];
#pragma unroll
        for (int mm = 0; mm < 8; ++mm)
#pragma unroll
            for (int ks = 0; ks < 4; ++ks) kf[mm][ks] = *(const v4u*)(MK + ((size_t)(b * 256 + (m4 * 8 + mm) * 16 + fr)) * 512 + h * 128 + g * 8 + ks * 32);
#pragma unroll
        for (int mm = 0; mm < 8; ++mm) { f32x4 a = {0.f, 0.f, 0.f, 0.f};
#pragma unroll
            for (int ks = 0; ks < 4; ++ks) a = MFMA16(as_bf16x8(kf[mm][ks]), qf[ks], a);
#pragma unroll
            for (int jj = 0; jj < 4; ++jj) mx = fmaxf(mx, a[jj]);
            s[m4 * 8 + mm] = a; } }
    mx = fmaxf(mx, __shfl_xor(mx, 16)); mx = fmaxf(mx, __shfl_xor(mx, 32));
    float l = 0.f;
#pragma unroll
    for (int mt = 0; mt < 16; ++mt)
#pragma unroll
        for (int jj = 0; jj < 4; ++jj) { const float p = __expf(s[mt][jj] - mx); s[mt][jj] = p; l += p; }
    l += __shfl_xor(l, 16); l += __shfl_xor(l, 32);
    f32x4 o[8];
#pragma unroll
    for (int dt = 0; dt < 8; ++dt) o[dt] = (f32x4){0.f, 0.f, 0.f, 0.f};
#pragma unroll
    for (int k4 = 0; k4 < 4; ++k4) { v2u vv[2][8][2];
#pragma unroll
        for (int k2 = 0; k2 < 2; ++k2)
#pragma unroll
            for (int dt = 0; dt < 8; ++dt) { const bf16* vp = MVT + ((size_t)((b * 4 + h) * 128 + dt * 16 + fr)) * 256 + (k4 * 2 + k2) * 32 + 4 * g; vv[k2][dt][0] = *(const v2u*)vp; vv[k2][dt][1] = *(const v2u*)(vp + 16); }
#pragma unroll
        for (int k2 = 0; k2 < 2; ++k2) { const int kb = k4 * 2 + k2; v4u pw; pw.x = pkbf(s[2 * kb][0], s[2 * kb][1]); pw.y = pkbf(s[2 * kb][2], s[2 * kb][3]); pw.z = pkbf(s[2 * kb + 1][0], s[2 * kb + 1][1]); pw.w = pkbf(s[2 * kb + 1][2], s[2 * kb + 1][3]);
            const bf16x8 pf = as_bf16x8(pw);
#pragma unroll
            for (int dt = 0; dt < 8; ++dt) { v4u vw; vw.x = vv[k2][dt][0].x; vw.y = vv[k2][dt][0].y; vw.z = vv[k2][dt][1].x; vw.w = vv[k2][dt][1].y; o[dt] = MFMA16(as_bf16x8(vw), pf, o[dt]); } } }
    const float inv = 1.0f / l;
#pragma unroll
    for (int dt = 0; dt < 8; ++dt) { v2u w; w.x = pkbf(o[dt][0] * inv, o[dt][1] * inv); w.y = pkbf(o[dt][2] * inv, o[dt][3] * inv);
        *(v2u*)(BR4 + tq * 512 + h * 128 + dt * 16 + 4 * g) = w; }
}
__device__ __forceinline__ void mem_wg_unit(LAS unsigned char* ring, const bf16* P, const bf16* MK, const bf16* MVT, bf16* BR4, int t0, int h, int wave, int lane, int tid) {
    const int fr = lane & 15, g = lane >> 4, b = t0 >> 12;
    { const bf16* ksrc = MK + (size_t)(b * 256) * 512 + h * 128;
#pragma unroll
      for (int i = 0; i < 8; ++i) { const int idx = i * 512 + tid, key = idx >> 4, c = idx & 15; const v4u w = *(const v4u*)(ksrc + (size_t)key * 512 + c * 8); *(LAS v4u*)(ring + key * 256 + ((c ^ (key & 15)) << 4)) = w; }
      const bf16* vsrc = MVT + (size_t)((b * 4 + h) * 128) * 256;
#pragma unroll
      for (int i = 0; i < 2; ++i) { const int idx = i * 512 + tid, d = idx >> 3, kb = idx & 7; const v4u* p = (const v4u*)(vsrc + (size_t)d * 256 + kb * 32); const v4u u0 = p[0], u1 = p[1], u2 = p[2], u3 = p[3];
          LAS unsigned char* row = ring + 65536 + d * 512; const int sw = d & 15;
          v4u c0, c1, c2, c3; c0.x = u0.x; c0.y = u0.y; c0.z = u2.x; c0.w = u2.y; c1.x = u0.z; c1.y = u0.w; c1.z = u2.z; c1.w = u2.w; c2.x = u1.x; c2.y = u1.y; c2.z = u3.x; c2.w = u3.y; c3.x = u1.z; c3.y = u1.w; c3.z = u3.z; c3.w = u3.w;
          *(LAS v4u*)(row + (((kb * 4 + 0) ^ sw) << 4)) = c0; *(LAS v4u*)(row + (((kb * 4 + 1) ^ sw) << 4)) = c1; *(LAS v4u*)(row + (((kb * 4 + 2) ^ sw) << 4)) = c2; *(LAS v4u*)(row + (((kb * 4 + 3) ^ sw) << 4)) = c3; } }
    __syncthreads();
#pragma unroll 1
    for (int sub = 0; sub < 2; ++sub) { const size_t tq = (size_t)t0 + sub * 128 + wave * 16 + fr;
        int fo = fr; asm volatile("" : "+v"(fo));
        bf16x8 qf[4];
#pragma unroll
        for (int ks = 0; ks < 4; ++ks) qf[ks] = as_bf16x8(*(const v4u*)(P + tq * LDP + C_MQ + h * 128 + ks * 32 + g * 8));
        f32x4 s[16]; float mx = -3.0e38f;
#pragma unroll
        for (int mt = 0; mt < 16; ++mt) { f32x4 a = {0.f, 0.f, 0.f, 0.f}; const LAS unsigned char* kr = ring + (mt * 16 + fo) * 256;
#pragma unroll
            for (int ks = 0; ks < 4; ++ks) a = MFMA16(as_bf16x8(*(const LAS v4u*)(kr + (((ks * 4 + g) ^ fo) << 4))), qf[ks], a);
#pragma unroll
            for (int jj = 0; jj < 4; ++jj) mx = fmaxf(mx, a[jj]);
            s[mt] = a; }
        mx = fmaxf(mx, __shfl_xor(mx, 16)); mx = fmaxf(mx, __shfl_xor(mx, 32));
        float l = 0.f;
#pragma unroll
        for (int mt = 0; mt < 16; ++mt)
#pragma unroll
            for (int jj = 0; jj < 4; ++jj) { const float p = __expf(s[mt][jj] - mx); s[mt][jj] = p; l += p; }
        l += __shfl_xor(l, 16); l += __shfl_xor(l, 32);
        f32x4 o[8];
#pragma unroll
        for (int dt = 0; dt < 8; ++dt) o[dt] = (f32x4){0.f, 0.f, 0.f, 0.f};
#pragma unroll
        for (int kb = 0; kb < 8; ++kb) { v4u pw; pw.x = pkbf(s[2 * kb][0], s[2 * kb][1]); pw.y = pkbf(s[2 * kb][2], s[2 * kb][3]); pw.z = pkbf(s[2 * kb + 1][0], s[2 * kb + 1][1]); pw.w = pkbf(s[2 * kb + 1][2], s[2 * kb + 1][3]);
            const bf16x8 pf = as_bf16x8(pw);
#pragma unroll
            for (int dt = 0; dt < 8; ++dt) o[dt] = MFMA16(as_bf16x8(*(const LAS v4u*)(ring + 65536 + (dt * 16 + fo) * 512 + (((kb * 4 + g) ^ fo) << 4))), pf, o[dt]); }
        const float inv = 1.0f / l;
#pragma unroll
        for (int dt = 0; dt < 8; ++dt) { v2u w; w.x = pkbf(o[dt][0] * inv, o[dt][1] * inv); w.y = pkbf(o[dt][2] * inv, o[dt][3] * inv);
            *(v2u*)(BR4 + tq * 512 + h * 128 + dt * 16 + 4 * g) = w; }
    }
}
#define CH_TOK(n, i) ((size_t)(dir ? (SEQ - 1 - ((n) * 16 + (i))) : ((n) * 16 + (i))))
__device__ __forceinline__ bf16 tobf(float x) { return (bf16)(pkbf(x, 0.f) & 0xffffu); }
constexpr size_t OA_GW = 0, OA_GU = 32 * MiB, OA_GKT = 64 * MiB, OA_GP = 96 * MiB, OA_GS = 100 * MiB, OA_HQD = 104 * MiB, OA_HKDT = 136 * MiB, OA_HP = 168 * MiB, OA_HV = 172 * MiB,
                 OA_LQD = 184 * MiB, OA_LKDT = 200 * MiB, OA_LP = 216 * MiB, OA_LV = 220 * MiB, OA_END = 226 * MiB;
struct DiagSrc { const bf16* q; int qp; const bf16* k; int kp; const float* lg; int lgp; const bf16* v; int vp; };
template <int K, int HG> __device__ __forceinline__ void s1_diag(LAS unsigned char* scr, const DiagSrc& S, int dir, int n, bf16* QD, bf16* KDT, bf16* PP, float* EB, int lane) {
    constexpr int NK = K / 64, LPI = K + 8;
    LAS bf16* QDs = (LAS bf16*)scr; LAS bf16* KDs = QDs + 16 * LPI;
#pragma unroll
    for (int c = 0; c < NK; ++c) { const int k = lane + 64 * c; float bi[16], lgv[16]; float b = 0.f;
#pragma unroll
        for (int i = 0; i < 16; ++i) { lgv[i] = S.lg[CH_TOK(n, i) * S.lgp + k]; b += lgv[i]; bi[i] = b; }
        unsigned kdw[8];
#pragma unroll
        for (int i = 0; i < 16; ++i) { const size_t tok = CH_TOK(n, i); const float qv = bf1(S.q[tok * S.qp + k]); float kv;
            if (HG) kv = 1.0f - __expf(lgv[i]); else kv = bf1(S.k[tok * S.kp + k]);
            const bf16 qh = tobf(qv * __expf(bi[i])), kh = tobf(kv * __expf(-bi[i]));
            QD[i * K + k] = qh; QDs[i * LPI + k] = qh; KDs[i * LPI + k] = kh;
            if (i & 1) kdw[i >> 1] |= ((unsigned)kh) << 16; else kdw[i >> 1] = kh; }
        *(v4u*)(KDT + k * 16) = (v4u){kdw[0], kdw[1], kdw[2], kdw[3]}; *(v4u*)(KDT + k * 16 + 8) = (v4u){kdw[4], kdw[5], kdw[6], kdw[7]};
        EB[k] = __expf(bi[15]); }
    LDS_WAIT(); asm volatile("" ::: "memory");
    const int fr = lane & 15, g = lane >> 4; f32x4 acc = {0.f, 0.f, 0.f, 0.f};
#pragma unroll
    for (int ks = 0; ks < K / 32; ++ks) { const bf16x8 qf = as_bf16x8(*(const LAS v4u*)(QDs + fr * LPI + 32 * ks + 8 * g)), kf = as_bf16x8(*(const LAS v4u*)(KDs + fr * LPI + 32 * ks + 8 * g)); acc = MFMA16(qf, kf, acc); }
#pragma unroll
    for (int jj = 0; jj < 4; ++jj) { const int i = 4 * g + jj; PP[i * 16 + fr] = tobf(fr <= i ? acc[jj] : 0.f); }
    LDS_WAIT(); asm volatile("" ::: "memory");
}
#define S2_BAR() do { asm volatile("s_waitcnt lgkmcnt(0)" ::: "memory"); __builtin_amdgcn_s_barrier(); asm volatile("" ::: "memory"); } while (0)
template <int K> struct DiagStage { v4u qd[K / 64], kdt[K / 64], v[2], p, eb; };
template <int K> struct DiagLds { static constexpr int QP = 2 * K + 16, LQD = 0, LKDT = 64 * QP, LV = LKDT + 4 * K * 32, LP = LV + 64 * 256, LEB = LP + 2048, BYTES = LEB + 4 * K * 4; };
template <int K> __device__ __forceinline__ void s2d_load(DiagStage<K>& R, const bf16* QD0, const bf16* KDT0, const bf16* PP0, const float* EB0, const bf16* vsrc, int vp, int dir, int grp, int tid) {
    const size_t c0 = (size_t)grp * 4;
#pragma unroll
    for (int j = 0; j < K / 64; ++j) { const int e = tid + 512 * j; R.qd[j] = *(const v4u*)(QD0 + c0 * 16 * K + (size_t)e * 8); R.kdt[j] = *(const v4u*)(KDT0 + c0 * 16 * K + (size_t)e * 8); }
#pragma unroll
    for (int j = 0; j < 2; ++j) { const int e = tid + 512 * j, row = e >> 4, col = e & 15; R.v[j] = *(const v4u*)(vsrc + CH_TOK(grp * 4 + (row >> 4), row & 15) * vp + col * 8); }
    if (tid < 128) R.p = *(const v4u*)(PP0 + c0 * 256 + tid * 8);
    else if (tid < 128 + K) R.eb = *(const v4u*)(EB0 + c0 * K + (tid - 128) * 4);
}
template <int K> __device__ __forceinline__ void s2d_store(const DiagStage<K>& R, LAS unsigned char* lds, int tid) {
    typedef DiagLds<K> L;
#pragma unroll
    for (int j = 0; j < K / 64; ++j) { const int e = tid + 512 * j, row = e / (K / 8), col = e % (K / 8); *(LAS v4u*)(lds + L::LQD + row * L::QP + col * 16) = R.qd[j]; *(LAS v4u*)(lds + L::LKDT + e * 16) = R.kdt[j]; }
#pragma unroll
    for (int j = 0; j < 2; ++j) { const int e = tid + 512 * j; *(LAS v4u*)(lds + L::LV + e * 16) = R.v[j]; }
    if (tid < 128) *(LAS v4u*)(lds + L::LP + tid * 16) = R.p;
    else if (tid < 128 + K) *(LAS v4u*)(lds + L::LEB + (tid - 128) * 16) = R.eb;
}
template <int K> __device__ __forceinline__ void s2d_chunk(LAS unsigned char* lds, int c, f32x4 (&S)[K / 16], bf16* osrc, int op, int dir, int n, int vt, int lane) {
    typedef DiagLds<K> L; const int fr = lane & 15, g = lane >> 4;
    f32x4 o = {0.f, 0.f, 0.f, 0.f};
#pragma unroll
    for (int ks = 0; ks < K / 32; ++ks) { const LAS unsigned char* qp = lds + L::LQD + (c * 16 + fr) * L::QP + (32 * ks + 4 * g) * 2; const v2u a = *(const LAS v2u*)qp, b = *(const LAS v2u*)(qp + 32);
        v4u sb; sb.x = pkbf(S[2 * ks][0], S[2 * ks][1]); sb.y = pkbf(S[2 * ks][2], S[2 * ks][3]); sb.z = pkbf(S[2 * ks + 1][0], S[2 * ks + 1][1]); sb.w = pkbf(S[2 * ks + 1][2], S[2 * ks + 1][3]);
        o = MFMA16(as_bf16x8((v4u){a.x, a.y, b.x, b.y}), as_bf16x8(sb), o); }
    unsigned vr[4];
#pragma unroll
    for (int jj = 0; jj < 4; ++jj) vr[jj] = *(const LAS unsigned short*)(lds + L::LV + ((c * 16 + 4 * g + jj) * 128 + vt * 16 + fr) * 2);
    const bf16x8 vf = as_bf16x8((v4u){vr[0] | (vr[1] << 16), vr[2] | (vr[3] << 16), 0u, 0u});
    { const v2u pp = *(const LAS v2u*)(lds + L::LP + (c * 256 + fr * 16 + 4 * g) * 2); o = MFMA16(as_bf16x8((v4u){pp.x, pp.y, 0u, 0u}), vf, o); }
#pragma unroll
    for (int kt = 0; kt < K / 16; ++kt) { const v2u kd = *(const LAS v2u*)(lds + L::LKDT + ((c * K + kt * 16 + fr) * 16 + 4 * g) * 2); const f32x4 eb = *(const LAS f32x4*)(lds + L::LEB + (c * K + kt * 16 + 4 * g) * 4);
        S[kt] = MFMA16(as_bf16x8((v4u){kd.x, kd.y, 0u, 0u}), vf, S[kt]); S[kt] = S[kt] * eb; }
#pragma unroll
    for (int jj = 0; jj < 4; ++jj) osrc[CH_TOK(n, 4 * g + jj) * op + vt * 16 + fr] = tobf(o[jj]);
}
template <int K> __device__ __forceinline__ void s2_diag(LAS unsigned char* lds, const bf16* QD0, const bf16* KDT0, const bf16* PP0, const float* EB0, const bf16* vsrc, int vp, bf16* osrc, int op, int dir, int vt, int lane, int tid) {
    static_assert(DiagLds<K>::BYTES <= RING_BYTES, "S2 LDS");
    f32x4 S[K / 16];
#pragma unroll
    for (int kt = 0; kt < K / 16; ++kt) S[kt] = (f32x4){0.f, 0.f, 0.f, 0.f};
    DiagStage<K> Ra, Rb;
    s2d_load<K>(Ra, QD0, KDT0, PP0, EB0, vsrc, vp, dir, 0, tid); s2d_load<K>(Rb, QD0, KDT0, PP0, EB0, vsrc, vp, dir, 1, tid);
#pragma unroll 1
    for (int grp = 0; grp < SEQ / 64; grp += 2) {
        S2_BAR(); s2d_store<K>(Ra, lds, tid); S2_BAR();
        s2d_load<K>(Ra, QD0, KDT0, PP0, EB0, vsrc, vp, dir, grp + 2 < SEQ / 64 ? grp + 2 : grp, tid);
#pragma unroll 2
        for (int c = 0; c < 4; ++c) s2d_chunk<K>(lds, c, S, osrc, op, dir, grp * 4 + c, vt, lane);
        S2_BAR(); s2d_store<K>(Rb, lds, tid); S2_BAR();
        s2d_load<K>(Rb, QD0, KDT0, PP0, EB0, vsrc, vp, dir, grp + 3 < SEQ / 64 ? grp + 3 : grp + 1, tid);
#pragma unroll 2
        for (int c = 0; c < 4; ++c) s2d_chunk<K>(lds, c, S, osrc, op, dir, (grp + 1) * 4 + c, vt, lane);
    }
    S2_BAR();
}
__device__ __forceinline__ void s1_gdn(LAS unsigned char* scr, const bf16* GQb, const float* GABb, int h, int dir, int n, bf16* GW, bf16* GU, bf16* GKT, bf16* GP, float* GS, int lane) {
    const int fr = lane & 15, g = lane >> 4;
    LAS float* AT = (LAS float*)scr;
    float c[16], be[16]; float cs = 0.f;
#pragma unroll
    for (int i = 0; i < 16; ++i) { const size_t tok = CH_TOK(n, i); cs += GABb[tok * 16]; c[i] = cs; be[i] = GABb[tok * 16 + 8]; }
    const size_t tr = CH_TOK(n, fr);
    f32x4 kk = {0.f, 0.f, 0.f, 0.f}, qk = {0.f, 0.f, 0.f, 0.f};
#pragma unroll
    for (int ks = 0; ks < 4; ++ks) { const bf16x8 kf = as_bf16x8(*(const v4u*)(GQb + tr * 1536 + 512 + h * 128 + 32 * ks + 8 * g)), qf = as_bf16x8(*(const v4u*)(GQb + tr * 1536 + h * 128 + 32 * ks + 8 * g));
        kk = MFMA16(kf, kf, kk); qk = MFMA16(qf, kf, qk); }
    float cj = 0.f;
#pragma unroll
    for (int i = 0; i < 16; ++i) cj = (fr == i) ? c[i] : cj;
    f32x4 av;
#pragma unroll
    for (int jj = 0; jj < 4; ++jj) { float ci = 0.f, bi = 0.f;
#pragma unroll
        for (int gg = 0; gg < 4; ++gg) { ci = (g == gg) ? c[4 * gg + jj] : ci; bi = (g == gg) ? be[4 * gg + jj] : bi; }
        const int i = 4 * g + jj; const float dec = __expf(ci - cj);
        av[jj] = (fr < i) ? bi * kk[jj] * dec : 0.f;
        GP[i * 16 + fr] = tobf(fr <= i ? qk[jj] * dec : 0.f); }
    *(LAS f32x4*)(AT + fr * 16 + 4 * g) = av;
    if (lane < 16) { GS[lane] = __expf(cj); GS[16 + lane] = __expf(c[15] - cj); } if (lane == 16) GS[32] = __expf(c[15]);
    LDS_WAIT(); asm volatile("" ::: "memory");
    float t[16];
#pragma unroll
    for (int j = 15; j >= 0; --j) { float a = (fr == j) ? 1.f : 0.f;
        if (j < 15) { f32x4 col[4];
#pragma unroll
            for (int q4 = 0; q4 < 4; ++q4) col[q4] = *(const LAS f32x4*)(AT + j * 16 + 4 * q4);
#pragma unroll
            for (int i = j + 1; i < 16; ++i) a -= t[i] * col[i >> 2][i & 3]; }
        t[j] = a; }
    float tf[4];
#pragma unroll
    for (int e = 0; e < 4; ++e) { float x = 0.f;
#pragma unroll
        for (int gg = 0; gg < 4; ++gg) x = (g == gg) ? t[4 * gg + e] : x;
        tf[e] = x; }
    const bf16x8 tfrag = as_bf16x8((v4u){pkbf(tf[0], tf[1]), pkbf(tf[2], tf[3]), 0u, 0u});
    float bj[4], bgj[4]; size_t tj[4];
#pragma unroll
    for (int e = 0; e < 4; ++e) { float cc = 0.f, bb = 0.f;
#pragma unroll
        for (int gg = 0; gg < 4; ++gg) { cc = (g == gg) ? c[4 * gg + e] : cc; bb = (g == gg) ? be[4 * gg + e] : bb; }
        bj[e] = bb; bgj[e] = bb * __expf(cc); tj[e] = CH_TOK(n, 4 * g + e); }
#pragma unroll 2
    for (int ct = 0; ct < 8; ++ct) {
        float vv[4], kv[4];
#pragma unroll
        for (int e = 0; e < 4; ++e) { vv[e] = bf1(GQb[tj[e] * 1536 + 1024 + h * 128 + ct * 16 + fr]); kv[e] = bf1(GQb[tj[e] * 1536 + 512 + h * 128 + ct * 16 + fr]); }
        const bf16x8 vb = as_bf16x8((v4u){pkbf(vv[0] * bj[0], vv[1] * bj[1]), pkbf(vv[2] * bj[2], vv[3] * bj[3]), 0u, 0u});
        const bf16x8 kb = as_bf16x8((v4u){pkbf(kv[0] * bgj[0], kv[1] * bgj[1]), pkbf(kv[2] * bgj[2], kv[3] * bgj[3]), 0u, 0u});
        const f32x4 z = {0.f, 0.f, 0.f, 0.f}; const f32x4 u = MFMA16(tfrag, vb, z), w = MFMA16(tfrag, kb, z);
#pragma unroll
        for (int jj = 0; jj < 4; ++jj) { GU[(4 * g + jj) * 128 + ct * 16 + fr] = tobf(u[jj]); GW[(4 * g + jj) * 128 + ct * 16 + fr] = tobf(w[jj]); }
        *(v2u*)(GKT + (ct * 16 + fr) * 16 + 4 * g) = (v2u){pkbf(kv[0], kv[1]), pkbf(kv[2], kv[3])};
    }
    LDS_WAIT(); asm volatile("" ::: "memory");
}
struct GdnStage { v4u w[2], q[2], kt[2], u[2], p, s; };
struct GdnLds { static constexpr int WP = 272, LW = 0, LQ = 64 * WP, LKT = 2 * 64 * WP, LU = LKT + 16384, LP = LU + 16384, LS = LP + 2048, BYTES = LS + 1024; };
__device__ __forceinline__ void s2g_load(GdnStage& R, const bf16* GW0, const bf16* GU0, const bf16* GKT0, const bf16* GP0, const float* GS0, const bf16* qsrc, int dir, int grp, int tid) {
    const size_t c0 = (size_t)grp * 4;
#pragma unroll
    for (int j = 0; j < 2; ++j) { const int e = tid + 512 * j, row = e >> 4, col = e & 15;
        R.w[j] = *(const v4u*)(GW0 + c0 * 2048 + (size_t)e * 8); R.kt[j] = *(const v4u*)(GKT0 + c0 * 2048 + (size_t)e * 8); R.u[j] = *(const v4u*)(GU0 + c0 * 2048 + (size_t)e * 8);
        R.q[j] = *(const v4u*)(qsrc + CH_TOK(grp * 4 + (row >> 4), row & 15) * 1536 + col * 8); }
    if (tid < 128) R.p = *(const v4u*)(GP0 + c0 * 256 + tid * 8);
    else if (tid < 192) R.s = *(const v4u*)(GS0 + c0 * 64 + (tid - 128) * 4);
}
__device__ __forceinline__ void s2g_store(const GdnStage& R, LAS unsigned char* lds, int tid) {
    typedef GdnLds L;
#pragma unroll
    for (int j = 0; j < 2; ++j) { const int e = tid + 512 * j, row = e >> 4, col = e & 15;
        *(LAS v4u*)(lds + L::LW + row * L::WP + col * 16) = R.w[j]; *(LAS v4u*)(lds + L::LQ + row * L::WP + col * 16) = R.q[j]; *(LAS v4u*)(lds + L::LKT + e * 16) = R.kt[j]; *(LAS v4u*)(lds + L::LU + e * 16) = R.u[j]; }
    if (tid < 128) *(LAS v4u*)(lds + L::LP + tid * 16) = R.p;
    else if (tid < 192) *(LAS v4u*)(lds + L::LS + (tid - 128) * 16) = R.s;
}
__device__ __forceinline__ void s2g_chunk(LAS unsigned char* lds, int c, f32x4 (&S)[8], bf16* osrc, int dir, int n, int vt, int lane) {
    typedef GdnLds L; const int fr = lane & 15, g = lane >> 4;
    f32x4 ws = {0.f, 0.f, 0.f, 0.f}, qs = {0.f, 0.f, 0.f, 0.f};
#pragma unroll
    for (int ks = 0; ks < 4; ++ks) { const int off = (c * 16 + fr) * L::WP + (32 * ks + 4 * g) * 2;
        const v2u a = *(const LAS v2u*)(lds + L::LW + off), b = *(const LAS v2u*)(lds + L::LW + off + 32), qa = *(const LAS v2u*)(lds + L::LQ + off), qb = *(const LAS v2u*)(lds + L::LQ + off + 32);
        v4u sb; sb.x = pkbf(S[2 * ks][0], S[2 * ks][1]); sb.y = pkbf(S[2 * ks][2], S[2 * ks][3]); sb.z = pkbf(S[2 * ks + 1][0], S[2 * ks + 1][1]); sb.w = pkbf(S[2 * ks + 1][2], S[2 * ks + 1][3]);
        const bf16x8 sbf = as_bf16x8(sb); ws = MFMA16(as_bf16x8((v4u){a.x, a.y, b.x, b.y}), sbf, ws); qs = MFMA16(as_bf16x8((v4u){qa.x, qa.y, qb.x, qb.y}), sbf, qs); }
    f32x4 vn;
#pragma unroll
    for (int jj = 0; jj < 4; ++jj) vn[jj] = bf1(*(const LAS unsigned short*)(lds + L::LU + ((c * 16 + 4 * g + jj) * 128 + vt * 16 + fr) * 2)) - ws[jj];
    const f32x4 gam = *(const LAS f32x4*)(lds + L::LS + (c * 64 + 4 * g) * 4), gdec = *(const LAS f32x4*)(lds + L::LS + (c * 64 + 16 + 4 * g) * 4); const float Gam = *(const LAS float*)(lds + L::LS + (c * 64 + 32) * 4);
    const bf16x8 vnf = as_bf16x8((v4u){pkbf(vn[0], vn[1]), pkbf(vn[2], vn[3]), 0u, 0u});
    f32x4 o = qs * gam; { const v2u pp = *(const LAS v2u*)(lds + L::LP + (c * 256 + fr * 16 + 4 * g) * 2); o = MFMA16(as_bf16x8((v4u){pp.x, pp.y, 0u, 0u}), vnf, o); }
    const f32x4 vd = vn * gdec; const bf16x8 vdf = as_bf16x8((v4u){pkbf(vd[0], vd[1]), pkbf(vd[2], vd[3]), 0u, 0u});
#pragma unroll
    for (int kt = 0; kt < 8; ++kt) { const v2u kk = *(const LAS v2u*)(lds + L::LKT + ((c * 128 + kt * 16 + fr) * 16 + 4 * g) * 2); S[kt] = S[kt] * Gam; S[kt] = MFMA16(as_bf16x8((v4u){kk.x, kk.y, 0u, 0u}), vdf, S[kt]); }
#pragma unroll
    for (int jj = 0; jj < 4; ++jj) osrc[CH_TOK(n, 4 * g + jj) * 512 + vt * 16 + fr] = tobf(o[jj]);
}
__device__ __forceinline__ void s2_gdn(LAS unsigned char* lds, const bf16* GW0, const bf16* GU0, const bf16* GKT0, const bf16* GP0, const float* GS0, const bf16* qsrc, bf16* osrc, int dir, int vt, int lane, int tid) {
    static_assert(GdnLds::BYTES <= RING_BYTES, "S2 LDS");
    f32x4 S[8];
#pragma unroll
    for (int kt = 0; kt < 8; ++kt) S[kt] = (f32x4){0.f, 0.f, 0.f, 0.f};
    GdnStage Ra, Rb;
    s2g_load(Ra, GW0, GU0, GKT0, GP0, GS0, qsrc, dir, 0, tid); s2g_load(Rb, GW0, GU0, GKT0, GP0, GS0, qsrc, dir, 1, tid);
#pragma unroll 1
    for (int grp = 0; grp < SEQ / 64; grp += 2) {
        S2_BAR(); s2g_store(Ra, lds, tid); S2_BAR();
        s2g_load(Ra, GW0, GU0, GKT0, GP0, GS0, qsrc, dir, grp + 2 < SEQ / 64 ? grp + 2 : grp, tid);
#pragma unroll 2
        for (int c = 0; c < 4; ++c) s2g_chunk(lds, c, S, osrc, dir, grp * 4 + c, vt, lane);
        S2_BAR(); s2g_store(Rb, lds, tid); S2_BAR();
        s2g_load(Rb, GW0, GU0, GKT0, GP0, GS0, qsrc, dir, grp + 3 < SEQ / 64 ? grp + 3 : grp + 1, tid);
#pragma unroll 2
        for (int c = 0; c < 4; ++c) s2g_chunk(lds, c, S, osrc, dir, (grp + 1) * 4 + c, vt, lane);
    }
    S2_BAR();
}
struct Args { const float* in[31]; float* out; unsigned char* ws; int ph_lo, ph_hi; };
static_assert(sizeof(Args) == 31 * 8 + 8 + 8 + 8, "Args has no padding");
typedef const __attribute__((address_space(4))) unsigned char* kptr_t;
typedef const float* cfptr_t; typedef float* fptr_t; typedef unsigned char* ucptr_t;
__device__ __forceinline__ kptr_t kargs() { kptr_t p = (kptr_t)__builtin_amdgcn_kernarg_segment_ptr(); asm volatile("" : "+s"(p)); return p; }
#define KIN(p, i) (*(const __attribute__((address_space(4))) cfptr_t*)((p) + 8 * (i)))
#define KOUT(p) (*(const __attribute__((address_space(4))) fptr_t*)((p) + 248))
#define KWS(p) (*(const __attribute__((address_space(4))) ucptr_t*)((p) + 256))

#ifndef STAGGER_TICKS
#define STAGGER_TICKS 0
#endif
#define GEMM_STAGGER() do { if (STAGGER_TICKS) { const unsigned long long t0_ = __builtin_amdgcn_s_memrealtime(); const unsigned long long dl_ = (unsigned long long)((bx & 15) * STAGGER_TICKS); while (__builtin_amdgcn_s_memrealtime() - t0_ < dl_) __builtin_amdgcn_s_sleep(4); } } while (0)
#ifndef FILL_TAIL
#define FILL_TAIL 1
#endif
#ifndef GATE_BATCH
#define GATE_BATCH 4
#endif
#ifndef F8_SP2
#define F8_SP2 true
#endif
#ifndef EN_MASK
#define EN_MASK 0xffffffffu
#endif
#define EN_PH(k) ((EN_MASK >> (k)) & 1u)
#ifndef REP_MASK
#define REP_MASK 0u
#endif
#define REPS(k) (((REP_MASK >> (k)) & 1u) ? 2 : 1)
#ifndef REP_S2
#define REP_S2 1
#define REP_ATT 1
#endif
__global__ void __launch_bounds__(NWAVES * 64, 2) mega_fwd(Args args) {
    extern __shared__ __attribute__((aligned(16))) unsigned char lds_raw[];
    LAS unsigned char* lds = (LAS unsigned char*)lds_raw;
    volatile LAS unsigned* MISC = (volatile LAS unsigned*)(lds + MISC_OFF);
    LAS int* TAB = (LAS int*)(lds + TAB_OFF);
    for (int u = threadIdx.x; u < (LDS_BYTES - LDSCTL_OFF) / 4; u += NWAVES * 64) ((LAS unsigned*)(lds + LDSCTL_OFF))[u] = 0u;
    __syncthreads();
    if ((threadIdx.x & 63) == 0) ((volatile LAS int*)(lds + WAVETAB_OFF))[hw_slot()] = (int)(threadIdx.x >> 6);
    __syncthreads();
    XcdBarrier bar; bar.bar = (unsigned*)(args.ws + WS_CTL) + CW_BAR; bar.x = 0; bar.st = nullptr;
    if (!MK_SPLIT) bar = xcd_barrier_post((unsigned*)(args.ws + WS_CTL) + CW_BAR, MISC + 8);
    const int lo = args.ph_lo, hi = args.ph_hi;
#define IN(k) (lo <= (k) && (k) < hi)
#define SEAM(k) do { if ((k) + 1 < hi) { if (MK_SPLIT) { if (mk_tid() == 0) __hip_atomic_store((gu32*)(args.ws + WS_CTL) + CW_TMO, 0xBADBA0u, RLX_AGENT); } else xcd_barrier(bar); } } while (0)
#define PHASE_VARS \
    const kptr_t kp = kargs(); unsigned char* const ws = KWS(kp); float* const out = KOUT(kp); (void)out; \
    int tid_ = mk_tid(); asm volatile("" : "+v"(tid_)); const int tid = tid_, lane = tid & 63, wave = __builtin_amdgcn_readfirstlane(tid >> 6); (void)lane; (void)wave; \
    int G_ = gridDim.x, bx_ = blockIdx.x; asm volatile("" : "+s"(G_), "+s"(bx_)); const int G = G_, bx = bx_; const int vcu = (G % 8 == 0) ? (bx % 8) * (G / 8) + bx / 8 : bx; const int gw = vcu * NWAVES + wave, NGW = G * NWAVES; (void)gw; (void)NGW; \
    gu32* const ctl = (gu32*)(ws + WS_CTL); (void)ctl
#define LAYER_PTRS(lp) LayerPtrs lp; \
        lp.g_mix = KIN(kp, 2) + L * DM; lp.na_q_gain = KIN(kp, 4) + L * 64; lp.na_k_gain = KIN(kp, 5) + L * 64; lp.na_rel_bias = KIN(kp, 6) + L * 8 * 15 * 31; \
        lp.gla_w_up = KIN(kp, 7) + L * 2 * 16 * 256; lp.gla_b = KIN(kp, 8) + L * 512; lp.gla_norm = KIN(kp, 9) + L * 128; lp.conv_w = KIN(kp, 10) + L * 5 * 1536; \
        lp.a_log = KIN(kp, 11) + L * 8; lp.dt_bias = KIN(kp, 12) + L * 8; lp.gdn_norm = KIN(kp, 13) + L * 128; lp.lb_raw0 = KIN(kp, 14); lp.lb_raw1 = KIN(kp, 14) + 1024; \
        lp.hg_norm = KIN(kp, 15) + L * 128; lp.mem_q_gain = KIN(kp, 18) + L * 128; lp.g_ffn = KIN(kp, 22) + L * DM
#define WSP(T, off) ((T*)(ws + (off)))

    if (EN_PH(31) && IN(0)) for (int rep_ = 0; rep_ < REPS(31); ++rep_) { PHASE_VARS;
        bf16* WIN = WSP(bf16, WS_WIN); bf16* WBR = WSP(bf16, WS_WBR); bf16* WOUT = WSP(bf16, WS_WOUT); bf16* WMKV = WSP(bf16, WS_WMKV);
        bf16* WGU = WSP(bf16, WS_WGU); bf16* WDN = WSP(bf16, WS_WDN); bf16* MOE1 = WSP(bf16, WS_MOE1); bf16* MOE2 = WSP(bf16, WS_MOE2F);
        LAS float* scr = (LAS float*)(lds + RING_OFF + wave * 16384);
        phase0_convert_all(KIN(kp, 3), KIN(kp, 20), KIN(kp, 21), KIN(kp, 17), KIN(kp, 23), KIN(kp, 24), KIN(kp, 25), ws, scr, gw, NGW, lane);
        for (int i = gw * 64 + lane; i < 2 * (LDP - C_PEND) * DM / 8; i += NGW * 64) { const int L = i / ((LDP - C_PEND) * DM / 8), r = i % ((LDP - C_PEND) * DM / 8);
            *(v4u*)(WIN + ((size_t)L * NIN + C_PEND) * DM + (size_t)r * 8) = (v4u){0u, 0u, 0u, 0u}; }
        const float* mem = KIN(kp, 1); bf16* MEMN = WSP(bf16, WS_MEMN);
        for (int row = gw; row < 2 * 1024; row += NGW) { const int L = row >> 10, m = row & 1023; f32x4 v[8]; rms_row(mem + (size_t)m * DM, KIN(kp, 16) + L * DM, MEMN + (size_t)row * DM, lane, v); }
    }

#pragma unroll 1
    for (int L = 0; L < NLAYER; ++L) {
        const int pb = 1 + 16 * L;
        if (EN_PH(0) && IN(pb + 0)) for (int rep_ = 0; rep_ < REPS(0); ++rep_) { PHASE_VARS; const float* xres = L ? (const float*)out : KIN(kp, 0); const float* gm = KIN(kp, 2) + L * DM; bf16* HM = WSP(bf16, WS_HM);
            for (int t = gw; t < NT; t += NGW) { f32x4 v[8]; rms_row(xres + (size_t)t * DM, gm, HM + (size_t)t * DM, lane, v, WSP(unsigned char, WS_H8) + (size_t)t * DM); } }
        SEAM(pb + 0);
        if (EN_PH(1) && IN(pb + 1)) for (int rep_ = 0; rep_ < REPS(1); ++rep_) {
            { PHASE_VARS; pg8::Gemm g{WSP(bf16, WS_HM), WSP(bf16, WS_WIN) + (size_t)L * NIN * DM, NT, LDP, DM}; pg8::StaticOrder S; S.init(NT, LDP, G, bx); pg8::EpiInProj E{WSP(bf16, WS_P), WSP(bf16, WS_G)};
#if defined(PROBE_NULL_EPI)
              if (rep_) { pg8::EpiNull EN; pg8::gemm_phase<pg8::EpiNull, pg8::StaticOrder, true, true>(lds + RING_OFF, g, S, EN); } else
#endif
              { GEMM_STAGGER(); pg8::gemm_phase<pg8::EpiInProj, pg8::StaticOrder, true, true>(lds + RING_OFF, g, S, E); } }
            if (L == 0) { PHASE_VARS; pg8::Gemm g{WSP(bf16, WS_MEMN), WSP(bf16, WS_WMKV), 2048, 2048, DM}; pg8::KvOrder S{bx, G >= 96 ? 64 : 0}; pg8::EpiResF32 E{nullptr, WSP(float, WS_KVRAW), 1024, 4};
              pg8::gemm_phase<pg8::EpiResF32, pg8::KvOrder, false, true>(lds + RING_OFF, g, S, E); }
            { PHASE_VARS; const int f0 = L ? 64 : 96;
              if (FILL_TAIL && G >= 128 && bx >= f0 && rep_ == 0) { LAS float* scr = (LAS float*)(lds + RING_OFF + wave * 16384); const int gwf = (bx - f0) * NWAVES + wave, ngwf = (G - f0) * NWAVES;
#pragma unroll 1
                  for (int e = 3 * L; e < 3 * L + 3; ++e) transpose_job_f8(KIN(kp, 30) + (size_t)e * DFFE * DM, 64.0f, DFFE, DM, WSP(unsigned char, WS_MOE2F) + (size_t)e * DM * DFFE, scr, gwf, ngwf, lane, RmOff{0}); } }
        }
        SEAM(pb + 1);
        if (EN_PH(2) && IN(pb + 2)) { PHASE_VARS; LAYER_PTRS(lp);
            for (int u = gw; u < NT / 8; u += NGW) prep_unit(L, lp, WSP(bf16, WS_P), WSP(float, WS_GLG), WSP(bf16, WS_GQ), WSP(float, WS_GAB), WSP(bf16, WS_HQ), WSP(float, WS_HF), WSP(bf16, WS_NAVT), u * 8, lane);
            if (L == 0) { const float* KVRAW = WSP(float, WS_KVRAW); bf16* MK = WSP(bf16, WS_MK); bf16* MVT = WSP(bf16, WS_MVT); const float* mkg = KIN(kp, 19);
                for (int row = gw; row < 2048; row += NGW) {
                    const int LL = row >> 10; const float* kr = KVRAW + (size_t)row * 1024;
                    const f32x4 k0 = *(const f32x4*)(kr + lane * 8), k1 = *(const f32x4*)(kr + lane * 8 + 4);
                    float f[8] = {k0[0], k0[1], k0[2], k0[3], k1[0], k1[1], k1[2], k1[3]}; float ss = 0.f;
#pragma unroll
                    for (int i = 0; i < 8; ++i) ss += f[i] * f[i];
                    ss = group_sum<16>(ss); const float sc = rsqrtf(ss * (1.0f / 128.0f) + RMS_EPS); const float* gn = mkg + LL * 128 + (lane & 15) * 8;
#pragma unroll
                    for (int i = 0; i < 8; ++i) f[i] = f[i] * sc * gn[i];
                    *(v4u*)(MK + (size_t)row * 512 + lane * 8) = pack8(f);
                    const int b = (row >> 8) & 3, m = row & 255; const float* vr = kr + 512;
#pragma unroll
                    for (int i = 0; i < 8; ++i) { const int cidx = lane * 8 + i; const int h = cidx >> 7, d = cidx & 127;
                        MVT[((size_t)((LL * 4 + b) * 4 + h) * 128 + d) * 256 + m] = (bf16)(pkbf(vr[cidx], 0.f) & 0xffffu); }
                }
            }
        }
        SEAM(pb + 2);
        if (EN_PH(13) && IN(pb + 13)) for (int rep_ = 0; rep_ < REPS(13); ++rep_) { PHASE_VARS;
            LAS unsigned char* scr = lds + RING_OFF + wave * 16384; unsigned char* oa = ws + WS_OA; bf16* P = WSP(bf16, WS_P);
#pragma unroll 1
            for (int u = gw; u < 3 * 8192; u += NGW) { const int br = u >> 13, cu = u & 8191, seq = cu >> 8, n = cu & 255, b = seq >> 3, h = (seq >> 1) & 3, dir = seq & 1; const size_t r0 = (size_t)b << 12;
                if (br == 0) s1_gdn(scr, WSP(bf16, WS_GQ) + r0 * 1536, WSP(float, WS_GAB) + r0 * 16 + dir * 4 + h, h, dir, n, (bf16*)(oa + OA_GW) + (size_t)cu * 2048, (bf16*)(oa + OA_GU) + (size_t)cu * 2048,
                                    (bf16*)(oa + OA_GKT) + (size_t)cu * 2048, (bf16*)(oa + OA_GP) + (size_t)cu * 256, (float*)(oa + OA_GS) + (size_t)cu * 64, lane);
                else if (br == 1) { DiagSrc S{WSP(bf16, WS_HQ) + r0 * 512 + h * 128, 512, nullptr, 0, WSP(float, WS_HF) + r0 * 1024 + dir * 512 + h * 128, 1024, nullptr, 0};
                    s1_diag<128, 1>(scr, S, dir, n, (bf16*)(oa + OA_HQD) + (size_t)cu * 2048, (bf16*)(oa + OA_HKDT) + (size_t)cu * 2048, (bf16*)(oa + OA_HP) + (size_t)cu * 256, (float*)(oa + OA_HV) + (size_t)cu * 128, lane); }
                else { DiagSrc S{P + r0 * LDP + C_GLQ + h * 64, LDP, P + r0 * LDP + C_GLK + h * 64, LDP, WSP(float, WS_GLG) + r0 * 512 + dir * 256 + h * 64, 512, nullptr, 0};
                    s1_diag<64, 0>(scr, S, dir, n, (bf16*)(oa + OA_LQD) + (size_t)cu * 1024, (bf16*)(oa + OA_LKDT) + (size_t)cu * 1024, (bf16*)(oa + OA_LP) + (size_t)cu * 256, (float*)(oa + OA_LV) + (size_t)cu * 64, lane); }
            }
        }
        SEAM(pb + 13);
        if (EN_PH(3) && IN(pb + 3)) for (int rep_ = 0; rep_ < REPS(3); ++rep_) { PHASE_VARS;
            gu32* wq = ctl + CW_WQ + 64 * (L + 2 * rep_); gu32* gq = ctl + CW_GQ + 64 * 8 * (L + 2 * rep_);
            bf16* P = WSP(bf16, WS_P); bf16* SOUT = WSP(bf16, WS_SOUT); bf16* BR = WSP(bf16, WS_BR); unsigned char* oa = ws + WS_OA;
            if (!rep_ || REP_S2) {
#pragma unroll 1
                for (int seq = bx; seq < 32; seq += G) { const int b = seq >> 3, h = (seq >> 1) & 3, dir = seq & 1; const size_t r0 = (size_t)b << 12, c0 = (size_t)seq * 256;
                    s2_gdn(lds + RING_OFF, (const bf16*)(oa + OA_GW) + c0 * 2048, (const bf16*)(oa + OA_GU) + c0 * 2048, (const bf16*)(oa + OA_GKT) + c0 * 2048, (const bf16*)(oa + OA_GP) + c0 * 256, (const float*)(oa + OA_GS) + c0 * 64,
                           WSP(bf16, WS_GQ) + r0 * 1536 + h * 128, SOUT + ((size_t)(1 * 2 + dir) * NT + r0) * 512 + h * 128, dir, wave, lane, tid); }
#pragma unroll 1
                for (int i2 = bx; i2 < 64; i2 += G) if (i2 >= 32) { const int seq = i2 - 32, b = seq >> 3, h = (seq >> 1) & 3, dir = seq & 1; const size_t r0 = (size_t)b << 12, c0 = (size_t)seq * 256;
                    s2_diag<128>(lds + RING_OFF, (const bf16*)(oa + OA_HQD) + c0 * 2048, (const bf16*)(oa + OA_HKDT) + c0 * 2048, (const bf16*)(oa + OA_HP) + c0 * 256, (const float*)(oa + OA_HV) + c0 * 128,
                                 P + r0 * LDP + C_HGI + h * 128, LDP, SOUT + ((size_t)(2 * 2 + dir) * NT + r0) * 512 + h * 128, 512, dir, wave, lane, tid); }
#pragma unroll 1
                for (int i2 = bx; i2 < 96; i2 += G) if (i2 >= 64) { const int seq = i2 - 64, b = seq >> 3, h = (seq >> 1) & 3, dir = seq & 1; const size_t r0 = (size_t)b << 12, c0 = (size_t)seq * 256;
                    s2_diag<64>(lds + RING_OFF, (const bf16*)(oa + OA_LQD) + c0 * 1024, (const bf16*)(oa + OA_LKDT) + c0 * 1024, (const bf16*)(oa + OA_LP) + c0 * 256, (const float*)(oa + OA_LV) + c0 * 64,
                                P + r0 * LDP + C_GLV + h * 128, LDP, SOUT + ((size_t)(0 * 2 + dir) * NT + r0) * 512 + h * 128, 512, dir, wave, lane, tid); }
            }
            if (bx < 96 && rep_ == 0) { __syncthreads(); if (tid == 0) __hip_atomic_fetch_add(ctl + CW_S2DONE + 64 * L, 1u, RLX_AGENT); }
            if (!rep_ || REP_ATT) {
            bool gates_left = true;
            for (;;) {
                __syncthreads();
                if (tid == 0) { unsigned v = 0xffffffffu;
                    if (gates_left) for (int k8 = 0; k8 < 8; ++k8) { const int x = (bx + k8) & 7; const unsigned b0 = __hip_atomic_fetch_add(gq + 64 * x, 1u, RLX_AGENT); if (b0 < (unsigned)(320 / GATE_BATCH)) { v = (unsigned)x * 4096u + b0; break; } }
                    MISC[17] = v; if (v == 0xffffffffu) MISC[16] = __hip_atomic_fetch_add(wq, 1u, RLX_AGENT); }
                __syncthreads();
                const unsigned gsel = MISC[17];
                if (gsel != 0xffffffffu) {
                    const unsigned char* g8b = (const unsigned char*)(WSP(bf16, WS_WIN) + ((size_t)L * NIN + LDP) * DM) - (size_t)33 * 256 * DM;
                    pg8::Gemm g8{WSP(bf16, WS_H8), (const bf16*)g8b, NT, NIN, DM / 2}; pg8::GateBatchOrder S8{(int)(gsel >> 12), (int)(gsel & 4095u) * GATE_BATCH, GATE_BATCH}; pg8::EpiInProj E8{WSP(bf16, WS_P), WSP(bf16, WS_G)};
                    pg8::gemm_phase_f8<pg8::EpiInProj, pg8::GateBatchOrder, true, F8_SP2>(lds + RING_OFF, g8, S8, E8);
                    continue; }
                gates_left = false;
                int it = (int)MISC[16];
                if (it >= 512) break;
                int lane_ = lane, tid_q = tid; asm volatile("" : "+v"(lane_), "+v"(tid_q));
                if (it < 256) {
                    const int b = it >> 6, h = (it >> 3) & 7, rq = it & 7;
#pragma unroll 1
                    for (int q4 = 0; q4 < 4; ++q4) na_wave_unit(P, WSP(bf16, WS_NAVT), KIN(kp, 6) + L * 8 * 15 * 31, BR, b, h, 8 * rq + 2 * q4 + (wave >> 2), wave & 3, lane_);
                } else {
                    const int i2 = it - 256, tb = i2 >> 2, h = i2 & 3;
                    mem_wg_unit(lds + RING_OFF, P, WSP(bf16, WS_MK) + (size_t)L * 1024 * 512, WSP(bf16, WS_MVT) + (size_t)L * 4 * 4 * 128 * 256, BR + (size_t)4 * NT * 512, tb * 256, h, wave, lane_, tid_q);
                }
            }
            }
            if (FILL_TAIL && G >= 128 && rep_ == 0 && bx >= 144) { LAS float* scr = (LAS float*)(lds + RING_OFF + wave * 16384);
                moe_drain(KIN(kp, 28), KIN(kp, 29), KIN(kp, 30), ws, ctl + CW_CONVQ, ctl + CW_S2DONE + 64 * L, 96u, MISC + 20, scr, wave, lane, tid); }
        }
        SEAM(pb + 3);
        if (EN_PH(4) && IN(pb + 4)) for (int rep_ = 0; rep_ < REPS(4); ++rep_) { PHASE_VARS; LAYER_PTRS(lp); for (int t = gw; t < NT; t += NGW) post_token(lp, WSP(bf16, WS_P), WSP(bf16, WS_SOUT), WSP(bf16, WS_BR), t, lane);
            if (L == 1 && rep_ == 0) {
                bf16* MOE1 = WSP(bf16, WS_MOE1); bf16* MOE2 = WSP(bf16, WS_MOE2F); LAS float* scr = (LAS float*)(lds + RING_OFF + wave * 16384);
                if (FILL_TAIL && G >= 128) moe_drain(KIN(kp, 28), KIN(kp, 29), KIN(kp, 30), ws, ctl + CW_CONVQ, nullptr, 0u, MISC + 20, scr, wave, lane, tid);
                else { moe1_convert_all(KIN(kp, 28), KIN(kp, 29), (unsigned char*)MOE1, scr, gw, NGW, lane);
#pragma unroll 1
                    for (int e = 0; e < NEXP; ++e) transpose_job_f8(KIN(kp, 30) + (size_t)e * DFFE * DM, 64.0f, DFFE, DM, (unsigned char*)MOE2 + (size_t)e * DM * DFFE, scr, gw, NGW, lane, RmOff{0}); }
            }
        }
        SEAM(pb + 4);
        if (EN_PH(5) && IN(pb + 5)) { PHASE_VARS; pg8::Gemm g{WSP(bf16, WS_BR), WSP(bf16, WS_WBR) + (size_t)L * 5 * DM * 512, 5 * NT, 5 * DM, 512}; pg8::BranchOrder5 S{G, bx}; pg8::EpiBranchAcc E{WSP(bf16, WS_G), WSP(bf16, WS_HM)};
            pg8::gemm_phase<pg8::EpiBranchAcc, pg8::BranchOrder5, true, true>(lds + RING_OFF, g, S, E); }
        SEAM(pb + 5);
        if (EN_PH(7) && IN(pb + 7)) { PHASE_VARS; const float* xres = L ? (const float*)out : KIN(kp, 0);
            pg8::Gemm g{WSP(bf16, WS_HM), WSP(bf16, WS_WOUT) + (size_t)L * DM * DM, NT, DM, DM}; pg8::StaticOrder S; S.init(NT, DM, G, bx); pg8::EpiResF32 E{xres, out, DM, 1 << 20};
            pg8::gemm_phase<pg8::EpiResF32, pg8::StaticOrder, true, true>(lds + RING_OFF, g, S, E); }
        SEAM(pb + 7);
        if (L == 0) {
            if (EN_PH(8) && IN(pb + 8)) for (int rep_ = 0; rep_ < REPS(8); ++rep_) { PHASE_VARS; const float* gf = KIN(kp, 22) + L * DM; bf16* HM = WSP(bf16, WS_HM);
                for (int t = gw; t < NT; t += NGW) { f32x4 v[8]; rms_row(out + (size_t)t * DM, gf, HM + (size_t)t * DM, lane, v); } }
            SEAM(pb + 8);
            if (EN_PH(9) && IN(pb + 9)) for (int rep_ = 0; rep_ < REPS(9); ++rep_) { PHASE_VARS; pg8::Gemm g{WSP(bf16, WS_HM), WSP(bf16, WS_WGU), NT, 2 * DFF, DM}; pg8::StaticOrder S; S.init(NT, 2 * DFF, G, bx); pg8::EpiSwiGLU E{WSP(bf16, WS_HID), DFF, 1 << 20};
                GEMM_STAGGER(); pg8::gemm_phase<pg8::EpiSwiGLU, pg8::StaticOrder, true, true>(lds + RING_OFF, g, S, E); }
            SEAM(pb + 9);
            if (EN_PH(10) && IN(pb + 10)) { PHASE_VARS; pg8::Gemm g{WSP(bf16, WS_HID), WSP(bf16, WS_WDN), NT, DM, DFF}; pg8::StaticOrder S; S.init(NT, DM, G, bx); pg8::EpiResF32 E{out, out, DM, 1 << 20};
                pg8::gemm_phase<pg8::EpiResF32, pg8::StaticOrder, true, true>(lds + RING_OFF, g, S, E); }
            SEAM(pb + 10);
        } else {
            if (EN_PH(8) && IN(pb + 8)) { PHASE_VARS; gu32* cnt = ctl + CW_CNT; unsigned* ROUTE = WSP(unsigned, WS_ROUTE); bf16* HM = WSP(bf16, WS_HM);
                const float* wr = KIN(kp, 26); const float* brt = KIN(kp, 27); const float* gf = KIN(kp, 22) + L * DM;
                LAS unsigned* lcnt = (LAS unsigned*)(lds + RING_OFF); LAS unsigned* gbase = lcnt + 8;
                for (int blk = bx; blk < NT / 64; blk += G) {
                    __syncthreads(); if (tid < 8) lcnt[tid] = 0u; __syncthreads();
                    unsigned re0 = 0, re1 = 0, rp0 = 0, rp1 = 0; float rw0 = 0.f, rw1 = 0.f;
#pragma unroll 1
                    for (int tt = 0; tt < 8; ++tt) { const int t = blk * 64 + wave * 8 + tt; f32x4 v[8]; rms_row_f8(out + (size_t)t * DM, gf, (unsigned char*)HM + (size_t)t * DM, lane, v);
                        float lg[8];
#pragma unroll
                        for (int e = 0; e < 8; ++e) lg[e] = 0.f;
#pragma unroll
                        for (int j = 0; j < 8; ++j)
#pragma unroll
                            for (int q = 0; q < 4; ++q) { const float* wp = wr + (size_t)(4 * (lane + 64 * j) + q) * 8; const f32x4 w0 = *(const f32x4*)wp, w1 = *(const f32x4*)(wp + 4); const float hv = v[j][q];
                                lg[0] += hv * w0[0]; lg[1] += hv * w0[1]; lg[2] += hv * w0[2]; lg[3] += hv * w0[3]; lg[4] += hv * w1[0]; lg[5] += hv * w1[1]; lg[6] += hv * w1[2]; lg[7] += hv * w1[3]; }
#pragma unroll
                        for (int e = 0; e < 8; ++e) lg[e] = wave_sum(lg[e]) + brt[e];
                        int e0 = 0; float m0 = lg[0];
#pragma unroll
                        for (int e = 1; e < 8; ++e) if (lg[e] > m0) { m0 = lg[e]; e0 = e; }
                        int e1 = 0; float m1 = -3.0e38f;
#pragma unroll
                        for (int e = 0; e < 8; ++e) if (e != e0 && lg[e] > m1) { m1 = lg[e]; e1 = e; }
                        const float w0 = 1.0f / (1.0f + __expf(m1 - m0));
                        if (lane == tt) { re0 = e0; re1 = e1; rw0 = w0; rw1 = 1.0f - w0;
                            rp0 = __hip_atomic_fetch_add(&lcnt[e0], 1u, __ATOMIC_RELAXED, __HIP_MEMORY_SCOPE_WORKGROUP); rp1 = __hip_atomic_fetch_add(&lcnt[e1], 1u, __ATOMIC_RELAXED, __HIP_MEMORY_SCOPE_WORKGROUP); }
                    }
                    __syncthreads();
                    if (tid < 8) gbase[tid] = __hip_atomic_fetch_add(cnt + 64 * tid, lcnt[tid], RLX_AGENT);
                    __syncthreads();
                    if (lane < 8) { const int t = blk * 64 + wave * 8 + lane; unsigned* rr = ROUTE + (size_t)t * 8;
                        rr[0] = re0; rr[1] = re1; rr[2] = gbase[re0] + rp0; rr[3] = gbase[re1] + rp1; rr[4] = __float_as_uint(rw0); rr[5] = __float_as_uint(rw1); }
                }
            }
            SEAM(pb + 8);
            if (hi > pb + 9) { PHASE_VARS; gu32* cnt = ctl + CW_CNT;
                __syncthreads();
                if (tid == 0) { int acc = 0; for (int e = 0; e < 8; ++e) { const int c = (int)__hip_atomic_load(cnt + 64 * e, RLX_AGENT); const int nb = (c + 255) >> 8; TAB[e] = nb; TAB[8 + e] = acc; TAB[32 + e] = acc * 256; acc += nb; } TAB[40] = acc; }
                __syncthreads();
            }
            if (EN_PH(9) && IN(pb + 9)) for (int rep_ = 0; rep_ < REPS(9); ++rep_) { PHASE_VARS; bf16* XB = WSP(bf16, WS_XB); unsigned* ROUTE = WSP(unsigned, WS_ROUTE); const bf16* HM = WSP(bf16, WS_HM);
                for (int t = gw; t < NT; t += NGW) { unsigned* rr = ROUTE + (size_t)t * 8; const unsigned e0 = rr[0], e1 = rr[1]; const unsigned s0 = (unsigned)TAB[32 + e0] + rr[2], s1 = (unsigned)TAB[32 + e1] + rr[3];
                    if (lane == 0) { rr[6] = s0; rr[7] = s1; }
                    const v4u* src = (const v4u*)((const unsigned char*)HM + (size_t)t * DM) + lane; v4u* d0 = (v4u*)((unsigned char*)XB + (size_t)s0 * DM) + lane; v4u* d1 = (v4u*)((unsigned char*)XB + (size_t)s1 * DM) + lane;
#pragma unroll
                    for (int j = 0; j < 2; ++j) { const v4u x = src[64 * j]; d0[64 * j] = x; d1[64 * j] = x; } } }
            SEAM(pb + 9);
            if (EN_PH(10) && IN(pb + 10)) for (int rep_ = 0; rep_ < REPS(20); ++rep_) { PHASE_VARS; __syncthreads(); if (tid == 0) { for (int e = 0; e <= 8; ++e) TAB[16 + e] = (e < 8 ? TAB[8 + e] : TAB[40]) * 56; } __syncthreads();
                pg8::Gemm g{WSP(bf16, WS_XB), WSP(bf16, WS_MOE1), MAXSLOT, 8 * 2 * DFFE, DM / 2}; pg8::MoeOrder S{G, bx, 56, TAB[40] * 56, TAB}; pg8::EpiSwiGLU8 E{WSP(unsigned char, WS_HIDM), DFFE, 56};
                GEMM_STAGGER(); pg8::gemm_phase_f8<pg8::EpiSwiGLU8, pg8::MoeOrder, true, F8_SP2>(lds + RING_OFF, g, S, E); }
            SEAM(pb + 10);
            if (EN_PH(11) && IN(pb + 11)) for (int rep_ = 0; rep_ < REPS(11); ++rep_) { PHASE_VARS; __syncthreads(); if (tid == 0) { for (int e = 0; e <= 8; ++e) TAB[16 + e] = (e < 8 ? TAB[8 + e] : TAB[40]) * 8; } __syncthreads();
                pg8::Gemm g{WSP(bf16, WS_HIDM), WSP(bf16, WS_MOE2F), MAXSLOT, 8 * DM, DFFE / 2}; pg8::MoeOrder S{G, bx, 8, TAB[40] * 8, TAB}; pg8::EpiBf16Out E{WSP(bf16, WS_YB), DM, 8};
                GEMM_STAGGER(); pg8::gemm_phase_f8<pg8::EpiBf16Out, pg8::MoeOrder, true, F8_SP2>(lds + RING_OFF, g, S, E); }
            SEAM(pb + 11);
            if (EN_PH(12) && IN(pb + 12)) { PHASE_VARS; const bf16* YB = WSP(bf16, WS_YB); const unsigned* ROUTE = WSP(unsigned, WS_ROUTE);
                for (int t = gw; t < NT; t += NGW) { const unsigned* rr = ROUTE + (size_t)t * 8; const float w0 = __uint_as_float(rr[4]), w1 = __uint_as_float(rr[5]); const size_t s0 = rr[6], s1 = rr[7];
                    f32x4* o = (f32x4*)(out + (size_t)t * DM) + lane; const v2u* y0 = (const v2u*)(YB + s0 * DM) + lane; const v2u* y1 = (const v2u*)(YB + s1 * DM) + lane;
#pragma unroll
                    for (int j = 0; j < 8; ++j) { const v2u a = y0[64 * j], b = y1[64 * j];
                        o[64 * j] = o[64 * j] + w0 * (f32x4){bflo(a.x), bfhi(a.x), bflo(a.y), bfhi(a.y)} + w1 * (f32x4){bflo(b.x), bfhi(b.x), bflo(b.y), bfhi(b.y)}; } } }
        }
    }
#undef IN
#undef SEAM
}
extern "C" void kernel_launch(void* const* d_in, const int* in_sizes, int n_in, void* d_out, int out_size, void* d_ws, size_t ws_size, hipStream_t stream) {
    static int grid = 0;
    if (grid == 0) {
        if (n_in != 31 || in_sizes[0] != NT * DM || out_size != NT * DM || ws_size < WS_END) { fprintf(stderr, "kernel_launch: unexpected shapes (n_in %d, in0 %d, out %d, ws %zu < %zu); nothing launched\n", n_in, n_in > 0 ? in_sizes[0] : -1, out_size, ws_size, (size_t)WS_END); grid = -1; return; }
        int dev = 0, cus = 0, per_cu = 0;
        if (hipGetDevice(&dev) != hipSuccess || hipDeviceGetAttribute(&cus, hipDeviceAttributeMultiprocessorCount, dev) != hipSuccess) { grid = -1; return; }
        if (hipFuncSetAttribute((const void*)mega_fwd, hipFuncAttributeMaxDynamicSharedMemorySize, LDS_BYTES) != hipSuccess) { fprintf(stderr, "kernel_launch: hipFuncSetAttribute failed\n"); grid = -1; return; }
        if (hipOccupancyMaxActiveBlocksPerMultiprocessor(&per_cu, (const void*)mega_fwd, NWAVES * 64, LDS_BYTES) != hipSuccess || per_cu < 1) fprintf(stderr, "kernel_launch: occupancy query reports %d\n", per_cu);
        (void)hipGetLastError();
        grid = cus;
    }
    if (grid < 0) return;
    if (hipMemsetAsync((char*)d_ws + WS_CTL, 0, CTL_ZERO_BYTES, stream) != hipSuccess) return;
    Args a{};
    for (int i = 0; i < 31; ++i) a.in[i] = (const float*)d_in[i];
    a.out = (float*)d_out; a.ws = (unsigned char*)d_ws;
#if MK_SPLIT
    int ids[40]; int n = 0; ids[n++] = 0;
    for (int L = 0; L < 2; ++L) for (int k = 0; k < (L ? 13 : 11); ++k) { ids[n++] = 1 + 16 * L + k; if (k == 2) ids[n++] = 1 + 16 * L + 13; }
    for (int i = 0; i < n; ++i) { a.ph_lo = ids[i]; a.ph_hi = ids[i] + 1; hipLaunchKernelGGL(mega_fwd, dim3(grid), dim3(NWAVES * 64), LDS_BYTES, stream, a); }
#else
    a.ph_lo = 0; a.ph_hi = 64;
    hipLaunchKernelGGL(mega_fwd, dim3(grid), dim3(NWAVES * 64), LDS_BYTES, stream, a);
#endif
    const hipError_t le = hipPeekAtLastError();
    if (le != hipSuccess) fprintf(stderr, "kernel_launch: launch failed: %s\n", hipGetErrorName(le));
}
```

```cpp
#include <hip/hip_runtime.h>
#include <cstdio>
#include <cstdint>
__device__ __forceinline__ int pg8_tid();
namespace pg8 {
#define PG8_LAS __attribute__((address_space(3)))
typedef unsigned short bf16_t;
typedef short bf16x8 __attribute__((ext_vector_type(8)));
typedef float f32x4 __attribute__((ext_vector_type(4)));
typedef unsigned u32x4 __attribute__((ext_vector_type(4)));
constexpr int BM = 256, BK = 64, HALF = 128, HTB = HALF * BK * 2  , STAGE_BYTES = 8 * HTB, NXCD = 8, WGM = 8;

__host__ __device__ __forceinline__ int lds_byte(int r, int c) { const int st = (r >> 4) * 2 + (c >> 5), rr = r & 15, cc = c & 31, ob = rr * 64 + cc * 2; return st * 1024 + (ob ^ (((ob >> 9) & 1) << 5)); }
__host__ __device__ __forceinline__ void stage_rc(int b, int& R, int& C) { const int st = b / 1024, sb = b % 1024, swz = sb ^ (((sb >> 9) & 1) << 5); R = (st >> 1) * 16 + swz / 64; C = (st & 1) * 32 + (swz % 64) / 2; }
__host__ __device__ __forceinline__ int perm32(int rho) { const int n = rho >> 4, i = rho & 15; return 8 * (i >> 2) + 4 * n + (i & 3); }

struct Unit { int pm, pn; };
struct Gemm { const bf16_t* A; const bf16_t* Bt; int M, N, K; };

struct StaticOrder {
    int nM, nN, nwg, G, c;
    __host__ __device__ void init(int M, int N, int G_, int c_) { nM = M / BM; nN = N / BM; nwg = nM * nN; G = G_; c = c_; }
    __host__ __device__ bool next(int i, Unit& u) const {
        const long L = (long)i * G + c; if (L >= nwg) return false;
        int wgid = (int)L; { const int q = nwg / NXCD, r = nwg % NXCD, xcd = wgid % NXCD, off = wgid / NXCD; wgid = (xcd < r ? xcd * (q + 1) : r * (q + 1) + (xcd - r) * q) + off; }
        const int nig = WGM * nN, gid = wgid / nig, fm = gid * WGM, gsz = (nM - fm) < WGM ? (nM - fm) : WGM;
        u.pm = fm + ((wgid % nig) % gsz); u.pn = (wgid % nig) / gsz; return true;
    }
    __device__ __forceinline__ void a_ready(const Unit&) const {}
    __device__ __forceinline__ void done(const Unit&) const {}
};
__device__ __forceinline__ unsigned cvt_pk_bf16(float lo, float hi) { unsigned r; asm volatile("v_cvt_pk_bf16_f32 %0, %1, %2" : "=v"(r) : "v"(lo), "v"(hi)); return r; }
typedef float f32x2 __attribute__((ext_vector_type(2)));
__device__ __forceinline__ float sigm(float x) { return __builtin_amdgcn_rcpf(1.0f + __expf(-x)); }
struct EpiInProj {
    static constexpr bool PERM = true, AFTER_DRAIN = false, CARRY = false;
    bf16_t* P; bf16_t* G;
    __device__ __forceinline__ void operator()(const f32x4 (&acc)[2][2][4][2], const Unit& u, int wr, int wc, int fr, int fq) const {
        const int row0 = u.pm * BM + wr * 64 + fr; const bool isg = u.pn >= 33;
#if defined(SKIP_G)
        if (isg) return;
#endif
        bf16_t* base = isg ? G : P; const int ldc = isg ? 10240 : 8448; const int col0 = (isg ? (u.pn - 33) : u.pn) * BM + wc * 32 + 8 * fq;
#pragma unroll
        for (int ai = 0; ai < 2; ++ai)
#pragma unroll
            for (int m = 0; m < 4; ++m) { bf16_t* rowp = base + (size_t)(row0 + ai * HALF + m * 16) * ldc + col0;
#pragma unroll
                for (int bj = 0; bj < 2; ++bj) { f32x4 v0 = acc[ai][bj][m][0], v1 = acc[ai][bj][m][1];
                    if (isg) {
                        unsigned lo = 0u, hi = 0u;
#pragma unroll
                        for (int j = 0; j < 4; ++j) { lo = __builtin_amdgcn_cvt_pk_u8_f32(sigm(v0[j]) * 255.0f, j, lo); hi = __builtin_amdgcn_cvt_pk_u8_f32(sigm(v1[j]) * 255.0f, j, hi); }
                        typedef unsigned u32x2 __attribute__((ext_vector_type(2)));
                        *(u32x2*)((unsigned char*)G + (size_t)(row0 + ai * HALF + m * 16) * 10240 + col0 + bj * HALF) = (u32x2){lo, hi};
                    } else {
                    u32x4 w; w.x = cvt_pk_bf16(v0[0], v0[1]); w.y = cvt_pk_bf16(v0[2], v0[3]); w.z = cvt_pk_bf16(v1[0], v1[1]); w.w = cvt_pk_bf16(v1[2], v1[3]);
                    *(u32x4*)(rowp + bj * HALF) = w; } } }
    }
};
struct EpiGate {
    static constexpr bool PERM = true, AFTER_DRAIN = false, CARRY = false;
    bf16_t* G;
    __device__ __forceinline__ void operator()(const f32x4 (&acc)[2][2][4][2], const Unit& u, int wr, int wc, int fr, int fq) const {
        const int row0 = u.pm * BM + wr * 64 + fr, col0 = u.pn * BM + wc * 32 + 8 * fq;
#pragma unroll
        for (int ai = 0; ai < 2; ++ai)
#pragma unroll
            for (int m = 0; m < 4; ++m) { bf16_t* rowp = G + (size_t)(row0 + ai * HALF + m * 16) * 10240 + col0;
#pragma unroll
                for (int bj = 0; bj < 2; ++bj) { f32x4 v0 = acc[ai][bj][m][0], v1 = acc[ai][bj][m][1];
#pragma unroll
                    for (int j = 0; j < 4; ++j) { v0[j] = sigm(v0[j]); v1[j] = sigm(v1[j]); }
                    u32x4 w; w.x = cvt_pk_bf16(v0[0], v0[1]); w.y = cvt_pk_bf16(v0[2], v0[3]); w.z = cvt_pk_bf16(v1[0], v1[1]); w.w = cvt_pk_bf16(v1[2], v1[3]);
                    *(u32x4*)(rowp + bj * HALF) = w; } }
    }
};
struct EpiBranch {
    static constexpr bool PERM = true, AFTER_DRAIN = false, CARRY = false;
    bf16_t* G;
    __device__ __forceinline__ void operator()(const f32x4 (&acc)[2][2][4][2], const Unit& u, int wr, int wc, int fr, int fq) const {
        const int n = u.pn >> 3, j = u.pn & 7; const int row0 = (u.pm & 63) * BM + wr * 64 + fr, col0 = n * 2048 + j * BM + wc * 32 + 8 * fq;
#pragma unroll
        for (int ai = 0; ai < 2; ++ai)
#pragma unroll
            for (int m = 0; m < 4; ++m) { bf16_t* rowp = G + (size_t)(row0 + ai * HALF + m * 16) * 10240 + col0;
#pragma unroll
                for (int bj = 0; bj < 2; ++bj) { const u32x4 g = *(const u32x4*)(rowp + bj * HALF); const f32x4 v0 = acc[ai][bj][m][0], v1 = acc[ai][bj][m][1];
                    u32x4 w;
                    w.x = cvt_pk_bf16(v0[0] * __uint_as_float(g.x << 16), v0[1] * __uint_as_float(g.x & 0xffff0000u));
                    w.y = cvt_pk_bf16(v0[2] * __uint_as_float(g.y << 16), v0[3] * __uint_as_float(g.y & 0xffff0000u));
                    w.z = cvt_pk_bf16(v1[0] * __uint_as_float(g.z << 16), v1[1] * __uint_as_float(g.z & 0xffff0000u));
                    w.w = cvt_pk_bf16(v1[2] * __uint_as_float(g.w << 16), v1[3] * __uint_as_float(g.w & 0xffff0000u));
                    *(u32x4*)(rowp + bj * HALF) = w; } }
    }
};
struct EpiBranchAcc {
    static constexpr bool PERM = true, AFTER_DRAIN = false, CARRY = false;
    const bf16_t* G; bf16_t* Mg;
    __device__ __forceinline__ void operator()(const f32x4 (&acc)[2][2][4][2], const Unit& u, int wr, int wc, int fr, int fq) const {
        typedef unsigned u32x2 __attribute__((ext_vector_type(2)));
        const int n = u.pn >> 3, j = u.pn & 7; const int row0 = (u.pm & 63) * BM + wr * 64 + fr, gcol0 = n * 2048 + j * BM + wc * 32 + 8 * fq, mcol0 = j * BM + wc * 32 + 8 * fq;
#pragma unroll
        for (int ai = 0; ai < 2; ++ai) { u32x2 gg[4][2]; u32x4 ov[4][2];
#pragma unroll
            for (int m = 0; m < 4; ++m) { const unsigned char* gp = (const unsigned char*)G + (size_t)(row0 + ai * HALF + m * 16) * 10240 + gcol0; const bf16_t* mp = Mg + (size_t)(row0 + ai * HALF + m * 16) * 2048 + mcol0;
#pragma unroll
                for (int bj = 0; bj < 2; ++bj) { gg[m][bj] = *(const u32x2*)(gp + bj * HALF);
                    if (n) ov[m][bj] = *(const u32x4*)(mp + bj * HALF); } }
#pragma unroll
            for (int m = 0; m < 4; ++m) { bf16_t* mp = Mg + (size_t)(row0 + ai * HALF + m * 16) * 2048 + mcol0;
#pragma unroll
                for (int bj = 0; bj < 2; ++bj) { const u32x2 g = gg[m][bj]; const f32x4 v0 = acc[ai][bj][m][0] * (1.0f / 255.0f), v1 = acc[ai][bj][m][1] * (1.0f / 255.0f);
                    float z[8] = {v0[0] * (float)(g.x & 0xffu), v0[1] * (float)((g.x >> 8) & 0xffu), v0[2] * (float)((g.x >> 16) & 0xffu), v0[3] * (float)(g.x >> 24),
                                  v1[0] * (float)(g.y & 0xffu), v1[1] * (float)((g.y >> 8) & 0xffu), v1[2] * (float)((g.y >> 16) & 0xffu), v1[3] * (float)(g.y >> 24)};
                    if (n) { const unsigned w0 = ov[m][bj].x, w1 = ov[m][bj].y, w2 = ov[m][bj].z, w3 = ov[m][bj].w;
                        z[0] += __uint_as_float(w0 << 16); z[1] += __uint_as_float(w0 & 0xffff0000u); z[2] += __uint_as_float(w1 << 16); z[3] += __uint_as_float(w1 & 0xffff0000u);
                        z[4] += __uint_as_float(w2 << 16); z[5] += __uint_as_float(w2 & 0xffff0000u); z[6] += __uint_as_float(w3 << 16); z[7] += __uint_as_float(w3 & 0xffff0000u); }
                    u32x4 w; w.x = cvt_pk_bf16(z[0], z[1]); w.y = cvt_pk_bf16(z[2], z[3]); w.z = cvt_pk_bf16(z[4], z[5]); w.w = cvt_pk_bf16(z[6], z[7]);
                    *(u32x4*)(mp + bj * HALF) = w; } }
            asm volatile("" ::: "memory"); }
    }
};
struct EpiResF32 {
    static constexpr bool PERM = false, AFTER_DRAIN = false, CARRY = false;
    const float* R; float* O; int ldc; int ntn;
    __device__ __forceinline__ void operator()(const f32x4 (&acc)[2][2][4][2], const Unit& u, int wr, int wc, int fr, int fq) const {
        const int row0 = u.pm * BM + wr * 64 + fr, col0 = (u.pn % ntn) * BM + wc * 32 + 4 * fq;
#pragma unroll
        for (int ai = 0; ai < 2; ++ai) { f32x4 r[4][2][2];
            if (R) {
#pragma unroll
                for (int m = 0; m < 4; ++m) { const size_t off = (size_t)(row0 + ai * HALF + m * 16) * ldc + col0;
#pragma unroll
                    for (int bj = 0; bj < 2; ++bj)
#pragma unroll
                        for (int n = 0; n < 2; ++n) r[m][bj][n] = *(const f32x4*)(R + off + bj * HALF + n * 16); } }
#pragma unroll
            for (int m = 0; m < 4; ++m) { const size_t off = (size_t)(row0 + ai * HALF + m * 16) * ldc + col0;
#pragma unroll
                for (int bj = 0; bj < 2; ++bj)
#pragma unroll
                    for (int n = 0; n < 2; ++n) { f32x4 o = acc[ai][bj][m][n]; if (R) o = o + r[m][bj][n]; *(f32x4*)(O + off + bj * HALF + n * 16) = o; } }
            asm volatile("" ::: "memory"); }
    }
};
struct EpiBf16Out {
    static constexpr bool PERM = false, AFTER_DRAIN = false, CARRY = false;
    bf16_t* O; int ldc; int ntn;
    __device__ __forceinline__ void operator()(const f32x4 (&acc)[2][2][4][2], const Unit& u, int wr, int wc, int fr, int fq) const {
        typedef unsigned u32x2 __attribute__((ext_vector_type(2)));
        const int row0 = u.pm * BM + wr * 64 + fr, col0 = (u.pn % ntn) * BM + wc * 32 + 4 * fq;
#pragma unroll
        for (int ai = 0; ai < 2; ++ai)
#pragma unroll
            for (int m = 0; m < 4; ++m) { bf16_t* rowp = O + (size_t)(row0 + ai * HALF + m * 16) * ldc + col0;
#pragma unroll
                for (int bj = 0; bj < 2; ++bj)
#pragma unroll
                    for (int n = 0; n < 2; ++n) { const f32x4 v = acc[ai][bj][m][n]; *(u32x2*)(rowp + bj * HALF + n * 16) = (u32x2){cvt_pk_bf16(v[0], v[1]), cvt_pk_bf16(v[2], v[3])}; } }
    }
};
struct EpiSwiGLU {
    static constexpr bool PERM = true, AFTER_DRAIN = false, CARRY = false;
    bf16_t* H; int ldh; int tpg;
    __device__ __forceinline__ void operator()(const f32x4 (&acc)[2][2][4][2], const Unit& u, int wr, int wc, int fr, int fq) const {
        const int row0 = u.pm * BM + wr * 64 + fr, col0 = (u.pn % tpg) * HALF + wc * 32 + 8 * fq;
#pragma unroll
        for (int ai = 0; ai < 2; ++ai)
#pragma unroll
            for (int m = 0; m < 4; ++m) { bf16_t* rowp = H + (size_t)(row0 + ai * HALF + m * 16) * ldh + col0;
                f32x4 h0, h1;
#pragma unroll
                for (int j = 0; j < 4; ++j) { const float g0 = acc[ai][0][m][0][j], g1 = acc[ai][0][m][1][j]; h0[j] = g0 * sigm(g0) * acc[ai][1][m][0][j]; h1[j] = g1 * sigm(g1) * acc[ai][1][m][1][j]; }
                u32x4 w; w.x = cvt_pk_bf16(h0[0], h0[1]); w.y = cvt_pk_bf16(h0[2], h0[3]); w.z = cvt_pk_bf16(h1[0], h1[1]); w.w = cvt_pk_bf16(h1[2], h1[3]);
                *(u32x4*)rowp = w; }
    }
};
struct EpiNull {
    static constexpr bool PERM = true, AFTER_DRAIN = false, CARRY = false;
    __device__ __forceinline__ void operator()(const f32x4 (&acc)[2][2][4][2], const Unit&, int, int, int, int) const {
#pragma unroll
        for (int a = 0; a < 2; ++a)
#pragma unroll
            for (int b = 0; b < 2; ++b)
#pragma unroll
                for (int m = 0; m < 4; ++m)
#pragma unroll
                    for (int n = 0; n < 2; ++n) asm volatile("" :: "v"(acc[a][b][m][n]));
    }
};
struct EpiSwiGLU8 {
    static constexpr bool PERM = true, AFTER_DRAIN = false, CARRY = false;
    unsigned char* H; int ldh; int tpg;
    __device__ __forceinline__ void operator()(const f32x4 (&acc)[2][2][4][2], const Unit& u, int wr, int wc, int fr, int fq) const {
        const int row0 = u.pm * BM + wr * 64 + fr, col0 = (u.pn % tpg) * HALF + wc * 32 + 8 * fq;
#pragma unroll
        for (int ai = 0; ai < 2; ++ai)
#pragma unroll
            for (int m = 0; m < 4; ++m) { unsigned char* rowp = H + (size_t)(row0 + ai * HALF + m * 16) * ldh + col0;
                f32x4 h0, h1;
#pragma unroll
                for (int j = 0; j < 4; ++j) { const float g0 = acc[ai][0][m][0][j], g1 = acc[ai][0][m][1][j]; h0[j] = g0 * sigm(g0) * acc[ai][1][m][0][j]; h1[j] = g1 * sigm(g1) * acc[ai][1][m][1][j]; }
                int w0 = __builtin_amdgcn_cvt_pk_fp8_f32(h0[0], h0[1], 0, false); w0 = __builtin_amdgcn_cvt_pk_fp8_f32(h0[2], h0[3], w0, true);
                int w1 = __builtin_amdgcn_cvt_pk_fp8_f32(h1[0], h1[1], 0, false); w1 = __builtin_amdgcn_cvt_pk_fp8_f32(h1[2], h1[3], w1, true);
                typedef unsigned u32x2 __attribute__((ext_vector_type(2))); *(u32x2*)rowp = (u32x2){(unsigned)w0, (unsigned)w1}; }
    }
};
struct BranchOrder {
    int G, c;
    __device__ bool next(int i, Unit& u) const {
        const long L = (long)i * G + c; if (L >= 2560) return false;
        int w = (int)L; { const int xcd = w % NXCD, off = w / NXCD; w = xcd * 320 + off; }
        const int n = w / 512, rem = w % 512, gid = rem / 64, r2 = rem % 64;
        u.pm = n * 64 + gid * 8 + (r2 % 8); u.pn = n * 8 + r2 / 8; return true;
    }
    __device__ __forceinline__ void a_ready(const Unit&) const {}
    __device__ __forceinline__ void done(const Unit&) const {}
};
struct BranchOrder5 {
    int G, c;
    __device__ bool next(int i, Unit& u) const {
        const int tt = (i / 5) * G + c; if (tt >= 512) return false; const int n = i % 5;
        const int w = (tt % NXCD) * 64 + tt / NXCD, gid = w / 64, r2 = w % 64;
        u.pm = n * 64 + gid * 8 + (r2 % 8); u.pn = n * 8 + r2 / 8; return true;
    }
    __device__ __forceinline__ void a_ready(const Unit&) const {}
    __device__ __forceinline__ void done(const Unit&) const {}
};
struct GateOrder : StaticOrder {
    __device__ bool next(int i, Unit& u) const { if (!StaticOrder::next(i, u)) return false; u.pn += 33; return true; }
};
struct GateBatchOrder {
    int grp, base, n;
    __device__ bool next(int i, Unit& u) const { if (i >= n) return false; const int r = base + i; u.pm = grp * 8 + (r & 7); u.pn = 33 + (r >> 3); return true; }
    __device__ __forceinline__ void a_ready(const Unit&) const {}
    __device__ __forceinline__ void done(const Unit&) const {}
};
struct KvOrder {
    int c, c0;
    __device__ bool next(int i, Unit& u) const { const int w = c - c0; if (i != 0 || w < 0 || w >= 32) return false; u.pm = w >> 2; u.pn = (w >> 4) * 4 + (w & 3); return true; }
    __device__ __forceinline__ void a_ready(const Unit&) const {}
    __device__ __forceinline__ void done(const Unit&) const {}
};
struct MoeOrder {
    int G, c, tpe, total; const PG8_LAS int* tb;
    __device__ bool next(int i, Unit& u) const {
        const long L = (long)i * G + c; if (L >= total) return false;
        int w = (int)L; { const int q = total / NXCD, r = total % NXCD, xcd = w % NXCD, off = w / NXCD; w = (xcd < r ? xcd * (q + 1) : r * (q + 1) + (xcd - r) * q) + off; }
        int e = 0;
#pragma unroll
        for (int k = 1; k < 8; ++k) if (w >= tb[16 + k]) e = k;
        const int loc = w - tb[16 + e], nb = tb[e];
        u.pm = tb[8 + e] + loc % nb; u.pn = e * tpe + loc / nb; return true;
    }
    __device__ __forceinline__ void a_ready(const Unit&) const {}
    __device__ __forceinline__ void done(const Unit&) const {}
};
template <class Epi, class Sched, bool ALIGN_EPI = false, bool SP2 = false>
__device__ __forceinline__ void gemm_phase(PG8_LAS unsigned char* lds, const Gemm g, const Sched& S, const Epi& E) {
    int tid = pg8_tid(); asm volatile("" : "+v"(tid));
    const int wid = __builtin_amdgcn_readfirstlane(tid >> 6), lane = tid & 63, wr = wid >> 2, wc = wid & 3, fr = lane & 15, fq = lane >> 4;
    const int K = g.K, nt = K / BK;
    unsigned voffA[2], voffB[2];
#pragma unroll
    for (int i = 0; i < 2; ++i) { int R, C; stage_rc(tid * 16 + i * 8192, R, C); const int Rb = Epi::PERM ? ((R & ~31) + perm32(R & 31)) : R;
        voffA[i] = (unsigned)(R * K + C) * 2u; voffB[i] = (unsigned)(Rb * K + C) * 2u; }
    const size_t kstep = (size_t)(BK * 2);
    const size_t hstep = (size_t)HALF * K * 2;
    const size_t tstep = 2 * hstep;
    const unsigned ldsw = (unsigned)wid * 1024u;
    const int aoff = lds_byte(wr * 64 + fr, fq * 8), boff = lds_byte(wc * 32 + fr, fq * 8);
#define PG8_SA(b, h) (((b) * 2 + (h)) * HTB)
#define PG8_SB(b, h) ((4 + (b) * 2 + (h)) * HTB)
#define PG8_STAGE(bufoff, gbase, voff) do { _Pragma("unroll") for (int _i = 0; _i < 2; ++_i) \
        __builtin_amdgcn_global_load_lds((const unsigned*)((const char*)(gbase) + (voff)[_i]), (PG8_LAS unsigned*)(lds + (bufoff) + ldsw + _i * 8192), 16, 0, 0); } while (0)
#define PG8_LDA(dst, b, h) do { _Pragma("unroll") for (int m = 0; m < 4; ++m) _Pragma("unroll") for (int k = 0; k < 2; ++k) dst[m][k] = *(const PG8_LAS bf16x8*)(lds + PG8_SA(b, h) + aoff + m * 2048 + k * 1024); } while (0)
#define PG8_LDB(dst, b, h) do { _Pragma("unroll") for (int n = 0; n < 2; ++n) _Pragma("unroll") for (int k = 0; k < 2; ++k) dst[n][k] = *(const PG8_LAS bf16x8*)(lds + PG8_SB(b, h) + boff + n * 2048 + k * 1024); } while (0)
#define PG8_MMA(ai, bj, At, Bt) do { __builtin_amdgcn_s_setprio(1); _Pragma("unroll") for (int m = 0; m < 4; ++m) _Pragma("unroll") for (int n = 0; n < 2; ++n) _Pragma("unroll") for (int k = 0; k < 2; ++k) \
        acc[ai][bj][m][n] = __builtin_amdgcn_mfma_f32_16x16x32_bf16(Bt[n][k], At[m][k], acc[ai][bj][m][n], 0, 0, 0); __builtin_amdgcn_s_setprio(0); } while (0)
#define PG8_WAIT_V(n) asm volatile("s_waitcnt vmcnt(" #n ")" ::: "memory")
#define PG8_WAIT_L(n) asm volatile("s_waitcnt lgkmcnt(" #n ")" ::: "memory")
#define PG8_BAR __builtin_amdgcn_s_barrier()
#define PG8_SCHED __builtin_amdgcn_sched_barrier(0)
    Unit cur, nxt; int ui = 0;
    if (!S.next(0, cur)) return;
    f32x4 acc[2][2][4][2];
#pragma unroll
    for (int a = 0; a < 2; ++a)
#pragma unroll
        for (int b = 0; b < 2; ++b)
#pragma unroll
            for (int m = 0; m < 4; ++m)
#pragma unroll
                for (int n = 0; n < 2; ++n) acc[a][b][m][n] = (f32x4){0.f, 0.f, 0.f, 0.f};
    bf16x8 At[4][2], B0[2][2], B1[2][2];
    const char* cA = (const char*)g.A + (size_t)cur.pm * tstep; const char* cB = (const char*)g.Bt + (size_t)cur.pn * tstep;
    S.a_ready(cur);
    if constexpr (SP2) {
        PG8_STAGE(PG8_SB(0, 0), cB, voffB); PG8_STAGE(PG8_SB(0, 1), cB + hstep, voffB); PG8_STAGE(PG8_SA(0, 0), cA, voffA); PG8_STAGE(PG8_SA(0, 1), cA + hstep, voffA);
        if (wr == 1) PG8_BAR;
        PG8_WAIT_V(2); PG8_BAR;
        PG8_STAGE(PG8_SB(1, 0), cB + kstep, voffB); PG8_STAGE(PG8_SA(1, 0), cA + kstep, voffA); PG8_STAGE(PG8_SB(1, 1), cB + hstep + kstep, voffB);
        PG8_WAIT_V(6); PG8_BAR;
    } else {
        PG8_STAGE(PG8_SB(0, 0), cB, voffB); PG8_STAGE(PG8_SA(0, 0), cA, voffA); PG8_STAGE(PG8_SB(0, 1), cB + hstep, voffB); PG8_STAGE(PG8_SA(0, 1), cA + hstep, voffA);
        if (wr == 1) PG8_BAR;
        PG8_WAIT_V(4); PG8_BAR;
        PG8_STAGE(PG8_SB(1, 0), cB + kstep, voffB); PG8_STAGE(PG8_SA(1, 0), cA + kstep, voffA); PG8_STAGE(PG8_SB(1, 1), cB + hstep + kstep, voffB);
        PG8_WAIT_V(6); PG8_BAR;
    }
    for (;;) {
        const bool has_next = S.next(ui + 1, nxt);
        const char* nA = has_next ? (const char*)g.A + (size_t)nxt.pm * tstep : cA; const char* nB = has_next ? (const char*)g.Bt + (size_t)nxt.pn * tstep : cB;
        for (int t = 0; t < nt; t += 2) {
            const bool last = (t == nt - 2);
            const char* a1 = cA + (size_t)(t + 1) * kstep;
            const char* a2 = last ? nA : cA + (size_t)(t + 2) * kstep; const char* b2 = last ? nB : cB + (size_t)(t + 2) * kstep;
            const char* a3 = a2 + kstep; const char* b3 = b2 + kstep;
            if (last && has_next) S.a_ready(nxt);
            if constexpr (SP2) {
            PG8_LDB(B0, 0, 0); PG8_LDB(B1, 0, 1); PG8_SCHED; PG8_LDA(At, 0, 0); PG8_STAGE(PG8_SA(1, 1), a1 + hstep, voffA);
            PG8_WAIT_V(8); PG8_WAIT_L(0); PG8_BAR; PG8_MMA(0, 0, At, B0); PG8_MMA(0, 1, At, B1); PG8_BAR; PG8_SCHED;
            PG8_LDA(At, 0, 1); PG8_STAGE(PG8_SB(0, 0), b2, voffB); PG8_STAGE(PG8_SB(0, 1), b2 + hstep, voffB); PG8_STAGE(PG8_SA(0, 0), a2, voffA);
            PG8_WAIT_V(8); PG8_WAIT_L(0); PG8_BAR; PG8_MMA(1, 0, At, B0); PG8_MMA(1, 1, At, B1); PG8_BAR; PG8_SCHED;
            PG8_LDB(B0, 1, 0); PG8_LDB(B1, 1, 1); PG8_SCHED; PG8_LDA(At, 1, 0); PG8_STAGE(PG8_SA(0, 1), a2 + hstep, voffA);
            PG8_WAIT_V(8); PG8_WAIT_L(0); PG8_BAR; PG8_MMA(0, 0, At, B0); PG8_MMA(0, 1, At, B1); PG8_BAR; PG8_SCHED;
            PG8_LDA(At, 1, 1); PG8_STAGE(PG8_SB(1, 0), b3, voffB); PG8_STAGE(PG8_SB(1, 1), b3 + hstep, voffB); PG8_STAGE(PG8_SA(1, 0), a3, voffA);
            PG8_WAIT_V(8); PG8_WAIT_L(0); PG8_BAR; PG8_MMA(1, 0, At, B0); PG8_MMA(1, 1, At, B1); PG8_BAR; PG8_SCHED;
            } else {
            PG8_LDB(B0, 0, 0); PG8_SCHED; PG8_LDA(At, 0, 0); PG8_STAGE(PG8_SA(1, 1), a1 + hstep, voffA);
            PG8_WAIT_L(8); PG8_BAR; PG8_WAIT_L(0); PG8_MMA(0, 0, At, B0); PG8_BAR; PG8_SCHED;
            PG8_LDB(B1, 0, 1); PG8_STAGE(PG8_SB(0, 0), b2, voffB);
            PG8_BAR; PG8_WAIT_L(0); PG8_MMA(0, 1, At, B1); PG8_BAR;
            PG8_LDA(At, 0, 1); PG8_STAGE(PG8_SA(0, 0), a2, voffA);
            PG8_BAR; PG8_WAIT_L(0); PG8_MMA(1, 0, At, B0); PG8_BAR; PG8_SCHED;
            PG8_STAGE(PG8_SB(0, 1), b2 + hstep, voffB);
            PG8_WAIT_V(6); PG8_BAR; PG8_MMA(1, 1, At, B1); PG8_BAR;
            PG8_LDB(B0, 1, 0); PG8_SCHED; PG8_LDA(At, 1, 0); PG8_STAGE(PG8_SA(0, 1), a2 + hstep, voffA);
            PG8_WAIT_L(8); PG8_BAR; PG8_WAIT_L(0); PG8_MMA(0, 0, At, B0); PG8_BAR; PG8_SCHED;
            PG8_LDB(B1, 1, 1); PG8_STAGE(PG8_SB(1, 0), b3, voffB);
            PG8_BAR; PG8_WAIT_L(0); PG8_MMA(0, 1, At, B1); PG8_BAR;
            PG8_LDA(At, 1, 1); PG8_STAGE(PG8_SA(1, 0), a3, voffA);
            PG8_BAR; PG8_WAIT_L(0); PG8_MMA(1, 0, At, B0); PG8_BAR; PG8_SCHED;
            PG8_STAGE(PG8_SB(1, 1), b3 + hstep, voffB);
            PG8_WAIT_V(6); PG8_BAR; PG8_MMA(1, 1, At, B1); PG8_BAR;
            }
        }
        if constexpr (ALIGN_EPI) { if (wr == 0) PG8_BAR; }
        if constexpr (Epi::CARRY) { int fr_ = fr, fq_ = fq; asm volatile("" : "+v"(fr_), "+v"(fq_)); E.carry(acc, cur, wr, wc, fr_, fq_); S.done(cur); }
        else if constexpr (!Epi::AFTER_DRAIN) { E(acc, cur, wr, wc, fr, fq); S.done(cur); }
        if (!has_next) break;
        if constexpr (!Epi::CARRY)
#pragma unroll
        for (int a = 0; a < 2; ++a)
#pragma unroll
            for (int b = 0; b < 2; ++b)
#pragma unroll
                for (int m = 0; m < 4; ++m)
#pragma unroll
                    for (int n = 0; n < 2; ++n) acc[a][b][m][n] = (f32x4){0.f, 0.f, 0.f, 0.f};
        cur = nxt; cA = nA; cB = nB; ++ui;
        if constexpr (ALIGN_EPI) { if (wr == 1) PG8_BAR; }
    }
    PG8_WAIT_V(0);
    if constexpr (!ALIGN_EPI) { if (wr == 0) PG8_BAR; }
    PG8_BAR;
    if constexpr (Epi::AFTER_DRAIN) { E.fused(acc, cur, wr, wc, fr, fq, lds, wid, lane); S.done(cur); }
#undef PG8_SA
#undef PG8_SB
#undef PG8_STAGE
#undef PG8_LDA
#undef PG8_LDB
#undef PG8_MMA
#undef PG8_WAIT_V
#undef PG8_WAIT_L
#undef PG8_BAR
#undef PG8_SCHED
}
typedef int i32x8 __attribute__((ext_vector_type(8)));
typedef int i32x8a __attribute__((ext_vector_type(8), aligned(16)));
template <class Epi, class Sched, bool ALIGN_EPI = false, bool SP2 = true>
__device__ __forceinline__ void gemm_phase_f8(PG8_LAS unsigned char* lds, const Gemm g, const Sched& S, const Epi& E) {
    int tid = pg8_tid(); asm volatile("" : "+v"(tid));
    const int wid = __builtin_amdgcn_readfirstlane(tid >> 6), lane = tid & 63, wr = wid >> 2, wc = wid & 3, fr = lane & 15, fq = lane >> 4;
    const int K = g.K, nt = K / BK;
    unsigned voffA[2], voffB[2];
#pragma unroll
    for (int i = 0; i < 2; ++i) { int R, C; stage_rc(tid * 16 + i * 8192, R, C); const int Rb = Epi::PERM ? ((R & ~31) + perm32(R & 31)) : R;
        voffA[i] = (unsigned)(R * K + C) * 2u; voffB[i] = (unsigned)(Rb * K + C) * 2u; }
    const size_t kstep = (size_t)(BK * 2);
    const size_t hstep = (size_t)HALF * K * 2;
    const size_t tstep = 2 * hstep;
    const unsigned ldsw = (unsigned)wid * 1024u;
    const int aoff = lds_byte(wr * 64 + fr, fq * 8), boff = lds_byte(wc * 32 + fr, fq * 8);
#define PG8_SA(b, h) (((b) * 2 + (h)) * HTB)
#define PG8_SB(b, h) ((4 + (b) * 2 + (h)) * HTB)
#define PG8_STAGE(bufoff, gbase, voff) do { _Pragma("unroll") for (int _i = 0; _i < 2; ++_i) \
        __builtin_amdgcn_global_load_lds((const unsigned*)((const char*)(gbase) + (voff)[_i]), (PG8_LAS unsigned*)(lds + (bufoff) + ldsw + _i * 8192), 16, 0, 0); } while (0)
#define PG8_LDA(dst, b, h) do { _Pragma("unroll") for (int m = 0; m < 4; ++m) { const u32x4 lo_ = *(const PG8_LAS u32x4*)(lds + PG8_SA(b, h) + aoff + m * 2048), hi_ = *(const PG8_LAS u32x4*)(lds + PG8_SA(b, h) + aoff + m * 2048 + 1024); dst[m] = (i32x8){(int)lo_.x, (int)lo_.y, (int)lo_.z, (int)lo_.w, (int)hi_.x, (int)hi_.y, (int)hi_.z, (int)hi_.w}; } } while (0)
#define PG8_LDB(dst, b, h) do { _Pragma("unroll") for (int n = 0; n < 2; ++n) { const u32x4 lo_ = *(const PG8_LAS u32x4*)(lds + PG8_SB(b, h) + boff + n * 2048), hi_ = *(const PG8_LAS u32x4*)(lds + PG8_SB(b, h) + boff + n * 2048 + 1024); dst[n] = (i32x8){(int)lo_.x, (int)lo_.y, (int)lo_.z, (int)lo_.w, (int)hi_.x, (int)hi_.y, (int)hi_.z, (int)hi_.w}; } } while (0)
#define PG8_MMA(ai, bj, At, Bt) do { __builtin_amdgcn_s_setprio(1); _Pragma("unroll") for (int m = 0; m < 4; ++m) _Pragma("unroll") for (int n = 0; n < 2; ++n) \
        asm volatile("s_nop 1\n\tv_mfma_scale_f32_16x16x128_f8f6f4 %0, %1, %2, %0, %3, %4 op_sel_hi:[0,0,0]" : "+v"(acc[ai][bj][m][n]) : "v"(Bt[n]), "v"(At[m]), "v"(sc_w), "v"(sc_a)); __builtin_amdgcn_s_setprio(0); } while (0)
#define PG8_WAIT_V(n) asm volatile("s_waitcnt vmcnt(" #n ")" ::: "memory")
#define PG8_WAIT_L(n) asm volatile("s_waitcnt lgkmcnt(" #n ")" ::: "memory")
#define PG8_BAR __builtin_amdgcn_s_barrier()
#define PG8_SCHED __builtin_amdgcn_sched_barrier(0)
    Unit cur, nxt; int ui = 0;
    if (!S.next(0, cur)) return;
    f32x4 acc[2][2][4][2];
#pragma unroll
    for (int a = 0; a < 2; ++a)
#pragma unroll
        for (int b = 0; b < 2; ++b)
#pragma unroll
            for (int m = 0; m < 4; ++m)
#pragma unroll
                for (int n = 0; n < 2; ++n) acc[a][b][m][n] = (f32x4){0.f, 0.f, 0.f, 0.f};
    i32x8 At[4], B0[2], B1[2];
    int sc_w = 0x79797979, sc_a = 0x7F7F7F7F;
    asm volatile("" : "+v"(sc_w), "+v"(sc_a));
    const char* cA = (const char*)g.A + (size_t)cur.pm * tstep; const char* cB = (const char*)g.Bt + (size_t)cur.pn * tstep;
    S.a_ready(cur);
    if constexpr (SP2) {
        PG8_STAGE(PG8_SB(0, 0), cB, voffB); PG8_STAGE(PG8_SB(0, 1), cB + hstep, voffB); PG8_STAGE(PG8_SA(0, 0), cA, voffA); PG8_STAGE(PG8_SA(0, 1), cA + hstep, voffA);
        if (wr == 1) PG8_BAR;
        PG8_WAIT_V(2); PG8_BAR;
        PG8_STAGE(PG8_SB(1, 0), cB + kstep, voffB); PG8_STAGE(PG8_SA(1, 0), cA + kstep, voffA); PG8_STAGE(PG8_SB(1, 1), cB + hstep + kstep, voffB);
        PG8_WAIT_V(6); PG8_BAR;
    } else {
        PG8_STAGE(PG8_SB(0, 0), cB, voffB); PG8_STAGE(PG8_SA(0, 0), cA, voffA); PG8_STAGE(PG8_SB(0, 1), cB + hstep, voffB); PG8_STAGE(PG8_SA(0, 1), cA + hstep, voffA);
        if (wr == 1) PG8_BAR;
        PG8_WAIT_V(4); PG8_BAR;
        PG8_STAGE(PG8_SB(1, 0), cB + kstep, voffB); PG8_STAGE(PG8_SA(1, 0), cA + kstep, voffA); PG8_STAGE(PG8_SB(1, 1), cB + hstep + kstep, voffB);
        PG8_WAIT_V(6); PG8_BAR;
    }
    for (;;) {
        const bool has_next = S.next(ui + 1, nxt);
        const char* nA = has_next ? (const char*)g.A + (size_t)nxt.pm * tstep : cA; const char* nB = has_next ? (const char*)g.Bt + (size_t)nxt.pn * tstep : cB;
        for (int t = 0; t < nt; t += 2) {
            const bool last = (t == nt - 2);
            const char* a1 = cA + (size_t)(t + 1) * kstep;
            const char* a2 = last ? nA : cA + (size_t)(t + 2) * kstep; const char* b2 = last ? nB : cB + (size_t)(t + 2) * kstep;
            const char* a3 = a2 + kstep; const char* b3 = b2 + kstep;
            if (last && has_next) S.a_ready(nxt);
            if constexpr (SP2) {
            PG8_LDB(B0, 0, 0); PG8_LDB(B1, 0, 1); PG8_SCHED; PG8_LDA(At, 0, 0); PG8_STAGE(PG8_SA(1, 1), a1 + hstep, voffA);
            PG8_WAIT_V(8); PG8_WAIT_L(0); PG8_BAR; PG8_MMA(0, 0, At, B0); PG8_MMA(0, 1, At, B1); PG8_BAR; PG8_SCHED;
            PG8_LDA(At, 0, 1); PG8_STAGE(PG8_SB(0, 0), b2, voffB); PG8_STAGE(PG8_SB(0, 1), b2 + hstep, voffB); PG8_STAGE(PG8_SA(0, 0), a2, voffA);
            PG8_WAIT_V(8); PG8_WAIT_L(0); PG8_BAR; PG8_MMA(1, 0, At, B0); PG8_MMA(1, 1, At, B1); PG8_BAR; PG8_SCHED;
            PG8_LDB(B0, 1, 0); PG8_LDB(B1, 1, 1); PG8_SCHED; PG8_LDA(At, 1, 0); PG8_STAGE(PG8_SA(0, 1), a2 + hstep, voffA);
            PG8_WAIT_V(8); PG8_WAIT_L(0); PG8_BAR; PG8_MMA(0, 0, At, B0); PG8_MMA(0, 1, At, B1); PG8_BAR; PG8_SCHED;
            PG8_LDA(At, 1, 1); PG8_STAGE(PG8_SB(1, 0), b3, voffB); PG8_STAGE(PG8_SB(1, 1), b3 + hstep, voffB); PG8_STAGE(PG8_SA(1, 0), a3, voffA);
            PG8_WAIT_V(8); PG8_WAIT_L(0); PG8_BAR; PG8_MMA(1, 0, At, B0); PG8_MMA(1, 1, At, B1); PG8_BAR; PG8_SCHED;
            } else {
            PG8_LDB(B0, 0, 0); PG8_SCHED; PG8_LDA(At, 0, 0); PG8_STAGE(PG8_SA(1, 1), a1 + hstep, voffA);
            PG8_WAIT_L(8); PG8_BAR; PG8_WAIT_L(0); PG8_MMA(0, 0, At, B0); PG8_BAR; PG8_SCHED;
            PG8_LDB(B1, 0, 1); PG8_STAGE(PG8_SB(0, 0), b2, voffB);
            PG8_BAR; PG8_WAIT_L(0); PG8_MMA(0, 1, At, B1); PG8_BAR;
            PG8_LDA(At, 0, 1); PG8_STAGE(PG8_SA(0, 0), a2, voffA);
            PG8_BAR; PG8_WAIT_L(0); PG8_MMA(1, 0, At, B0); PG8_BAR; PG8_SCHED;
            PG8_STAGE(PG8_SB(0, 1), b2 + hstep, voffB);
            PG8_WAIT_V(6); PG8_BAR; PG8_MMA(1, 1, At, B1); PG8_BAR;
            PG8_LDB(B0, 1, 0); PG8_SCHED; PG8_LDA(At, 1, 0); PG8_STAGE(PG8_SA(0, 1), a2 + hstep, voffA);
            PG8_WAIT_L(8); PG8_BAR; PG8_WAIT_L(0); PG8_MMA(0, 0, At, B0); PG8_BAR; PG8_SCHED;
            PG8_LDB(B1, 1, 1); PG8_STAGE(PG8_SB(1, 0), b3, voffB);
            PG8_BAR; PG8_WAIT_L(0); PG8_MMA(0, 1, At, B1); PG8_BAR;
            PG8_LDA(At, 1, 1); PG8_STAGE(PG8_SA(1, 0), a3, voffA);
            PG8_BAR; PG8_WAIT_L(0); PG8_MMA(1, 0, At, B0); PG8_BAR; PG8_SCHED;
            PG8_STAGE(PG8_SB(1, 1), b3 + hstep, voffB);
            PG8_WAIT_V(6); PG8_BAR; PG8_MMA(1, 1, At, B1); PG8_BAR;
            }
        }
        if constexpr (ALIGN_EPI) { if (wr == 0) PG8_BAR; }
#pragma unroll
        for (int a_ = 0; a_ < 2; ++a_)
#pragma unroll
            for (int b_ = 0; b_ < 2; ++b_) asm volatile("s_nop 15\n\ts_nop 15" : "+v"(acc[a_][b_][0][0]), "+v"(acc[a_][b_][0][1]), "+v"(acc[a_][b_][1][0]), "+v"(acc[a_][b_][1][1]), "+v"(acc[a_][b_][2][0]), "+v"(acc[a_][b_][2][1]), "+v"(acc[a_][b_][3][0]), "+v"(acc[a_][b_][3][1]));
        if constexpr (!Epi::AFTER_DRAIN) { int fr_ = fr, fq_ = fq; asm volatile("" : "+v"(fr_), "+v"(fq_));
            E(acc, cur, wr, wc, fr_, fq_); S.done(cur); }
        if (!has_next) break;
#pragma unroll
        for (int a = 0; a < 2; ++a)
#pragma unroll
            for (int b = 0; b < 2; ++b)
#pragma unroll
                for (int m = 0; m < 4; ++m)
#pragma unroll
                    for (int n = 0; n < 2; ++n) acc[a][b][m][n] = (f32x4){0.f, 0.f, 0.f, 0.f};
        cur = nxt; cA = nA; cB = nB; ++ui;
        if constexpr (ALIGN_EPI) { if (wr == 1) PG8_BAR; }
    }
    PG8_WAIT_V(0);
    if constexpr (!ALIGN_EPI) { if (wr == 0) PG8_BAR; }
    PG8_BAR;
    if constexpr (Epi::AFTER_DRAIN) { E.fused(acc, cur, wr, wc, fr, fq, lds, wid, lane); S.done(cur); }
#undef PG8_SA
#undef PG8_SB
#undef PG8_STAGE
#undef PG8_LDA
#undef PG8_LDB
#undef PG8_MMA
#undef PG8_WAIT_V
#undef PG8_WAIT_L
#undef PG8_BAR
#undef PG8_SCHED
}
}
constexpr int NT = 16384, DM = 2048, SEQ = 4096, NBATCH = 4, NLAYER = 2;
constexpr int LDP = 8448, NGATE = 10240, NIN = 18688, PIN = 18480;
constexpr int C_NAQ = 0, C_NAK = 512, C_NAV = 1024, C_GLQ = 1536, C_GLK = 1792, C_GLV = 2048, C_GLLR = 2560, C_GLOG = 2592, C_GDQKV = 3104, C_GDA = 4640, C_GDB = 4648,
              C_GDOG = 4656, C_HGQ = 5168, C_HGF = 5680, C_HGI = 6704, C_HGOG = 7216, C_MQ = 7728, C_PEND = 8240;
constexpr int DFF = 5632, DFFE = 7168, NEXP = 8, MAXSLOT = 34816;
constexpr float RMS_EPS = 1e-6f;
constexpr size_t MiB = 1u << 20;
constexpr size_t WS_CTL = 0, CTL_ZERO_BYTES = 1 * MiB;
constexpr size_t WS_ROUTE = 1 * MiB;
constexpr size_t WS_MK = 2 * MiB;
constexpr size_t WS_MVT = 4 * MiB;
constexpr size_t WS_KVRAW = 6 * MiB;
constexpr size_t WS_MEMN = 14 * MiB;
constexpr size_t WS_WIN = 24 * MiB;
constexpr size_t WS_WBR = WS_WIN + 146 * MiB;
constexpr size_t WS_WOUT = WS_WBR + 20 * MiB;
constexpr size_t WS_WMKV = WS_WOUT + 16 * MiB;
constexpr size_t WS_WGU = WS_WMKV + 8 * MiB;
constexpr size_t WS_WDN = WS_WGU + 44 * MiB;
constexpr size_t WS_MOE1 = WS_WDN + 22 * MiB;
constexpr size_t WS_MOE2 = WS_MOE1 + 448 * MiB;
constexpr size_t WS_OA = WS_MOE1 + 224 * MiB, WS_MOE2F = WS_MOE2 + 112 * MiB;
constexpr size_t WS_HM = WS_MOE2 + 224 * MiB;
constexpr size_t WS_P = WS_HM + 64 * MiB;
constexpr size_t WS_G = WS_P + 264 * MiB;
constexpr size_t WS_GLG = WS_G + 320 * MiB;
constexpr size_t WS_GQ = WS_GLG + 32 * MiB;
constexpr size_t WS_GAB = WS_GQ + 48 * MiB;
constexpr size_t WS_HQ = WS_GAB + 1 * MiB;
constexpr size_t WS_HF = WS_HQ + 16 * MiB;
constexpr size_t WS_NAVT = WS_HF + 64 * MiB;
constexpr size_t WS_SOUT = WS_NAVT + 16 * MiB;
constexpr size_t WS_BR = WS_SOUT + 96 * MiB;
constexpr size_t WS_H8 = WS_BR + 80 * MiB;
constexpr size_t WS_END = WS_H8 + 32 * MiB;
constexpr size_t WS_HID = WS_P;
constexpr size_t WS_XB = WS_P;
constexpr size_t WS_HIDM = WS_XB + 136 * MiB;
constexpr size_t WS_YB = WS_HIDM + 476 * MiB;
static_assert(WS_YB + 272 * MiB <= WS_END, "MoE overlay fits");
static_assert(WS_END <= 2085645600ull, "workspace map fits sum(inputs)");
constexpr int CW_TMO = 0, CW_CODE = 1, CW_BAR = 4096, CW_WQ = 8192, CW_CNT = 8192 + 1024, CW_CONVQ = 8192 + 2048, CW_S2DONE = 8192 + 2048 + 64, CW_GQ = 16384;
constexpr int RING_OFF = 0, RING_BYTES = 131072, LDSCTL_OFF = RING_BYTES, MISC_OFF = LDSCTL_OFF + 320, TAB_OFF = LDSCTL_OFF + 512, LDS_BYTES = 147456;
constexpr int NWAVES = 8;
#ifndef MK_SPLIT
#define MK_SPLIT 0
#endif
#define GAS __attribute__((address_space(1)))
#define LAS __attribute__((address_space(3)))
typedef unsigned short bf16;
typedef unsigned v4u __attribute__((ext_vector_type(4)));
typedef float f32x4 __attribute__((ext_vector_type(4)));
typedef short bf16x8 __attribute__((ext_vector_type(8)));
typedef GAS unsigned gu32;
typedef GAS unsigned long long gu64;
#define RLX_AGENT __ATOMIC_RELAXED, __HIP_MEMORY_SCOPE_AGENT
#define LDS_WAIT() asm volatile("s_waitcnt lgkmcnt(0)" ::: "memory")
#define VM_WAIT() asm volatile("s_waitcnt vmcnt(0)" ::: "memory")
__device__ __forceinline__ unsigned long long rt() { return __builtin_amdgcn_s_memrealtime(); }
__device__ __forceinline__ unsigned f2bf(float f) { unsigned u = __builtin_bit_cast(unsigned, f); return (u + 0x7fffu + ((u >> 16) & 1u)) >> 16; }
__device__ __forceinline__ unsigned pk2(float lo, float hi) { return f2bf(lo) | (f2bf(hi) << 16); }
constexpr int WAVETAB_OFF = 131072 + 1024;
__device__ __forceinline__ unsigned hw_slot() { return (unsigned)__builtin_amdgcn_s_getreg((5 << 11) | 4) & 63u; }
__device__ __forceinline__ int mk_lane() { return (int)__builtin_amdgcn_mbcnt_hi(~0u, __builtin_amdgcn_mbcnt_lo(~0u, 0u)); }
__device__ __forceinline__ int mk_wave() { extern __shared__ __attribute__((aligned(16))) unsigned char lds_raw_[]; const volatile LAS int* tab = (const volatile LAS int*)((LAS unsigned char*)lds_raw_ + WAVETAB_OFF); return __builtin_amdgcn_readfirstlane(tab[hw_slot()]); }
__device__ __forceinline__ int mk_tid() { return mk_wave() * 64 + mk_lane(); }
__device__ __forceinline__ int pg8_tid() { return mk_tid(); }
#define XB_TMO      128
#define XB_XCNT(j)  (256  + 64 * (j))
#define XB_XSUB(j)  (1280 + 64 * (j))
#define XB_XGEN(j)  (2304 + 64 * (j))
#define XB_TOP      3328
#define XB_TOPGEN   3392
#define XCD_BAR_WORDS 3456
#define XB_SPIN_CAP (1u << 22)

__device__ __forceinline__ unsigned xb_ld(unsigned* p)              { return __hip_atomic_load(p, __ATOMIC_RELAXED, __HIP_MEMORY_SCOPE_AGENT); }
__device__ __forceinline__ unsigned xb_add(unsigned* p, unsigned v) { return __hip_atomic_fetch_add(p, v, __ATOMIC_RELAXED, __HIP_MEMORY_SCOPE_AGENT); }
__device__ __forceinline__ unsigned xb_xcc_id() { return (unsigned)__builtin_amdgcn_s_getreg((3 << 11) | 20) & 0xFu; }
#define XB_SPIN(cond, bar) do { unsigned _sp = 0; while (cond) { __builtin_amdgcn_s_sleep(1); \
    if ((++_sp & 255u) == 0u) { if (xb_ld(&(bar)[XB_TMO])) break; if (_sp > XB_SPIN_CAP) { atomicAdd(&(bar)[XB_TMO], 1u); break; } } } } while (0)

struct XcdBarrier {
    unsigned* bar; unsigned x;
    volatile LAS unsigned* st;
};

__device__ __forceinline__ XcdBarrier xcd_barrier_post(unsigned* bar, volatile LAS unsigned* st) {
    XcdBarrier b; b.bar = bar; b.x = xb_xcc_id(); b.st = st;
    if (mk_tid() == 0) (void)xb_add(&bar[XB_XCNT(b.x)], 1u);
    return b;
}
__device__ __forceinline__ void xcd_barrier_complete(unsigned* bar, unsigned x, unsigned& nloc, unsigned& nx) {
    const unsigned G = gridDim.x * gridDim.y * gridDim.z;
    unsigned sum, cnt, mine, sp = 0u;
    for (;;) {
        sum = 0u; cnt = 0u; mine = 0u;
#pragma unroll
        for (unsigned j = 0; j < 16; ++j) { const unsigned c = xb_ld(&bar[XB_XCNT(j)]); sum += c; cnt += (c > 0u) ? 1u : 0u; mine = (j == x) ? c : mine; }
        if (sum == G) break;
        __builtin_amdgcn_s_sleep(1);
        if ((++sp & 255u) == 0u) { if (xb_ld(&bar[XB_TMO])) break; if (sp > XB_SPIN_CAP) { atomicAdd(&bar[XB_TMO], 1u); break; } }
    }
    nloc = mine > 0u ? mine : 1u; nx = cnt > 0u ? cnt : 1u;
}

__device__ __forceinline__ void xcd_barrier(const XcdBarrier& b) {
    asm volatile("s_waitcnt vmcnt(0)" ::: "memory");
    __syncthreads();
    if (mk_tid() == 0) {
        unsigned* bar = b.bar;
        __builtin_amdgcn_s_waitcnt(0);
        unsigned nloc = b.st[0], nx = b.st[1];
        if (nloc == 0u) { xcd_barrier_complete(bar, b.x, nloc, nx); b.st[0] = nloc; b.st[1] = nx; }
        const unsigned old = xb_add(&bar[XB_XSUB(b.x)], 1u);
        const unsigned gen = old / nloc;
        if (old + 1u == (gen + 1u) * nloc) {
            __builtin_amdgcn_fence(__ATOMIC_RELEASE, "agent");
            asm volatile("s_waitcnt vmcnt(0)" ::: "memory");
            const unsigned og = xb_add(&bar[XB_TOP], 1u);
            const unsigned tg = og / nx;
            if (og + 1u == (tg + 1u) * nx) xb_add(&bar[XB_TOPGEN], 1u);
            else XB_SPIN(xb_ld(&bar[XB_TOPGEN]) == tg, bar);
            __builtin_amdgcn_fence(__ATOMIC_ACQUIRE, "agent");
            xb_add(&bar[XB_XGEN(b.x)], 1u);
            asm volatile("s_waitcnt vmcnt(0)" ::: "memory");
        } else {
            XB_SPIN(xb_ld(&bar[XB_XGEN(b.x)]) == gen, bar);
            __builtin_amdgcn_fence(__ATOMIC_ACQUIRE, "agent");
            asm volatile("s_waitcnt vmcnt(0)" ::: "memory");
        }
    }
    __syncthreads();
}
typedef unsigned v2u __attribute__((ext_vector_type(2)));
typedef float f32x2v __attribute__((ext_vector_type(2)));
__device__ __forceinline__ float bflo(unsigned w) { return __uint_as_float(w << 16); }
__device__ __forceinline__ float bfhi(unsigned w) { return __uint_as_float(w & 0xffff0000u); }
__device__ __forceinline__ float bf1(bf16 h) { return __uint_as_float(((unsigned)h) << 16); }
typedef __bf16 bf16x2_t __attribute__((ext_vector_type(2)));
__device__ __forceinline__ unsigned pkbf(float lo, float hi) { const f32x2v v = {lo, hi}; return __builtin_bit_cast(unsigned, __builtin_convertvector(v, bf16x2_t)); }
__device__ __forceinline__ void unpack8(const v4u w, float (&f)[8]) { f[0] = bflo(w.x); f[1] = bfhi(w.x); f[2] = bflo(w.y); f[3] = bfhi(w.y); f[4] = bflo(w.z); f[5] = bfhi(w.z); f[6] = bflo(w.w); f[7] = bfhi(w.w); }
__device__ __forceinline__ v4u pack8(const float (&f)[8]) { v4u w; w.x = pkbf(f[0], f[1]); w.y = pkbf(f[2], f[3]); w.z = pkbf(f[4], f[5]); w.w = pkbf(f[6], f[7]); return w; }
__device__ __forceinline__ float sigmf(float x) { return __builtin_amdgcn_rcpf(1.0f + __expf(-x)); }
__device__ __forceinline__ float siluf(float x) { return x * __builtin_amdgcn_rcpf(1.0f + __expf(-x)); }
__device__ __forceinline__ float softplusf(float x) { return fmaxf(x, 0.f) + __logf(1.0f + __expf(-fabsf(x))); }
#define DPP_ADD(v, ctrl) ((v) + __int_as_float(__builtin_amdgcn_update_dpp(0, __float_as_int(v), (ctrl), 0xF, 0xF, true)))
__device__ __forceinline__ float row16_sum(float v) { v = DPP_ADD(v, 0xB1); v = DPP_ADD(v, 0x4E); v = DPP_ADD(v, 0x141); v = DPP_ADD(v, 0x140); return v; }
__device__ __forceinline__ float wave_sum(float v) { v = row16_sum(v); v += __shfl_xor(v, 16); v += __shfl_xor(v, 32); return v; }
template <int N> __device__ __forceinline__ float group_sum(float v) {
    v = DPP_ADD(v, 0xB1); v = DPP_ADD(v, 0x4E); v = DPP_ADD(v, 0x141); if (N == 16) v = DPP_ADD(v, 0x140);
    return v;
}
template <int KL> __device__ __forceinline__ float kl_sum(float v) {
    v = DPP_ADD(v, 0xB1); v = DPP_ADD(v, 0x4E); v = DPP_ADD(v, 0x141);
    if (KL == 16) v = DPP_ADD(v, 0x140);
    return v;
}
__device__ __forceinline__ unsigned pk4_f8(float a, float b, float c, float d);
__device__ __forceinline__ void rms_row(const float* xrow, const float* gain, bf16* orow, int lane, f32x4 (&v)[8], unsigned char* o8row = nullptr) {
    const f32x4* xr = (const f32x4*)xrow + lane; float s = 0.f;
#pragma unroll
    for (int j = 0; j < 8; ++j) { v[j] = xr[64 * j]; s += (v[j].x * v[j].x + v[j].y * v[j].y) + (v[j].z * v[j].z + v[j].w * v[j].w); }
    const float sc = rsqrtf(wave_sum(s) * (1.0f / DM) + RMS_EPS);
    const f32x4* gr = (const f32x4*)gain + lane; v2u* o8 = (v2u*)orow + lane;
#pragma unroll
    for (int j = 0; j < 8; ++j) { v[j] = v[j] * sc * gr[64 * j]; v2u w; w.x = pkbf(v[j].x, v[j].y); w.y = pkbf(v[j].z, v[j].w); o8[64 * j] = w;
        if (o8row) ((unsigned*)o8row)[lane + 64 * j] = pk4_f8(v[j].x, v[j].y, v[j].z, v[j].w); }
}
__device__ __forceinline__ unsigned pk4_f8(float a, float b, float c, float d);
__device__ __forceinline__ void rms_row_f8(const float* xrow, const float* gain, unsigned char* orow, int lane, f32x4 (&v)[8]) {
    const f32x4* xr = (const f32x4*)xrow + lane; float s = 0.f;
#pragma unroll
    for (int j = 0; j < 8; ++j) { v[j] = xr[64 * j]; s += (v[j].x * v[j].x + v[j].y * v[j].y) + (v[j].z * v[j].z + v[j].w * v[j].w); }
    const float sc = rsqrtf(wave_sum(s) * (1.0f / DM) + RMS_EPS);
    const f32x4* gr = (const f32x4*)gain + lane; unsigned* o4 = (unsigned*)orow + lane;
#pragma unroll
    for (int j = 0; j < 8; ++j) { v[j] = v[j] * sc * gr[64 * j]; o4[64 * j] = pk4_f8(v[j].x, v[j].y, v[j].z, v[j].w); }
}
__device__ __forceinline__ unsigned pk4_f8(float a, float b, float c, float d) { int w = __builtin_amdgcn_cvt_pk_fp8_f32(a, b, 0, false); w = __builtin_amdgcn_cvt_pk_fp8_f32(c, d, w, true); return (unsigned)w; }
struct RmOff { int off; __device__ __forceinline__ int operator()(int n) const { return n + off; } };
struct RmWin { __device__ __forceinline__ int operator()(int n) const { return n < C_PEND ? n : n + (LDP - C_PEND); } };
struct RmGU { int up; __device__ __forceinline__ int operator()(int n) const { return (n >> 7) * 256 + (n & 127) + up * 128; } };
__device__ __forceinline__ void tr_load(float (&v)[64], const float* W, int ldw, int N, int nblk, int it, int lane) {
    const int kb = it / nblk, nb = it % nblk; const int n = 64 * nb + lane; const bool ok = n < N; const float* p = W + (size_t)(64 * kb) * ldw + (ok ? n : 0);
#pragma unroll
    for (int kk = 0; kk < 64; ++kk) v[kk] = p[(size_t)kk * ldw];
    if (!ok) {
#pragma unroll
        for (int kk = 0; kk < 64; ++kk) v[kk] = 0.f; }
}
template <class RowMap> __device__ __forceinline__ void tr_store(const float (&v)[64], int K, int N, int nblk, int it, bf16* WT, LAS unsigned* scr, int lane, const RowMap& rm) {
    const int kb = it / nblk, nb = it % nblk;
#pragma unroll
    for (int kp = 0; kp < 32; ++kp) scr[lane * 33 + kp] = pkbf(v[2 * kp], v[2 * kp + 1]);
    LDS_WAIT(); asm volatile("" ::: "memory");
    const int c = lane & 7;
#pragma unroll
    for (int j = 0; j < 8; ++j) { const int nl = (lane >> 3) + 8 * j; const LAS unsigned* s = scr + nl * 33 + 4 * c; v4u o; o.x = s[0]; o.y = s[1]; o.z = s[2]; o.w = s[3];
        const int n = 64 * nb + nl; if (n < N) *(GAS v4u*)(WT + (size_t)rm(n) * K + 64 * kb + 8 * c) = o; }
    LDS_WAIT(); asm volatile("" ::: "memory");
}
template <class RowMap> __device__ __forceinline__ void transpose_job(const float* W, int K, int N, bf16* WT, LAS float* scr_f, int gw, int NGW, int lane, const RowMap& rm, int ldw = 0) {
    if (!ldw) ldw = N;
    LAS unsigned* scr = (LAS unsigned*)scr_f; const int nblk = (N + 63) / 64, nit = (K / 64) * nblk;
    float va[64], vb[64]; int it = gw;
    if (it < nit) tr_load(va, W, ldw, N, nblk, it, lane);
#pragma unroll 1
    for (; it < nit; it += 2 * NGW) { const int it2 = it + NGW, it3 = it2 + NGW;
        if (it2 < nit) tr_load(vb, W, ldw, N, nblk, it2, lane);
        tr_store(va, K, N, nblk, it, WT, scr, lane, rm);
        if (it3 < nit) tr_load(va, W, ldw, N, nblk, it3, lane);
        if (it2 < nit) tr_store(vb, K, N, nblk, it2, WT, scr, lane, rm);
    }
}
template <class RowMap> __device__ __forceinline__ void tr_store_f8(const float (&v)[64], float scale, int K, int N, int nblk, int it, unsigned char* WT, LAS unsigned* scr, int lane, const RowMap& rm) {
    const int kb = it / nblk, nb = it % nblk;
#pragma unroll
    for (int q = 0; q < 16; ++q) scr[lane * 17 + q] = pk4_f8(v[4 * q] * scale, v[4 * q + 1] * scale, v[4 * q + 2] * scale, v[4 * q + 3] * scale);
    LDS_WAIT(); asm volatile("" ::: "memory");
    const int c = lane & 3;
#pragma unroll
    for (int j = 0; j < 4; ++j) { const int nl = (lane >> 2) + 16 * j; const LAS unsigned* s = scr + nl * 17 + 4 * c; v4u o; o.x = s[0]; o.y = s[1]; o.z = s[2]; o.w = s[3];
        const int n = 64 * nb + nl; if (n < N) *(GAS v4u*)(WT + (size_t)rm(n) * K + 64 * kb + 16 * c) = o; }
    LDS_WAIT(); asm volatile("" ::: "memory");
}
template <class RowMap> __device__ __forceinline__ void transpose_job_f8(const float* W, float scale, int K, int N, unsigned char* WT, LAS float* scr_f, int gw, int NGW, int lane, const RowMap& rm, int ldw = 0) {
    if (!ldw) ldw = N;
    LAS unsigned* scr = (LAS unsigned*)scr_f; const int nblk = (N + 63) / 64, nit = (K / 64) * nblk;
    float va[64], vb[64]; int it = gw;
    if (it < nit) tr_load(va, W, ldw, N, nblk, it, lane);
#pragma unroll 1
    for (; it < nit; it += 2 * NGW) { const int it2 = it + NGW, it3 = it2 + NGW;
        if (it2 < nit) tr_load(vb, W, ldw, N, nblk, it2, lane);
        tr_store_f8(va, scale, K, N, nblk, it, WT, scr, lane, rm);
        if (it3 < nit) tr_load(va, W, ldw, N, nblk, it3, lane);
        if (it2 < nit) tr_store_f8(vb, scale, K, N, nblk, it2, WT, scr, lane, rm);
    }
}
__device__ __forceinline__ void moe1_convert_all(const float* wg, const float* wu, unsigned char* MOE1, LAS float* scr_f, int gw, int NGW, int lane) {
    LAS unsigned* scr = (LAS unsigned*)scr_f; constexpr int NB = DFFE / 64, TPJ = (DM / 64) * NB, NIT = 16 * TPJ;
    float va[64], vb[64]; int it = gw;
#define M1_SRC(t) (((((t) / TPJ) & 1) ? wu : wg) + (size_t)(((t) / TPJ) >> 1) * DM * DFFE)
#define M1_DST(t) (MOE1 + (size_t)(((t) / TPJ) >> 1) * 2 * DFFE * DM)
    if (it < NIT) tr_load(va, M1_SRC(it), DFFE, DFFE, NB, it % TPJ, lane);
#pragma unroll 1
    for (; it < NIT; it += 2 * NGW) { const int it2 = it + NGW, it3 = it2 + NGW;
        if (it2 < NIT) tr_load(vb, M1_SRC(it2), DFFE, DFFE, NB, it2 % TPJ, lane);
        tr_store_f8(va, 64.0f, DM, DFFE, NB, it % TPJ, M1_DST(it), scr, lane, RmGU{(it / TPJ) & 1});
        if (it3 < NIT) tr_load(va, M1_SRC(it3), DFFE, DFFE, NB, it3 % TPJ, lane);
        if (it2 < NIT) tr_store_f8(vb, 64.0f, DM, DFFE, NB, it2 % TPJ, M1_DST(it2), scr, lane, RmGU{(it2 / TPJ) & 1});
    }
#undef M1_SRC
#undef M1_DST
}
struct RmGen { int kind, off; __device__ __forceinline__ int operator()(int n) const { return kind ? (n >> 7) * 256 + (n & 127) + off * 128 : n + off; } };
struct P0Job { const float* W; int ldw, N, K, nblk, loc, f8; unsigned char* WT; RmGen rm; };
__device__ __forceinline__ P0Job p0_job(int t, const float* w_in, const float* w_br, const float* w_out, const float* w_kv, const float* f_gate, const float* f_up, const float* f_down, unsigned char* ws) {
    P0Job j; j.f8 = 0; j.rm = RmGen{0, 0};
    constexpr int T_P = 32 * 129, T_G = 32 * 160, T_B = 8 * 32, T_O = 32 * 32, T_K = 32 * 16, T_L = T_P + T_G + 5 * T_B + T_O + T_K, T_D = 32 * 88;
    if (t < 2 * T_L) { const int L = t / T_L; int r = t % T_L;
        if (r < T_P) { j.W = w_in + (size_t)L * DM * PIN; j.ldw = PIN; j.N = C_PEND; j.K = DM; j.nblk = 129; j.loc = r; j.WT = ws + WS_WIN + (size_t)L * NIN * DM * 2; return j; } r -= T_P;
        if (r < T_G) { j.W = w_in + (size_t)L * DM * PIN + C_PEND; j.ldw = PIN; j.N = NGATE; j.K = DM; j.nblk = 160; j.loc = r; j.f8 = 1; j.WT = ws + WS_WIN + ((size_t)L * NIN + LDP) * DM * 2; return j; } r -= T_G;
        if (r < 5 * T_B) { const int n = r / T_B; j.W = w_br + (size_t)(L * 5 + n) * 512 * DM; j.ldw = DM; j.N = DM; j.K = 512; j.nblk = 32; j.loc = r % T_B; j.WT = ws + WS_WBR + (size_t)(L * 5 + n) * DM * 512 * 2; return j; } r -= 5 * T_B;
        if (r < T_O) { j.W = w_out + (size_t)L * DM * DM; j.ldw = DM; j.N = DM; j.K = DM; j.nblk = 32; j.loc = r; j.WT = ws + WS_WOUT + (size_t)L * DM * DM * 2; return j; } r -= T_O;
        j.W = w_kv + (size_t)L * DM * 1024; j.ldw = 1024; j.N = 1024; j.K = DM; j.nblk = 16; j.loc = r; j.WT = ws + WS_WMKV + (size_t)L * 1024 * DM * 2; return j; }
    int r = t - 2 * T_L;
    if (r < 2 * T_D) { const int up = r / T_D; j.W = up ? f_up : f_gate; j.ldw = DFF; j.N = DFF; j.K = DM; j.nblk = 88; j.loc = r % T_D; j.WT = ws + WS_WGU; j.rm = RmGen{1, up}; return j; } r -= 2 * T_D;
    j.W = f_down; j.ldw = DM; j.N = DM; j.K = DFF; j.nblk = 32; j.loc = r; j.WT = ws + WS_WDN; return j;
}
constexpr int P0_TILES = 2 * (32 * 129 + 32 * 160 + 5 * 8 * 32 + 32 * 32 + 32 * 16) + 3 * 32 * 88;
__device__ __forceinline__ void p0_store(const float (&v)[64], const P0Job& j, LAS unsigned* scr, int lane) {
    if (j.f8) tr_store_f8(v, 64.0f, j.K, j.N, j.nblk, j.loc, j.WT, scr, lane, j.rm); else tr_store(v, j.K, j.N, j.nblk, j.loc, (bf16*)j.WT, scr, lane, j.rm);
}
__device__ __forceinline__ void phase0_convert_all(const float* w_in, const float* w_br, const float* w_out, const float* w_kv, const float* f_gate, const float* f_up, const float* f_down, unsigned char* ws, LAS float* scr_f, int gw, int NGW, int lane) {
    LAS unsigned* scr = (LAS unsigned*)scr_f; float va[64], vb[64]; int it = gw;
    P0Job ja = p0_job(it < P0_TILES ? it : 0, w_in, w_br, w_out, w_kv, f_gate, f_up, f_down, ws), jb = ja;
    if (it < P0_TILES) tr_load(va, ja.W, ja.ldw, ja.N, ja.nblk, ja.loc, lane);
#pragma unroll 1
    for (; it < P0_TILES; it += 2 * NGW) { const int it2 = it + NGW, it3 = it2 + NGW;
        if (it2 < P0_TILES) { jb = p0_job(it2, w_in, w_br, w_out, w_kv, f_gate, f_up, f_down, ws); tr_load(vb, jb.W, jb.ldw, jb.N, jb.nblk, jb.loc, lane); }
        p0_store(va, ja, scr, lane);
        if (it3 < P0_TILES) { ja = p0_job(it3, w_in, w_br, w_out, w_kv, f_gate, f_up, f_down, ws); tr_load(va, ja.W, ja.ldw, ja.N, ja.nblk, ja.loc, lane); }
        if (it2 < P0_TILES) p0_store(vb, jb, scr, lane);
    }
}
constexpr int MQ_GU = 16 * 32 * 112, MQ_TILES = MQ_GU + 2 * 112 * 32, MQ_GRAB = 16;
__device__ __forceinline__ P0Job moe_job(int t, const float* wg, const float* wu, const float* wd, unsigned char* ws) {
    P0Job j; j.f8 = 1; constexpr int TPJ = 32 * 112;
    if (t < MQ_GU) { const int jb = t / TPJ, e = jb >> 1, up = jb & 1; j.W = (up ? wu : wg) + (size_t)e * DM * DFFE; j.ldw = DFFE; j.N = DFFE; j.K = DM; j.nblk = 112; j.loc = t % TPJ; j.WT = ws + WS_MOE1 + (size_t)e * 2 * DFFE * DM; j.rm = RmGen{1, up}; return j; }
    const int r = t - MQ_GU, e = 6 + r / TPJ; j.W = wd + (size_t)e * DFFE * DM; j.ldw = DM; j.N = DM; j.K = DFFE; j.nblk = 32; j.loc = r % TPJ; j.WT = ws + WS_MOE2F + (size_t)e * DM * DFFE; j.rm = RmGen{0, 0}; return j;
}
__device__ __forceinline__ unsigned mq_grab(gu32* q, const gu32* stop, unsigned stop_val) {
    if (stop && __hip_atomic_load(stop, RLX_AGENT) >= stop_val) return 0x7fffffffu;
    return __hip_atomic_fetch_add(q, (unsigned)MQ_GRAB, RLX_AGENT);
}
__device__ __forceinline__ void moe_drain(const float* wg, const float* wu, const float* wd, unsigned char* ws, gu32* q, const gu32* stop, unsigned stop_val, volatile LAS unsigned* slot, LAS float* scr_f, int wave, int lane, int tid) {
    LAS unsigned* scr = (LAS unsigned*)scr_f; float va[64], vb[64];
    __syncthreads();
    if (tid == 0) slot[0] = mq_grab(q, stop, stop_val);
    __syncthreads();
    unsigned t = slot[0]; int i = 0; P0Job ja, jb;
    if (t < (unsigned)MQ_TILES) { ja = moe_job((int)t + 2 * wave, wg, wu, wd, ws); tr_load(va, ja.W, ja.ldw, ja.N, ja.nblk, ja.loc, lane); jb = moe_job((int)t + 2 * wave + 1, wg, wu, wd, ws); tr_load(vb, jb.W, jb.ldw, jb.N, jb.nblk, jb.loc, lane); }
#pragma unroll 1
    while (t < (unsigned)MQ_TILES) {
        if (tid == 0) slot[(i + 1) & 1] = mq_grab(q, stop, stop_val);
        tr_store_f8(va, 64.0f, ja.K, ja.N, ja.nblk, ja.loc, ja.WT, scr, lane, ja.rm);
        __syncthreads();
        const unsigned tn = slot[(i + 1) & 1];
        if (tn < (unsigned)MQ_TILES) { ja = moe_job((int)tn + 2 * wave, wg, wu, wd, ws); tr_load(va, ja.W, ja.ldw, ja.N, ja.nblk, ja.loc, lane); }
        tr_store_f8(vb, 64.0f, jb.K, jb.N, jb.nblk, jb.loc, jb.WT, scr, lane, jb.rm);
        if (tn < (unsigned)MQ_TILES) { jb = moe_job((int)tn + 2 * wave + 1, wg, wu, wd, ws); tr_load(vb, jb.W, jb.ldw, jb.N, jb.nblk, jb.loc, lane); }
        t = tn; ++i;
    }
}
struct LayerPtrs {
    const float *g_mix, *na_q_gain, *na_k_gain, *na_rel_bias, *gla_w_up, *gla_b, *gla_norm, *conv_w, *a_log, *dt_bias, *gdn_norm, *lb_raw0, *lb_raw1, *hg_norm, *mem_q_gain, *g_ffn;
};
__device__ __forceinline__ void prep_unit(int L, const LayerPtrs& lp, const LAS float* glaw, bf16* P, float* GLG, bf16* GQ, float* GAB, bf16* HQ, float* HF, bf16* NAVT, int t0, int lane) {
    const int b = t0 >> 12, s0 = t0 & 4095;
    float lbv[2][8];
#pragma unroll
    for (int d = 0; d < 2; ++d)
#pragma unroll
        for (int i = 0; i < 8; ++i) { const int c = d * 512 + lane * 8 + i; lbv[d][i] = L ? sigmf(lp.lb_raw1[c] - lp.lb_raw0[c]) : 0.f; }
#pragma unroll 1
    for (int tt = 0; tt < 8; ++tt) { bf16* pr = P + (size_t)(t0 + tt) * LDP;
        const v4u rq = *(const v4u*)(pr + C_NAQ + lane * 8), rk = *(const v4u*)(pr + C_NAK + lane * 8), rm = *(const v4u*)(pr + C_MQ + lane * 8), rh = *(const v4u*)(pr + C_HGQ + lane * 8),
                  rf0 = *(const v4u*)(pr + C_HGF + lane * 8), rf1 = *(const v4u*)(pr + C_HGF + 512 + lane * 8), rl0 = *(const v4u*)(pr + C_GLLR + (lane >> 5) * 16), rl1 = *(const v4u*)(pr + C_GLLR + (lane >> 5) * 16 + 8);
        const bf16 ra = pr[C_GDA + (lane & 15)];
#pragma unroll
        for (int qk = 0; qk < 2; ++qk) { bf16* p = pr + (qk ? C_NAK : C_NAQ) + lane * 8; float f[8]; unpack8(qk ? rk : rq, f);
            float ss = 0.f;
#pragma unroll
            for (int i = 0; i < 8; ++i) ss += f[i] * f[i];
            ss = group_sum<8>(ss); const float sc = rsqrtf(ss * (1.0f / 64.0f) + RMS_EPS) * (qk ? 1.0f : 0.125f);
            const float* gn = (qk ? lp.na_k_gain : lp.na_q_gain) + (lane & 7) * 8;
#pragma unroll
            for (int i = 0; i < 8; ++i) f[i] = f[i] * sc * gn[i];
            *(v4u*)p = pack8(f); }
        { bf16* p = pr + C_MQ + lane * 8; float f[8]; unpack8(rm, f); float ss = 0.f;
#pragma unroll
            for (int i = 0; i < 8; ++i) ss += f[i] * f[i];
            ss = group_sum<16>(ss); const float sc = rsqrtf(ss * (1.0f / 128.0f) + RMS_EPS) * 0.08838834764831845f; const float* gn = lp.mem_q_gain + (lane & 15) * 8;
#pragma unroll
            for (int i = 0; i < 8; ++i) f[i] = f[i] * sc * gn[i];
            *(v4u*)p = pack8(f); }
        { float f[8]; unpack8(rh, f);
#pragma unroll
            for (int i = 0; i < 8; ++i) f[i] = siluf(f[i]);
            *(v4u*)(HQ + (size_t)(t0 + tt) * 512 + lane * 8) = pack8(f);
#pragma unroll
            for (int d = 0; d < 2; ++d) { float z[8]; unpack8(d ? rf1 : rf0, z); float o[8];
#pragma unroll
                for (int i = 0; i < 8; ++i) { if (L) { const float lb = lbv[d][i]; o[i] = __logf(lb + (1.0f - lb) * sigmf(z[i])); } else o[i] = -softplusf(-z[i]); }
                float* hf = HF + (size_t)(t0 + tt) * 1024 + d * 512 + lane * 8;
                *(f32x4*)hf = (f32x4){o[0], o[1], o[2], o[3]}; *(f32x4*)(hf + 4) = (f32x4){o[4], o[5], o[6], o[7]}; } }
        { const int dir = lane >> 5, c8 = (lane & 31) * 8; float lr[16];
            { float t8[8]; unpack8(rl0, t8);
#pragma unroll
              for (int i = 0; i < 8; ++i) lr[i] = t8[i];
              unpack8(rl1, t8);
#pragma unroll
              for (int i = 0; i < 8; ++i) lr[8 + i] = t8[i]; }
            const float* bb = lp.gla_b + dir * 256 + c8; f32x4 a0 = *(const f32x4*)bb, a1 = *(const f32x4*)(bb + 4);
            int c8l = c8; asm volatile("" : "+v"(c8l));
#pragma unroll
            for (int r = 0; r < 16; ++r) { const LAS float* wp = glaw + (dir * 16 + r) * 256 + c8l; a0 = a0 + lr[r] * *(const LAS f32x4*)wp; a1 = a1 + lr[r] * *(const LAS f32x4*)(wp + 4); }
            f32x4 g0, g1;
#pragma unroll
            for (int i = 0; i < 4; ++i) { g0[i] = -softplusf(-a0[i]) * 0.0625f; g1[i] = -softplusf(-a1[i]) * 0.0625f; }
            float* gp = GLG + (size_t)(t0 + tt) * 512 + dir * 256 + c8; *(f32x4*)gp = g0; *(f32x4*)(gp + 4) = g1; }
        if (lane < 16) { const float val = bf1(ra); float o;
            if (lane < 8) o = -__expf(lp.a_log[lane]) * softplusf(val + lp.dt_bias[lane]); else o = sigmf(val);
            GAB[(size_t)(t0 + tt) * 16 + lane] = o; }
    }
#pragma unroll 1
    for (int j = 0; j < 3; ++j) { const int col = j * 512 + lane * 8; float w[5][8];
#pragma unroll
        for (int tap = 0; tap < 5; ++tap) { const float* wp = lp.conv_w + tap * 1536 + col; const f32x4 w0 = *(const f32x4*)wp, w1 = *(const f32x4*)(wp + 4);
            w[tap][0] = w0[0]; w[tap][1] = w0[1]; w[tap][2] = w0[2]; w[tap][3] = w0[3]; w[tap][4] = w1[0]; w[tap][5] = w1[1]; w[tap][6] = w1[2]; w[tap][7] = w1[3]; }
#pragma unroll 1
        for (int hf = 0; hf < 2; ++hf) {
        v4u xr[8];
#pragma unroll
        for (int r = 0; r < 8; ++r) { const int s = s0 + hf * 4 + r - 2; xr[r] = (v4u){0u, 0u, 0u, 0u}; if (s >= 0 && s < SEQ) xr[r] = *(const v4u*)(P + (size_t)((b << 12) + s) * LDP + C_GDQKV + col); }
#pragma unroll
        for (int t4 = 0; t4 < 4; ++t4) { const int tt = hf * 4 + t4; float acc[8]; __builtin_amdgcn_sched_barrier(0);
#pragma unroll
            for (int i = 0; i < 8; ++i) acc[i] = 0.f;
#pragma unroll
            for (int tap = 0; tap < 5; ++tap) { float x[8]; unpack8(xr[t4 + tap], x);
#pragma unroll
                for (int i = 0; i < 8; ++i) acc[i] += w[tap][i] * x[i]; }
#pragma unroll
            for (int i = 0; i < 8; ++i) acc[i] = siluf(acc[i]);
            if (j < 2) { float ss = 0.f;
#pragma unroll
                for (int i = 0; i < 8; ++i) ss += acc[i] * acc[i];
                ss = group_sum<16>(ss); const float sc = rsqrtf(ss + 1e-6f) * (j == 0 ? 0.08838834764831845f : 1.0f);
#pragma unroll
                for (int i = 0; i < 8; ++i) acc[i] *= sc; }
            *(v4u*)(GQ + (size_t)(t0 + tt) * 1536 + col) = pack8(acc); } } }
    { unsigned vw[8][4];
#pragma unroll
        for (int tt = 0; tt < 8; ++tt) { const v4u x = *(const v4u*)(P + (size_t)(t0 + tt) * LDP + C_NAV + lane * 8); vw[tt][0] = x.x; vw[tt][1] = x.y; vw[tt][2] = x.z; vw[tt][3] = x.w; }
#pragma unroll
        for (int i = 0; i < 8; ++i) { unsigned e[8];
#pragma unroll
            for (int tt = 0; tt < 8; ++tt) e[tt] = (i & 1) ? (vw[tt][i >> 1] >> 16) : (vw[tt][i >> 1] & 0xffffu);
            v4u o; o.x = e[0] | (e[1] << 16); o.y = e[2] | (e[3] << 16); o.z = e[4] | (e[5] << 16); o.w = e[6] | (e[7] << 16);
            *(v4u*)(NAVT + ((size_t)((b * 8 + (lane >> 3)) * 64 + (lane & 7) * 8 + i)) * SEQ + s0) = o; } }
}
__device__ __forceinline__ void post_token(const LayerPtrs& lp, const bf16* P, const bf16* SOUT, bf16* BR, int t, int lane) {
    const bf16* pr = P + (size_t)t * LDP;
#pragma unroll
    for (int br = 0; br < 3; ++br) {
        float a[8], c[8], og[8];
        unpack8(*(const v4u*)(SOUT + ((size_t)(br * 2 + 0) * NT + t) * 512 + lane * 8), a);
        unpack8(*(const v4u*)(SOUT + ((size_t)(br * 2 + 1) * NT + t) * 512 + lane * 8), c);
        unpack8(*(const v4u*)(pr + (br == 0 ? C_GLOG : br == 1 ? C_GDOG : C_HGOG) + lane * 8), og);
        const float qs = br == 0 ? 0.125f : 1.0f; float ss = 0.f;
#pragma unroll
        for (int i = 0; i < 8; ++i) { a[i] = (a[i] + c[i]) * qs; ss += a[i] * a[i]; }
        ss = group_sum<16>(ss); const float sc = rsqrtf(ss * (1.0f / 128.0f) + RMS_EPS);
        const float* gn = (br == 0 ? lp.gla_norm : br == 1 ? lp.gdn_norm : lp.hg_norm) + (lane & 15) * 8;
#pragma unroll
        for (int i = 0; i < 8; ++i) a[i] = a[i] * sc * gn[i] * (br == 2 ? sigmf(og[i]) : siluf(og[i]));
        *(v4u*)(BR + ((size_t)(1 + br) * NT + t) * 512 + lane * 8) = pack8(a);
    }
}
typedef short bf16x8 __attribute__((ext_vector_type(8)));
__device__ __forceinline__ bf16x8 as_bf16x8(v4u w) { return __builtin_bit_cast(bf16x8, w); }
#define MFMA16(a, b, c) __builtin_amdgcn_mfma_f32_16x16x32_bf16((a), (b), (c), 0, 0, 0)
typedef short bf16x4 __attribute__((ext_vector_type(4)));
__device__ __forceinline__ bf16x4 as_bf16x4(v2u w) { return __builtin_bit_cast(bf16x4, w); }
#define MFMA16K16(a, b, c) __builtin_amdgcn_mfma_f32_16x16x16bf16_1k((a), (b), (c), 0, 0, 0)
__device__ __forceinline__ void na_wave_unit(const bf16* P, const bf16* NAVT, const float* rel_bias, bf16* BR0, int b, int h, int r, int qc, int lane) {
    const int fr = lane & 15, g = lane >> 4; const int c = qc * 16 + fr;
    const int kc_lo = qc == 0 ? 0 : qc == 1 ? 8 : qc == 2 ? 24 : 32;
    const int cs = min(max(c - 8, 0), 48), rbase = min(max(r - 4, 0), 56);
    const size_t tq = (size_t)(b << 12) + r * 64 + c;
    bf16x8 qf[2];
#pragma unroll
    for (int ks = 0; ks < 2; ++ks) qf[ks] = as_bf16x8(*(const v4u*)(P + tq * LDP + C_NAQ + h * 64 + ks * 32 + g * 8));
    f32x4 s[8][2]; float mx = -3.0e38f;
    v4u kf[8][2][2];
#pragma unroll
    for (int i = 0; i < 8; ++i)
#pragma unroll
        for (int kt = 0; kt < 2; ++kt) { const bf16* kp = P + ((size_t)(b << 12) + (rbase + i) * 64 + kc_lo + (fr >> 2) * 8 + kt * 4 + (fr & 3)) * LDP + C_NAK + h * 64 + g * 8; kf[i][kt][0] = *(const v4u*)kp; kf[i][kt][1] = *(const v4u*)(kp + 32); }
#pragma unroll
    for (int i = 0; i < 8; ++i) { const float* bp = rel_bias + (h * 15 + (rbase + i - r + 7)) * 31;
#pragma unroll
        for (int kt = 0; kt < 2; ++kt) {
            f32x4 a = {0.f, 0.f, 0.f, 0.f}; a = MFMA16(as_bf16x8(kf[i][kt][0]), qf[0], a); a = MFMA16(as_bf16x8(kf[i][kt][1]), qf[1], a);
            const int ck0 = kc_lo + 8 * g + 4 * kt, dc0 = ck0 - c + 15, dcl = min(max(dc0, 0), 27); const f32x4 b4 = *(const f32x4*)(bp + dcl);
#pragma unroll
            for (int jj = 0; jj < 4; ++jj) { const int ck = ck0 + jj; const bool inw = (ck >= cs) && (ck < cs + 16); const int sh = dc0 + jj - dcl;
                const float bv = sh == 0 ? b4[0] : sh == 1 ? b4[1] : sh == 2 ? b4[2] : b4[3];
                a[jj] = inw ? a[jj] + bv : -1.0e30f; mx = fmaxf(mx, a[jj]); }
            s[i][kt] = a; } }
    mx = fmaxf(mx, __shfl_xor(mx, 16)); mx = fmaxf(mx, __shfl_xor(mx, 32));
    float l = 0.f;
#pragma unroll
    for (int i = 0; i < 8; ++i)
#pragma unroll
        for (int kt = 0; kt < 2; ++kt)
#pragma unroll
            for (int jj = 0; jj < 4; ++jj) { const float p = __expf(s[i][kt][jj] - mx); s[i][kt][jj] = p; l += p; }
    l += __shfl_xor(l, 16); l += __shfl_xor(l, 32);
    f32x4 o[4];
#pragma unroll
    for (int dt = 0; dt < 4; ++dt) o[dt] = (f32x4){0.f, 0.f, 0.f, 0.f};
#pragma unroll
    for (int hh = 0; hh < 2; ++hh) { v4u vv[4][4];
#pragma unroll
        for (int i4 = 0; i4 < 4; ++i4)
#pragma unroll
            for (int dt = 0; dt < 4; ++dt) { const bf16* vp = NAVT + ((size_t)((b * 8 + h) * 64 + dt * 16 + fr)) * SEQ + (rbase + hh * 4 + i4) * 64 + kc_lo + 8 * g; vv[i4][dt] = *(const v4u*)vp; }
#pragma unroll
        for (int i4 = 0; i4 < 4; ++i4) { const int i = hh * 4 + i4; v4u pw; pw.x = pkbf(s[i][0][0], s[i][0][1]); pw.y = pkbf(s[i][0][2], s[i][0][3]); pw.z = pkbf(s[i][1][0], s[i][1][1]); pw.w = pkbf(s[i][1][2], s[i][1][3]);
            const bf16x8 pf = as_bf16x8(pw);
#pragma unroll
            for (int dt = 0; dt < 4; ++dt) o[dt] = MFMA16(as_bf16x8(vv[i4][dt]), pf, o[dt]); } }
    const float inv = 1.0f / l;
#pragma unroll
    for (int dt = 0; dt < 4; ++dt) { v2u w; w.x = pkbf(o[dt][0] * inv, o[dt][1] * inv); w.y = pkbf(o[dt][2] * inv, o[dt][3] * inv);
        *(v2u*)(BR0 + tq * 512 + h * 64 + dt * 16 + 4 * g) = w; }
}
__device__ __forceinline__ void mem_wave_unit(const bf16* P, const bf16* MK, const bf16* MVT, bf16* BR4, int t0, int h, int lane) {
    const int fr = lane & 15, g = lane >> 4, b = t0 >> 12; const size_t tq = (size_t)t0 + fr;
    bf16x8 qf[4];
#pragma unroll
    for (int ks = 0; ks < 4; ++ks) qf[ks] = as_bf16x8(*(const v4u*)(P + tq * LDP + C_MQ + h * 128 + ks * 32 + g * 8));
    f32x4 s[16]; float mx = -3.0e38f;
#pragma unroll
    for (int m4 = 0; m4 < 2; ++m4) { v4u kf[8][4];
#pragma unroll
        for (int mm = 0; mm < 8; ++mm)
#pragma unroll
            for (int ks = 0; ks < 4; ++ks) kf[mm][ks] = *(const v4u*)(MK + ((size_t)(b * 256 + (m4 * 8 + mm) * 16 + fr)) * 512 + h * 128 + g * 8 + ks * 32);
#pragma unroll
        for (int mm = 0; mm < 8; ++mm) { f32x4 a = {0.f, 0.f, 0.f, 0.f};
#pragma unroll
            for (int ks = 0; ks < 4; ++ks) a = MFMA16(as_bf16x8(kf[mm][ks]), qf[ks], a);
#pragma unroll
            for (int jj = 0; jj < 4; ++jj) mx = fmaxf(mx, a[jj]);
            s[m4 * 8 + mm] = a; } }
    mx = fmaxf(mx, __shfl_xor(mx, 16)); mx = fmaxf(mx, __shfl_xor(mx, 32));
    float l = 0.f;
#pragma unroll
    for (int mt = 0; mt < 16; ++mt)
#pragma unroll
        for (int jj = 0; jj < 4; ++jj) { const float p = __expf(s[mt][jj] - mx); s[mt][jj] = p; l += p; }
    l += __shfl_xor(l, 16); l += __shfl_xor(l, 32);
    f32x4 o[8];
#pragma unroll
    for (int dt = 0; dt < 8; ++dt) o[dt] = (f32x4){0.f, 0.f, 0.f, 0.f};
#pragma unroll
    for (int k4 = 0; k4 < 4; ++k4) { v2u vv[2][8][2];
#pragma unroll
        for (int k2 = 0; k2 < 2; ++k2)
#pragma unroll
            for (int dt = 0; dt < 8; ++dt) { const bf16* vp = MVT + ((size_t)((b * 4 + h) * 128 + dt * 16 + fr)) * 256 + (k4 * 2 + k2) * 32 + 4 * g; vv[k2][dt][0] = *(const v2u*)vp; vv[k2][dt][1] = *(const v2u*)(vp + 16); }
#pragma unroll
        for (int k2 = 0; k2 < 2; ++k2) { const int kb = k4 * 2 + k2; v4u pw; pw.x = pkbf(s[2 * kb][0], s[2 * kb][1]); pw.y = pkbf(s[2 * kb][2], s[2 * kb][3]); pw.z = pkbf(s[2 * kb + 1][0], s[2 * kb + 1][1]); pw.w = pkbf(s[2 * kb + 1][2], s[2 * kb + 1][3]);
            const bf16x8 pf = as_bf16x8(pw);
#pragma unroll
            for (int dt = 0; dt < 8; ++dt) { v4u vw; vw.x = vv[k2][dt][0].x; vw.y = vv[k2][dt][0].y; vw.z = vv[k2][dt][1].x; vw.w = vv[k2][dt][1].y; o[dt] = MFMA16(as_bf16x8(vw), pf, o[dt]); } } }
    const float inv = 1.0f / l;
#pragma unroll
    for (int dt = 0; dt < 8; ++dt) { v2u w; w.x = pkbf(o[dt][0] * inv, o[dt][1] * inv); w.y = pkbf(o[dt][2] * inv, o[dt][3] * inv);
        *(v2u*)(BR4 + tq * 512 + h * 128 + dt * 16 + 4 * g) = w; }
}
__device__ __forceinline__ void mem_wg_unit(LAS unsigned char* ring, const bf16* P, const bf16* MK, const bf16* MVT, bf16* BR4, int t0, int h, int wave, int lane, int tid) {
    const int fr = lane & 15, g = lane >> 4, b = t0 >> 12;
    { const bf16* ksrc = MK + (size_t)(b * 256) * 512 + h * 128;
#pragma unroll
      for (int i = 0; i < 8; ++i) { const int idx = i * 512 + tid, key = idx >> 4, c = idx & 15; const v4u w = *(const v4u*)(ksrc + (size_t)key * 512 + c * 8); *(LAS v4u*)(ring + key * 256 + ((c ^ (key & 15)) << 4)) = w; }
      const bf16* vsrc = MVT + (size_t)((b * 4 + h) * 128) * 256;
#pragma unroll
      for (int i = 0; i < 2; ++i) { const int idx = i * 512 + tid, d = idx >> 3, kb = idx & 7; const v4u* p = (const v4u*)(vsrc + (size_t)d * 256 + kb * 32); const v4u u0 = p[0], u1 = p[1], u2 = p[2], u3 = p[3];
          LAS unsigned char* row = ring + 65536 + d * 512; const int sw = d & 15;
          v4u c0, c1, c2, c3; c0.x = u0.x; c0.y = u0.y; c0.z = u2.x; c0.w = u2.y; c1.x = u0.z; c1.y = u0.w; c1.z = u2.z; c1.w = u2.w; c2.x = u1.x; c2.y = u1.y; c2.z = u3.x; c2.w = u3.y; c3.x = u1.z; c3.y = u1.w; c3.z = u3.z; c3.w = u3.w;
          *(LAS v4u*)(row + (((kb * 4 + 0) ^ sw) << 4)) = c0; *(LAS v4u*)(row + (((kb * 4 + 1) ^ sw) << 4)) = c1; *(LAS v4u*)(row + (((kb * 4 + 2) ^ sw) << 4)) = c2; *(LAS v4u*)(row + (((kb * 4 + 3) ^ sw) << 4)) = c3; } }
    __syncthreads();
#pragma unroll 1
    for (int sub = 0; sub < 2; ++sub) { const size_t tq = (size_t)t0 + sub * 128 + wave * 16 + fr;
        int fo = fr; asm volatile("" : "+v"(fo));
        bf16x8 qf[4];
#pragma unroll
        for (int ks = 0; ks < 4; ++ks) qf[ks] = as_bf16x8(*(const v4u*)(P + tq * LDP + C_MQ + h * 128 + ks * 32 + g * 8));
        f32x4 s[16]; float mx = -3.0e38f;
#pragma unroll
        for (int mt = 0; mt < 16; ++mt) { f32x4 a = {0.f, 0.f, 0.f, 0.f}; const LAS unsigned char* kr = ring + (mt * 16 + fo) * 256;
#pragma unroll
            for (int ks = 0; ks < 4; ++ks) a = MFMA16(as_bf16x8(*(const LAS v4u*)(kr + (((ks * 4 + g) ^ fo) << 4))), qf[ks], a);
#pragma unroll
            for (int jj = 0; jj < 4; ++jj) mx = fmaxf(mx, a[jj]);
            s[mt] = a; }
        mx = fmaxf(mx, __shfl_xor(mx, 16)); mx = fmaxf(mx, __shfl_xor(mx, 32));
        float l = 0.f;
#pragma unroll
        for (int mt = 0; mt < 16; ++mt)
#pragma unroll
            for (int jj = 0; jj < 4; ++jj) { const float p = __expf(s[mt][jj] - mx); s[mt][jj] = p; l += p; }
        l += __shfl_xor(l, 16); l += __shfl_xor(l, 32);
        f32x4 o[8];
#pragma unroll
        for (int dt = 0; dt < 8; ++dt) o[dt] = (f32x4){0.f, 0.f, 0.f, 0.f};
#pragma unroll
        for (int kb = 0; kb < 8; ++kb) { v4u pw; pw.x = pkbf(s[2 * kb][0], s[2 * kb][1]); pw.y = pkbf(s[2 * kb][2], s[2 * kb][3]); pw.z = pkbf(s[2 * kb + 1][0], s[2 * kb + 1][1]); pw.w = pkbf(s[2 * kb + 1][2], s[2 * kb + 1][3]);
            const bf16x8 pf = as_bf16x8(pw);
#pragma unroll
            for (int dt = 0; dt < 8; ++dt) o[dt] = MFMA16(as_bf16x8(*(const LAS v4u*)(ring + 65536 + (dt * 16 + fo) * 512 + (((kb * 4 + g) ^ fo) << 4))), pf, o[dt]); }
        const float inv = 1.0f / l;
#pragma unroll
        for (int dt = 0; dt < 8; ++dt) { v2u w; w.x = pkbf(o[dt][0] * inv, o[dt][1] * inv); w.y = pkbf(o[dt][2] * inv, o[dt][3] * inv);
            *(v2u*)(BR4 + tq * 512 + h * 128 + dt * 16 + 4 * g) = w; }
    }
}
#define CH_TOK(n, i) ((size_t)(dir ? (SEQ - 1 - ((n) * 16 + (i))) : ((n) * 16 + (i))))
__device__ __forceinline__ bf16 tobf(float x) { return (bf16)(pkbf(x, 0.f) & 0xffffu); }
constexpr size_t OA_GW = 0, OA_GU = 32 * MiB, OA_GKT = 64 * MiB, OA_GP = 96 * MiB, OA_GS = 100 * MiB, OA_HQD = 104 * MiB, OA_HKDT = 136 * MiB, OA_HP = 168 * MiB, OA_HV = 172 * MiB,
                 OA_LQD = 184 * MiB, OA_LKDT = 200 * MiB, OA_LP = 216 * MiB, OA_LV = 220 * MiB, OA_END = 226 * MiB;
struct DiagSrc { const bf16* q; int qp; const bf16* k; int kp; const float* lg; int lgp; const bf16* v; int vp; };
template <int K, int HG> __device__ __forceinline__ void s1_diag(LAS unsigned char* scr, const DiagSrc& S, int dir, int n, bf16* QD, bf16* KDT, bf16* PP, float* EB, int lane) {
    constexpr int NK = K / 64, LPI = K + 8;
    LAS bf16* QDs = (LAS bf16*)scr; LAS bf16* KDs = QDs + 16 * LPI;
#pragma unroll
    for (int c = 0; c < NK; ++c) { const int k = lane + 64 * c; float bi[16], lgv[16]; float b = 0.f;
#pragma unroll
        for (int i = 0; i < 16; ++i) { lgv[i] = S.lg[CH_TOK(n, i) * S.lgp + k]; b += lgv[i]; bi[i] = b; }
        unsigned kdw[8];
#pragma unroll
        for (int i = 0; i < 16; ++i) { const size_t tok = CH_TOK(n, i); const float qv = bf1(S.q[tok * S.qp + k]); float kv;
            if (HG) kv = 1.0f - __expf(lgv[i]); else kv = bf1(S.k[tok * S.kp + k]);
            const bf16 qh = tobf(qv * __expf(bi[i])), kh = tobf(kv * __expf(-bi[i]));
            QD[i * K + k] = qh; QDs[i * LPI + k] = qh; KDs[i * LPI + k] = kh;
            if (i & 1) kdw[i >> 1] |= ((unsigned)kh) << 16; else kdw[i >> 1] = kh; }
        *(v4u*)(KDT + k * 16) = (v4u){kdw[0], kdw[1], kdw[2], kdw[3]}; *(v4u*)(KDT + k * 16 + 8) = (v4u){kdw[4], kdw[5], kdw[6], kdw[7]};
        EB[k] = __expf(bi[15]); }
    LDS_WAIT(); asm volatile("" ::: "memory");
    const int fr = lane & 15, g = lane >> 4; f32x4 acc = {0.f, 0.f, 0.f, 0.f};
#pragma unroll
    for (int ks = 0; ks < K / 32; ++ks) { const bf16x8 qf = as_bf16x8(*(const LAS v4u*)(QDs + fr * LPI + 32 * ks + 8 * g)), kf = as_bf16x8(*(const LAS v4u*)(KDs + fr * LPI + 32 * ks + 8 * g)); acc = MFMA16(qf, kf, acc); }
#pragma unroll
    for (int jj = 0; jj < 4; ++jj) { const int i = 4 * g + jj; PP[i * 16 + fr] = tobf(fr <= i ? acc[jj] : 0.f); }
    LDS_WAIT(); asm volatile("" ::: "memory");
}
#define S2_BAR() do { asm volatile("s_waitcnt lgkmcnt(0)" ::: "memory"); __builtin_amdgcn_s_barrier(); asm volatile("" ::: "memory"); } while (0)
template <int K> struct DiagStage { v4u qd[K / 64], kdt[K / 64], v[2], p, eb; };
template <int K> struct DiagLds { static constexpr int QP = 2 * K + 16, LQD = 0, LKDT = 64 * QP, LV = LKDT + 4 * K * 32, LP = LV + 64 * 256, LEB = LP + 2048, BYTES = LEB + 4 * K * 4; };
template <int K> __device__ __forceinline__ void s2d_load(DiagStage<K>& R, const bf16* QD0, const bf16* KDT0, const bf16* PP0, const float* EB0, const bf16* vsrc, int vp, int dir, int grp, int tid) {
    const size_t c0 = (size_t)grp * 4;
#pragma unroll
    for (int j = 0; j < K / 64; ++j) { const int e = tid + 512 * j; R.qd[j] = *(const v4u*)(QD0 + c0 * 16 * K + (size_t)e * 8); R.kdt[j] = *(const v4u*)(KDT0 + c0 * 16 * K + (size_t)e * 8); }
#pragma unroll
    for (int j = 0; j < 2; ++j) { const int e = tid + 512 * j, row = e >> 4, col = e & 15; R.v[j] = *(const v4u*)(vsrc + CH_TOK(grp * 4 + (row >> 4), row & 15) * vp + col * 8); }
    if (tid < 128) R.p = *(const v4u*)(PP0 + c0 * 256 + tid * 8);
    else if (tid < 128 + K) R.eb = *(const v4u*)(EB0 + c0 * K + (tid - 128) * 4);
}
template <int K> __device__ __forceinline__ void s2d_store(const DiagStage<K>& R, LAS unsigned char* lds, int tid) {
    typedef DiagLds<K> L;
#pragma unroll
    for (int j = 0; j < K / 64; ++j) { const int e = tid + 512 * j, row = e / (K / 8), col = e % (K / 8); *(LAS v4u*)(lds + L::LQD + row * L::QP + col * 16) = R.qd[j]; *(LAS v4u*)(lds + L::LKDT + e * 16) = R.kdt[j]; }
#pragma unroll
    for (int j = 0; j < 2; ++j) { const int e = tid + 512 * j; *(LAS v4u*)(lds + L::LV + e * 16) = R.v[j]; }
    if (tid < 128) *(LAS v4u*)(lds + L::LP + tid * 16) = R.p;
    else if (tid < 128 + K) *(LAS v4u*)(lds + L::LEB + (tid - 128) * 16) = R.eb;
}
template <int K> __device__ __forceinline__ void s2d_chunk(LAS unsigned char* lds, int c, f32x4 (&S)[K / 16], bf16* osrc, int op, int dir, int n, int vt, int lane) {
    typedef DiagLds<K> L; const int fr = lane & 15, g = lane >> 4;
    f32x4 o = {0.f, 0.f, 0.f, 0.f};
#pragma unroll
    for (int ks = 0; ks < K / 32; ++ks) { const LAS unsigned char* qp = lds + L::LQD + (c * 16 + fr) * L::QP + (32 * ks + 4 * g) * 2; const v2u a = *(const LAS v2u*)qp, b = *(const LAS v2u*)(qp + 32);
        v4u sb; sb.x = pkbf(S[2 * ks][0], S[2 * ks][1]); sb.y = pkbf(S[2 * ks][2], S[2 * ks][3]); sb.z = pkbf(S[2 * ks + 1][0], S[2 * ks + 1][1]); sb.w = pkbf(S[2 * ks + 1][2], S[2 * ks + 1][3]);
        o = MFMA16(as_bf16x8((v4u){a.x, a.y, b.x, b.y}), as_bf16x8(sb), o); }
    unsigned vr[4];
#pragma unroll
    for (int jj = 0; jj < 4; ++jj) vr[jj] = *(const LAS unsigned short*)(lds + L::LV + ((c * 16 + 4 * g + jj) * 128 + vt * 16 + fr) * 2);
    const bf16x8 vf = as_bf16x8((v4u){vr[0] | (vr[1] << 16), vr[2] | (vr[3] << 16), 0u, 0u});
    { const v2u pp = *(const LAS v2u*)(lds + L::LP + (c * 256 + fr * 16 + 4 * g) * 2); o = MFMA16(as_bf16x8((v4u){pp.x, pp.y, 0u, 0u}), vf, o); }
#pragma unroll
    for (int kt = 0; kt < K / 16; ++kt) { const v2u kd = *(const LAS v2u*)(lds + L::LKDT + ((c * K + kt * 16 + fr) * 16 + 4 * g) * 2); const f32x4 eb = *(const LAS f32x4*)(lds + L::LEB + (c * K + kt * 16 + 4 * g) * 4);
        S[kt] = MFMA16(as_bf16x8((v4u){kd.x, kd.y, 0u, 0u}), vf, S[kt]); S[kt] = S[kt] * eb; }
#pragma unroll
    for (int jj = 0; jj < 4; ++jj) osrc[CH_TOK(n, 4 * g + jj) * op + vt * 16 + fr] = tobf(o[jj]);
}
template <int K> __device__ __forceinline__ void s2_diag(LAS unsigned char* lds, const bf16* QD0, const bf16* KDT0, const bf16* PP0, const float* EB0, const bf16* vsrc, int vp, bf16* osrc, int op, int dir, int vt, int lane, int tid) {
    static_assert(DiagLds<K>::BYTES <= RING_BYTES, "S2 LDS");
    f32x4 S[K / 16];
#pragma unroll
    for (int kt = 0; kt < K / 16; ++kt) S[kt] = (f32x4){0.f, 0.f, 0.f, 0.f};
    DiagStage<K> Ra, Rb;
    s2d_load<K>(Ra, QD0, KDT0, PP0, EB0, vsrc, vp, dir, 0, tid); s2d_load<K>(Rb, QD0, KDT0, PP0, EB0, vsrc, vp, dir, 1, tid);
#pragma unroll 1
    for (int grp = 0; grp < SEQ / 64; grp += 2) {
        S2_BAR(); s2d_store<K>(Ra, lds, tid); S2_BAR();
        s2d_load<K>(Ra, QD0, KDT0, PP0, EB0, vsrc, vp, dir, grp + 2 < SEQ / 64 ? grp + 2 : grp, tid);
#pragma unroll 2
        for (int c = 0; c < 4; ++c) s2d_chunk<K>(lds, c, S, osrc, op, dir, grp * 4 + c, vt, lane);
        S2_BAR(); s2d_store<K>(Rb, lds, tid); S2_BAR();
        s2d_load<K>(Rb, QD0, KDT0, PP0, EB0, vsrc, vp, dir, grp + 3 < SEQ / 64 ? grp + 3 : grp + 1, tid);
#pragma unroll 2
        for (int c = 0; c < 4; ++c) s2d_chunk<K>(lds, c, S, osrc, op, dir, (grp + 1) * 4 + c, vt, lane);
    }
    S2_BAR();
}
__device__ __forceinline__ void s1_gdn(LAS unsigned char* scr, const bf16* GQb, const float* GABb, int h, int dir, int n, bf16* GW, bf16* GU, bf16* GKT, bf16* GP, float* GS, int lane) {
    const int fr = lane & 15, g = lane >> 4;
    LAS float* AT = (LAS float*)scr;
    float c[16], be[16]; float cs = 0.f;
#pragma unroll
    for (int i = 0; i < 16; ++i) { const size_t tok = CH_TOK(n, i); cs += GABb[tok * 16]; c[i] = cs; be[i] = GABb[tok * 16 + 8]; }
    const size_t tr = CH_TOK(n, fr);
    f32x4 kk = {0.f, 0.f, 0.f, 0.f}, qk = {0.f, 0.f, 0.f, 0.f};
#pragma unroll
    for (int ks = 0; ks < 4; ++ks) { const bf16x8 kf = as_bf16x8(*(const v4u*)(GQb + tr * 1536 + 512 + h * 128 + 32 * ks + 8 * g)), qf = as_bf16x8(*(const v4u*)(GQb + tr * 1536 + h * 128 + 32 * ks + 8 * g));
        kk = MFMA16(kf, kf, kk); qk = MFMA16(qf, kf, qk); }
    float cj = 0.f;
#pragma unroll
    for (int i = 0; i < 16; ++i) cj = (fr == i) ? c[i] : cj;
    f32x4 av;
#pragma unroll
    for (int jj = 0; jj < 4; ++jj) { float ci = 0.f, bi = 0.f;
#pragma unroll
        for (int gg = 0; gg < 4; ++gg) { ci = (g == gg) ? c[4 * gg + jj] : ci; bi = (g == gg) ? be[4 * gg + jj] : bi; }
        const int i = 4 * g + jj; const float dec = __expf(ci - cj);
        av[jj] = (fr < i) ? bi * kk[jj] * dec : 0.f;
        GP[i * 16 + fr] = tobf(fr <= i ? qk[jj] * dec : 0.f); }
    *(LAS f32x4*)(AT + fr * 16 + 4 * g) = av;
    if (lane < 16) { GS[lane] = __expf(cj); GS[16 + lane] = __expf(c[15] - cj); } if (lane == 16) GS[32] = __expf(c[15]);
    LDS_WAIT(); asm volatile("" ::: "memory");
    float t[16];
#pragma unroll
    for (int j = 15; j >= 0; --j) { float a = (fr == j) ? 1.f : 0.f;
        if (j < 15) { f32x4 col[4];
#pragma unroll
            for (int q4 = 0; q4 < 4; ++q4) col[q4] = *(const LAS f32x4*)(AT + j * 16 + 4 * q4);
#pragma unroll
            for (int i = j + 1; i < 16; ++i) a -= t[i] * col[i >> 2][i & 3]; }
        t[j] = a; }
    float tf[4];
#pragma unroll
    for (int e = 0; e < 4; ++e) { float x = 0.f;
#pragma unroll
        for (int gg = 0; gg < 4; ++gg) x = (g == gg) ? t[4 * gg + e] : x;
        tf[e] = x; }
    const bf16x8 tfrag = as_bf16x8((v4u){pkbf(tf[0], tf[1]), pkbf(tf[2], tf[3]), 0u, 0u});
    float bj[4], bgj[4]; size_t tj[4];
#pragma unroll
    for (int e = 0; e < 4; ++e) { float cc = 0.f, bb = 0.f;
#pragma unroll
        for (int gg = 0; gg < 4; ++gg) { cc = (g == gg) ? c[4 * gg + e] : cc; bb = (g == gg) ? be[4 * gg + e] : bb; }
        bj[e] = bb; bgj[e] = bb * __expf(cc); tj[e] = CH_TOK(n, 4 * g + e); }
#pragma unroll 2
    for (int ct = 0; ct < 8; ++ct) {
        float vv[4], kv[4];
#pragma unroll
        for (int e = 0; e < 4; ++e) { vv[e] = bf1(GQb[tj[e] * 1536 + 1024 + h * 128 + ct * 16 + fr]); kv[e] = bf1(GQb[tj[e] * 1536 + 512 + h * 128 + ct * 16 + fr]); }
        const bf16x8 vb = as_bf16x8((v4u){pkbf(vv[0] * bj[0], vv[1] * bj[1]), pkbf(vv[2] * bj[2], vv[3] * bj[3]), 0u, 0u});
        const bf16x8 kb = as_bf16x8((v4u){pkbf(kv[0] * bgj[0], kv[1] * bgj[1]), pkbf(kv[2] * bgj[2], kv[3] * bgj[3]), 0u, 0u});
        const f32x4 z = {0.f, 0.f, 0.f, 0.f}; const f32x4 u = MFMA16(tfrag, vb, z), w = MFMA16(tfrag, kb, z);
#pragma unroll
        for (int jj = 0; jj < 4; ++jj) { GU[(4 * g + jj) * 128 + ct * 16 + fr] = tobf(u[jj]); GW[(4 * g + jj) * 128 + ct * 16 + fr] = tobf(w[jj]); }
        *(v2u*)(GKT + (ct * 16 + fr) * 16 + 4 * g) = (v2u){pkbf(kv[0], kv[1]), pkbf(kv[2], kv[3])};
    }
    LDS_WAIT(); asm volatile("" ::: "memory");
}
struct GdnStage { v4u w[2], q[2], kt[2], u[2], p, s; };
struct GdnLds { static constexpr int WP = 272, LW = 0, LQ = 64 * WP, LKT = 2 * 64 * WP, LU = LKT + 16384, LP = LU + 16384, LS = LP + 2048, BYTES = LS + 1024; };
__device__ __forceinline__ void s2g_load(GdnStage& R, const bf16* GW0, const bf16* GU0, const bf16* GKT0, const bf16* GP0, const float* GS0, const bf16* qsrc, int dir, int grp, int tid) {
    const size_t c0 = (size_t)grp * 4;
#pragma unroll
    for (int j = 0; j < 2; ++j) { const int e = tid + 512 * j, row = e >> 4, col = e & 15;
        R.w[j] = *(const v4u*)(GW0 + c0 * 2048 + (size_t)e * 8); R.kt[j] = *(const v4u*)(GKT0 + c0 * 2048 + (size_t)e * 8); R.u[j] = *(const v4u*)(GU0 + c0 * 2048 + (size_t)e * 8);
        R.q[j] = *(const v4u*)(qsrc + CH_TOK(grp * 4 + (row >> 4), row & 15) * 1536 + col * 8); }
    if (tid < 128) R.p = *(const v4u*)(GP0 + c0 * 256 + tid * 8);
    else if (tid < 192) R.s = *(const v4u*)(GS0 + c0 * 64 + (tid - 128) * 4);
}
__device__ __forceinline__ void s2g_store(const GdnStage& R, LAS unsigned char* lds, int tid) {
    typedef GdnLds L;
#pragma unroll
    for (int j = 0; j < 2; ++j) { const int e = tid + 512 * j, row = e >> 4, col = e & 15;
        *(LAS v4u*)(lds + L::LW + row * L::WP + col * 16) = R.w[j]; *(LAS v4u*)(lds + L::LQ + row * L::WP + col * 16) = R.q[j]; *(LAS v4u*)(lds + L::LKT + e * 16) = R.kt[j]; *(LAS v4u*)(lds + L::LU + e * 16) = R.u[j]; }
    if (tid < 128) *(LAS v4u*)(lds + L::LP + tid * 16) = R.p;
    else if (tid < 192) *(LAS v4u*)(lds + L::LS + (tid - 128) * 16) = R.s;
}
__device__ __forceinline__ void s2g_chunk(LAS unsigned char* lds, int c, f32x4 (&S)[8], bf16* osrc, int dir, int n, int vt, int lane) {
    typedef GdnLds L; const int fr = lane & 15, g = lane >> 4;
    f32x4 ws = {0.f, 0.f, 0.f, 0.f}, qs = {0.f, 0.f, 0.f, 0.f};
#pragma unroll
    for (int ks = 0; ks < 4; ++ks) { const int off = (c * 16 + fr) * L::WP + (32 * ks + 4 * g) * 2;
        const v2u a = *(const LAS v2u*)(lds + L::LW + off), b = *(const LAS v2u*)(lds + L::LW + off + 32), qa = *(const LAS v2u*)(lds + L::LQ + off), qb = *(const LAS v2u*)(lds + L::LQ + off + 32);
        v4u sb; sb.x = pkbf(S[2 * ks][0], S[2 * ks][1]); sb.y = pkbf(S[2 * ks][2], S[2 * ks][3]); sb.z = pkbf(S[2 * ks + 1][0], S[2 * ks + 1][1]); sb.w = pkbf(S[2 * ks + 1][2], S[2 * ks + 1][3]);
        const bf16x8 sbf = as_bf16x8(sb); ws = MFMA16(as_bf16x8((v4u){a.x, a.y, b.x, b.y}), sbf, ws); qs = MFMA16(as_bf16x8((v4u){qa.x, qa.y, qb.x, qb.y}), sbf, qs); }
    f32x4 vn;
#pragma unroll
    for (int jj = 0; jj < 4; ++jj) vn[jj] = bf1(*(const LAS unsigned short*)(lds + L::LU + ((c * 16 + 4 * g + jj) * 128 + vt * 16 + fr) * 2)) - ws[jj];
    const f32x4 gam = *(const LAS f32x4*)(lds + L::LS + (c * 64 + 4 * g) * 4), gdec = *(const LAS f32x4*)(lds + L::LS + (c * 64 + 16 + 4 * g) * 4); const float Gam = *(const LAS float*)(lds + L::LS + (c * 64 + 32) * 4);
    const bf16x8 vnf = as_bf16x8((v4u){pkbf(vn[0], vn[1]), pkbf(vn[2], vn[3]), 0u, 0u});
    f32x4 o = qs * gam; { const v2u pp = *(const LAS v2u*)(lds + L::LP + (c * 256 + fr * 16 + 4 * g) * 2); o = MFMA16(as_bf16x8((v4u){pp.x, pp.y, 0u, 0u}), vnf, o); }
    const f32x4 vd = vn * gdec; const bf16x8 vdf = as_bf16x8((v4u){pkbf(vd[0], vd[1]), pkbf(vd[2], vd[3]), 0u, 0u});
#pragma unroll
    for (int kt = 0; kt < 8; ++kt) { const v2u kk = *(const LAS v2u*)(lds + L::LKT + ((c * 128 + kt * 16 + fr) * 16 + 4 * g) * 2); S[kt] = S[kt] * Gam; S[kt] = MFMA16(as_bf16x8((v4u){kk.x, kk.y, 0u, 0u}), vdf, S[kt]); }
#pragma unroll
    for (int jj = 0; jj < 4; ++jj) osrc[CH_TOK(n, 4 * g + jj) * 512 + vt * 16 + fr] = tobf(o[jj]);
}
__device__ __forceinline__ void s2_gdn(LAS unsigned char* lds, const bf16* GW0, const bf16* GU0, const bf16* GKT0, const bf16* GP0, const float* GS0, const bf16* qsrc, bf16* osrc, int dir, int vt, int lane, int tid) {
    static_assert(GdnLds::BYTES <= RING_BYTES, "S2 LDS");
    f32x4 S[8];
#pragma unroll
    for (int kt = 0; kt < 8; ++kt) S[kt] = (f32x4){0.f, 0.f, 0.f, 0.f};
    GdnStage Ra, Rb;
    s2g_load(Ra, GW0, GU0, GKT0, GP0, GS0, qsrc, dir, 0, tid); s2g_load(Rb, GW0, GU0, GKT0, GP0, GS0, qsrc, dir, 1, tid);
#pragma unroll 1
    for (int grp = 0; grp < SEQ / 64; grp += 2) {
        S2_BAR(); s2g_store(Ra, lds, tid); S2_BAR();
        s2g_load(Ra, GW0, GU0, GKT0, GP0, GS0, qsrc, dir, grp + 2 < SEQ / 64 ? grp + 2 : grp, tid);
#pragma unroll 2
        for (int c = 0; c < 4; ++c) s2g_chunk(lds, c, S, osrc, dir, grp * 4 + c, vt, lane);
        S2_BAR(); s2g_store(Rb, lds, tid); S2_BAR();
        s2g_load(Rb, GW0, GU0, GKT0, GP0, GS0, qsrc, dir, grp + 3 < SEQ / 64 ? grp + 3 : grp + 1, tid);
#pragma unroll 2
        for (int c = 0; c < 4; ++c) s2g_chunk(lds, c, S, osrc, dir, (grp + 1) * 4 + c, vt, lane);
    }
    S2_BAR();
}
struct Args { const float* in[31]; float* out; unsigned char* ws; int ph_lo, ph_hi; };
static_assert(sizeof(Args) == 31 * 8 + 8 + 8 + 8, "Args has no padding");
typedef const __attribute__((address_space(4))) unsigned char* kptr_t;
typedef const float* cfptr_t; typedef float* fptr_t; typedef unsigned char* ucptr_t;
__device__ __forceinline__ kptr_t kargs() { kptr_t p = (kptr_t)__builtin_amdgcn_kernarg_segment_ptr(); asm volatile("" : "+s"(p)); return p; }
#define KIN(p, i) (*(const __attribute__((address_space(4))) cfptr_t*)((p) + 8 * (i)))
#define KOUT(p) (*(const __attribute__((address_space(4))) fptr_t*)((p) + 248))
#define KWS(p) (*(const __attribute__((address_space(4))) ucptr_t*)((p) + 256))

#ifndef STAGGER_TICKS
#define STAGGER_TICKS 0
#endif
#define GEMM_STAGGER() do { if (STAGGER_TICKS) { const unsigned long long t0_ = __builtin_amdgcn_s_memrealtime(); const unsigned long long dl_ = (unsigned long long)((bx & 15) * STAGGER_TICKS); while (__builtin_amdgcn_s_memrealtime() - t0_ < dl_) __builtin_amdgcn_s_sleep(4); } } while (0)
#ifndef FILL_TAIL
#define FILL_TAIL 1
#endif
#ifndef GATE_BATCH
#define GATE_BATCH 4
#endif
#ifndef F8_SP2
#define F8_SP2 true
#endif
#ifndef EN_MASK
#define EN_MASK 0xffffffffu
#endif
#define EN_PH(k) ((EN_MASK >> (k)) & 1u)
#ifndef REP_MASK
#define REP_MASK 0u
#endif
#define REPS(k) (((REP_MASK >> (k)) & 1u) ? 2 : 1)
#ifndef REP_S2
#define REP_S2 1
#define REP_ATT 1
#endif
__global__ void __launch_bounds__(NWAVES * 64, 2) mega_fwd(Args args) {
    extern __shared__ __attribute__((aligned(16))) unsigned char lds_raw[];
    LAS unsigned char* lds = (LAS unsigned char*)lds_raw;
    volatile LAS unsigned* MISC = (volatile LAS unsigned*)(lds + MISC_OFF);
    LAS int* TAB = (LAS int*)(lds + TAB_OFF);
    for (int u = threadIdx.x; u < (LDS_BYTES - LDSCTL_OFF) / 4; u += NWAVES * 64) ((LAS unsigned*)(lds + LDSCTL_OFF))[u] = 0u;
    __syncthreads();
    if ((threadIdx.x & 63) == 0) ((volatile LAS int*)(lds + WAVETAB_OFF))[hw_slot()] = (int)(threadIdx.x >> 6);
    __syncthreads();
    XcdBarrier bar; bar.bar = (unsigned*)(args.ws + WS_CTL) + CW_BAR; bar.x = 0; bar.st = nullptr;
    if (!MK_SPLIT) bar = xcd_barrier_post((unsigned*)(args.ws + WS_CTL) + CW_BAR, MISC + 8);
    const int lo = args.ph_lo, hi = args.ph_hi;
#define IN(k) (lo <= (k) && (k) < hi)
#define SEAM(k) do { if ((k) + 1 < hi) { if (MK_SPLIT) { if (mk_tid() == 0) __hip_atomic_store((gu32*)(args.ws + WS_CTL) + CW_TMO, 0xBADBA0u, RLX_AGENT); } else xcd_barrier(bar); } } while (0)
#define PHASE_VARS \
    const kptr_t kp = kargs(); unsigned char* const ws = KWS(kp); float* const out = KOUT(kp); (void)out; \
    int tid_ = mk_tid(); asm volatile("" : "+v"(tid_)); const int tid = tid_, lane = tid & 63, wave = __builtin_amdgcn_readfirstlane(tid >> 6); (void)lane; (void)wave; \
    int G_ = gridDim.x, bx_ = blockIdx.x; asm volatile("" : "+s"(G_), "+s"(bx_)); const int G = G_, bx = bx_; const int vcu = (G % 8 == 0) ? (bx % 8) * (G / 8) + bx / 8 : bx; const int gw = vcu * NWAVES + wave, NGW = G * NWAVES; (void)gw; (void)NGW; \
    gu32* const ctl = (gu32*)(ws + WS_CTL); (void)ctl
#define LAYER_PTRS(lp) LayerPtrs lp; \
        lp.g_mix = KIN(kp, 2) + L * DM; lp.na_q_gain = KIN(kp, 4) + L * 64; lp.na_k_gain = KIN(kp, 5) + L * 64; lp.na_rel_bias = KIN(kp, 6) + L * 8 * 15 * 31; \
        lp.gla_w_up = KIN(kp, 7) + L * 2 * 16 * 256; lp.gla_b = KIN(kp, 8) + L * 512; lp.gla_norm = KIN(kp, 9) + L * 128; lp.conv_w = KIN(kp, 10) + L * 5 * 1536; \
        lp.a_log = KIN(kp, 11) + L * 8; lp.dt_bias = KIN(kp, 12) + L * 8; lp.gdn_norm = KIN(kp, 13) + L * 128; lp.lb_raw0 = KIN(kp, 14); lp.lb_raw1 = KIN(kp, 14) + 1024; \
        lp.hg_norm = KIN(kp, 15) + L * 128; lp.mem_q_gain = KIN(kp, 18) + L * 128; lp.g_ffn = KIN(kp, 22) + L * DM
#define WSP(T, off) ((T*)(ws + (off)))

    if (EN_PH(31) && IN(0)) for (int rep_ = 0; rep_ < REPS(31); ++rep_) { PHASE_VARS;
        bf16* WIN = WSP(bf16, WS_WIN); bf16* WBR = WSP(bf16, WS_WBR); bf16* WOUT = WSP(bf16, WS_WOUT); bf16* WMKV = WSP(bf16, WS_WMKV);
        bf16* WGU = WSP(bf16, WS_WGU); bf16* WDN = WSP(bf16, WS_WDN); bf16* MOE1 = WSP(bf16, WS_MOE1); bf16* MOE2 = WSP(bf16, WS_MOE2F);
        LAS float* scr = (LAS float*)(lds + RING_OFF + wave * 16384);
        phase0_convert_all(KIN(kp, 3), KIN(kp, 20), KIN(kp, 21), KIN(kp, 17), KIN(kp, 23), KIN(kp, 24), KIN(kp, 25), ws, scr, gw, NGW, lane);
        for (int i = gw * 64 + lane; i < 2 * (LDP - C_PEND) * DM / 8; i += NGW * 64) { const int L = i / ((LDP - C_PEND) * DM / 8), r = i % ((LDP - C_PEND) * DM / 8);
            *(v4u*)(WIN + ((size_t)L * NIN + C_PEND) * DM + (size_t)r * 8) = (v4u){0u, 0u, 0u, 0u}; }
        const float* mem = KIN(kp, 1); bf16* MEMN = WSP(bf16, WS_MEMN);
        for (int row = gw; row < 2 * 1024; row += NGW) { const int L = row >> 10, m = row & 1023; f32x4 v[8]; rms_row(mem + (size_t)m * DM, KIN(kp, 16) + L * DM, MEMN + (size_t)row * DM, lane, v); }
    }

#pragma unroll 1
    for (int L = 0; L < NLAYER; ++L) {
        const int pb = 1 + 16 * L;
        if (EN_PH(0) && IN(pb + 0)) for (int rep_ = 0; rep_ < REPS(0); ++rep_) { PHASE_VARS; const float* xres = L ? (const float*)out : KIN(kp, 0); const float* gm = KIN(kp, 2) + L * DM; bf16* HM = WSP(bf16, WS_HM);
            for (int t = gw; t < NT; t += NGW) { f32x4 v[8]; rms_row(xres + (size_t)t * DM, gm, HM + (size_t)t * DM, lane, v, WSP(unsigned char, WS_H8) + (size_t)t * DM); } }
        SEAM(pb + 0);
        if (EN_PH(1) && IN(pb + 1)) for (int rep_ = 0; rep_ < REPS(1); ++rep_) {
            { PHASE_VARS; pg8::Gemm g{WSP(bf16, WS_HM), WSP(bf16, WS_WIN) + (size_t)L * NIN * DM, NT, LDP, DM}; pg8::StaticOrder S; S.init(NT, LDP, G, bx); pg8::EpiInProj E{WSP(bf16, WS_P), WSP(bf16, WS_G)};
#if defined(PROBE_NULL_EPI)
              if (rep_) { pg8::EpiNull EN; pg8::gemm_phase<pg8::EpiNull, pg8::StaticOrder, true, true>(lds + RING_OFF, g, S, EN); } else
#endif
              { GEMM_STAGGER(); pg8::gemm_phase<pg8::EpiInProj, pg8::StaticOrder, true, true>(lds + RING_OFF, g, S, E); } }
            if (L == 0) { PHASE_VARS; pg8::Gemm g{WSP(bf16, WS_MEMN), WSP(bf16, WS_WMKV), 2048, 2048, DM}; pg8::KvOrder S{bx, G >= 96 ? 64 : 0}; pg8::EpiResF32 E{nullptr, WSP(float, WS_KVRAW), 1024, 4};
              pg8::gemm_phase<pg8::EpiResF32, pg8::KvOrder, false, true>(lds + RING_OFF, g, S, E); }
            { PHASE_VARS; const int f0 = L ? 64 : 96;
              if (FILL_TAIL && G >= 128 && bx >= f0 && rep_ == 0) { LAS float* scr = (LAS float*)(lds + RING_OFF + wave * 16384); const int gwf = (bx - f0) * NWAVES + wave, ngwf = (G - f0) * NWAVES;
#pragma unroll 1
                  for (int e = 3 * L; e < 3 * L + 3; ++e) transpose_job_f8(KIN(kp, 30) + (size_t)e * DFFE * DM, 64.0f, DFFE, DM, WSP(unsigned char, WS_MOE2F) + (size_t)e * DM * DFFE, scr, gwf, ngwf, lane, RmOff{0}); } }
        }
        SEAM(pb + 1);
        if (EN_PH(2) && IN(pb + 2)) { PHASE_VARS; LAYER_PTRS(lp);
            { LAS float* glaw = (LAS float*)(lds + RING_OFF); __syncthreads();
#pragma unroll
              for (int i = 0; i < 4; ++i) { const int e = (i * 512 + tid) * 4; *(LAS f32x4*)(glaw + e) = *(const f32x4*)(lp.gla_w_up + e); }
              __syncthreads(); }
            for (int u = gw; u < NT / 8; u += NGW) prep_unit(L, lp, (const LAS float*)(lds + RING_OFF), WSP(bf16, WS_P), WSP(float, WS_GLG), WSP(bf16, WS_GQ), WSP(float, WS_GAB), WSP(bf16, WS_HQ), WSP(float, WS_HF), WSP(bf16, WS_NAVT), u * 8, lane);
            if (L == 0) { const float* KVRAW = WSP(float, WS_KVRAW); bf16* MK = WSP(bf16, WS_MK); bf16* MVT = WSP(bf16, WS_MVT); const float* mkg = KIN(kp, 19);
                for (int row = gw; row < 2048; row += NGW) {
                    const int LL = row >> 10; const float* kr = KVRAW + (size_t)row * 1024;
                    const f32x4 k0 = *(const f32x4*)(kr + lane * 8), k1 = *(const f32x4*)(kr + lane * 8 + 4);
                    float f[8] = {k0[0], k0[1], k0[2], k0[3], k1[0], k1[1], k1[2], k1[3]}; float ss = 0.f;
#pragma unroll
                    for (int i = 0; i < 8; ++i) ss += f[i] * f[i];
                    ss = group_sum<16>(ss); const float sc = rsqrtf(ss * (1.0f / 128.0f) + RMS_EPS); const float* gn = mkg + LL * 128 + (lane & 15) * 8;
#pragma unroll
                    for (int i = 0; i < 8; ++i) f[i] = f[i] * sc * gn[i];
                    *(v4u*)(MK + (size_t)row * 512 + lane * 8) = pack8(f);
                    const int b = (row >> 8) & 3, m = row & 255; const float* vr = kr + 512;
#pragma unroll
                    for (int i = 0; i < 8; ++i) { const int cidx = lane * 8 + i; const int h = cidx >> 7, d = cidx & 127;
                        MVT[((size_t)((LL * 4 + b) * 4 + h) * 128 + d) * 256 + m] = (bf16)(pkbf(vr[cidx], 0.f) & 0xffffu); }
                }
            }
        }
        SEAM(pb + 2);
        if (EN_PH(13) && IN(pb + 13)) for (int rep_ = 0; rep_ < REPS(13); ++rep_) { PHASE_VARS;
            LAS unsigned char* scr = lds + RING_OFF + wave * 16384; unsigned char* oa = ws + WS_OA; bf16* P = WSP(bf16, WS_P);
#pragma unroll 1
            for (int u = gw; u < 3 * 8192; u += NGW) { const int br = u >> 13, cu = u & 8191, seq = cu >> 8, n = cu & 255, b = seq >> 3, h = (seq >> 1) & 3, dir = seq & 1; const size_t r0 = (size_t)b << 12;
                if (br == 0) s1_gdn(scr, WSP(bf16, WS_GQ) + r0 * 1536, WSP(float, WS_GAB) + r0 * 16 + dir * 4 + h, h, dir, n, (bf16*)(oa + OA_GW) + (size_t)cu * 2048, (bf16*)(oa + OA_GU) + (size_t)cu * 2048,
                                    (bf16*)(oa + OA_GKT) + (size_t)cu * 2048, (bf16*)(oa + OA_GP) + (size_t)cu * 256, (float*)(oa + OA_GS) + (size_t)cu * 64, lane);
                else if (br == 1) { DiagSrc S{WSP(bf16, WS_HQ) + r0 * 512 + h * 128, 512, nullptr, 0, WSP(float, WS_HF) + r0 * 1024 + dir * 512 + h * 128, 1024, nullptr, 0};
                    s1_diag<128, 1>(scr, S, dir, n, (bf16*)(oa + OA_HQD) + (size_t)cu * 2048, (bf16*)(oa + OA_HKDT) + (size_t)cu * 2048, (bf16*)(oa + OA_HP) + (size_t)cu * 256, (float*)(oa + OA_HV) + (size_t)cu * 128, lane); }
                else { DiagSrc S{P + r0 * LDP + C_GLQ + h * 64, LDP, P + r0 * LDP + C_GLK + h * 64, LDP, WSP(float, WS_GLG) + r0 * 512 + dir * 256 + h * 64, 512, nullptr, 0};
                    s1_diag<64, 0>(scr, S, dir, n, (bf16*)(oa + OA_LQD) + (size_t)cu * 1024, (bf16*)(oa + OA_LKDT) + (size_t)cu * 1024, (bf16*)(oa + OA_LP) + (size_t)cu * 256, (float*)(oa + OA_LV) + (size_t)cu * 64, lane); }
            }
        }
        SEAM(pb + 13);
        if (EN_PH(3) && IN(pb + 3)) for (int rep_ = 0; rep_ < REPS(3); ++rep_) { PHASE_VARS;
            gu32* wq = ctl + CW_WQ + 64 * (L + 2 * rep_); gu32* gq = ctl + CW_GQ + 64 * 8 * (L + 2 * rep_);
            bf16* P = WSP(bf16, WS_P); bf16* SOUT = WSP(bf16, WS_SOUT); bf16* BR = WSP(bf16, WS_BR); unsigned char* oa = ws + WS_OA;
            if (!rep_ || REP_S2) {
#pragma unroll 1
                for (int seq = bx; seq < 32; seq += G) { const int b = seq >> 3, h = (seq >> 1) & 3, dir = seq & 1; const size_t r0 = (size_t)b << 12, c0 = (size_t)seq * 256;
                    s2_gdn(lds + RING_OFF, (const bf16*)(oa + OA_GW) + c0 * 2048, (const bf16*)(oa + OA_GU) + c0 * 2048, (const bf16*)(oa + OA_GKT) + c0 * 2048, (const bf16*)(oa + OA_GP) + c0 * 256, (const float*)(oa + OA_GS) + c0 * 64,
                           WSP(bf16, WS_GQ) + r0 * 1536 + h * 128, SOUT + ((size_t)(1 * 2 + dir) * NT + r0) * 512 + h * 128, dir, wave, lane, tid); }
#pragma unroll 1
                for (int i2 = bx; i2 < 64; i2 += G) if (i2 >= 32) { const int seq = i2 - 32, b = seq >> 3, h = (seq >> 1) & 3, dir = seq & 1; const size_t r0 = (size_t)b << 12, c0 = (size_t)seq * 256;
                    s2_diag<128>(lds + RING_OFF, (const bf16*)(oa + OA_HQD) + c0 * 2048, (const bf16*)(oa + OA_HKDT) + c0 * 2048, (const bf16*)(oa + OA_HP) + c0 * 256, (const float*)(oa + OA_HV) + c0 * 128,
                                 P + r0 * LDP + C_HGI + h * 128, LDP, SOUT + ((size_t)(2 * 2 + dir) * NT + r0) * 512 + h * 128, 512, dir, wave, lane, tid); }
#pragma unroll 1
                for (int i2 = bx; i2 < 96; i2 += G) if (i2 >= 64) { const int seq = i2 - 64, b = seq >> 3, h = (seq >> 1) & 3, dir = seq & 1; const size_t r0 = (size_t)b << 12, c0 = (size_t)seq * 256;
                    s2_diag<64>(lds + RING_OFF, (const bf16*)(oa + OA_LQD) + c0 * 1024, (const bf16*)(oa + OA_LKDT) + c0 * 1024, (const bf16*)(oa + OA_LP) + c0 * 256, (const float*)(oa + OA_LV) + c0 * 64,
                                P + r0 * LDP + C_GLV + h * 128, LDP, SOUT + ((size_t)(0 * 2 + dir) * NT + r0) * 512 + h * 128, 512, dir, wave, lane, tid); }
            }
            if (bx < 96 && rep_ == 0) { __syncthreads(); if (tid == 0) __hip_atomic_fetch_add(ctl + CW_S2DONE + 64 * L, 1u, RLX_AGENT); }
            if (!rep_ || REP_ATT) {
            bool gates_left = true;
            for (;;) {
                __syncthreads();
                if (tid == 0) { unsigned v = 0xffffffffu;
                    if (gates_left) for (int k8 = 0; k8 < 8; ++k8) { const int x = (bx + k8) & 7; const unsigned b0 = __hip_atomic_fetch_add(gq + 64 * x, 1u, RLX_AGENT); if (b0 < (unsigned)(320 / GATE_BATCH)) { v = (unsigned)x * 4096u + b0; break; } }
                    MISC[17] = v; if (v == 0xffffffffu) MISC[16] = __hip_atomic_fetch_add(wq, 1u, RLX_AGENT); }
                __syncthreads();
                const unsigned gsel = MISC[17];
                if (gsel != 0xffffffffu) {
                    const unsigned char* g8b = (const unsigned char*)(WSP(bf16, WS_WIN) + ((size_t)L * NIN + LDP) * DM) - (size_t)33 * 256 * DM;
                    pg8::Gemm g8{WSP(bf16, WS_H8), (const bf16*)g8b, NT, NIN, DM / 2}; pg8::GateBatchOrder S8{(int)(gsel >> 12), (int)(gsel & 4095u) * GATE_BATCH, GATE_BATCH}; pg8::EpiInProj E8{WSP(bf16, WS_P), WSP(bf16, WS_G)};
                    pg8::gemm_phase_f8<pg8::EpiInProj, pg8::GateBatchOrder, true, F8_SP2>(lds + RING_OFF, g8, S8, E8);
                    continue; }
                gates_left = false;
                int it = (int)MISC[16];
                if (it >= 768) break;
                int lane_ = lane, tid_q = tid; asm volatile("" : "+v"(lane_), "+v"(tid_q));
                if (it < 512) {
                    const int b = it >> 7, h = (it >> 4) & 7, rq = it & 15;
                    na_wave_unit(P, WSP(bf16, WS_NAVT), KIN(kp, 6) + L * 8 * 15 * 31, BR, b, h, 4 * rq + (wave >> 2), wave & 3, lane_);
                    na_wave_unit(P, WSP(bf16, WS_NAVT), KIN(kp, 6) + L * 8 * 15 * 31, BR, b, h, 4 * rq + 2 + (wave >> 2), wave & 3, lane_);
                } else {
                    const int i2 = it - 512, tb = i2 >> 2, h = i2 & 3;
                    mem_wg_unit(lds + RING_OFF, P, WSP(bf16, WS_MK) + (size_t)L * 1024 * 512, WSP(bf16, WS_MVT) + (size_t)L * 4 * 4 * 128 * 256, BR + (size_t)4 * NT * 512, tb * 256, h, wave, lane_, tid_q);
                }
            }
            }
            if (FILL_TAIL && G >= 128 && rep_ == 0 && bx >= 144) { LAS float* scr = (LAS float*)(lds + RING_OFF + wave * 16384);
                moe_drain(KIN(kp, 28), KIN(kp, 29), KIN(kp, 30), ws, ctl + CW_CONVQ, ctl + CW_S2DONE + 64 * L, 96u, MISC + 20, scr, wave, lane, tid); }
        }
        SEAM(pb + 3);
        if (EN_PH(4) && IN(pb + 4)) for (int rep_ = 0; rep_ < REPS(4); ++rep_) { PHASE_VARS; LAYER_PTRS(lp); for (int t = gw; t < NT; t += NGW) post_token(lp, WSP(bf16, WS_P), WSP(bf16, WS_SOUT), WSP(bf16, WS_BR), t, lane);
            if (L == 1 && rep_ == 0) {
                bf16* MOE1 = WSP(bf16, WS_MOE1); bf16* MOE2 = WSP(bf16, WS_MOE2F); LAS float* scr = (LAS float*)(lds + RING_OFF + wave * 16384);
                if (FILL_TAIL && G >= 128) moe_drain(KIN(kp, 28), KIN(kp, 29), KIN(kp, 30), ws, ctl + CW_CONVQ, nullptr, 0u, MISC + 20, scr, wave, lane, tid);
                else { moe1_convert_all(KIN(kp, 28), KIN(kp, 29), (unsigned char*)MOE1, scr, gw, NGW, lane);
#pragma unroll 1
                    for (int e = 0; e < NEXP; ++e) transpose_job_f8(KIN(kp, 30) + (size_t)e * DFFE * DM, 64.0f, DFFE, DM, (unsigned char*)MOE2 + (size_t)e * DM * DFFE, scr, gw, NGW, lane, RmOff{0}); }
            }
        }
        SEAM(pb + 4);
        if (EN_PH(5) && IN(pb + 5)) { PHASE_VARS; pg8::Gemm g{WSP(bf16, WS_BR), WSP(bf16, WS_WBR) + (size_t)L * 5 * DM * 512, 5 * NT, 5 * DM, 512}; pg8::BranchOrder5 S{G, bx}; pg8::EpiBranchAcc E{WSP(bf16, WS_G), WSP(bf16, WS_HM)};
            pg8::gemm_phase<pg8::EpiBranchAcc, pg8::BranchOrder5, true, true>(lds + RING_OFF, g, S, E); }
        SEAM(pb + 5);
        if (EN_PH(7) && IN(pb + 7)) { PHASE_VARS; const float* xres = L ? (const float*)out : KIN(kp, 0);
            pg8::Gemm g{WSP(bf16, WS_HM), WSP(bf16, WS_WOUT) + (size_t)L * DM * DM, NT, DM, DM}; pg8::StaticOrder S; S.init(NT, DM, G, bx); pg8::EpiResF32 E{xres, out, DM, 1 << 20};
            pg8::gemm_phase<pg8::EpiResF32, pg8::StaticOrder, true, true>(lds + RING_OFF, g, S, E); }
        SEAM(pb + 7);
        if (L == 0) {
            if (EN_PH(8) && IN(pb + 8)) for (int rep_ = 0; rep_ < REPS(8); ++rep_) { PHASE_VARS; const float* gf = KIN(kp, 22) + L * DM; bf16* HM = WSP(bf16, WS_HM);
                for (int t = gw; t < NT; t += NGW) { f32x4 v[8]; rms_row(out + (size_t)t * DM, gf, HM + (size_t)t * DM, lane, v); } }
            SEAM(pb + 8);
            if (EN_PH(9) && IN(pb + 9)) for (int rep_ = 0; rep_ < REPS(9); ++rep_) { PHASE_VARS; pg8::Gemm g{WSP(bf16, WS_HM), WSP(bf16, WS_WGU), NT, 2 * DFF, DM}; pg8::StaticOrder S; S.init(NT, 2 * DFF, G, bx); pg8::EpiSwiGLU E{WSP(bf16, WS_HID), DFF, 1 << 20};
                GEMM_STAGGER(); pg8::gemm_phase<pg8::EpiSwiGLU, pg8::StaticOrder, true, true>(lds + RING_OFF, g, S, E); }
            SEAM(pb + 9);
            if (EN_PH(10) && IN(pb + 10)) { PHASE_VARS; pg8::Gemm g{WSP(bf16, WS_HID), WSP(bf16, WS_WDN), NT, DM, DFF}; pg8::StaticOrder S; S.init(NT, DM, G, bx); pg8::EpiResF32 E{out, out, DM, 1 << 20};
                pg8::gemm_phase<pg8::EpiResF32, pg8::StaticOrder, true, true>(lds + RING_OFF, g, S, E); }
            SEAM(pb + 10);
        } else {
            if (EN_PH(8) && IN(pb + 8)) { PHASE_VARS; gu32* cnt = ctl + CW_CNT; unsigned* ROUTE = WSP(unsigned, WS_ROUTE); bf16* HM = WSP(bf16, WS_HM);
                const float* wr = KIN(kp, 26); const float* brt = KIN(kp, 27); const float* gf = KIN(kp, 22) + L * DM;
                LAS unsigned* lcnt = (LAS unsigned*)(lds + RING_OFF); LAS unsigned* gbase = lcnt + 8;
                for (int blk = bx; blk < NT / 64; blk += G) {
                    __syncthreads(); if (tid < 8) lcnt[tid] = 0u; __syncthreads();
                    unsigned re0 = 0, re1 = 0, rp0 = 0, rp1 = 0; float rw0 = 0.f, rw1 = 0.f;
#pragma unroll 1
                    for (int tt = 0; tt < 8; ++tt) { const int t = blk * 64 + wave * 8 + tt; f32x4 v[8]; rms_row_f8(out + (size_t)t * DM, gf, (unsigned char*)HM + (size_t)t * DM, lane, v);
                        float lg[8];
#pragma unroll
                        for (int e = 0; e < 8; ++e) lg[e] = 0.f;
#pragma unroll
                        for (int j = 0; j < 8; ++j)
#pragma unroll
                            for (int q = 0; q < 4; ++q) { const float* wp = wr + (size_t)(4 * (lane + 64 * j) + q) * 8; const f32x4 w0 = *(const f32x4*)wp, w1 = *(const f32x4*)(wp + 4); const float hv = v[j][q];
                                lg[0] += hv * w0[0]; lg[1] += hv * w0[1]; lg[2] += hv * w0[2]; lg[3] += hv * w0[3]; lg[4] += hv * w1[0]; lg[5] += hv * w1[1]; lg[6] += hv * w1[2]; lg[7] += hv * w1[3]; }
#pragma unroll
                        for (int e = 0; e < 8; ++e) lg[e] = wave_sum(lg[e]) + brt[e];
                        int e0 = 0; float m0 = lg[0];
#pragma unroll
                        for (int e = 1; e < 8; ++e) if (lg[e] > m0) { m0 = lg[e]; e0 = e; }
                        int e1 = 0; float m1 = -3.0e38f;
#pragma unroll
                        for (int e = 0; e < 8; ++e) if (e != e0 && lg[e] > m1) { m1 = lg[e]; e1 = e; }
                        const float w0 = 1.0f / (1.0f + __expf(m1 - m0));
                        if (lane == tt) { re0 = e0; re1 = e1; rw0 = w0; rw1 = 1.0f - w0;
                            rp0 = __hip_atomic_fetch_add(&lcnt[e0], 1u, __ATOMIC_RELAXED, __HIP_MEMORY_SCOPE_WORKGROUP); rp1 = __hip_atomic_fetch_add(&lcnt[e1], 1u, __ATOMIC_RELAXED, __HIP_MEMORY_SCOPE_WORKGROUP); }
                    }
                    __syncthreads();
                    if (tid < 8) gbase[tid] = __hip_atomic_fetch_add(cnt + 64 * tid, lcnt[tid], RLX_AGENT);
                    __syncthreads();
                    if (lane < 8) { const int t = blk * 64 + wave * 8 + lane; unsigned* rr = ROUTE + (size_t)t * 8;
                        rr[0] = re0; rr[1] = re1; rr[2] = gbase[re0] + rp0; rr[3] = gbase[re1] + rp1; rr[4] = __float_as_uint(rw0); rr[5] = __float_as_uint(rw1); }
                }
            }
            SEAM(pb + 8);
            if (hi > pb + 9) { PHASE_VARS; gu32* cnt = ctl + CW_CNT;
                __syncthreads();
                if (tid == 0) { int acc = 0; for (int e = 0; e < 8; ++e) { const int c = (int)__hip_atomic_load(cnt + 64 * e, RLX_AGENT); const int nb = (c + 255) >> 8; TAB[e] = nb; TAB[8 + e] = acc; TAB[32 + e] = acc * 256; acc += nb; } TAB[40] = acc; }
                __syncthreads();
            }
            if (EN_PH(9) && IN(pb + 9)) for (int rep_ = 0; rep_ < REPS(9); ++rep_) { PHASE_VARS; bf16* XB = WSP(bf16, WS_XB); unsigned* ROUTE = WSP(unsigned, WS_ROUTE); const bf16* HM = WSP(bf16, WS_HM);
                for (int t = gw; t < NT; t += NGW) { unsigned* rr = ROUTE + (size_t)t * 8; const unsigned e0 = rr[0], e1 = rr[1]; const unsigned s0 = (unsigned)TAB[32 + e0] + rr[2], s1 = (unsigned)TAB[32 + e1] + rr[3];
                    if (lane == 0) { rr[6] = s0; rr[7] = s1; }
                    const v4u* src = (const v4u*)((const unsigned char*)HM + (size_t)t * DM) + lane; v4u* d0 = (v4u*)((unsigned char*)XB + (size_t)s0 * DM) + lane; v4u* d1 = (v4u*)((unsigned char*)XB + (size_t)s1 * DM) + lane;
#pragma unroll
                    for (int j = 0; j < 2; ++j) { const v4u x = src[64 * j]; d0[64 * j] = x; d1[64 * j] = x; } } }
            SEAM(pb + 9);
            if (EN_PH(10) && IN(pb + 10)) for (int rep_ = 0; rep_ < REPS(20); ++rep_) { PHASE_VARS; __syncthreads(); if (tid == 0) { for (int e = 0; e <= 8; ++e) TAB[16 + e] = (e < 8 ? TAB[8 + e] : TAB[40]) * 56; } __syncthreads();
                pg8::Gemm g{WSP(bf16, WS_XB), WSP(bf16, WS_MOE1), MAXSLOT, 8 * 2 * DFFE, DM / 2}; pg8::MoeOrder S{G, bx, 56, TAB[40] * 56, TAB}; pg8::EpiSwiGLU8 E{WSP(unsigned char, WS_HIDM), DFFE, 56};
                GEMM_STAGGER(); pg8::gemm_phase_f8<pg8::EpiSwiGLU8, pg8::MoeOrder, true, F8_SP2>(lds + RING_OFF, g, S, E); }
            SEAM(pb + 10);
            if (EN_PH(11) && IN(pb + 11)) for (int rep_ = 0; rep_ < REPS(11); ++rep_) { PHASE_VARS; __syncthreads(); if (tid == 0) { for (int e = 0; e <= 8; ++e) TAB[16 + e] = (e < 8 ? TAB[8 + e] : TAB[40]) * 8; } __syncthreads();
                pg8::Gemm g{WSP(bf16, WS_HIDM), WSP(bf16, WS_MOE2F), MAXSLOT, 8 * DM, DFFE / 2}; pg8::MoeOrder S{G, bx, 8, TAB[40] * 8, TAB}; pg8::EpiBf16Out E{WSP(bf16, WS_YB), DM, 8};
                GEMM_STAGGER(); pg8::gemm_phase_f8<pg8::EpiBf16Out, pg8::MoeOrder, true, F8_SP2>(lds + RING_OFF, g, S, E); }
            SEAM(pb + 11);
            if (EN_PH(12) && IN(pb + 12)) { PHASE_VARS; const bf16* YB = WSP(bf16, WS_YB); const unsigned* ROUTE = WSP(unsigned, WS_ROUTE);
                for (int t = gw; t < NT; t += NGW) { const unsigned* rr = ROUTE + (size_t)t * 8; const float w0 = __uint_as_float(rr[4]), w1 = __uint_as_float(rr[5]); const size_t s0 = rr[6], s1 = rr[7];
                    f32x4* o = (f32x4*)(out + (size_t)t * DM) + lane; const v2u* y0 = (const v2u*)(YB + s0 * DM) + lane; const v2u* y1 = (const v2u*)(YB + s1 * DM) + lane;
#pragma unroll
                    for (int j = 0; j < 8; ++j) { const v2u a = y0[64 * j], b = y1[64 * j];
                        o[64 * j] = o[64 * j] + w0 * (f32x4){bflo(a.x), bfhi(a.x), bflo(a.y), bfhi(a.y)} + w1 * (f32x4){bflo(b.x), bfhi(b.x), bflo(b.y), bfhi(b.y)}; } } }
        }
    }
#undef IN
#undef SEAM
}
extern "C" void kernel_launch(void* const* d_in, const int* in_sizes, int n_in, void* d_out, int out_size, void* d_ws, size_t ws_size, hipStream_t stream) {
    static int grid = 0;
    if (grid == 0) {
        if (n_in != 31 || in_sizes[0] != NT * DM || out_size != NT * DM || ws_size < WS_END) { fprintf(stderr, "kernel_launch: unexpected shapes (n_in %d, in0 %d, out %d, ws %zu < %zu); nothing launched\n", n_in, n_in > 0 ? in_sizes[0] : -1, out_size, ws_size, (size_t)WS_END); grid = -1; return; }
        int dev = 0, cus = 0, per_cu = 0;
        if (hipGetDevice(&dev) != hipSuccess || hipDeviceGetAttribute(&cus, hipDeviceAttributeMultiprocessorCount, dev) != hipSuccess) { grid = -1; return; }
        if (hipFuncSetAttribute((const void*)mega_fwd, hipFuncAttributeMaxDynamicSharedMemorySize, LDS_BYTES) != hipSuccess) { fprintf(stderr, "kernel_launch: hipFuncSetAttribute failed\n"); grid = -1; return; }
        if (hipOccupancyMaxActiveBlocksPerMultiprocessor(&per_cu, (const void*)mega_fwd, NWAVES * 64, LDS_BYTES) != hipSuccess || per_cu < 1) fprintf(stderr, "kernel_launch: occupancy query reports %d\n", per_cu);
        (void)hipGetLastError();
        grid = cus;
    }
    if (grid < 0) return;
    if (hipMemsetAsync((char*)d_ws + WS_CTL, 0, CTL_ZERO_BYTES, stream) != hipSuccess) return;
    Args a{};
    for (int i = 0; i < 31; ++i) a.in[i] = (const float*)d_in[i];
    a.out = (float*)d_out; a.ws = (unsigned char*)d_ws;
#if MK_SPLIT
    int ids[40]; int n = 0; ids[n++] = 0;
    for (int L = 0; L < 2; ++L) for (int k = 0; k < (L ? 13 : 11); ++k) { ids[n++] = 1 + 16 * L + k; if (k == 2) ids[n++] = 1 + 16 * L + 13; }
    for (int i = 0; i < n; ++i) { a.ph_lo = ids[i]; a.ph_hi = ids[i] + 1; hipLaunchKernelGGL(mega_fwd, dim3(grid), dim3(NWAVES * 64), LDS_BYTES, stream, a); }
#else
    a.ph_lo = 0; a.ph_hi = 64;
    hipLaunchKernelGGL(mega_fwd, dim3(grid), dim3(NWAVES * 64), LDS_BYTES, stream, a);
#endif
    const hipError_t le = hipPeekAtLastError();
    if (le != hipSuccess) fprintf(stderr, "kernel_launch: launch failed: %s\n", hipGetErrorName(le));
}
```

```cpp
#include <hip/hip_runtime.h>
#include <cstdio>
#include <cstdint>
__device__ __forceinline__ int pg8_tid();
namespace pg8 {
#define PG8_LAS __attribute__((address_space(3)))
typedef unsigned short bf16_t;
typedef short bf16x8 __attribute__((ext_vector_type(8)));
typedef float f32x4 __attribute__((ext_vector_type(4)));
typedef unsigned u32x4 __attribute__((ext_vector_type(4)));
constexpr int BM = 256, BK = 64, HALF = 128, HTB = HALF * BK * 2  , STAGE_BYTES = 8 * HTB, NXCD = 8, WGM = 8;

__host__ __device__ __forceinline__ int lds_byte(int r, int c) { const int st = (r >> 4) * 2 + (c >> 5), rr = r & 15, cc = c & 31, ob = rr * 64 + cc * 2; return st * 1024 + (ob ^ (((ob >> 9) & 1) << 5)); }
__host__ __device__ __forceinline__ void stage_rc(int b, int& R, int& C) { const int st = b / 1024, sb = b % 1024, swz = sb ^ (((sb >> 9) & 1) << 5); R = (st >> 1) * 16 + swz / 64; C = (st & 1) * 32 + (swz % 64) / 2; }
__host__ __device__ __forceinline__ int perm32(int rho) { const int n = rho >> 4, i = rho & 15; return 8 * (i >> 2) + 4 * n + (i & 3); }

struct Unit { int pm, pn; };
struct Gemm { const bf16_t* A; const bf16_t* Bt; int M, N, K; };

struct StaticOrder {
    int nM, nN, nwg, G, c;
    __host__ __device__ void init(int M, int N, int G_, int c_) { nM = M / BM; nN = N / BM; nwg = nM * nN; G = G_; c = c_; }
    __host__ __device__ bool next(int i, Unit& u) const {
        const long L = (long)i * G + c; if (L >= nwg) return false;
        int wgid = (int)L; { const int q = nwg / NXCD, r = nwg % NXCD, xcd = wgid % NXCD, off = wgid / NXCD; wgid = (xcd < r ? xcd * (q + 1) : r * (q + 1) + (xcd - r) * q) + off; }
        const int nig = WGM * nN, gid = wgid / nig, fm = gid * WGM, gsz = (nM - fm) < WGM ? (nM - fm) : WGM;
        u.pm = fm + ((wgid % nig) % gsz); u.pn = (wgid % nig) / gsz; return true;
    }
    __device__ __forceinline__ void a_ready(const Unit&) const {}
    __device__ __forceinline__ void done(const Unit&) const {}
};
__device__ __forceinline__ unsigned cvt_pk_bf16(float lo, float hi) { unsigned r; asm volatile("v_cvt_pk_bf16_f32 %0, %1, %2" : "=v"(r) : "v"(lo), "v"(hi)); return r; }
typedef float f32x2 __attribute__((ext_vector_type(2)));
__device__ __forceinline__ float sigm(float x) { return __builtin_amdgcn_rcpf(1.0f + __expf(-x)); }
struct EpiInProj {
    static constexpr bool PERM = true, AFTER_DRAIN = false, CARRY = false;
    bf16_t* P; bf16_t* G;
    __device__ __forceinline__ void operator()(const f32x4 (&acc)[2][2][4][2], const Unit& u, int wr, int wc, int fr, int fq) const {
        const int row0 = u.pm * BM + wr * 64 + fr; const bool isg = u.pn >= 33;
#if defined(SKIP_G)
        if (isg) return;
#endif
        bf16_t* base = isg ? G : P; const int ldc = isg ? 10240 : 8448; const int col0 = (isg ? (u.pn - 33) : u.pn) * BM + wc * 32 + 8 * fq;
#pragma unroll
        for (int ai = 0; ai < 2; ++ai)
#pragma unroll
            for (int m = 0; m < 4; ++m) { bf16_t* rowp = base + (size_t)(row0 + ai * HALF + m * 16) * ldc + col0;
#pragma unroll
                for (int bj = 0; bj < 2; ++bj) { f32x4 v0 = acc[ai][bj][m][0], v1 = acc[ai][bj][m][1];
                    if (isg) {
                        unsigned lo = 0u, hi = 0u;
#pragma unroll
                        for (int j = 0; j < 4; ++j) { lo = __builtin_amdgcn_cvt_pk_u8_f32(sigm(v0[j]) * 255.0f, j, lo); hi = __builtin_amdgcn_cvt_pk_u8_f32(sigm(v1[j]) * 255.0f, j, hi); }
                        typedef unsigned u32x2 __attribute__((ext_vector_type(2)));
                        *(u32x2*)((unsigned char*)G + (size_t)(row0 + ai * HALF + m * 16) * 10240 + col0 + bj * HALF) = (u32x2){lo, hi};
                    } else {
                    u32x4 w; w.x = cvt_pk_bf16(v0[0], v0[1]); w.y = cvt_pk_bf16(v0[2], v0[3]); w.z = cvt_pk_bf16(v1[0], v1[1]); w.w = cvt_pk_bf16(v1[2], v1[3]);
                    *(u32x4*)(rowp + bj * HALF) = w; } } }
    }
};
struct EpiGate {
    static constexpr bool PERM = true, AFTER_DRAIN = false, CARRY = false;
    bf16_t* G;
    __device__ __forceinline__ void operator()(const f32x4 (&acc)[2][2][4][2], const Unit& u, int wr, int wc, int fr, int fq) const {
        const int row0 = u.pm * BM + wr * 64 + fr, col0 = u.pn * BM + wc * 32 + 8 * fq;
#pragma unroll
        for (int ai = 0; ai < 2; ++ai)
#pragma unroll
            for (int m = 0; m < 4; ++m) { bf16_t* rowp = G + (size_t)(row0 + ai * HALF + m * 16) * 10240 + col0;
#pragma unroll
                for (int bj = 0; bj < 2; ++bj) { f32x4 v0 = acc[ai][bj][m][0], v1 = acc[ai][bj][m][1];
#pragma unroll
                    for (int j = 0; j < 4; ++j) { v0[j] = sigm(v0[j]); v1[j] = sigm(v1[j]); }
                    u32x4 w; w.x = cvt_pk_bf16(v0[0], v0[1]); w.y = cvt_pk_bf16(v0[2], v0[3]); w.z = cvt_pk_bf16(v1[0], v1[1]); w.w = cvt_pk_bf16(v1[2], v1[3]);
                    *(u32x4*)(rowp + bj * HALF) = w; } }
    }
};
struct EpiBranch {
    static constexpr bool PERM = true, AFTER_DRAIN = false, CARRY = false;
    bf16_t* G;
    __device__ __forceinline__ void operator()(const f32x4 (&acc)[2][2][4][2], const Unit& u, int wr, int wc, int fr, int fq) const {
        const int n = u.pn >> 3, j = u.pn & 7; const int row0 = (u.pm & 63) * BM + wr * 64 + fr, col0 = n * 2048 + j * BM + wc * 32 + 8 * fq;
#pragma unroll
        for (int ai = 0; ai < 2; ++ai)
#pragma unroll
            for (int m = 0; m < 4; ++m) { bf16_t* rowp = G + (size_t)(row0 + ai * HALF + m * 16) * 10240 + col0;
#pragma unroll
                for (int bj = 0; bj < 2; ++bj) { const u32x4 g = *(const u32x4*)(rowp + bj * HALF); const f32x4 v0 = acc[ai][bj][m][0], v1 = acc[ai][bj][m][1];
                    u32x4 w;
                    w.x = cvt_pk_bf16(v0[0] * __uint_as_float(g.x << 16), v0[1] * __uint_as_float(g.x & 0xffff0000u));
                    w.y = cvt_pk_bf16(v0[2] * __uint_as_float(g.y << 16), v0[3] * __uint_as_float(g.y & 0xffff0000u));
                    w.z = cvt_pk_bf16(v1[0] * __uint_as_float(g.z << 16), v1[1] * __uint_as_float(g.z & 0xffff0000u));
                    w.w = cvt_pk_bf16(v1[2] * __uint_as_float(g.w << 16), v1[3] * __uint_as_float(g.w & 0xffff0000u));
                    *(u32x4*)(rowp + bj * HALF) = w; } }
    }
};
struct EpiBranchAcc {
    static constexpr bool PERM = true, AFTER_DRAIN = false, CARRY = false;
    const bf16_t* G; bf16_t* Mg;
    __device__ __forceinline__ void operator()(const f32x4 (&acc)[2][2][4][2], const Unit& u, int wr, int wc, int fr, int fq) const {
        typedef unsigned u32x2 __attribute__((ext_vector_type(2)));
        const int n = u.pn >> 3, j = u.pn & 7; const int row0 = (u.pm & 63) * BM + wr * 64 + fr, gcol0 = n * 2048 + j * BM + wc * 32 + 8 * fq, mcol0 = j * BM + wc * 32 + 8 * fq;
#pragma unroll
        for (int ai = 0; ai < 2; ++ai) { u32x2 gg[4][2]; u32x4 ov[4][2];
#pragma unroll
            for (int m = 0; m < 4; ++m) { const unsigned char* gp = (const unsigned char*)G + (size_t)(row0 + ai * HALF + m * 16) * 10240 + gcol0; const bf16_t* mp = Mg + (size_t)(row0 + ai * HALF + m * 16) * 2048 + mcol0;
#pragma unroll
                for (int bj = 0; bj < 2; ++bj) { gg[m][bj] = *(const u32x2*)(gp + bj * HALF);
                    if (n) ov[m][bj] = *(const u32x4*)(mp + bj * HALF); } }
#pragma unroll
            for (int m = 0; m < 4; ++m) { bf16_t* mp = Mg + (size_t)(row0 + ai * HALF + m * 16) * 2048 + mcol0;
#pragma unroll
                for (int bj = 0; bj < 2; ++bj) { const u32x2 g = gg[m][bj]; const f32x4 v0 = acc[ai][bj][m][0] * (1.0f / 255.0f), v1 = acc[ai][bj][m][1] * (1.0f / 255.0f);
                    float z[8] = {v0[0] * (float)(g.x & 0xffu), v0[1] * (float)((g.x >> 8) & 0xffu), v0[2] * (float)((g.x >> 16) & 0xffu), v0[3] * (float)(g.x >> 24),
                                  v1[0] * (float)(g.y & 0xffu), v1[1] * (float)((g.y >> 8) & 0xffu), v1[2] * (float)((g.y >> 16) & 0xffu), v1[3] * (float)(g.y >> 24)};
                    if (n) { const unsigned w0 = ov[m][bj].x, w1 = ov[m][bj].y, w2 = ov[m][bj].z, w3 = ov[m][bj].w;
                        z[0] += __uint_as_float(w0 << 16); z[1] += __uint_as_float(w0 & 0xffff0000u); z[2] += __uint_as_float(w1 << 16); z[3] += __uint_as_float(w1 & 0xffff0000u);
                        z[4] += __uint_as_float(w2 << 16); z[5] += __uint_as_float(w2 & 0xffff0000u); z[6] += __uint_as_float(w3 << 16); z[7] += __uint_as_float(w3 & 0xffff0000u); }
                    u32x4 w; w.x = cvt_pk_bf16(z[0], z[1]); w.y = cvt_pk_bf16(z[2], z[3]); w.z = cvt_pk_bf16(z[4], z[5]); w.w = cvt_pk_bf16(z[6], z[7]);
                    *(u32x4*)(mp + bj * HALF) = w; } }
            asm volatile("" ::: "memory"); }
    }
};
struct EpiResF32 {
    static constexpr bool PERM = false, AFTER_DRAIN = false, CARRY = false;
    const float* R; float* O; int ldc; int ntn;
    __device__ __forceinline__ void operator()(const f32x4 (&acc)[2][2][4][2], const Unit& u, int wr, int wc, int fr, int fq) const {
        const int row0 = u.pm * BM + wr * 64 + fr, col0 = (u.pn % ntn) * BM + wc * 32 + 4 * fq;
#pragma unroll
        for (int ai = 0; ai < 2; ++ai) { f32x4 r[4][2][2];
            if (R) {
#pragma unroll
                for (int m = 0; m < 4; ++m) { const size_t off = (size_t)(row0 + ai * HALF + m * 16) * ldc + col0;
#pragma unroll
                    for (int bj = 0; bj < 2; ++bj)
#pragma unroll
                        for (int n = 0; n < 2; ++n) r[m][bj][n] = *(const f32x4*)(R + off + bj * HALF + n * 16); } }
#pragma unroll
            for (int m = 0; m < 4; ++m) { const size_t off = (size_t)(row0 + ai * HALF + m * 16) * ldc + col0;
#pragma unroll
                for (int bj = 0; bj < 2; ++bj)
#pragma unroll
                    for (int n = 0; n < 2; ++n) { f32x4 o = acc[ai][bj][m][n]; if (R) o = o + r[m][bj][n]; *(f32x4*)(O + off + bj * HALF + n * 16) = o; } }
            asm volatile("" ::: "memory"); }
    }
};
struct EpiBf16Out {
    static constexpr bool PERM = false, AFTER_DRAIN = false, CARRY = false;
    bf16_t* O; int ldc; int ntn;
    __device__ __forceinline__ void operator()(const f32x4 (&acc)[2][2][4][2], const Unit& u, int wr, int wc, int fr, int fq) const {
        typedef unsigned u32x2 __attribute__((ext_vector_type(2)));
        const int row0 = u.pm * BM + wr * 64 + fr, col0 = (u.pn % ntn) * BM + wc * 32 + 4 * fq;
#pragma unroll
        for (int ai = 0; ai < 2; ++ai)
#pragma unroll
            for (int m = 0; m < 4; ++m) { bf16_t* rowp = O + (size_t)(row0 + ai * HALF + m * 16) * ldc + col0;
#pragma unroll
                for (int bj = 0; bj < 2; ++bj)
#pragma unroll
                    for (int n = 0; n < 2; ++n) { const f32x4 v = acc[ai][bj][m][n]; *(u32x2*)(rowp + bj * HALF + n * 16) = (u32x2){cvt_pk_bf16(v[0], v[1]), cvt_pk_bf16(v[2], v[3])}; } }
    }
};
struct EpiSwiGLU {
    static constexpr bool PERM = true, AFTER_DRAIN = false, CARRY = false;
    bf16_t* H; int ldh; int tpg;
    __device__ __forceinline__ void operator()(const f32x4 (&acc)[2][2][4][2], const Unit& u, int wr, int wc, int fr, int fq) const {
        const int row0 = u.pm * BM + wr * 64 + fr, col0 = (u.pn % tpg) * HALF + wc * 32 + 8 * fq;
#pragma unroll
        for (int ai = 0; ai < 2; ++ai)
#pragma unroll
            for (int m = 0; m < 4; ++m) { bf16_t* rowp = H + (size_t)(row0 + ai * HALF + m * 16) * ldh + col0;
                f32x4 h0, h1;
#pragma unroll
                for (int j = 0; j < 4; ++j) { const float g0 = acc[ai][0][m][0][j], g1 = acc[ai][0][m][1][j]; h0[j] = g0 * sigm(g0) * acc[ai][1][m][0][j]; h1[j] = g1 * sigm(g1) * acc[ai][1][m][1][j]; }
                u32x4 w; w.x = cvt_pk_bf16(h0[0], h0[1]); w.y = cvt_pk_bf16(h0[2], h0[3]); w.z = cvt_pk_bf16(h1[0], h1[1]); w.w = cvt_pk_bf16(h1[2], h1[3]);
                *(u32x4*)rowp = w; }
    }
};
struct EpiNull {
    static constexpr bool PERM = true, AFTER_DRAIN = false, CARRY = false;
    __device__ __forceinline__ void operator()(const f32x4 (&acc)[2][2][4][2], const Unit&, int, int, int, int) const {
#pragma unroll
        for (int a = 0; a < 2; ++a)
#pragma unroll
            for (int b = 0; b < 2; ++b)
#pragma unroll
                for (int m = 0; m < 4; ++m)
#pragma unroll
                    for (int n = 0; n < 2; ++n) asm volatile("" :: "v"(acc[a][b][m][n]));
    }
};
struct EpiSwiGLU8 {
    static constexpr bool PERM = true, AFTER_DRAIN = false, CARRY = false;
    unsigned char* H; int ldh; int tpg;
    __device__ __forceinline__ void operator()(const f32x4 (&acc)[2][2][4][2], const Unit& u, int wr, int wc, int fr, int fq) const {
        const int row0 = u.pm * BM + wr * 64 + fr, col0 = (u.pn % tpg) * HALF + wc * 32 + 8 * fq;
#pragma unroll
        for (int ai = 0; ai < 2; ++ai)
#pragma unroll
            for (int m = 0; m < 4; ++m) { unsigned char* rowp = H + (size_t)(row0 + ai * HALF + m * 16) * ldh + col0;
                f32x4 h0, h1;
#pragma unroll
                for (int j = 0; j < 4; ++j) { const float g0 = acc[ai][0][m][0][j], g1 = acc[ai][0][m][1][j]; h0[j] = g0 * sigm(g0) * acc[ai][1][m][0][j]; h1[j] = g1 * sigm(g1) * acc[ai][1][m][1][j]; }
                int w0 = __builtin_amdgcn_cvt_pk_fp8_f32(h0[0], h0[1], 0, false); w0 = __builtin_amdgcn_cvt_pk_fp8_f32(h0[2], h0[3], w0, true);
                int w1 = __builtin_amdgcn_cvt_pk_fp8_f32(h1[0], h1[1], 0, false); w1 = __builtin_amdgcn_cvt_pk_fp8_f32(h1[2], h1[3], w1, true);
                typedef unsigned u32x2 __attribute__((ext_vector_type(2))); *(u32x2*)rowp = (u32x2){(unsigned)w0, (unsigned)w1}; }
    }
};
struct BranchOrder {
    int G, c;
    __device__ bool next(int i, Unit& u) const {
        const long L = (long)i * G + c; if (L >= 2560) return false;
        int w = (int)L; { const int xcd = w % NXCD, off = w / NXCD; w = xcd * 320 + off; }
        const int n = w / 512, rem = w % 512, gid = rem / 64, r2 = rem % 64;
        u.pm = n * 64 + gid * 8 + (r2 % 8); u.pn = n * 8 + r2 / 8; return true;
    }
    __device__ __forceinline__ void a_ready(const Unit&) const {}
    __device__ __forceinline__ void done(const Unit&) const {}
};
struct BranchOrder5 {
    int G, c;
    __device__ bool next(int i, Unit& u) const {
        const int tt = (i / 5) * G + c; if (tt >= 512) return false; const int n = i % 5;
        const int w = (tt % NXCD) * 64 + tt / NXCD, gid = w / 64, r2 = w % 64;
        u.pm = n * 64 + gid * 8 + (r2 % 8); u.pn = n * 8 + r2 / 8; return true;
    }
    __device__ __forceinline__ void a_ready(const Unit&) const {}
    __device__ __forceinline__ void done(const Unit&) const {}
};
struct GateOrder : StaticOrder {
    __device__ bool next(int i, Unit& u) const { if (!StaticOrder::next(i, u)) return false; u.pn += 33; return true; }
};
struct GateBatchOrder {
    int grp, base, n;
    __device__ bool next(int i, Unit& u) const { if (i >= n) return false; const int r = base + i; u.pm = grp * 8 + (r & 7); u.pn = 33 + (r >> 3); return true; }
    __device__ __forceinline__ void a_ready(const Unit&) const {}
    __device__ __forceinline__ void done(const Unit&) const {}
};
struct KvOrder {
    int c, c0;
    __device__ bool next(int i, Unit& u) const { const int w = c - c0; if (i != 0 || w < 0 || w >= 32) return false; u.pm = w >> 2; u.pn = (w >> 4) * 4 + (w & 3); return true; }
    __device__ __forceinline__ void a_ready(const Unit&) const {}
    __device__ __forceinline__ void done(const Unit&) const {}
};
struct MoeOrder {
    int G, c, tpe, total; const PG8_LAS int* tb;
    __device__ bool next(int i, Unit& u) const {
        const long L = (long)i * G + c; if (L >= total) return false;
        int w = (int)L; { const int q = total / NXCD, r = total % NXCD, xcd = w % NXCD, off = w / NXCD; w = (xcd < r ? xcd * (q + 1) : r * (q + 1) + (xcd - r) * q) + off; }
        int e = 0;
#pragma unroll
        for (int k = 1; k < 8; ++k) if (w >= tb[16 + k]) e = k;
        const int loc = w - tb[16 + e], nb = tb[e];
        u.pm = tb[8 + e] + loc % nb; u.pn = e * tpe + loc / nb; return true;
    }
    __device__ __forceinline__ void a_ready(const Unit&) const {}
    __device__ __forceinline__ void done(const Unit&) const {}
};
template <class Epi, class Sched, bool ALIGN_EPI = false, bool SP2 = false>
__device__ __forceinline__ void gemm_phase(PG8_LAS unsigned char* lds, const Gemm g, const Sched& S, const Epi& E) {
    int tid = pg8_tid(); asm volatile("" : "+v"(tid));
    const int wid = __builtin_amdgcn_readfirstlane(tid >> 6), lane = tid & 63, wr = wid >> 2, wc = wid & 3, fr = lane & 15, fq = lane >> 4;
    const int K = g.K, nt = K / BK;
    unsigned voffA[2], voffB[2];
#pragma unroll
    for (int i = 0; i < 2; ++i) { int R, C; stage_rc(tid * 16 + i * 8192, R, C); const int Rb = Epi::PERM ? ((R & ~31) + perm32(R & 31)) : R;
        voffA[i] = (unsigned)(R * K + C) * 2u; voffB[i] = (unsigned)(Rb * K + C) * 2u; }
    const size_t kstep = (size_t)(BK * 2);
    const size_t hstep = (size_t)HALF * K * 2;
    const size_t tstep = 2 * hstep;
    const unsigned ldsw = (unsigned)wid * 1024u;
    const int aoff = lds_byte(wr * 64 + fr, fq * 8), boff = lds_byte(wc * 32 + fr, fq * 8);
#define PG8_SA(b, h) (((b) * 2 + (h)) * HTB)
#define PG8_SB(b, h) ((4 + (b) * 2 + (h)) * HTB)
#define PG8_STAGE(bufoff, gbase, voff) do { _Pragma("unroll") for (int _i = 0; _i < 2; ++_i) \
        __builtin_amdgcn_global_load_lds((const unsigned*)((const char*)(gbase) + (voff)[_i]), (PG8_LAS unsigned*)(lds + (bufoff) + ldsw + _i * 8192), 16, 0, 0); } while (0)
#define PG8_LDA(dst, b, h) do { _Pragma("unroll") for (int m = 0; m < 4; ++m) _Pragma("unroll") for (int k = 0; k < 2; ++k) dst[m][k] = *(const PG8_LAS bf16x8*)(lds + PG8_SA(b, h) + aoff + m * 2048 + k * 1024); } while (0)
#define PG8_LDB(dst, b, h) do { _Pragma("unroll") for (int n = 0; n < 2; ++n) _Pragma("unroll") for (int k = 0; k < 2; ++k) dst[n][k] = *(const PG8_LAS bf16x8*)(lds + PG8_SB(b, h) + boff + n * 2048 + k * 1024); } while (0)
#define PG8_MMA(ai, bj, At, Bt) do { __builtin_amdgcn_s_setprio(1); _Pragma("unroll") for (int m = 0; m < 4; ++m) _Pragma("unroll") for (int n = 0; n < 2; ++n) _Pragma("unroll") for (int k = 0; k < 2; ++k) \
        acc[ai][bj][m][n] = __builtin_amdgcn_mfma_f32_16x16x32_bf16(Bt[n][k], At[m][k], acc[ai][bj][m][n], 0, 0, 0); __builtin_amdgcn_s_setprio(0); } while (0)
#define PG8_WAIT_V(n) asm volatile("s_waitcnt vmcnt(" #n ")" ::: "memory")
#define PG8_WAIT_L(n) asm volatile("s_waitcnt lgkmcnt(" #n ")" ::: "memory")
#define PG8_BAR __builtin_amdgcn_s_barrier()
#define PG8_SCHED __builtin_amdgcn_sched_barrier(0)
    Unit cur, nxt; int ui = 0;
    if (!S.next(0, cur)) return;
    f32x4 acc[2][2][4][2];
#pragma unroll
    for (int a = 0; a < 2; ++a)
#pragma unroll
        for (int b = 0; b < 2; ++b)
#pragma unroll
            for (int m = 0; m < 4; ++m)
#pragma unroll
                for (int n = 0; n < 2; ++n) acc[a][b][m][n] = (f32x4){0.f, 0.f, 0.f, 0.f};
    bf16x8 At[4][2], B0[2][2], B1[2][2];
    const char* cA = (const char*)g.A + (size_t)cur.pm * tstep; const char* cB = (const char*)g.Bt + (size_t)cur.pn * tstep;
    S.a_ready(cur);
    if constexpr (SP2) {
        PG8_STAGE(PG8_SB(0, 0), cB, voffB); PG8_STAGE(PG8_SB(0, 1), cB + hstep, voffB); PG8_STAGE(PG8_SA(0, 0), cA, voffA); PG8_STAGE(PG8_SA(0, 1), cA + hstep, voffA);
        if (wr == 1) PG8_BAR;
        PG8_WAIT_V(2); PG8_BAR;
        PG8_STAGE(PG8_SB(1, 0), cB + kstep, voffB); PG8_STAGE(PG8_SA(1, 0), cA + kstep, voffA); PG8_STAGE(PG8_SB(1, 1), cB + hstep + kstep, voffB);
        PG8_WAIT_V(6); PG8_BAR;
    } else {
        PG8_STAGE(PG8_SB(0, 0), cB, voffB); PG8_STAGE(PG8_SA(0, 0), cA, voffA); PG8_STAGE(PG8_SB(0, 1), cB + hstep, voffB); PG8_STAGE(PG8_SA(0, 1), cA + hstep, voffA);
        if (wr == 1) PG8_BAR;
        PG8_WAIT_V(4); PG8_BAR;
        PG8_STAGE(PG8_SB(1, 0), cB + kstep, voffB); PG8_STAGE(PG8_SA(1, 0), cA + kstep, voffA); PG8_STAGE(PG8_SB(1, 1), cB + hstep + kstep, voffB);
        PG8_WAIT_V(6); PG8_BAR;
    }
    for (;;) {
        const bool has_next = S.next(ui + 1, nxt);
        const char* nA = has_next ? (const char*)g.A + (size_t)nxt.pm * tstep : cA; const char* nB = has_next ? (const char*)g.Bt + (size_t)nxt.pn * tstep : cB;
        for (int t = 0; t < nt; t += 2) {
            const bool last = (t == nt - 2);
            const char* a1 = cA + (size_t)(t + 1) * kstep;
            const char* a2 = last ? nA : cA + (size_t)(t + 2) * kstep; const char* b2 = last ? nB : cB + (size_t)(t + 2) * kstep;
            const char* a3 = a2 + kstep; const char* b3 = b2 + kstep;
            if (last && has_next) S.a_ready(nxt);
            if constexpr (SP2) {
            PG8_LDB(B0, 0, 0); PG8_LDB(B1, 0, 1); PG8_SCHED; PG8_LDA(At, 0, 0); PG8_STAGE(PG8_SA(1, 1), a1 + hstep, voffA);
            PG8_WAIT_V(8); PG8_WAIT_L(0); PG8_BAR; PG8_MMA(0, 0, At, B0); PG8_MMA(0, 1, At, B1); PG8_BAR; PG8_SCHED;
            PG8_LDA(At, 0, 1); PG8_STAGE(PG8_SB(0, 0), b2, voffB); PG8_STAGE(PG8_SB(0, 1), b2 + hstep, voffB); PG8_STAGE(PG8_SA(0, 0), a2, voffA);
            PG8_WAIT_V(8); PG8_WAIT_L(0); PG8_BAR; PG8_MMA(1, 0, At, B0); PG8_MMA(1, 1, At, B1); PG8_BAR; PG8_SCHED;
            PG8_LDB(B0, 1, 0); PG8_LDB(B1, 1, 1); PG8_SCHED; PG8_LDA(At, 1, 0); PG8_STAGE(PG8_SA(0, 1), a2 + hstep, voffA);
            PG8_WAIT_V(8); PG8_WAIT_L(0); PG8_BAR; PG8_MMA(0, 0, At, B0); PG8_MMA(0, 1, At, B1); PG8_BAR; PG8_SCHED;
            PG8_LDA(At, 1, 1); PG8_STAGE(PG8_SB(1, 0), b3, voffB); PG8_STAGE(PG8_SB(1, 1), b3 + hstep, voffB); PG8_STAGE(PG8_SA(1, 0), a3, voffA);
            PG8_WAIT_V(8); PG8_WAIT_L(0); PG8_BAR; PG8_MMA(1, 0, At, B0); PG8_MMA(1, 1, At, B1); PG8_BAR; PG8_SCHED;
            } else {
            PG8_LDB(B0, 0, 0); PG8_SCHED; PG8_LDA(At, 0, 0); PG8_STAGE(PG8_SA(1, 1), a1 + hstep, voffA);
            PG8_WAIT_L(8); PG8_BAR; PG8_WAIT_L(0); PG8_MMA(0, 0, At, B0); PG8_BAR; PG8_SCHED;
            PG8_LDB(B1, 0, 1); PG8_STAGE(PG8_SB(0, 0), b2, voffB);
            PG8_BAR; PG8_WAIT_L(0); PG8_MMA(0, 1, At, B1); PG8_BAR;
            PG8_LDA(At, 0, 1); PG8_STAGE(PG8_SA(0, 0), a2, voffA);
            PG8_BAR; PG8_WAIT_L(0); PG8_MMA(1, 0, At, B0); PG8_BAR; PG8_SCHED;
            PG8_STAGE(PG8_SB(0, 1), b2 + hstep, voffB);
            PG8_WAIT_V(6); PG8_BAR; PG8_MMA(1, 1, At, B1); PG8_BAR;
            PG8_LDB(B0, 1, 0); PG8_SCHED; PG8_LDA(At, 1, 0); PG8_STAGE(PG8_SA(0, 1), a2 + hstep, voffA);
            PG8_WAIT_L(8); PG8_BAR; PG8_WAIT_L(0); PG8_MMA(0, 0, At, B0); PG8_BAR; PG8_SCHED;
            PG8_LDB(B1, 1, 1); PG8_STAGE(PG8_SB(1, 0), b3, voffB);
            PG8_BAR; PG8_WAIT_L(0); PG8_MMA(0, 1, At, B1); PG8_BAR;
            PG8_LDA(At, 1, 1); PG8_STAGE(PG8_SA(1, 0), a3, voffA);
            PG8_BAR; PG8_WAIT_L(0); PG8_MMA(1, 0, At, B0); PG8_BAR; PG8_SCHED;
            PG8_STAGE(PG8_SB(1, 1), b3 + hstep, voffB);
            PG8_WAIT_V(6); PG8_BAR; PG8_MMA(1, 1, At, B1); PG8_BAR;
            }
        }
        if constexpr (ALIGN_EPI) { if (wr == 0) PG8_BAR; }
        if constexpr (Epi::CARRY) { int fr_ = fr, fq_ = fq; asm volatile("" : "+v"(fr_), "+v"(fq_)); E.carry(acc, cur, wr, wc, fr_, fq_); S.done(cur); }
        else if constexpr (!Epi::AFTER_DRAIN) { E(acc, cur, wr, wc, fr, fq); S.done(cur); }
        if (!has_next) break;
        if constexpr (!Epi::CARRY)
#pragma unroll
        for (int a = 0; a < 2; ++a)
#pragma unroll
            for (int b = 0; b < 2; ++b)
#pragma unroll
                for (int m = 0; m < 4; ++m)
#pragma unroll
                    for (int n = 0; n < 2; ++n) acc[a][b][m][n] = (f32x4){0.f, 0.f, 0.f, 0.f};
        cur = nxt; cA = nA; cB = nB; ++ui;
        if constexpr (ALIGN_EPI) { if (wr == 1) PG8_BAR; }
    }
    PG8_WAIT_V(0);
    if constexpr (!ALIGN_EPI) { if (wr == 0) PG8_BAR; }
    PG8_BAR;
    if constexpr (Epi::AFTER_DRAIN) { E.fused(acc, cur, wr, wc, fr, fq, lds, wid, lane); S.done(cur); }
#undef PG8_SA
#undef PG8_SB
#undef PG8_STAGE
#undef PG8_LDA
#undef PG8_LDB
#undef PG8_MMA
#undef PG8_WAIT_V
#undef PG8_WAIT_L
#undef PG8_BAR
#undef PG8_SCHED
}
typedef int i32x8 __attribute__((ext_vector_type(8)));
typedef int i32x8a __attribute__((ext_vector_type(8), aligned(16)));
template <class Epi, class Sched, bool ALIGN_EPI = false, bool SP2 = true>
__device__ __forceinline__ void gemm_phase_f8(PG8_LAS unsigned char* lds, const Gemm g, const Sched& S, const Epi& E) {
    int tid = pg8_tid(); asm volatile("" : "+v"(tid));
    const int wid = __builtin_amdgcn_readfirstlane(tid >> 6), lane = tid & 63, wr = wid >> 2, wc = wid & 3, fr = lane & 15, fq = lane >> 4;
    const int K = g.K, nt = K / BK;
    unsigned voffA[2], voffB[2];
#pragma unroll
    for (int i = 0; i < 2; ++i) { int R, C; stage_rc(tid * 16 + i * 8192, R, C); const int Rb = Epi::PERM ? ((R & ~31) + perm32(R & 31)) : R;
        voffA[i] = (unsigned)(R * K + C) * 2u; voffB[i] = (unsigned)(Rb * K + C) * 2u; }
    const size_t kstep = (size_t)(BK * 2);
    const size_t hstep = (size_t)HALF * K * 2;
    const size_t tstep = 2 * hstep;
    const unsigned ldsw = (unsigned)wid * 1024u;
    const int aoff = lds_byte(wr * 64 + fr, fq * 8), boff = lds_byte(wc * 32 + fr, fq * 8);
#define PG8_SA(b, h) (((b) * 2 + (h)) * HTB)
#define PG8_SB(b, h) ((4 + (b) * 2 + (h)) * HTB)
#define PG8_STAGE(bufoff, gbase, voff) do { _Pragma("unroll") for (int _i = 0; _i < 2; ++_i) \
        __builtin_amdgcn_global_load_lds((const unsigned*)((const char*)(gbase) + (voff)[_i]), (PG8_LAS unsigned*)(lds + (bufoff) + ldsw + _i * 8192), 16, 0, 0); } while (0)
#define PG8_LDA(dst, b, h) do { _Pragma("unroll") for (int m = 0; m < 4; ++m) { const u32x4 lo_ = *(const PG8_LAS u32x4*)(lds + PG8_SA(b, h) + aoff + m * 2048), hi_ = *(const PG8_LAS u32x4*)(lds + PG8_SA(b, h) + aoff + m * 2048 + 1024); dst[m] = (i32x8){(int)lo_.x, (int)lo_.y, (int)lo_.z, (int)lo_.w, (int)hi_.x, (int)hi_.y, (int)hi_.z, (int)hi_.w}; } } while (0)
#define PG8_LDB(dst, b, h) do { _Pragma("unroll") for (int n = 0; n < 2; ++n) { const u32x4 lo_ = *(const PG8_LAS u32x4*)(lds + PG8_SB(b, h) + boff + n * 2048), hi_ = *(const PG8_LAS u32x4*)(lds + PG8_SB(b, h) + boff + n * 2048 + 1024); dst[n] = (i32x8){(int)lo_.x, (int)lo_.y, (int)lo_.z, (int)lo_.w, (int)hi_.x, (int)hi_.y, (int)hi_.z, (int)hi_.w}; } } while (0)
#define PG8_MMA(ai, bj, At, Bt) do { __builtin_amdgcn_s_setprio(1); _Pragma("unroll") for (int m = 0; m < 4; ++m) _Pragma("unroll") for (int n = 0; n < 2; ++n) \
        asm volatile("s_nop 1\n\tv_mfma_scale_f32_16x16x128_f8f6f4 %0, %1, %2, %0, %3, %4 op_sel_hi:[0,0,0]" : "+v"(acc[ai][bj][m][n]) : "v"(Bt[n]), "v"(At[m]), "v"(sc_w), "v"(sc_a)); __builtin_amdgcn_s_setprio(0); } while (0)
#define PG8_WAIT_V(n) asm volatile("s_waitcnt vmcnt(" #n ")" ::: "memory")
#define PG8_WAIT_L(n) asm volatile("s_waitcnt lgkmcnt(" #n ")" ::: "memory")
#define PG8_BAR __builtin_amdgcn_s_barrier()
#define PG8_SCHED __builtin_amdgcn_sched_barrier(0)
    Unit cur, nxt; int ui = 0;
    if (!S.next(0, cur)) return;
    f32x4 acc[2][2][4][2];
#pragma unroll
    for (int a = 0; a < 2; ++a)
#pragma unroll
        for (int b = 0; b < 2; ++b)
#pragma unroll
            for (int m = 0; m < 4; ++m)
#pragma unroll
                for (int n = 0; n < 2; ++n) acc[a][b][m][n] = (f32x4){0.f, 0.f, 0.f, 0.f};
    i32x8 At[4], B0[2], B1[2];
    int sc_w = 0x79797979, sc_a = 0x7F7F7F7F;
    asm volatile("" : "+v"(sc_w), "+v"(sc_a));
    const char* cA = (const char*)g.A + (size_t)cur.pm * tstep; const char* cB = (const char*)g.Bt + (size_t)cur.pn * tstep;
    S.a_ready(cur);
    if constexpr (SP2) {
        PG8_STAGE(PG8_SB(0, 0), cB, voffB); PG8_STAGE(PG8_SB(0, 1), cB + hstep, voffB); PG8_STAGE(PG8_SA(0, 0), cA, voffA); PG8_STAGE(PG8_SA(0, 1), cA + hstep, voffA);
        if (wr == 1) PG8_BAR;
        PG8_WAIT_V(2); PG8_BAR;
        PG8_STAGE(PG8_SB(1, 0), cB + kstep, voffB); PG8_STAGE(PG8_SA(1, 0), cA + kstep, voffA); PG8_STAGE(PG8_SB(1, 1), cB + hstep + kstep, voffB);
        PG8_WAIT_V(6); PG8_BAR;
    } else {
        PG8_STAGE(PG8_SB(0, 0), cB, voffB); PG8_STAGE(PG8_SA(0, 0), cA, voffA); PG8_STAGE(PG8_SB(0, 1), cB + hstep, voffB); PG8_STAGE(PG8_SA(0, 1), cA + hstep, voffA);
        if (wr == 1) PG8_BAR;
        PG8_WAIT_V(4); PG8_BAR;
        PG8_STAGE(PG8_SB(1, 0), cB + kstep, voffB); PG8_STAGE(PG8_SA(1, 0), cA + kstep, voffA); PG8_STAGE(PG8_SB(1, 1), cB + hstep + kstep, voffB);
        PG8_WAIT_V(6); PG8_BAR;
    }
    for (;;) {
        const bool has_next = S.next(ui + 1, nxt);
        const char* nA = has_next ? (const char*)g.A + (size_t)nxt.pm * tstep : cA; const char* nB = has_next ? (const char*)g.Bt + (size_t)nxt.pn * tstep : cB;
        for (int t = 0; t < nt; t += 2) {
            const bool last = (t == nt - 2);
            const char* a1 = cA + (size_t)(t + 1) * kstep;
            const char* a2 = last ? nA : cA + (size_t)(t + 2) * kstep; const char* b2 = last ? nB : cB + (size_t)(t + 2) * kstep;
            const char* a3 = a2 + kstep; const char* b3 = b2 + kstep;
            if (last && has_next) S.a_ready(nxt);
            if constexpr (SP2) {
            PG8_LDB(B0, 0, 0); PG8_LDB(B1, 0, 1); PG8_SCHED; PG8_LDA(At, 0, 0); PG8_STAGE(PG8_SA(1, 1), a1 + hstep, voffA);
            PG8_WAIT_V(8); PG8_WAIT_L(0); PG8_BAR; PG8_MMA(0, 0, At, B0); PG8_MMA(0, 1, At, B1); PG8_BAR; PG8_SCHED;
            PG8_LDA(At, 0, 1); PG8_STAGE(PG8_SB(0, 0), b2, voffB); PG8_STAGE(PG8_SB(0, 1), b2 + hstep, voffB); PG8_STAGE(PG8_SA(0, 0), a2, voffA);
            PG8_WAIT_V(8); PG8_WAIT_L(0); PG8_BAR; PG8_MMA(1, 0, At, B0); PG8_MMA(1, 1, At, B1); PG8_BAR; PG8_SCHED;
            PG8_LDB(B0, 1, 0); PG8_LDB(B1, 1, 1); PG8_SCHED; PG8_LDA(At, 1, 0); PG8_STAGE(PG8_SA(0, 1), a2 + hstep, voffA);
            PG8_WAIT_V(8); PG8_WAIT_L(0); PG8_BAR; PG8_MMA(0, 0, At, B0); PG8_MMA(0, 1, At, B1); PG8_BAR; PG8_SCHED;
            PG8_LDA(At, 1, 1); PG8_STAGE(PG8_SB(1, 0), b3, voffB); PG8_STAGE(PG8_SB(1, 1), b3 + hstep, voffB); PG8_STAGE(PG8_SA(1, 0), a3, voffA);
            PG8_WAIT_V(8); PG8_WAIT_L(0); PG8_BAR; PG8_MMA(1, 0, At, B0); PG8_MMA(1, 1, At, B1); PG8_BAR; PG8_SCHED;
            } else {
            PG8_LDB(B0, 0, 0); PG8_SCHED; PG8_LDA(At, 0, 0); PG8_STAGE(PG8_SA(1, 1), a1 + hstep, voffA);
            PG8_WAIT_L(8); PG8_BAR; PG8_WAIT_L(0); PG8_MMA(0, 0, At, B0); PG8_BAR; PG8_SCHED;
            PG8_LDB(B1, 0, 1); PG8_STAGE(PG8_SB(0, 0), b2, voffB);
            PG8_BAR; PG8_WAIT_L(0); PG8_MMA(0, 1, At, B1); PG8_BAR;
            PG8_LDA(At, 0, 1); PG8_STAGE(PG8_SA(0, 0), a2, voffA);
            PG8_BAR; PG8_WAIT_L(0); PG8_MMA(1, 0, At, B0); PG8_BAR; PG8_SCHED;
            PG8_STAGE(PG8_SB(0, 1), b2 + hstep, voffB);
            PG8_WAIT_V(6); PG8_BAR; PG8_MMA(1, 1, At, B1); PG8_BAR;
            PG8_LDB(B0, 1, 0); PG8_SCHED; PG8_LDA(At, 1, 0); PG8_STAGE(PG8_SA(0, 1), a2 + hstep, voffA);
            PG8_WAIT_L(8); PG8_BAR; PG8_WAIT_L(0); PG8_MMA(0, 0, At, B0); PG8_BAR; PG8_SCHED;
            PG8_LDB(B1, 1, 1); PG8_STAGE(PG8_SB(1, 0), b3, voffB);
            PG8_BAR; PG8_WAIT_L(0); PG8_MMA(0, 1, At, B1); PG8_BAR;
            PG8_LDA(At, 1, 1); PG8_STAGE(PG8_SA(1, 0), a3, voffA);
            PG8_BAR; PG8_WAIT_L(0); PG8_MMA(1, 0, At, B0); PG8_BAR; PG8_SCHED;
            PG8_STAGE(PG8_SB(1, 1), b3 + hstep, voffB);
            PG8_WAIT_V(6); PG8_BAR; PG8_MMA(1, 1, At, B1); PG8_BAR;
            }
        }
        if constexpr (ALIGN_EPI) { if (wr == 0) PG8_BAR; }
#pragma unroll
        for (int a_ = 0; a_ < 2; ++a_)
#pragma unroll
            for (int b_ = 0; b_ < 2; ++b_) asm volatile("s_nop 15\n\ts_nop 15" : "+v"(acc[a_][b_][0][0]), "+v"(acc[a_][b_][0][1]), "+v"(acc[a_][b_][1][0]), "+v"(acc[a_][b_][1][1]), "+v"(acc[a_][b_][2][0]), "+v"(acc[a_][b_][2][1]), "+v"(acc[a_][b_][3][0]), "+v"(acc[a_][b_][3][1]));
        if constexpr (!Epi::AFTER_DRAIN) { int fr_ = fr, fq_ = fq; asm volatile("" : "+v"(fr_), "+v"(fq_));
            E(acc, cur, wr, wc, fr_, fq_); S.done(cur); }
        if (!has_next) break;
#pragma unroll
        for (int a = 0; a < 2; ++a)
#pragma unroll
            for (int b = 0; b < 2; ++b)
#pragma unroll
                for (int m = 0; m < 4; ++m)
#pragma unroll
                    for (int n = 0; n < 2; ++n) acc[a][b][m][n] = (f32x4){0.f, 0.f, 0.f, 0.f};
        cur = nxt; cA = nA; cB = nB; ++ui;
        if constexpr (ALIGN_EPI) { if (wr == 1) PG8_BAR; }
    }
    PG8_WAIT_V(0);
    if constexpr (!ALIGN_EPI) { if (wr == 0) PG8_BAR; }
    PG8_BAR;
    if constexpr (Epi::AFTER_DRAIN) { E.fused(acc, cur, wr, wc, fr, fq, lds, wid, lane); S.done(cur); }
#undef PG8_SA
#undef PG8_SB
#undef PG8_STAGE
#undef PG8_LDA
#undef PG8_LDB
#undef PG8_MMA
#undef PG8_WAIT_V
#undef PG8_WAIT_L
#undef PG8_BAR
#undef PG8_SCHED
}
}
constexpr int NT = 16384, DM = 2048, SEQ = 4096, NBATCH = 4, NLAYER = 2;
constexpr int LDP = 8448, NGATE = 10240, NIN = 18688, PIN = 18480;
constexpr int C_NAQ = 0, C_NAK = 512, C_NAV = 1024, C_GLQ = 1536, C_GLK = 1792, C_GLV = 2048, C_GLLR = 2560, C_GLOG = 2592, C_GDQKV = 3104, C_GDA = 4640, C_GDB = 4648,
              C_GDOG = 4656, C_HGQ = 5168, C_HGF = 5680, C_HGI = 6704, C_HGOG = 7216, C_MQ = 7728, C_PEND = 8240;
constexpr int DFF = 5632, DFFE = 7168, NEXP = 8, MAXSLOT = 34816;
constexpr float RMS_EPS = 1e-6f;
constexpr size_t MiB = 1u << 20;
constexpr size_t WS_CTL = 0, CTL_ZERO_BYTES = 1 * MiB;
constexpr size_t WS_ROUTE = 1 * MiB;
constexpr size_t WS_MK = 2 * MiB;
constexpr size_t WS_MVT = 4 * MiB;
constexpr size_t WS_KVRAW = 6 * MiB;
constexpr size_t WS_MEMN = 14 * MiB;
constexpr size_t WS_WIN = 24 * MiB;
constexpr size_t WS_WBR = WS_WIN + 146 * MiB;
constexpr size_t WS_WOUT = WS_WBR + 20 * MiB;
constexpr size_t WS_WMKV = WS_WOUT + 16 * MiB;
constexpr size_t WS_WGU = WS_WMKV + 8 * MiB;
constexpr size_t WS_WDN = WS_WGU + 44 * MiB;
constexpr size_t WS_MOE1 = WS_WDN + 22 * MiB;
constexpr size_t WS_MOE2 = WS_MOE1 + 448 * MiB;
constexpr size_t WS_OA = WS_MOE1 + 224 * MiB, WS_MOE2F = WS_MOE2 + 112 * MiB;
constexpr size_t WS_HM = WS_MOE2 + 224 * MiB;
constexpr size_t WS_P = WS_HM + 64 * MiB;
constexpr size_t WS_G = WS_P + 264 * MiB;
constexpr size_t WS_GLG = WS_G + 320 * MiB;
constexpr size_t WS_GQ = WS_GLG + 32 * MiB;
constexpr size_t WS_GAB = WS_GQ + 48 * MiB;
constexpr size_t WS_HQ = WS_GAB + 1 * MiB;
constexpr size_t WS_HF = WS_HQ + 16 * MiB;
constexpr size_t WS_NAVT = WS_HF + 64 * MiB;
constexpr size_t WS_SOUT = WS_NAVT + 16 * MiB;
constexpr size_t WS_BR = WS_SOUT + 96 * MiB;
constexpr size_t WS_H8 = WS_BR + 80 * MiB;
constexpr size_t WS_END = WS_H8 + 32 * MiB;
constexpr size_t WS_HID = WS_P;
constexpr size_t WS_XB = WS_P;
constexpr size_t WS_HIDM = WS_XB + 136 * MiB;
constexpr size_t WS_YB = WS_HIDM + 476 * MiB;
static_assert(WS_YB + 272 * MiB <= WS_END, "MoE overlay fits");
static_assert(WS_END <= 2085645600ull, "workspace map fits sum(inputs)");
constexpr int CW_TMO = 0, CW_CODE = 1, CW_BAR = 4096, CW_WQ = 8192, CW_CNT = 8192 + 1024, CW_CONVQ = 8192 + 2048, CW_S2DONE = 8192 + 2048 + 64, CW_GQ = 16384;
constexpr int RING_OFF = 0, RING_BYTES = 131072, LDSCTL_OFF = RING_BYTES, MISC_OFF = LDSCTL_OFF + 320, TAB_OFF = LDSCTL_OFF + 512, LDS_BYTES = 147456;
constexpr int NWAVES = 8;
#ifndef MK_SPLIT
#define MK_SPLIT 0
#endif
#define GAS __attribute__((address_space(1)))
#define LAS __attribute__((address_space(3)))
typedef unsigned short bf16;
typedef unsigned v4u __attribute__((ext_vector_type(4)));
typedef float f32x4 __attribute__((ext_vector_type(4)));
typedef short bf16x8 __attribute__((ext_vector_type(8)));
typedef GAS unsigned gu32;
typedef GAS unsigned long long gu64;
#define RLX_AGENT __ATOMIC_RELAXED, __HIP_MEMORY_SCOPE_AGENT
#define LDS_WAIT() asm volatile("s_waitcnt lgkmcnt(0)" ::: "memory")
#define VM_WAIT() asm volatile("s_waitcnt vmcnt(0)" ::: "memory")
__device__ __forceinline__ unsigned long long rt() { return __builtin_amdgcn_s_memrealtime(); }
__device__ __forceinline__ unsigned f2bf(float f) { unsigned u = __builtin_bit_cast(unsigned, f); return (u + 0x7fffu + ((u >> 16) & 1u)) >> 16; }
__device__ __forceinline__ unsigned pk2(float lo, float hi) { return f2bf(lo) | (f2bf(hi) << 16); }
constexpr int WAVETAB_OFF = 131072 + 1024;
__device__ __forceinline__ unsigned hw_slot() { return (unsigned)__builtin_amdgcn_s_getreg((5 << 11) | 4) & 63u; }
__device__ __forceinline__ int mk_lane() { return (int)__builtin_amdgcn_mbcnt_hi(~0u, __builtin_amdgcn_mbcnt_lo(~0u, 0u)); }
__device__ __forceinline__ int mk_wave() { extern __shared__ __attribute__((aligned(16))) unsigned char lds_raw_[]; const volatile LAS int* tab = (const volatile LAS int*)((LAS unsigned char*)lds_raw_ + WAVETAB_OFF); return __builtin_amdgcn_readfirstlane(tab[hw_slot()]); }
__device__ __forceinline__ int mk_tid() { return mk_wave() * 64 + mk_lane(); }
__device__ __forceinline__ int pg8_tid() { return mk_tid(); }
#define XB_TMO      128
#define XB_XCNT(j)  (256  + 64 * (j))
#define XB_XSUB(j)  (1280 + 64 * (j))
#define XB_XGEN(j)  (2304 + 64 * (j))
#define XB_TOP      3328
#define XB_TOPGEN   3392
#define XCD_BAR_WORDS 3456
#define XB_SPIN_CAP (1u << 22)

__device__ __forceinline__ unsigned xb_ld(unsigned* p)              { return __hip_atomic_load(p, __ATOMIC_RELAXED, __HIP_MEMORY_SCOPE_AGENT); }
__device__ __forceinline__ unsigned xb_add(unsigned* p, unsigned v) { return __hip_atomic_fetch_add(p, v, __ATOMIC_RELAXED, __HIP_MEMORY_SCOPE_AGENT); }
__device__ __forceinline__ unsigned xb_xcc_id() { return (unsigned)__builtin_amdgcn_s_getreg((3 << 11) | 20) & 0xFu; }
#define XB_SPIN(cond, bar) do { unsigned _sp = 0; while (cond) { __builtin_amdgcn_s_sleep(1); \
    if ((++_sp & 255u) == 0u) { if (xb_ld(&(bar)[XB_TMO])) break; if (_sp > XB_SPIN_CAP) { atomicAdd(&(bar)[XB_TMO], 1u); break; } } } } while (0)

struct XcdBarrier {
    unsigned* bar; unsigned x;
    volatile LAS unsigned* st;
};

__device__ __forceinline__ XcdBarrier xcd_barrier_post(unsigned* bar, volatile LAS unsigned* st) {
    XcdBarrier b; b.bar = bar; b.x = xb_xcc_id(); b.st = st;
    if (mk_tid() == 0) (void)xb_add(&bar[XB_XCNT(b.x)], 1u);
    return b;
}
__device__ __forceinline__ void xcd_barrier_complete(unsigned* bar, unsigned x, unsigned& nloc, unsigned& nx) {
    const unsigned G = gridDim.x * gridDim.y * gridDim.z;
    unsigned sum, cnt, mine, sp = 0u;
    for (;;) {
        sum = 0u; cnt = 0u; mine = 0u;
#pragma unroll
        for (unsigned j = 0; j < 16; ++j) { const unsigned c = xb_ld(&bar[XB_XCNT(j)]); sum += c; cnt += (c > 0u) ? 1u : 0u; mine = (j == x) ? c : mine; }
        if (sum == G) break;
        __builtin_amdgcn_s_sleep(1);
        if ((++sp & 255u) == 0u) { if (xb_ld(&bar[XB_TMO])) break; if (sp > XB_SPIN_CAP) { atomicAdd(&bar[XB_TMO], 1u); break; } }
    }
    nloc = mine > 0u ? mine : 1u; nx = cnt > 0u ? cnt : 1u;
}

__device__ __forceinline__ void xcd_barrier(const XcdBarrier& b) {
    asm volatile("s_waitcnt vmcnt(0)" ::: "memory");
    __syncthreads();
    if (mk_tid() == 0) {
        unsigned* bar = b.bar;
        __builtin_amdgcn_s_waitcnt(0);
        unsigned nloc = b.st[0], nx = b.st[1];
        if (nloc == 0u) { xcd_barrier_complete(bar, b.x, nloc, nx); b.st[0] = nloc; b.st[1] = nx; }
        const unsigned old = xb_add(&bar[XB_XSUB(b.x)], 1u);
        const unsigned gen = old / nloc;
        if (old + 1u == (gen + 1u) * nloc) {
            __builtin_amdgcn_fence(__ATOMIC_RELEASE, "agent");
            asm volatile("s_waitcnt vmcnt(0)" ::: "memory");
            const unsigned og = xb_add(&bar[XB_TOP], 1u);
            const unsigned tg = og / nx;
            if (og + 1u == (tg + 1u) * nx) xb_add(&bar[XB_TOPGEN], 1u);
            else XB_SPIN(xb_ld(&bar[XB_TOPGEN]) == tg, bar);
            __builtin_amdgcn_fence(__ATOMIC_ACQUIRE, "agent");
            xb_add(&bar[XB_XGEN(b.x)], 1u);
            asm volatile("s_waitcnt vmcnt(0)" ::: "memory");
        } else {
            XB_SPIN(xb_ld(&bar[XB_XGEN(b.x)]) == gen, bar);
            __builtin_amdgcn_fence(__ATOMIC_ACQUIRE, "agent");
            asm volatile("s_waitcnt vmcnt(0)" ::: "memory");
        }
    }
    __syncthreads();
}
typedef unsigned v2u __attribute__((ext_vector_type(2)));
typedef float f32x2v __attribute__((ext_vector_type(2)));
__device__ __forceinline__ float bflo(unsigned w) { return __uint_as_float(w << 16); }
__device__ __forceinline__ float bfhi(unsigned w) { return __uint_as_float(w & 0xffff0000u); }
__device__ __forceinline__ float bf1(bf16 h) { return __uint_as_float(((unsigned)h) << 16); }
typedef __bf16 bf16x2_t __attribute__((ext_vector_type(2)));
__device__ __forceinline__ unsigned pkbf(float lo, float hi) { const f32x2v v = {lo, hi}; return __builtin_bit_cast(unsigned, __builtin_convertvector(v, bf16x2_t)); }
__device__ __forceinline__ void unpack8(const v4u w, float (&f)[8]) { f[0] = bflo(w.x); f[1] = bfhi(w.x); f[2] = bflo(w.y); f[3] = bfhi(w.y); f[4] = bflo(w.z); f[5] = bfhi(w.z); f[6] = bflo(w.w); f[7] = bfhi(w.w); }
__device__ __forceinline__ v4u pack8(const float (&f)[8]) { v4u w; w.x = pkbf(f[0], f[1]); w.y = pkbf(f[2], f[3]); w.z = pkbf(f[4], f[5]); w.w = pkbf(f[6], f[7]); return w; }
__device__ __forceinline__ float sigmf(float x) { return __builtin_amdgcn_rcpf(1.0f + __expf(-x)); }
__device__ __forceinline__ float siluf(float x) { return x * __builtin_amdgcn_rcpf(1.0f + __expf(-x)); }
__device__ __forceinline__ float softplusf(float x) { return fmaxf(x, 0.f) + __logf(1.0f + __expf(-fabsf(x))); }
#define DPP_ADD(v, ctrl) ((v) + __int_as_float(__builtin_amdgcn_update_dpp(0, __float_as_int(v), (ctrl), 0xF, 0xF, true)))
__device__ __forceinline__ float row16_sum(float v) { v = DPP_ADD(v, 0xB1); v = DPP_ADD(v, 0x4E); v = DPP_ADD(v, 0x141); v = DPP_ADD(v, 0x140); return v; }
__device__ __forceinline__ float wave_sum(float v) { v = row16_sum(v); v += __shfl_xor(v, 16); v += __shfl_xor(v, 32); return v; }
template <int N> __device__ __forceinline__ float group_sum(float v) {
    v = DPP_ADD(v, 0xB1); v = DPP_ADD(v, 0x4E); v = DPP_ADD(v, 0x141); if (N == 16) v = DPP_ADD(v, 0x140);
    return v;
}
template <int KL> __device__ __forceinline__ float kl_sum(float v) {
    v = DPP_ADD(v, 0xB1); v = DPP_ADD(v, 0x4E); v = DPP_ADD(v, 0x141);
    if (KL == 16) v = DPP_ADD(v, 0x140);
    return v;
}
__device__ __forceinline__ unsigned pk4_f8(float a, float b, float c, float d);
__device__ __forceinline__ void rms_row(const float* xrow, const float* gain, bf16* orow, int lane, f32x4 (&v)[8], unsigned char* o8row = nullptr) {
    const f32x4* xr = (const f32x4*)xrow + lane; float s = 0.f;
#pragma unroll
    for (int j = 0; j < 8; ++j) { v[j] = xr[64 * j]; s += (v[j].x * v[j].x + v[j].y * v[j].y) + (v[j].z * v[j].z + v[j].w * v[j].w); }
    const float sc = rsqrtf(wave_sum(s) * (1.0f / DM) + RMS_EPS);
    const f32x4* gr = (const f32x4*)gain + lane; v2u* o8 = (v2u*)orow + lane;
#pragma unroll
    for (int j = 0; j < 8; ++j) { v[j] = v[j] * sc * gr[64 * j]; v2u w; w.x = pkbf(v[j].x, v[j].y); w.y = pkbf(v[j].z, v[j].w); o8[64 * j] = w;
        if (o8row) ((unsigned*)o8row)[lane + 64 * j] = pk4_f8(v[j].x, v[j].y, v[j].z, v[j].w); }
}
__device__ __forceinline__ unsigned pk4_f8(float a, float b, float c, float d);
__device__ __forceinline__ void rms_row_f8(const float* xrow, const float* gain, unsigned char* orow, int lane, f32x4 (&v)[8]) {
    const f32x4* xr = (const f32x4*)xrow + lane; float s = 0.f;
#pragma unroll
    for (int j = 0; j < 8; ++j) { v[j] = xr[64 * j]; s += (v[j].x * v[j].x + v[j].y * v[j].y) + (v[j].z * v[j].z + v[j].w * v[j].w); }
    const float sc = rsqrtf(wave_sum(s) * (1.0f / DM) + RMS_EPS);
    const f32x4* gr = (const f32x4*)gain + lane; unsigned* o4 = (unsigned*)orow + lane;
#pragma unroll
    for (int j = 0; j < 8; ++j) { v[j] = v[j] * sc * gr[64 * j]; o4[64 * j] = pk4_f8(v[j].x, v[j].y, v[j].z, v[j].w); }
}
__device__ __forceinline__ unsigned pk4_f8(float a, float b, float c, float d) { int w = __builtin_amdgcn_cvt_pk_fp8_f32(a, b, 0, false); w = __builtin_amdgcn_cvt_pk_fp8_f32(c, d, w, true); return (unsigned)w; }
struct RmOff { int off; __device__ __forceinline__ int operator()(int n) const { return n + off; } };
struct RmWin { __device__ __forceinline__ int operator()(int n) const { return n < C_PEND ? n : n + (LDP - C_PEND); } };
struct RmGU { int up; __device__ __forceinline__ int operator()(int n) const { return (n >> 7) * 256 + (n & 127) + up * 128; } };
__device__ __forceinline__ void tr_load(float (&v)[64], const float* W, int ldw, int N, int nblk, int it, int lane) {
    const int kb = it / nblk, nb = it % nblk; const int n = 64 * nb + lane; const bool ok = n < N; const float* p = W + (size_t)(64 * kb) * ldw + (ok ? n : 0);
#pragma unroll
    for (int kk = 0; kk < 64; ++kk) v[kk] = p[(size_t)kk * ldw];
    if (!ok) {
#pragma unroll
        for (int kk = 0; kk < 64; ++kk) v[kk] = 0.f; }
}
template <class RowMap> __device__ __forceinline__ void tr_store(const float (&v)[64], int K, int N, int nblk, int it, bf16* WT, LAS unsigned* scr, int lane, const RowMap& rm) {
    const int kb = it / nblk, nb = it % nblk;
#pragma unroll
    for (int kp = 0; kp < 32; ++kp) scr[lane * 33 + kp] = pkbf(v[2 * kp], v[2 * kp + 1]);
    LDS_WAIT(); asm volatile("" ::: "memory");
    const int c = lane & 7;
#pragma unroll
    for (int j = 0; j < 8; ++j) { const int nl = (lane >> 3) + 8 * j; const LAS unsigned* s = scr + nl * 33 + 4 * c; v4u o; o.x = s[0]; o.y = s[1]; o.z = s[2]; o.w = s[3];
        const int n = 64 * nb + nl; if (n < N) *(GAS v4u*)(WT + (size_t)rm(n) * K + 64 * kb + 8 * c) = o; }
    LDS_WAIT(); asm volatile("" ::: "memory");
}
template <class RowMap> __device__ __forceinline__ void transpose_job(const float* W, int K, int N, bf16* WT, LAS float* scr_f, int gw, int NGW, int lane, const RowMap& rm, int ldw = 0) {
    if (!ldw) ldw = N;
    LAS unsigned* scr = (LAS unsigned*)scr_f; const int nblk = (N + 63) / 64, nit = (K / 64) * nblk;
    float va[64], vb[64]; int it = gw;
    if (it < nit) tr_load(va, W, ldw, N, nblk, it, lane);
#pragma unroll 1
    for (; it < nit; it += 2 * NGW) { const int it2 = it + NGW, it3 = it2 + NGW;
        if (it2 < nit) tr_load(vb, W, ldw, N, nblk, it2, lane);
        tr_store(va, K, N, nblk, it, WT, scr, lane, rm);
        if (it3 < nit) tr_load(va, W, ldw, N, nblk, it3, lane);
        if (it2 < nit) tr_store(vb, K, N, nblk, it2, WT, scr, lane, rm);
    }
}
template <class RowMap> __device__ __forceinline__ void tr_store_f8(const float (&v)[64], float scale, int K, int N, int nblk, int it, unsigned char* WT, LAS unsigned* scr, int lane, const RowMap& rm) {
    const int kb = it / nblk, nb = it % nblk;
#pragma unroll
    for (int q = 0; q < 16; ++q) scr[lane * 17 + q] = pk4_f8(v[4 * q] * scale, v[4 * q + 1] * scale, v[4 * q + 2] * scale, v[4 * q + 3] * scale);
    LDS_WAIT(); asm volatile("" ::: "memory");
    const int c = lane & 3;
#pragma unroll
    for (int j = 0; j < 4; ++j) { const int nl = (lane >> 2) + 16 * j; const LAS unsigned* s = scr + nl * 17 + 4 * c; v4u o; o.x = s[0]; o.y = s[1]; o.z = s[2]; o.w = s[3];
        const int n = 64 * nb + nl; if (n < N) *(GAS v4u*)(WT + (size_t)rm(n) * K + 64 * kb + 16 * c) = o; }
    LDS_WAIT(); asm volatile("" ::: "memory");
}
template <class RowMap> __device__ __forceinline__ void transpose_job_f8(const float* W, float scale, int K, int N, unsigned char* WT, LAS float* scr_f, int gw, int NGW, int lane, const RowMap& rm, int ldw = 0) {
    if (!ldw) ldw = N;
    LAS unsigned* scr = (LAS unsigned*)scr_f; const int nblk = (N + 63) / 64, nit = (K / 64) * nblk;
    float va[64], vb[64]; int it = gw;
    if (it < nit) tr_load(va, W, ldw, N, nblk, it, lane);
#pragma unroll 1
    for (; it < nit; it += 2 * NGW) { const int it2 = it + NGW, it3 = it2 + NGW;
        if (it2 < nit) tr_load(vb, W, ldw, N, nblk, it2, lane);
        tr_store_f8(va, scale, K, N, nblk, it, WT, scr, lane, rm);
        if (it3 < nit) tr_load(va, W, ldw, N, nblk, it3, lane);
        if (it2 < nit) tr_store_f8(vb, scale, K, N, nblk, it2, WT, scr, lane, rm);
    }
}
__device__ __forceinline__ void moe1_convert_all(const float* wg, const float* wu, unsigned char* MOE1, LAS float* scr_f, int gw, int NGW, int lane) {
    LAS unsigned* scr = (LAS unsigned*)scr_f; constexpr int NB = DFFE / 64, TPJ = (DM / 64) * NB, NIT = 16 * TPJ;
    float va[64], vb[64]; int it = gw;
#define M1_SRC(t) (((((t) / TPJ) & 1) ? wu : wg) + (size_t)(((t) / TPJ) >> 1) * DM * DFFE)
#define M1_DST(t) (MOE1 + (size_t)(((t) / TPJ) >> 1) * 2 * DFFE * DM)
    if (it < NIT) tr_load(va, M1_SRC(it), DFFE, DFFE, NB, it % TPJ, lane);
#pragma unroll 1
    for (; it < NIT; it += 2 * NGW) { const int it2 = it + NGW, it3 = it2 + NGW;
        if (it2 < NIT) tr_load(vb, M1_SRC(it2), DFFE, DFFE, NB, it2 % TPJ, lane);
        tr_store_f8(va, 64.0f, DM, DFFE, NB, it % TPJ, M1_DST(it), scr, lane, RmGU{(it / TPJ) & 1});
        if (it3 < NIT) tr_load(va, M1_SRC(it3), DFFE, DFFE, NB, it3 % TPJ, lane);
        if (it2 < NIT) tr_store_f8(vb, 64.0f, DM, DFFE, NB, it2 % TPJ, M1_DST(it2), scr, lane, RmGU{(it2 / TPJ) & 1});
    }
#undef M1_SRC
#undef M1_DST
}
struct RmGen { int kind, off; __device__ __forceinline__ int operator()(int n) const { return kind ? (n >> 7) * 256 + (n & 127) + off * 128 : n + off; } };
struct P0Job { const float* W; int ldw, N, K, nblk, loc, f8; unsigned char* WT; RmGen rm; };
__device__ __forceinline__ P0Job p0_job(int t, const float* w_in, const float* w_br, const float* w_out, const float* w_kv, const float* f_gate, const float* f_up, const float* f_down, unsigned char* ws) {
    P0Job j; j.f8 = 0; j.rm = RmGen{0, 0};
    constexpr int T_P = 32 * 129, T_G = 32 * 160, T_B = 8 * 32, T_O = 32 * 32, T_K = 32 * 16, T_L = T_P + T_G + 5 * T_B + T_O + T_K, T_D = 32 * 88;
    if (t < 2 * T_L) { const int L = t / T_L; int r = t % T_L;
        if (r < T_P) { j.W = w_in + (size_t)L * DM * PIN; j.ldw = PIN; j.N = C_PEND; j.K = DM; j.nblk = 129; j.loc = r; j.WT = ws + WS_WIN + (size_t)L * NIN * DM * 2; return j; } r -= T_P;
        if (r < T_G) { j.W = w_in + (size_t)L * DM * PIN + C_PEND; j.ldw = PIN; j.N = NGATE; j.K = DM; j.nblk = 160; j.loc = r; j.f8 = 1; j.WT = ws + WS_WIN + ((size_t)L * NIN + LDP) * DM * 2; return j; } r -= T_G;
        if (r < 5 * T_B) { const int n = r / T_B; j.W = w_br + (size_t)(L * 5 + n) * 512 * DM; j.ldw = DM; j.N = DM; j.K = 512; j.nblk = 32; j.loc = r % T_B; j.WT = ws + WS_WBR + (size_t)(L * 5 + n) * DM * 512 * 2; return j; } r -= 5 * T_B;
        if (r < T_O) { j.W = w_out + (size_t)L * DM * DM; j.ldw = DM; j.N = DM; j.K = DM; j.nblk = 32; j.loc = r; j.WT = ws + WS_WOUT + (size_t)L * DM * DM * 2; return j; } r -= T_O;
        j.W = w_kv + (size_t)L * DM * 1024; j.ldw = 1024; j.N = 1024; j.K = DM; j.nblk = 16; j.loc = r; j.WT = ws + WS_WMKV + (size_t)L * 1024 * DM * 2; return j; }
    int r = t - 2 * T_L;
    if (r < 2 * T_D) { const int up = r / T_D; j.W = up ? f_up : f_gate; j.ldw = DFF; j.N = DFF; j.K = DM; j.nblk = 88; j.loc = r % T_D; j.WT = ws + WS_WGU; j.rm = RmGen{1, up}; return j; } r -= 2 * T_D;
    j.W = f_down; j.ldw = DM; j.N = DM; j.K = DFF; j.nblk = 32; j.loc = r; j.WT = ws + WS_WDN; return j;
}
constexpr int P0_TILES = 2 * (32 * 129 + 32 * 160 + 5 * 8 * 32 + 32 * 32 + 32 * 16) + 3 * 32 * 88;
__device__ __forceinline__ void p0_store(const float (&v)[64], const P0Job& j, LAS unsigned* scr, int lane) {
    if (j.f8) tr_store_f8(v, 64.0f, j.K, j.N, j.nblk, j.loc, j.WT, scr, lane, j.rm); else tr_store(v, j.K, j.N, j.nblk, j.loc, (bf16*)j.WT, scr, lane, j.rm);
}
__device__ __forceinline__ void phase0_convert_all(const float* w_in, const float* w_br, const float* w_out, const float* w_kv, const float* f_gate, const float* f_up, const float* f_down, unsigned char* ws, LAS float* scr_f, int gw, int NGW, int lane) {
    LAS unsigned* scr = (LAS unsigned*)scr_f; float va[64], vb[64]; int it = gw;
    P0Job ja = p0_job(it < P0_TILES ? it : 0, w_in, w_br, w_out, w_kv, f_gate, f_up, f_down, ws), jb = ja;
    if (it < P0_TILES) tr_load(va, ja.W, ja.ldw, ja.N, ja.nblk, ja.loc, lane);
#pragma unroll 1
    for (; it < P0_TILES; it += 2 * NGW) { const int it2 = it + NGW, it3 = it2 + NGW;
        if (it2 < P0_TILES) { jb = p0_job(it2, w_in, w_br, w_out, w_kv, f_gate, f_up, f_down, ws); tr_load(vb, jb.W, jb.ldw, jb.N, jb.nblk, jb.loc, lane); }
        p0_store(va, ja, scr, lane);
        if (it3 < P0_TILES) { ja = p0_job(it3, w_in, w_br, w_out, w_kv, f_gate, f_up, f_down, ws); tr_load(va, ja.W, ja.ldw, ja.N, ja.nblk, ja.loc, lane); }
        if (it2 < P0_TILES) p0_store(vb, jb, scr, lane);
    }
}
constexpr int MQ_GU = 16 * 32 * 112, MQ_TILES = MQ_GU + 2 * 112 * 32, MQ_GRAB = 16;
__device__ __forceinline__ P0Job moe_job(int t, const float* wg, const float* wu, const float* wd, unsigned char* ws) {
    P0Job j; j.f8 = 1; constexpr int TPJ = 32 * 112;
    if (t < MQ_GU) { const int jb = t / TPJ, e = jb >> 1, up = jb & 1; j.W = (up ? wu : wg) + (size_t)e * DM * DFFE; j.ldw = DFFE; j.N = DFFE; j.K = DM; j.nblk = 112; j.loc = t % TPJ; j.WT = ws + WS_MOE1 + (size_t)e * 2 * DFFE * DM; j.rm = RmGen{1, up}; return j; }
    const int r = t - MQ_GU, e = 6 + r / TPJ; j.W = wd + (size_t)e * DFFE * DM; j.ldw = DM; j.N = DM; j.K = DFFE; j.nblk = 32; j.loc = r % TPJ; j.WT = ws + WS_MOE2F + (size_t)e * DM * DFFE; j.rm = RmGen{0, 0}; return j;
}
__device__ __forceinline__ unsigned mq_grab(gu32* q, const gu32* stop, unsigned stop_val) {
    if (stop && __hip_atomic_load(stop, RLX_AGENT) >= stop_val) return 0x7fffffffu;
    return __hip_atomic_fetch_add(q, (unsigned)MQ_GRAB, RLX_AGENT);
}
__device__ __forceinline__ void moe_drain(const float* wg, const float* wu, const float* wd, unsigned char* ws, gu32* q, const gu32* stop, unsigned stop_val, volatile LAS unsigned* slot, LAS float* scr_f, int wave, int lane, int tid) {
    LAS unsigned* scr = (LAS unsigned*)scr_f; float va[64], vb[64];
    __syncthreads();
    if (tid == 0) slot[0] = mq_grab(q, stop, stop_val);
    __syncthreads();
    unsigned t = slot[0]; int i = 0; P0Job ja, jb;
    if (t < (unsigned)MQ_TILES) { ja = moe_job((int)t + 2 * wave, wg, wu, wd, ws); tr_load(va, ja.W, ja.ldw, ja.N, ja.nblk, ja.loc, lane); jb = moe_job((int)t + 2 * wave + 1, wg, wu, wd, ws); tr_load(vb, jb.W, jb.ldw, jb.N, jb.nblk, jb.loc, lane); }
#pragma unroll 1
    while (t < (unsigned)MQ_TILES) {
        if (tid == 0) slot[(i + 1) & 1] = mq_grab(q, stop, stop_val);
        tr_store_f8(va, 64.0f, ja.K, ja.N, ja.nblk, ja.loc, ja.WT, scr, lane, ja.rm);
        __syncthreads();
        const unsigned tn = slot[(i + 1) & 1];
        if (tn < (unsigned)MQ_TILES) { ja = moe_job((int)tn + 2 * wave, wg, wu, wd, ws); tr_load(va, ja.W, ja.ldw, ja.N, ja.nblk, ja.loc, lane); }
        tr_store_f8(vb, 64.0f, jb.K, jb.N, jb.nblk, jb.loc, jb.WT, scr, lane, jb.rm);
        if (tn < (unsigned)MQ_TILES) { jb = moe_job((int)tn + 2 * wave + 1, wg, wu, wd, ws); tr_load(vb, jb.W, jb.ldw, jb.N, jb.nblk, jb.loc, lane); }
        t = tn; ++i;
    }
}
struct LayerPtrs {
    const float *g_mix, *na_q_gain, *na_k_gain, *na_rel_bias, *gla_w_up, *gla_b, *gla_norm, *conv_w, *a_log, *dt_bias, *gdn_norm, *lb_raw0, *lb_raw1, *hg_norm, *mem_q_gain, *g_ffn;
};
__device__ __forceinline__ void prep_unit(int L, const LayerPtrs& lp, const LAS float* glaw, bf16* P, float* GLG, bf16* GQ, float* GAB, bf16* HQ, float* HF, bf16* NAVT, int t0, int lane) {
    const int b = t0 >> 12, s0 = t0 & 4095;
    const float* bb_ = lp.gla_b + (lane >> 5) * 256 + (lane & 31) * 8; const f32x4 glb0 = *(const f32x4*)bb_, glb1 = *(const f32x4*)(bb_ + 4);
    const float ealog = __expf(lp.a_log[lane & 7]), dtb = lp.dt_bias[lane & 7];
    float lbv[2][8];
#pragma unroll
    for (int d = 0; d < 2; ++d)
#pragma unroll
        for (int i = 0; i < 8; ++i) { const int c = d * 512 + lane * 8 + i; lbv[d][i] = L ? sigmf(lp.lb_raw1[c] - lp.lb_raw0[c]) : 0.f; }
#pragma unroll 1
    for (int tt = 0; tt < 8; ++tt) { bf16* pr = P + (size_t)(t0 + tt) * LDP;
        const v4u rq = *(const v4u*)(pr + C_NAQ + lane * 8), rk = *(const v4u*)(pr + C_NAK + lane * 8), rm = *(const v4u*)(pr + C_MQ + lane * 8), rh = *(const v4u*)(pr + C_HGQ + lane * 8),
                  rf0 = *(const v4u*)(pr + C_HGF + lane * 8), rf1 = *(const v4u*)(pr + C_HGF + 512 + lane * 8), rl0 = *(const v4u*)(pr + C_GLLR + (lane >> 5) * 16), rl1 = *(const v4u*)(pr + C_GLLR + (lane >> 5) * 16 + 8);
        const bf16 ra = pr[C_GDA + (lane & 15)];
#pragma unroll
        for (int qk = 0; qk < 2; ++qk) { bf16* p = pr + (qk ? C_NAK : C_NAQ) + lane * 8; float f[8]; unpack8(qk ? rk : rq, f);
            float ss = 0.f;
#pragma unroll
            for (int i = 0; i < 8; ++i) ss += f[i] * f[i];
            ss = group_sum<8>(ss); const float sc = rsqrtf(ss * (1.0f / 64.0f) + RMS_EPS) * (qk ? 1.0f : 0.125f);
            const float* gn = (qk ? lp.na_k_gain : lp.na_q_gain) + (lane & 7) * 8;
#pragma unroll
            for (int i = 0; i < 8; ++i) f[i] = f[i] * sc * gn[i];
            *(v4u*)p = pack8(f); }
        { bf16* p = pr + C_MQ + lane * 8; float f[8]; unpack8(rm, f); float ss = 0.f;
#pragma unroll
            for (int i = 0; i < 8; ++i) ss += f[i] * f[i];
            ss = group_sum<16>(ss); const float sc = rsqrtf(ss * (1.0f / 128.0f) + RMS_EPS) * 0.08838834764831845f; const float* gn = lp.mem_q_gain + (lane & 15) * 8;
#pragma unroll
            for (int i = 0; i < 8; ++i) f[i] = f[i] * sc * gn[i];
            *(v4u*)p = pack8(f); }
        { float f[8]; unpack8(rh, f);
#pragma unroll
            for (int i = 0; i < 8; ++i) f[i] = siluf(f[i]);
            *(v4u*)(HQ + (size_t)(t0 + tt) * 512 + lane * 8) = pack8(f);
#pragma unroll
            for (int d = 0; d < 2; ++d) { float z[8]; unpack8(d ? rf1 : rf0, z); float o[8];
#pragma unroll
                for (int i = 0; i < 8; ++i) { if (L) { const float lb = lbv[d][i]; o[i] = __logf(lb + (1.0f - lb) * sigmf(z[i])); } else o[i] = -softplusf(-z[i]); }
                float* hf = HF + (size_t)(t0 + tt) * 1024 + d * 512 + lane * 8;
                *(f32x4*)hf = (f32x4){o[0], o[1], o[2], o[3]}; *(f32x4*)(hf + 4) = (f32x4){o[4], o[5], o[6], o[7]}; } }
        { const int dir = lane >> 5, c8 = (lane & 31) * 8; float lr[16];
            { float t8[8]; unpack8(rl0, t8);
#pragma unroll
              for (int i = 0; i < 8; ++i) lr[i] = t8[i];
              unpack8(rl1, t8);
#pragma unroll
              for (int i = 0; i < 8; ++i) lr[8 + i] = t8[i]; }
            f32x4 a0 = glb0, a1 = glb1;
            int c8l = c8; asm volatile("" : "+v"(c8l));
#pragma unroll
            for (int r = 0; r < 16; ++r) { const LAS float* wp = glaw + (dir * 16 + r) * 256 + c8l; a0 = a0 + lr[r] * *(const LAS f32x4*)wp; a1 = a1 + lr[r] * *(const LAS f32x4*)(wp + 4); }
            f32x4 g0, g1;
#pragma unroll
            for (int i = 0; i < 4; ++i) { g0[i] = -softplusf(-a0[i]) * 0.0625f; g1[i] = -softplusf(-a1[i]) * 0.0625f; }
            float* gp = GLG + (size_t)(t0 + tt) * 512 + dir * 256 + c8; *(f32x4*)gp = g0; *(f32x4*)(gp + 4) = g1; }
        if (lane < 16) { const float val = bf1(ra); float o;
            if (lane < 8) o = -ealog * softplusf(val + dtb); else o = sigmf(val);
            GAB[(size_t)(t0 + tt) * 16 + lane] = o; }
    }
#pragma unroll 1
    for (int j = 0; j < 3; ++j) { const int col = j * 512 + lane * 8; float w[5][8];
#pragma unroll
        for (int tap = 0; tap < 5; ++tap) { const float* wp = lp.conv_w + tap * 1536 + col; const f32x4 w0 = *(const f32x4*)wp, w1 = *(const f32x4*)(wp + 4);
            w[tap][0] = w0[0]; w[tap][1] = w0[1]; w[tap][2] = w0[2]; w[tap][3] = w0[3]; w[tap][4] = w1[0]; w[tap][5] = w1[1]; w[tap][6] = w1[2]; w[tap][7] = w1[3]; }
#pragma unroll 1
        for (int hf = 0; hf < 2; ++hf) {
        v4u xr[8];
#pragma unroll
        for (int r = 0; r < 8; ++r) { const int s = s0 + hf * 4 + r - 2; xr[r] = (v4u){0u, 0u, 0u, 0u}; if (s >= 0 && s < SEQ) xr[r] = *(const v4u*)(P + (size_t)((b << 12) + s) * LDP + C_GDQKV + col); }
#pragma unroll
        for (int t4 = 0; t4 < 4; ++t4) { const int tt = hf * 4 + t4; float acc[8]; __builtin_amdgcn_sched_barrier(0);
#pragma unroll
            for (int i = 0; i < 8; ++i) acc[i] = 0.f;
#pragma unroll
            for (int tap = 0; tap < 5; ++tap) { float x[8]; unpack8(xr[t4 + tap], x);
#pragma unroll
                for (int i = 0; i < 8; ++i) acc[i] += w[tap][i] * x[i]; }
#pragma unroll
            for (int i = 0; i < 8; ++i) acc[i] = siluf(acc[i]);
            if (j < 2) { float ss = 0.f;
#pragma unroll
                for (int i = 0; i < 8; ++i) ss += acc[i] * acc[i];
                ss = group_sum<16>(ss); const float sc = rsqrtf(ss + 1e-6f) * (j == 0 ? 0.08838834764831845f : 1.0f);
#pragma unroll
                for (int i = 0; i < 8; ++i) acc[i] *= sc; }
            *(v4u*)(GQ + (size_t)(t0 + tt) * 1536 + col) = pack8(acc); } } }
    { unsigned vw[8][4];
#pragma unroll
        for (int tt = 0; tt < 8; ++tt) { const v4u x = *(const v4u*)(P + (size_t)(t0 + tt) * LDP + C_NAV + lane * 8); vw[tt][0] = x.x; vw[tt][1] = x.y; vw[tt][2] = x.z; vw[tt][3] = x.w; }
#pragma unroll
        for (int i = 0; i < 8; ++i) { unsigned e[8];
#pragma unroll
            for (int tt = 0; tt < 8; ++tt) e[tt] = (i & 1) ? (vw[tt][i >> 1] >> 16) : (vw[tt][i >> 1] & 0xffffu);
            v4u o; o.x = e[0] | (e[1] << 16); o.y = e[2] | (e[3] << 16); o.z = e[4] | (e[5] << 16); o.w = e[6] | (e[7] << 16);
            *(v4u*)(NAVT + ((size_t)((b * 8 + (lane >> 3)) * 64 + (lane & 7) * 8 + i)) * SEQ + s0) = o; } }
}
__device__ __forceinline__ void post_token(const LayerPtrs& lp, const bf16* P, const bf16* SOUT, bf16* BR, int t, int lane) {
    const bf16* pr = P + (size_t)t * LDP;
#pragma unroll
    for (int br = 0; br < 3; ++br) {
        float a[8], c[8], og[8];
        unpack8(*(const v4u*)(SOUT + ((size_t)(br * 2 + 0) * NT + t) * 512 + lane * 8), a);
        unpack8(*(const v4u*)(SOUT + ((size_t)(br * 2 + 1) * NT + t) * 512 + lane * 8), c);
        unpack8(*(const v4u*)(pr + (br == 0 ? C_GLOG : br == 1 ? C_GDOG : C_HGOG) + lane * 8), og);
        const float qs = br == 0 ? 0.125f : 1.0f; float ss = 0.f;
#pragma unroll
        for (int i = 0; i < 8; ++i) { a[i] = (a[i] + c[i]) * qs; ss += a[i] * a[i]; }
        ss = group_sum<16>(ss); const float sc = rsqrtf(ss * (1.0f / 128.0f) + RMS_EPS);
        const float* gn = (br == 0 ? lp.gla_norm : br == 1 ? lp.gdn_norm : lp.hg_norm) + (lane & 15) * 8;
#pragma unroll
        for (int i = 0; i < 8; ++i) a[i] = a[i] * sc * gn[i] * (br == 2 ? sigmf(og[i]) : siluf(og[i]));
        *(v4u*)(BR + ((size_t)(1 + br) * NT + t) * 512 + lane * 8) = pack8(a);
    }
}
typedef short bf16x8 __attribute__((ext_vector_type(8)));
__device__ __forceinline__ bf16x8 as_bf16x8(v4u w) { return __builtin_bit_cast(bf16x8, w); }
#define MFMA16(a, b, c) __builtin_amdgcn_mfma_f32_16x16x32_bf16((a), (b), (c), 0, 0, 0)
typedef short bf16x4 __attribute__((ext_vector_type(4)));
__device__ __forceinline__ bf16x4 as_bf16x4(v2u w) { return __builtin_bit_cast(bf16x4, w); }
#define MFMA16K16(a, b, c) __builtin_amdgcn_mfma_f32_16x16x16bf16_1k((a), (b), (c), 0, 0, 0)
__device__ __forceinline__ void na_wave_unit(const bf16* P, const bf16* NAVT, const float* rel_bias, bf16* BR0, int b, int h, int r, int qc, int lane) {
    const int fr = lane & 15, g = lane >> 4; const int c = qc * 16 + fr;
    const int kc_lo = qc == 0 ? 0 : qc == 1 ? 8 : qc == 2 ? 24 : 32;
    const int cs = min(max(c - 8, 0), 48), rbase = min(max(r - 4, 0), 56);
    const size_t tq = (size_t)(b << 12) + r * 64 + c;
    bf16x8 qf[2];
#pragma unroll
    for (int ks = 0; ks < 2; ++ks) qf[ks] = as_bf16x8(*(const v4u*)(P + tq * LDP + C_NAQ + h * 64 + ks * 32 + g * 8));
    f32x4 s[8][2]; float mx = -3.0e38f;
    v4u kf[8][2][2];
#pragma unroll
    for (int i = 0; i < 8; ++i)
#pragma unroll
        for (int kt = 0; kt < 2; ++kt) { const bf16* kp = P + ((size_t)(b << 12) + (rbase + i) * 64 + kc_lo + (fr >> 2) * 8 + kt * 4 + (fr & 3)) * LDP + C_NAK + h * 64 + g * 8; kf[i][kt][0] = *(const v4u*)kp; kf[i][kt][1] = *(const v4u*)(kp + 32); }
#pragma unroll
    for (int i = 0; i < 8; ++i) { const float* bp = rel_bias + (h * 15 + (rbase + i - r + 7)) * 31;
#pragma unroll
        for (int kt = 0; kt < 2; ++kt) {
            f32x4 a = {0.f, 0.f, 0.f, 0.f}; a = MFMA16(as_bf16x8(kf[i][kt][0]), qf[0], a); a = MFMA16(as_bf16x8(kf[i][kt][1]), qf[1], a);
            const int ck0 = kc_lo + 8 * g + 4 * kt, dc0 = ck0 - c + 15, dcl = min(max(dc0, 0), 27); const f32x4 b4 = *(const f32x4*)(bp + dcl);
#pragma unroll
            for (int jj = 0; jj < 4; ++jj) { const int ck = ck0 + jj; const bool inw = (ck >= cs) && (ck < cs + 16); const int sh = dc0 + jj - dcl;
                const float bv = sh == 0 ? b4[0] : sh == 1 ? b4[1] : sh == 2 ? b4[2] : b4[3];
                a[jj] = inw ? a[jj] + bv : -1.0e30f; mx = fmaxf(mx, a[jj]); }
            s[i][kt] = a; } }
    mx = fmaxf(mx, __shfl_xor(mx, 16)); mx = fmaxf(mx, __shfl_xor(mx, 32));
    float l = 0.f;
#pragma unroll
    for (int i = 0; i < 8; ++i)
#pragma unroll
        for (int kt = 0; kt < 2; ++kt)
#pragma unroll
            for (int jj = 0; jj < 4; ++jj) { const float p = __expf(s[i][kt][jj] - mx); s[i][kt][jj] = p; l += p; }
    l += __shfl_xor(l, 16); l += __shfl_xor(l, 32);
    f32x4 o[4];
#pragma unroll
    for (int dt = 0; dt < 4; ++dt) o[dt] = (f32x4){0.f, 0.f, 0.f, 0.f};
#pragma unroll
    for (int hh = 0; hh < 2; ++hh) { v4u vv[4][4];
#pragma unroll
        for (int i4 = 0; i4 < 4; ++i4)
#pragma unroll
            for (int dt = 0; dt < 4; ++dt) { const bf16* vp = NAVT + ((size_t)((b * 8 + h) * 64 + dt * 16 + fr)) * SEQ + (rbase + hh * 4 + i4) * 64 + kc_lo + 8 * g; vv[i4][dt] = *(const v4u*)vp; }
#pragma unroll
        for (int i4 = 0; i4 < 4; ++i4) { const int i = hh * 4 + i4; v4u pw; pw.x = pkbf(s[i][0][0], s[i][0][1]); pw.y = pkbf(s[i][0][2], s[i][0][3]); pw.z = pkbf(s[i][1][0], s[i][1][1]); pw.w = pkbf(s[i][1][2], s[i][1][3]);
            const bf16x8 pf = as_bf16x8(pw);
#pragma unroll
            for (int dt = 0; dt < 4; ++dt) o[dt] = MFMA16(as_bf16x8(vv[i4][dt]), pf, o[dt]); } }
    const float inv = 1.0f / l;
#pragma unroll
    for (int dt = 0; dt < 4; ++dt) { v2u w; w.x = pkbf(o[dt][0] * inv, o[dt][1] * inv); w.y = pkbf(o[dt][2] * inv, o[dt][3] * inv);
        *(v2u*)(BR0 + tq * 512 + h * 64 + dt * 16 + 4 * g) = w; }
}
__device__ __forceinline__ void mem_wave_unit(const bf16* P, const bf16* MK, const bf16* MVT, bf16* BR4, int t0, int h, int lane) {
    const int fr = lane & 15, g = lane >> 4, b = t0 >> 12; const size_t tq = (size_t)t0 + fr;
    bf16x8 qf[4];
#pragma unroll
    for (int ks = 0; ks < 4; ++ks) qf[ks] = as_bf16x8(*(const v4u*)(P + tq * LDP + C_MQ + h * 128 + ks * 32 + g * 8));
    f32x4 s[16]; float mx = -3.0e38f;
#pragma unroll
    for (int m4 = 0; m4 < 2; ++m4) { v4u kf[8][4];
#pragma unroll
        for (int mm = 0; mm < 8; ++mm)
#pragma unroll
            for (int ks = 0; ks < 4; ++ks) kf[mm][ks] = *(const v4u*)(MK + ((size_t)(b * 256 + (m4 * 8 + mm) * 16 + fr)) * 512 + h * 128 + g * 8 + ks * 32);
#pragma unroll
        for (int mm = 0; mm < 8; ++mm) { f32x4 a = {0.f, 0.f, 0.f, 0.f};
#pragma unroll
            for (int ks = 0; ks < 4; ++ks) a = MFMA16(as_bf16x8(kf[mm][ks]), qf[ks], a);
#pragma unroll
            for (int jj = 0; jj < 4; ++jj) mx = fmaxf(mx, a[jj]);
            s[m4 * 8 + mm] = a; } }
    mx = fmaxf(mx, __shfl_xor(mx, 16)); mx = fmaxf(mx, __shfl_xor(mx, 32));
    float l = 0.f;
#pragma unroll
    for (int mt = 0; mt < 16; ++mt)
#pragma unroll
        for (int jj = 0; jj < 4; ++jj) { const float p = __expf(s[mt][jj] - mx); s[mt][jj] = p; l += p; }
    l += __shfl_xor(l, 16); l += __shfl_xor(l, 32);
    f32x4 o[8];
#pragma unroll
    for (int dt = 0; dt < 8; ++dt) o[dt] = (f32x4){0.f, 0.f, 0.f, 0.f};
#pragma unroll
    for (int k4 = 0; k4 < 4; ++k4) { v2u vv[2][8][2];
#pragma unroll
        for (int k2 = 0; k2 < 2; ++k2)
#pragma unroll
            for (int dt = 0; dt < 8; ++dt) { const bf16* vp = MVT + ((size_t)((b * 4 + h) * 128 + dt * 16 + fr)) * 256 + (k4 * 2 + k2) * 32 + 4 * g; vv[k2][dt][0] = *(const v2u*)vp; vv[k2][dt][1] = *(const v2u*)(vp + 16); }
#pragma unroll
        for (int k2 = 0; k2 < 2; ++k2) { const int kb = k4 * 2 + k2; v4u pw; pw.x = pkbf(s[2 * kb][0], s[2 * kb][1]); pw.y = pkbf(s[2 * kb][2], s[2 * kb][3]); pw.z = pkbf(s[2 * kb + 1][0], s[2 * kb + 1][1]); pw.w = pkbf(s[2 * kb + 1][2], s[2 * kb + 1][3]);
            const bf16x8 pf = as_bf16x8(pw);
#pragma unroll
            for (int dt = 0; dt < 8; ++dt) { v4u vw; vw.x = vv[k2][dt][0].x; vw.y = vv[k2][dt][0].y; vw.z = vv[k2][dt][1].x; vw.w = vv[k2][dt][1].y; o[dt] = MFMA16(as_bf16x8(vw), pf, o[dt]); } } }
    const float inv = 1.0f / l;
#pragma unroll
    for (int dt = 0; dt < 8; ++dt) { v2u w; w.x = pkbf(o[dt][0] * inv, o[dt][1] * inv); w.y = pkbf(o[dt][2] * inv, o[dt][3] * inv);
        *(v2u*)(BR4 + tq * 512 + h * 128 + dt * 16 + 4 * g) = w; }
}
__device__ __forceinline__ void mem_wg_unit(LAS unsigned char* ring, const bf16* P, const bf16* MK, const bf16* MVT, bf16* BR4, int t0, int h, int wave, int lane, int tid) {
    const int fr = lane & 15, g = lane >> 4, b = t0 >> 12;
    { const bf16* ksrc = MK + (size_t)(b * 256) * 512 + h * 128;
#pragma unroll
      for (int i = 0; i < 8; ++i) { const int idx = i * 512 + tid, key = idx >> 4, c = idx & 15; const v4u w = *(const v4u*)(ksrc + (size_t)key * 512 + c * 8); *(LAS v4u*)(ring + key * 256 + ((c ^ (key & 15)) << 4)) = w; }
      const bf16* vsrc = MVT + (size_t)((b * 4 + h) * 128) * 256;
#pragma unroll
      for (int i = 0; i < 2; ++i) { const int idx = i * 512 + tid, d = idx >> 3, kb = idx & 7; const v4u* p = (const v4u*)(vsrc + (size_t)d * 256 + kb * 32); const v4u u0 = p[0], u1 = p[1], u2 = p[2], u3 = p[3];
          LAS unsigned char* row = ring + 65536 + d * 512; const int sw = d & 15;
          v4u c0, c1, c2, c3; c0.x = u0.x; c0.y = u0.y; c0.z = u2.x; c0.w = u2.y; c1.x = u0.z; c1.y = u0.w; c1.z = u2.z; c1.w = u2.w; c2.x = u1.x; c2.y = u1.y; c2.z = u3.x; c2.w = u3.y; c3.x = u1.z; c3.y = u1.w; c3.z = u3.z; c3.w = u3.w;
          *(LAS v4u*)(row + (((kb * 4 + 0) ^ sw) << 4)) = c0; *(LAS v4u*)(row + (((kb * 4 + 1) ^ sw) << 4)) = c1; *(LAS v4u*)(row + (((kb * 4 + 2) ^ sw) << 4)) = c2; *(LAS v4u*)(row + (((kb * 4 + 3) ^ sw) << 4)) = c3; } }
    __syncthreads();
#pragma unroll 1
    for (int sub = 0; sub < 2; ++sub) { const size_t tq = (size_t)t0 + sub * 128 + wave * 16 + fr;
        int fo = fr; asm volatile("" : "+v"(fo));
        bf16x8 qf[4];
#pragma unroll
        for (int ks = 0; ks < 4; ++ks) qf[ks] = as_bf16x8(*(const v4u*)(P + tq * LDP + C_MQ + h * 128 + ks * 32 + g * 8));
        f32x4 s[16]; float mx = -3.0e38f;
#pragma unroll
        for (int mt = 0; mt < 16; ++mt) { f32x4 a = {0.f, 0.f, 0.f, 0.f}; const LAS unsigned char* kr = ring + (mt * 16 + fo) * 256;
#pragma unroll
            for (int ks = 0; ks < 4; ++ks) a = MFMA16(as_bf16x8(*(const LAS v4u*)(kr + (((ks * 4 + g) ^ fo) << 4))), qf[ks], a);
#pragma unroll
            for (int jj = 0; jj < 4; ++jj) mx = fmaxf(mx, a[jj]);
            s[mt] = a; }
        mx = fmaxf(mx, __shfl_xor(mx, 16)); mx = fmaxf(mx, __shfl_xor(mx, 32));
        float l = 0.f;
#pragma unroll
        for (int mt = 0; mt < 16; ++mt)
#pragma unroll
            for (int jj = 0; jj < 4; ++jj) { const float p = __expf(s[mt][jj] - mx); s[mt][jj] = p; l += p; }
        l += __shfl_xor(l, 16); l += __shfl_xor(l, 32);
        f32x4 o[8];
#pragma unroll
        for (int dt = 0; dt < 8; ++dt) o[dt] = (f32x4){0.f, 0.f, 0.f, 0.f};
#pragma unroll
        for (int kb = 0; kb < 8; ++kb) { v4u pw; pw.x = pkbf(s[2 * kb][0], s[2 * kb][1]); pw.y = pkbf(s[2 * kb][2], s[2 * kb][3]); pw.z = pkbf(s[2 * kb + 1][0], s[2 * kb + 1][1]); pw.w = pkbf(s[2 * kb + 1][2], s[2 * kb + 1][3]);
            const bf16x8 pf = as_bf16x8(pw);
#pragma unroll
            for (int dt = 0; dt < 8; ++dt) o[dt] = MFMA16(as_bf16x8(*(const LAS v4u*)(ring + 65536 + (dt * 16 + fo) * 512 + (((kb * 4 + g) ^ fo) << 4))), pf, o[dt]); }
        const float inv = 1.0f / l;
#pragma unroll
        for (int dt = 0; dt < 8; ++dt) { v2u w; w.x = pkbf(o[dt][0] * inv, o[dt][1] * inv); w.y = pkbf(o[dt][2] * inv, o[dt][3] * inv);
            *(v2u*)(BR4 + tq * 512 + h * 128 + dt * 16 + 4 * g) = w; }
    }
}
#define CH_TOK(n, i) ((size_t)(dir ? (SEQ - 1 - ((n) * 16 + (i))) : ((n) * 16 + (i))))
__device__ __forceinline__ bf16 tobf(float x) { return (bf16)(pkbf(x, 0.f) & 0xffffu); }
constexpr size_t OA_GW = 0, OA_GU = 32 * MiB, OA_GKT = 64 * MiB, OA_GP = 96 * MiB, OA_GS = 100 * MiB, OA_HQD = 104 * MiB, OA_HKDT = 136 * MiB, OA_HP = 168 * MiB, OA_HV = 172 * MiB,
                 OA_LQD = 184 * MiB, OA_LKDT = 200 * MiB, OA_LP = 216 * MiB, OA_LV = 220 * MiB, OA_END = 226 * MiB;
struct DiagSrc { const bf16* q; int qp; const bf16* k; int kp; const float* lg; int lgp; const bf16* v; int vp; };
template <int K, int HG> __device__ __forceinline__ void s1_diag(LAS unsigned char* scr, const DiagSrc& S, int dir, int n, bf16* QD, bf16* KDT, bf16* PP, float* EB, int lane) {
    constexpr int NK = K / 64, LPI = K + 8;
    LAS bf16* QDs = (LAS bf16*)scr; LAS bf16* KDs = QDs + 16 * LPI;
#pragma unroll
    for (int c = 0; c < NK; ++c) { const int k = lane + 64 * c; float bi[16], lgv[16]; float b = 0.f;
#pragma unroll
        for (int i = 0; i < 16; ++i) { lgv[i] = S.lg[CH_TOK(n, i) * S.lgp + k]; b += lgv[i]; bi[i] = b; }
        unsigned kdw[8];
#pragma unroll
        for (int i = 0; i < 16; ++i) { const size_t tok = CH_TOK(n, i); const float qv = bf1(S.q[tok * S.qp + k]); float kv;
            if (HG) kv = 1.0f - __expf(lgv[i]); else kv = bf1(S.k[tok * S.kp + k]);
            const bf16 qh = tobf(qv * __expf(bi[i])), kh = tobf(kv * __expf(-bi[i]));
            QD[i * K + k] = qh; QDs[i * LPI + k] = qh; KDs[i * LPI + k] = kh;
            if (i & 1) kdw[i >> 1] |= ((unsigned)kh) << 16; else kdw[i >> 1] = kh; }
        *(v4u*)(KDT + k * 16) = (v4u){kdw[0], kdw[1], kdw[2], kdw[3]}; *(v4u*)(KDT + k * 16 + 8) = (v4u){kdw[4], kdw[5], kdw[6], kdw[7]};
        EB[k] = __expf(bi[15]); }
    LDS_WAIT(); asm volatile("" ::: "memory");
    const int fr = lane & 15, g = lane >> 4; f32x4 acc = {0.f, 0.f, 0.f, 0.f};
#pragma unroll
    for (int ks = 0; ks < K / 32; ++ks) { const bf16x8 qf = as_bf16x8(*(const LAS v4u*)(QDs + fr * LPI + 32 * ks + 8 * g)), kf = as_bf16x8(*(const LAS v4u*)(KDs + fr * LPI + 32 * ks + 8 * g)); acc = MFMA16(qf, kf, acc); }
#pragma unroll
    for (int jj = 0; jj < 4; ++jj) { const int i = 4 * g + jj; PP[i * 16 + fr] = tobf(fr <= i ? acc[jj] : 0.f); }
    LDS_WAIT(); asm volatile("" ::: "memory");
}
#define S2_BAR() do { asm volatile("s_waitcnt lgkmcnt(0)" ::: "memory"); __builtin_amdgcn_s_barrier(); asm volatile("" ::: "memory"); } while (0)
template <int K> struct DiagStage { v4u qd[K / 64], kdt[K / 64], v[2], p, eb; };
template <int K> struct DiagLds { static constexpr int QP = 2 * K + 16, LQD = 0, LKDT = 64 * QP, LV = LKDT + 4 * K * 32, LP = LV + 64 * 256, LEB = LP + 2048, BYTES = LEB + 4 * K * 4; };
template <int K> __device__ __forceinline__ void s2d_load(DiagStage<K>& R, const bf16* QD0, const bf16* KDT0, const bf16* PP0, const float* EB0, const bf16* vsrc, int vp, int dir, int grp, int tid) {
    const size_t c0 = (size_t)grp * 4;
#pragma unroll
    for (int j = 0; j < K / 64; ++j) { const int e = tid + 512 * j; R.qd[j] = *(const v4u*)(QD0 + c0 * 16 * K + (size_t)e * 8); R.kdt[j] = *(const v4u*)(KDT0 + c0 * 16 * K + (size_t)e * 8); }
#pragma unroll
    for (int j = 0; j < 2; ++j) { const int e = tid + 512 * j, row = e >> 4, col = e & 15; R.v[j] = *(const v4u*)(vsrc + CH_TOK(grp * 4 + (row >> 4), row & 15) * vp + col * 8); }
    if (tid < 128) R.p = *(const v4u*)(PP0 + c0 * 256 + tid * 8);
    else if (tid < 128 + K) R.eb = *(const v4u*)(EB0 + c0 * K + (tid - 128) * 4);
}
template <int K> __device__ __forceinline__ void s2d_store(const DiagStage<K>& R, LAS unsigned char* lds, int tid) {
    typedef DiagLds<K> L;
#pragma unroll
    for (int j = 0; j < K / 64; ++j) { const int e = tid + 512 * j, row = e / (K / 8), col = e % (K / 8); *(LAS v4u*)(lds + L::LQD + row * L::QP + col * 16) = R.qd[j]; *(LAS v4u*)(lds + L::LKDT + e * 16) = R.kdt[j]; }
#pragma unroll
    for (int j = 0; j < 2; ++j) { const int e = tid + 512 * j; *(LAS v4u*)(lds + L::LV + e * 16) = R.v[j]; }
    if (tid < 128) *(LAS v4u*)(lds + L::LP + tid * 16) = R.p;
    else if (tid < 128 + K) *(LAS v4u*)(lds + L::LEB + (tid - 128) * 16) = R.eb;
}
template <int K> __device__ __forceinline__ void s2d_chunk(LAS unsigned char* lds, int c, f32x4 (&S)[K / 16], bf16* osrc, int op, int dir, int n, int vt, int lane) {
    typedef DiagLds<K> L; const int fr = lane & 15, g = lane >> 4;
    f32x4 o = {0.f, 0.f, 0.f, 0.f};
#pragma unroll
    for (int ks = 0; ks < K / 32; ++ks) { const LAS unsigned char* qp = lds + L::LQD + (c * 16 + fr) * L::QP + (32 * ks + 4 * g) * 2; const v2u a = *(const LAS v2u*)qp, b = *(const LAS v2u*)(qp + 32);
        v4u sb; sb.x = pkbf(S[2 * ks][0], S[2 * ks][1]); sb.y = pkbf(S[2 * ks][2], S[2 * ks][3]); sb.z = pkbf(S[2 * ks + 1][0], S[2 * ks + 1][1]); sb.w = pkbf(S[2 * ks + 1][2], S[2 * ks + 1][3]);
        o = MFMA16(as_bf16x8((v4u){a.x, a.y, b.x, b.y}), as_bf16x8(sb), o); }
    unsigned vr[4];
#pragma unroll
    for (int jj = 0; jj < 4; ++jj) vr[jj] = *(const LAS unsigned short*)(lds + L::LV + ((c * 16 + 4 * g + jj) * 128 + vt * 16 + fr) * 2);
    const bf16x8 vf = as_bf16x8((v4u){vr[0] | (vr[1] << 16), vr[2] | (vr[3] << 16), 0u, 0u});
    { const v2u pp = *(const LAS v2u*)(lds + L::LP + (c * 256 + fr * 16 + 4 * g) * 2); o = MFMA16(as_bf16x8((v4u){pp.x, pp.y, 0u, 0u}), vf, o); }
#pragma unroll
    for (int kt = 0; kt < K / 16; ++kt) { const v2u kd = *(const LAS v2u*)(lds + L::LKDT + ((c * K + kt * 16 + fr) * 16 + 4 * g) * 2); const f32x4 eb = *(const LAS f32x4*)(lds + L::LEB + (c * K + kt * 16 + 4 * g) * 4);
        S[kt] = MFMA16(as_bf16x8((v4u){kd.x, kd.y, 0u, 0u}), vf, S[kt]); S[kt] = S[kt] * eb; }
#pragma unroll
    for (int jj = 0; jj < 4; ++jj) osrc[CH_TOK(n, 4 * g + jj) * op + vt * 16 + fr] = tobf(o[jj]);
}
template <int K> __device__ __forceinline__ void s2_diag(LAS unsigned char* lds, const bf16* QD0, const bf16* KDT0, const bf16* PP0, const float* EB0, const bf16* vsrc, int vp, bf16* osrc, int op, int dir, int vt, int lane, int tid) {
    static_assert(DiagLds<K>::BYTES <= RING_BYTES, "S2 LDS");
    f32x4 S[K / 16];
#pragma unroll
    for (int kt = 0; kt < K / 16; ++kt) S[kt] = (f32x4){0.f, 0.f, 0.f, 0.f};
    DiagStage<K> Ra, Rb;
    s2d_load<K>(Ra, QD0, KDT0, PP0, EB0, vsrc, vp, dir, 0, tid); s2d_load<K>(Rb, QD0, KDT0, PP0, EB0, vsrc, vp, dir, 1, tid);
#pragma unroll 1
    for (int grp = 0; grp < SEQ / 64; grp += 2) {
        S2_BAR(); s2d_store<K>(Ra, lds, tid); S2_BAR();
        s2d_load<K>(Ra, QD0, KDT0, PP0, EB0, vsrc, vp, dir, grp + 2 < SEQ / 64 ? grp + 2 : grp, tid);
#pragma unroll 2
        for (int c = 0; c < 4; ++c) s2d_chunk<K>(lds, c, S, osrc, op, dir, grp * 4 + c, vt, lane);
        S2_BAR(); s2d_store<K>(Rb, lds, tid); S2_BAR();
        s2d_load<K>(Rb, QD0, KDT0, PP0, EB0, vsrc, vp, dir, grp + 3 < SEQ / 64 ? grp + 3 : grp + 1, tid);
#pragma unroll 2
        for (int c = 0; c < 4; ++c) s2d_chunk<K>(lds, c, S, osrc, op, dir, (grp + 1) * 4 + c, vt, lane);
    }
    S2_BAR();
}
__device__ __forceinline__ void s1_gdn(LAS unsigned char* scr, const bf16* GQb, const float* GABb, int h, int dir, int n, bf16* GW, bf16* GU, bf16* GKT, bf16* GP, float* GS, int lane) {
    const int fr = lane & 15, g = lane >> 4;
    LAS float* AT = (LAS float*)scr;
    float c[16], be[16]; float cs = 0.f;
#pragma unroll
    for (int i = 0; i < 16; ++i) { const size_t tok = CH_TOK(n, i); cs += GABb[tok * 16]; c[i] = cs; be[i] = GABb[tok * 16 + 8]; }
    const size_t tr = CH_TOK(n, fr);
    f32x4 kk = {0.f, 0.f, 0.f, 0.f}, qk = {0.f, 0.f, 0.f, 0.f};
#pragma unroll
    for (int ks = 0; ks < 4; ++ks) { const bf16x8 kf = as_bf16x8(*(const v4u*)(GQb + tr * 1536 + 512 + h * 128 + 32 * ks + 8 * g)), qf = as_bf16x8(*(const v4u*)(GQb + tr * 1536 + h * 128 + 32 * ks + 8 * g));
        kk = MFMA16(kf, kf, kk); qk = MFMA16(qf, kf, qk); }
    float cj = 0.f;
#pragma unroll
    for (int i = 0; i < 16; ++i) cj = (fr == i) ? c[i] : cj;
    f32x4 av;
#pragma unroll
    for (int jj = 0; jj < 4; ++jj) { float ci = 0.f, bi = 0.f;
#pragma unroll
        for (int gg = 0; gg < 4; ++gg) { ci = (g == gg) ? c[4 * gg + jj] : ci; bi = (g == gg) ? be[4 * gg + jj] : bi; }
        const int i = 4 * g + jj; const float dec = __expf(ci - cj);
        av[jj] = (fr < i) ? bi * kk[jj] * dec : 0.f;
        GP[i * 16 + fr] = tobf(fr <= i ? qk[jj] * dec : 0.f); }
    *(LAS f32x4*)(AT + fr * 16 + 4 * g) = av;
    if (lane < 16) { GS[lane] = __expf(cj); GS[16 + lane] = __expf(c[15] - cj); } if (lane == 16) GS[32] = __expf(c[15]);
    LDS_WAIT(); asm volatile("" ::: "memory");
    float t[16];
#pragma unroll
    for (int j = 15; j >= 0; --j) { float a = (fr == j) ? 1.f : 0.f;
        if (j < 15) { f32x4 col[4];
#pragma unroll
            for (int q4 = 0; q4 < 4; ++q4) col[q4] = *(const LAS f32x4*)(AT + j * 16 + 4 * q4);
#pragma unroll
            for (int i = j + 1; i < 16; ++i) a -= t[i] * col[i >> 2][i & 3]; }
        t[j] = a; }
    float tf[4];
#pragma unroll
    for (int e = 0; e < 4; ++e) { float x = 0.f;
#pragma unroll
        for (int gg = 0; gg < 4; ++gg) x = (g == gg) ? t[4 * gg + e] : x;
        tf[e] = x; }
    const bf16x8 tfrag = as_bf16x8((v4u){pkbf(tf[0], tf[1]), pkbf(tf[2], tf[3]), 0u, 0u});
    float bj[4], bgj[4]; size_t tj[4];
#pragma unroll
    for (int e = 0; e < 4; ++e) { float cc = 0.f, bb = 0.f;
#pragma unroll
        for (int gg = 0; gg < 4; ++gg) { cc = (g == gg) ? c[4 * gg + e] : cc; bb = (g == gg) ? be[4 * gg + e] : bb; }
        bj[e] = bb; bgj[e] = bb * __expf(cc); tj[e] = CH_TOK(n, 4 * g + e); }
#pragma unroll 2
    for (int ct = 0; ct < 8; ++ct) {
        float vv[4], kv[4];
#pragma unroll
        for (int e = 0; e < 4; ++e) { vv[e] = bf1(GQb[tj[e] * 1536 + 1024 + h * 128 + ct * 16 + fr]); kv[e] = bf1(GQb[tj[e] * 1536 + 512 + h * 128 + ct * 16 + fr]); }
        const bf16x8 vb = as_bf16x8((v4u){pkbf(vv[0] * bj[0], vv[1] * bj[1]), pkbf(vv[2] * bj[2], vv[3] * bj[3]), 0u, 0u});
        const bf16x8 kb = as_bf16x8((v4u){pkbf(kv[0] * bgj[0], kv[1] * bgj[1]), pkbf(kv[2] * bgj[2], kv[3] * bgj[3]), 0u, 0u});
        const f32x4 z = {0.f, 0.f, 0.f, 0.f}; const f32x4 u = MFMA16(tfrag, vb, z), w = MFMA16(tfrag, kb, z);
#pragma unroll
        for (int jj = 0; jj < 4; ++jj) { GU[(4 * g + jj) * 128 + ct * 16 + fr] = tobf(u[jj]); GW[(4 * g + jj) * 128 + ct * 16 + fr] = tobf(w[jj]); }
        *(v2u*)(GKT + (ct * 16 + fr) * 16 + 4 * g) = (v2u){pkbf(kv[0], kv[1]), pkbf(kv[2], kv[3])};
    }
    LDS_WAIT(); asm volatile("" ::: "memory");
}
struct GdnStage { v4u w[2], q[2], kt[2], u[2], p, s; };
struct GdnLds { static constexpr int WP = 272, LW = 0, LQ = 64 * WP, LKT = 2 * 64 * WP, LU = LKT + 16384, LP = LU + 16384, LS = LP + 2048, BYTES = LS + 1024; };
__device__ __forceinline__ void s2g_load(GdnStage& R, const bf16* GW0, const bf16* GU0, const bf16* GKT0, const bf16* GP0, const float* GS0, const bf16* qsrc, int dir, int grp, int tid) {
    const size_t c0 = (size_t)grp * 4;
#pragma unroll
    for (int j = 0; j < 2; ++j) { const int e = tid + 512 * j, row = e >> 4, col = e & 15;
        R.w[j] = *(const v4u*)(GW0 + c0 * 2048 + (size_t)e * 8); R.kt[j] = *(const v4u*)(GKT0 + c0 * 2048 + (size_t)e * 8); R.u[j] = *(const v4u*)(GU0 + c0 * 2048 + (size_t)e * 8);
        R.q[j] = *(const v4u*)(qsrc + CH_TOK(grp * 4 + (row >> 4), row & 15) * 1536 + col * 8); }
    if (tid < 128) R.p = *(const v4u*)(GP0 + c0 * 256 + tid * 8);
    else if (tid < 192) R.s = *(const v4u*)(GS0 + c0 * 64 + (tid - 128) * 4);
}
__device__ __forceinline__ void s2g_store(const GdnStage& R, LAS unsigned char* lds, int tid) {
    typedef GdnLds L;
#pragma unroll
    for (int j = 0; j < 2; ++j) { const int e = tid + 512 * j, row = e >> 4, col = e & 15;
        *(LAS v4u*)(lds + L::LW + row * L::WP + col * 16) = R.w[j]; *(LAS v4u*)(lds + L::LQ + row * L::WP + col * 16) = R.q[j]; *(LAS v4u*)(lds + L::LKT + e * 16) = R.kt[j]; *(LAS v4u*)(lds + L::LU + e * 16) = R.u[j]; }
    if (tid < 128) *(LAS v4u*)(lds + L::LP + tid * 16) = R.p;
    else if (tid < 192) *(LAS v4u*)(lds + L::LS + (tid - 128) * 16) = R.s;
}
__device__ __forceinline__ void s2g_chunk(LAS unsigned char* lds, int c, f32x4 (&S)[8], bf16* osrc, int dir, int n, int vt, int lane) {
    typedef GdnLds L; const int fr = lane & 15, g = lane >> 4;
    f32x4 ws = {0.f, 0.f, 0.f, 0.f}, qs = {0.f, 0.f, 0.f, 0.f};
#pragma unroll
    for (int ks = 0; ks < 4; ++ks) { const int off = (c * 16 + fr) * L::WP + (32 * ks + 4 * g) * 2;
        const v2u a = *(const LAS v2u*)(lds + L::LW + off), b = *(const LAS v2u*)(lds + L::LW + off + 32), qa = *(const LAS v2u*)(lds + L::LQ + off), qb = *(const LAS v2u*)(lds + L::LQ + off + 32);
        v4u sb; sb.x = pkbf(S[2 * ks][0], S[2 * ks][1]); sb.y = pkbf(S[2 * ks][2], S[2 * ks][3]); sb.z = pkbf(S[2 * ks + 1][0], S[2 * ks + 1][1]); sb.w = pkbf(S[2 * ks + 1][2], S[2 * ks + 1][3]);
        const bf16x8 sbf = as_bf16x8(sb); ws = MFMA16(as_bf16x8((v4u){a.x, a.y, b.x, b.y}), sbf, ws); qs = MFMA16(as_bf16x8((v4u){qa.x, qa.y, qb.x, qb.y}), sbf, qs); }
    f32x4 vn;
#pragma unroll
    for (int jj = 0; jj < 4; ++jj) vn[jj] = bf1(*(const LAS unsigned short*)(lds + L::LU + ((c * 16 + 4 * g + jj) * 128 + vt * 16 + fr) * 2)) - ws[jj];
    const f32x4 gam = *(const LAS f32x4*)(lds + L::LS + (c * 64 + 4 * g) * 4), gdec = *(const LAS f32x4*)(lds + L::LS + (c * 64 + 16 + 4 * g) * 4); const float Gam = *(const LAS float*)(lds + L::LS + (c * 64 + 32) * 4);
    const bf16x8 vnf = as_bf16x8((v4u){pkbf(vn[0], vn[1]), pkbf(vn[2], vn[3]), 0u, 0u});
    f32x4 o = qs * gam; { const v2u pp = *(const LAS v2u*)(lds + L::LP + (c * 256 + fr * 16 + 4 * g) * 2); o = MFMA16(as_bf16x8((v4u){pp.x, pp.y, 0u, 0u}), vnf, o); }
    const f32x4 vd = vn * gdec; const bf16x8 vdf = as_bf16x8((v4u){pkbf(vd[0], vd[1]), pkbf(vd[2], vd[3]), 0u, 0u});
#pragma unroll
    for (int kt = 0; kt < 8; ++kt) { const v2u kk = *(const LAS v2u*)(lds + L::LKT + ((c * 128 + kt * 16 + fr) * 16 + 4 * g) * 2); S[kt] = S[kt] * Gam; S[kt] = MFMA16(as_bf16x8((v4u){kk.x, kk.y, 0u, 0u}), vdf, S[kt]); }
#pragma unroll
    for (int jj = 0; jj < 4; ++jj) osrc[CH_TOK(n, 4 * g + jj) * 512 + vt * 16 + fr] = tobf(o[jj]);
}
__device__ __forceinline__ void s2_gdn(LAS unsigned char* lds, const bf16* GW0, const bf16* GU0, const bf16* GKT0, const bf16* GP0, const float* GS0, const bf16* qsrc, bf16* osrc, int dir, int vt, int lane, int tid) {
    static_assert(GdnLds::BYTES <= RING_BYTES, "S2 LDS");
    f32x4 S[8];
#pragma unroll
    for (int kt = 0; kt < 8; ++kt) S[kt] = (f32x4){0.f, 0.f, 0.f, 0.f};
    GdnStage Ra, Rb;
    s2g_load(Ra, GW0, GU0, GKT0, GP0, GS0, qsrc, dir, 0, tid); s2g_load(Rb, GW0, GU0, GKT0, GP0, GS0, qsrc, dir, 1, tid);
#pragma unroll 1
    for (int grp = 0; grp < SEQ / 64; grp += 2) {
        S2_BAR(); s2g_store(Ra, lds, tid); S2_BAR();
        s2g_load(Ra, GW0, GU0, GKT0, GP0, GS0, qsrc, dir, grp + 2 < SEQ / 64 ? grp + 2 : grp, tid);
#pragma unroll 2
        for (int c = 0; c < 4; ++c) s2g_chunk(lds, c, S, osrc, dir, grp * 4 + c, vt, lane);
        S2_BAR(); s2g_store(Rb, lds, tid); S2_BAR();
        s2g_load(Rb, GW0, GU0, GKT0, GP0, GS0, qsrc, dir, grp + 3 < SEQ / 64 ? grp + 3 : grp + 1, tid);
#pragma unroll 2
        for (int c = 0; c < 4; ++c) s2g_chunk(lds, c, S, osrc, dir, (grp + 1) * 4 + c, vt, lane);
    }
    S2_BAR();
}
struct Args { const float* in[31]; float* out; unsigned char* ws; int ph_lo, ph_hi; };
static_assert(sizeof(Args) == 31 * 8 + 8 + 8 + 8, "Args has no padding");
typedef const __attribute__((address_space(4))) unsigned char* kptr_t;
typedef const float* cfptr_t; typedef float* fptr_t; typedef unsigned char* ucptr_t;
__device__ __forceinline__ kptr_t kargs() { kptr_t p = (kptr_t)__builtin_amdgcn_kernarg_segment_ptr(); asm volatile("" : "+s"(p)); return p; }
#define KIN(p, i) (*(const __attribute__((address_space(4))) cfptr_t*)((p) + 8 * (i)))
#define KOUT(p) (*(const __attribute__((address_space(4))) fptr_t*)((p) + 248))
#define KWS(p) (*(const __attribute__((address_space(4))) ucptr_t*)((p) + 256))

#ifndef STAGGER_TICKS
#define STAGGER_TICKS 0
#endif
#define GEMM_STAGGER() do { if (STAGGER_TICKS) { const unsigned long long t0_ = __builtin_amdgcn_s_memrealtime(); const unsigned long long dl_ = (unsigned long long)((bx & 15) * STAGGER_TICKS); while (__builtin_amdgcn_s_memrealtime() - t0_ < dl_) __builtin_amdgcn_s_sleep(4); } } while (0)
#ifndef FILL_TAIL
#define FILL_TAIL 1
#endif
#ifndef GATE_BATCH
#define GATE_BATCH 4
#endif
#ifndef F8_SP2
#define F8_SP2 true
#endif
#ifndef EN_MASK
#define EN_MASK 0xffffffffu
#endif
#define EN_PH(k) ((EN_MASK >> (k)) & 1u)
#ifndef REP_MASK
#define REP_MASK 0u
#endif
#define REPS(k) (((REP_MASK >> (k)) & 1u) ? 2 : 1)
#ifndef REP_S2
#define REP_S2 1
#define REP_ATT 1
#endif
__global__ void __launch_bounds__(NWAVES * 64, 2) mega_fwd(Args args) {
    extern __shared__ __attribute__((aligned(16))) unsigned char lds_raw[];
    LAS unsigned char* lds = (LAS unsigned char*)lds_raw;
    volatile LAS unsigned* MISC = (volatile LAS unsigned*)(lds + MISC_OFF);
    LAS int* TAB = (LAS int*)(lds + TAB_OFF);
    for (int u = threadIdx.x; u < (LDS_BYTES - LDSCTL_OFF) / 4; u += NWAVES * 64) ((LAS unsigned*)(lds + LDSCTL_OFF))[u] = 0u;
    __syncthreads();
    if ((threadIdx.x & 63) == 0) ((volatile LAS int*)(lds + WAVETAB_OFF))[hw_slot()] = (int)(threadIdx.x >> 6);
    __syncthreads();
    XcdBarrier bar; bar.bar = (unsigned*)(args.ws + WS_CTL) + CW_BAR; bar.x = 0; bar.st = nullptr;
    if (!MK_SPLIT) bar = xcd_barrier_post((unsigned*)(args.ws + WS_CTL) + CW_BAR, MISC + 8);
    const int lo = args.ph_lo, hi = args.ph_hi;
#define IN(k) (lo <= (k) && (k) < hi)
#define SEAM(k) do { if ((k) + 1 < hi) { if (MK_SPLIT) { if (mk_tid() == 0) __hip_atomic_store((gu32*)(args.ws + WS_CTL) + CW_TMO, 0xBADBA0u, RLX_AGENT); } else xcd_barrier(bar); } } while (0)
#define PHASE_VARS \
    const kptr_t kp = kargs(); unsigned char* const ws = KWS(kp); float* const out = KOUT(kp); (void)out; \
    int tid_ = mk_tid(); asm volatile("" : "+v"(tid_)); const int tid = tid_, lane = tid & 63, wave = __builtin_amdgcn_readfirstlane(tid >> 6); (void)lane; (void)wave; \
    int G_ = gridDim.x, bx_ = blockIdx.x; asm volatile("" : "+s"(G_), "+s"(bx_)); const int G = G_, bx = bx_; const int vcu = (G % 8 == 0) ? (bx % 8) * (G / 8) + bx / 8 : bx; const int gw = vcu * NWAVES + wave, NGW = G * NWAVES; (void)gw; (void)NGW; \
    gu32* const ctl = (gu32*)(ws + WS_CTL); (void)ctl
#define LAYER_PTRS(lp) LayerPtrs lp; \
        lp.g_mix = KIN(kp, 2) + L * DM; lp.na_q_gain = KIN(kp, 4) + L * 64; lp.na_k_gain = KIN(kp, 5) + L * 64; lp.na_rel_bias = KIN(kp, 6) + L * 8 * 15 * 31; \
        lp.gla_w_up = KIN(kp, 7) + L * 2 * 16 * 256; lp.gla_b = KIN(kp, 8) + L * 512; lp.gla_norm = KIN(kp, 9) + L * 128; lp.conv_w = KIN(kp, 10) + L * 5 * 1536; \
        lp.a_log = KIN(kp, 11) + L * 8; lp.dt_bias = KIN(kp, 12) + L * 8; lp.gdn_norm = KIN(kp, 13) + L * 128; lp.lb_raw0 = KIN(kp, 14); lp.lb_raw1 = KIN(kp, 14) + 1024; \
        lp.hg_norm = KIN(kp, 15) + L * 128; lp.mem_q_gain = KIN(kp, 18) + L * 128; lp.g_ffn = KIN(kp, 22) + L * DM
#define WSP(T, off) ((T*)(ws + (off)))

    if (EN_PH(31) && IN(0)) for (int rep_ = 0; rep_ < REPS(31); ++rep_) { PHASE_VARS;
        bf16* WIN = WSP(bf16, WS_WIN); bf16* WBR = WSP(bf16, WS_WBR); bf16* WOUT = WSP(bf16, WS_WOUT); bf16* WMKV = WSP(bf16, WS_WMKV);
        bf16* WGU = WSP(bf16, WS_WGU); bf16* WDN = WSP(bf16, WS_WDN); bf16* MOE1 = WSP(bf16, WS_MOE1); bf16* MOE2 = WSP(bf16, WS_MOE2F);
        LAS float* scr = (LAS float*)(lds + RING_OFF + wave * 16384);
        phase0_convert_all(KIN(kp, 3), KIN(kp, 20), KIN(kp, 21), KIN(kp, 17), KIN(kp, 23), KIN(kp, 24), KIN(kp, 25), ws, scr, gw, NGW, lane);
        for (int i = gw * 64 + lane; i < 2 * (LDP - C_PEND) * DM / 8; i += NGW * 64) { const int L = i / ((LDP - C_PEND) * DM / 8), r = i % ((LDP - C_PEND) * DM / 8);
            *(v4u*)(WIN + ((size_t)L * NIN + C_PEND) * DM + (size_t)r * 8) = (v4u){0u, 0u, 0u, 0u}; }
        const float* mem = KIN(kp, 1); bf16* MEMN = WSP(bf16, WS_MEMN);
        for (int row = gw; row < 2 * 1024; row += NGW) { const int L = row >> 10, m = row & 1023; f32x4 v[8]; rms_row(mem + (size_t)m * DM, KIN(kp, 16) + L * DM, MEMN + (size_t)row * DM, lane, v); }
    }

#pragma unroll 1
    for (int L = 0; L < NLAYER; ++L) {
        const int pb = 1 + 16 * L;
        if (EN_PH(0) && IN(pb + 0)) for (int rep_ = 0; rep_ < REPS(0); ++rep_) { PHASE_VARS; const float* xres = L ? (const float*)out : KIN(kp, 0); const float* gm = KIN(kp, 2) + L * DM; bf16* HM = WSP(bf16, WS_HM);
            for (int t = gw; t < NT; t += NGW) { f32x4 v[8]; rms_row(xres + (size_t)t * DM, gm, HM + (size_t)t * DM, lane, v, WSP(unsigned char, WS_H8) + (size_t)t * DM); } }
        SEAM(pb + 0);
        if (EN_PH(1) && IN(pb + 1)) for (int rep_ = 0; rep_ < REPS(1); ++rep_) {
            { PHASE_VARS; pg8::Gemm g{WSP(bf16, WS_HM), WSP(bf16, WS_WIN) + (size_t)L * NIN * DM, NT, LDP, DM}; pg8::StaticOrder S; S.init(NT, LDP, G, bx); pg8::EpiInProj E{WSP(bf16, WS_P), WSP(bf16, WS_G)};
#if defined(PROBE_NULL_EPI)
              if (rep_) { pg8::EpiNull EN; pg8::gemm_phase<pg8::EpiNull, pg8::StaticOrder, true, true>(lds + RING_OFF, g, S, EN); } else
#endif
              { GEMM_STAGGER(); pg8::gemm_phase<pg8::EpiInProj, pg8::StaticOrder, true, true>(lds + RING_OFF, g, S, E); } }
            if (L == 0) { PHASE_VARS; pg8::Gemm g{WSP(bf16, WS_MEMN), WSP(bf16, WS_WMKV), 2048, 2048, DM}; pg8::KvOrder S{bx, G >= 96 ? 64 : 0}; pg8::EpiResF32 E{nullptr, WSP(float, WS_KVRAW), 1024, 4};
              pg8::gemm_phase<pg8::EpiResF32, pg8::KvOrder, false, true>(lds + RING_OFF, g, S, E); }
            { PHASE_VARS; const int f0 = L ? 64 : 96;
              if (FILL_TAIL && G >= 128 && bx >= f0 && rep_ == 0) { LAS float* scr = (LAS float*)(lds + RING_OFF + wave * 16384); const int gwf = (bx - f0) * NWAVES + wave, ngwf = (G - f0) * NWAVES;
#pragma unroll 1
                  for (int e = 3 * L; e < 3 * L + 3; ++e) transpose_job_f8(KIN(kp, 30) + (size_t)e * DFFE * DM, 64.0f, DFFE, DM, WSP(unsigned char, WS_MOE2F) + (size_t)e * DM * DFFE, scr, gwf, ngwf, lane, RmOff{0}); } }
        }
        SEAM(pb + 1);
        if (EN_PH(2) && IN(pb + 2)) { PHASE_VARS; LAYER_PTRS(lp);
            { LAS float* glaw = (LAS float*)(lds + RING_OFF); __syncthreads();
#pragma unroll
              for (int i = 0; i < 4; ++i) { const int e = (i * 512 + tid) * 4; *(LAS f32x4*)(glaw + e) = *(const f32x4*)(lp.gla_w_up + e); }
              __syncthreads(); }
            for (int u = gw; u < NT / 8; u += NGW) prep_unit(L, lp, (const LAS float*)(lds + RING_OFF), WSP(bf16, WS_P), WSP(float, WS_GLG), WSP(bf16, WS_GQ), WSP(float, WS_GAB), WSP(bf16, WS_HQ), WSP(float, WS_HF), WSP(bf16, WS_NAVT), u * 8, lane);
            if (L == 0) { const float* KVRAW = WSP(float, WS_KVRAW); bf16* MK = WSP(bf16, WS_MK); bf16* MVT = WSP(bf16, WS_MVT); const float* mkg = KIN(kp, 19);
                for (int row = gw; row < 2048; row += NGW) {
                    const int LL = row >> 10; const float* kr = KVRAW + (size_t)row * 1024;
                    const f32x4 k0 = *(const f32x4*)(kr + lane * 8), k1 = *(const f32x4*)(kr + lane * 8 + 4);
                    float f[8] = {k0[0], k0[1], k0[2], k0[3], k1[0], k1[1], k1[2], k1[3]}; float ss = 0.f;
#pragma unroll
                    for (int i = 0; i < 8; ++i) ss += f[i] * f[i];
                    ss = group_sum<16>(ss); const float sc = rsqrtf(ss * (1.0f / 128.0f) + RMS_EPS); const float* gn = mkg + LL * 128 + (lane & 15) * 8;
#pragma unroll
                    for (int i = 0; i < 8; ++i) f[i] = f[i] * sc * gn[i];
                    *(v4u*)(MK + (size_t)row * 512 + lane * 8) = pack8(f);
                    const int b = (row >> 8) & 3, m = row & 255; const float* vr = kr + 512;
#pragma unroll
                    for (int i = 0; i < 8; ++i) { const int cidx = lane * 8 + i; const int h = cidx >> 7, d = cidx & 127;
                        MVT[((size_t)((LL * 4 + b) * 4 + h) * 128 + d) * 256 + m] = (bf16)(pkbf(vr[cidx], 0.f) & 0xffffu); }
                }
            }
        }
        SEAM(pb + 2);
        if (EN_PH(13) && IN(pb + 13)) for (int rep_ = 0; rep_ < REPS(13); ++rep_) { PHASE_VARS;
            LAS unsigned char* scr = lds + RING_OFF + wave * 16384; unsigned char* oa = ws + WS_OA; bf16* P = WSP(bf16, WS_P);
#pragma unroll 1
            for (int u = gw; u < 3 * 8192; u += NGW) { const int br = u >> 13, cu = u & 8191, seq = cu >> 8, n = cu & 255, b = seq >> 3, h = (seq >> 1) & 3, dir = seq & 1; const size_t r0 = (size_t)b << 12;
                if (br == 0) s1_gdn(scr, WSP(bf16, WS_GQ) + r0 * 1536, WSP(float, WS_GAB) + r0 * 16 + dir * 4 + h, h, dir, n, (bf16*)(oa + OA_GW) + (size_t)cu * 2048, (bf16*)(oa + OA_GU) + (size_t)cu * 2048,
                                    (bf16*)(oa + OA_GKT) + (size_t)cu * 2048, (bf16*)(oa + OA_GP) + (size_t)cu * 256, (float*)(oa + OA_GS) + (size_t)cu * 64, lane);
                else if (br == 1) { DiagSrc S{WSP(bf16, WS_HQ) + r0 * 512 + h * 128, 512, nullptr, 0, WSP(float, WS_HF) + r0 * 1024 + dir * 512 + h * 128, 1024, nullptr, 0};
                    s1_diag<128, 1>(scr, S, dir, n, (bf16*)(oa + OA_HQD) + (size_t)cu * 2048, (bf16*)(oa + OA_HKDT) + (size_t)cu * 2048, (bf16*)(oa + OA_HP) + (size_t)cu * 256, (float*)(oa + OA_HV) + (size_t)cu * 128, lane); }
                else { DiagSrc S{P + r0 * LDP + C_GLQ + h * 64, LDP, P + r0 * LDP + C_GLK + h * 64, LDP, WSP(float, WS_GLG) + r0 * 512 + dir * 256 + h * 64, 512, nullptr, 0};
                    s1_diag<64, 0>(scr, S, dir, n, (bf16*)(oa + OA_LQD) + (size_t)cu * 1024, (bf16*)(oa + OA_LKDT) + (size_t)cu * 1024, (bf16*)(oa + OA_LP) + (size_t)cu * 256, (float*)(oa + OA_LV) + (size_t)cu * 64, lane); }
            }
        }
        SEAM(pb + 13);
        if (EN_PH(3) && IN(pb + 3)) for (int rep_ = 0; rep_ < REPS(3); ++rep_) { PHASE_VARS;
            gu32* wq = ctl + CW_WQ + 64 * (L + 2 * rep_); gu32* gq = ctl + CW_GQ + 64 * 8 * (L + 2 * rep_);
            bf16* P = WSP(bf16, WS_P); bf16* SOUT = WSP(bf16, WS_SOUT); bf16* BR = WSP(bf16, WS_BR); unsigned char* oa = ws + WS_OA;
            if (!rep_ || REP_S2) {
#pragma unroll 1
                for (int seq = bx; seq < 32; seq += G) { const int b = seq >> 3, h = (seq >> 1) & 3, dir = seq & 1; const size_t r0 = (size_t)b << 12, c0 = (size_t)seq * 256;
                    s2_gdn(lds + RING_OFF, (const bf16*)(oa + OA_GW) + c0 * 2048, (const bf16*)(oa + OA_GU) + c0 * 2048, (const bf16*)(oa + OA_GKT) + c0 * 2048, (const bf16*)(oa + OA_GP) + c0 * 256, (const float*)(oa + OA_GS) + c0 * 64,
                           WSP(bf16, WS_GQ) + r0 * 1536 + h * 128, SOUT + ((size_t)(1 * 2 + dir) * NT + r0) * 512 + h * 128, dir, wave, lane, tid); }
#pragma unroll 1
                for (int i2 = bx; i2 < 64; i2 += G) if (i2 >= 32) { const int seq = i2 - 32, b = seq >> 3, h = (seq >> 1) & 3, dir = seq & 1; const size_t r0 = (size_t)b << 12, c0 = (size_t)seq * 256;
                    s2_diag<128>(lds + RING_OFF, (const bf16*)(oa + OA_HQD) + c0 * 2048, (const bf16*)(oa + OA_HKDT) + c0 * 2048, (const bf16*)(oa + OA_HP) + c0 * 256, (const float*)(oa + OA_HV) + c0 * 128,
                                 P + r0 * LDP + C_HGI + h * 128, LDP, SOUT + ((size_t)(2 * 2 + dir) * NT + r0) * 512 + h * 128, 512, dir, wave, lane, tid); }
#pragma unroll 1
                for (int i2 = bx; i2 < 96; i2 += G) if (i2 >= 64) { const int seq = i2 - 64, b = seq >> 3, h = (seq >> 1) & 3, dir = seq & 1; const size_t r0 = (size_t)b << 12, c0 = (size_t)seq * 256;
                    s2_diag<64>(lds + RING_OFF, (const bf16*)(oa + OA_LQD) + c0 * 1024, (const bf16*)(oa + OA_LKDT) + c0 * 1024, (const bf16*)(oa + OA_LP) + c0 * 256, (const float*)(oa + OA_LV) + c0 * 64,
                                P + r0 * LDP + C_GLV + h * 128, LDP, SOUT + ((size_t)(0 * 2 + dir) * NT + r0) * 512 + h * 128, 512, dir, wave, lane, tid); }
            }
            if (bx < 96 && rep_ == 0) { __syncthreads(); if (tid == 0) __hip_atomic_fetch_add(ctl + CW_S2DONE + 64 * L, 1u, RLX_AGENT); }
            if (!rep_ || REP_ATT) {
            bool gates_left = true;
            for (;;) {
                __syncthreads();
                if (tid == 0) { unsigned v = 0xffffffffu;
                    if (gates_left) for (int k8 = 0; k8 < 8; ++k8) { const int x = (bx + k8) & 7; const unsigned b0 = __hip_atomic_fetch_add(gq + 64 * x, 1u, RLX_AGENT); if (b0 < (unsigned)(320 / GATE_BATCH)) { v = (unsigned)x * 4096u + b0; break; } }
                    MISC[17] = v; if (v == 0xffffffffu) MISC[16] = __hip_atomic_fetch_add(wq, 1u, RLX_AGENT); }
                __syncthreads();
                const unsigned gsel = MISC[17];
                if (gsel != 0xffffffffu) {
                    const unsigned char* g8b = (const unsigned char*)(WSP(bf16, WS_WIN) + ((size_t)L * NIN + LDP) * DM) - (size_t)33 * 256 * DM;
                    pg8::Gemm g8{WSP(bf16, WS_H8), (const bf16*)g8b, NT, NIN, DM / 2}; pg8::GateBatchOrder S8{(int)(gsel >> 12), (int)(gsel & 4095u) * GATE_BATCH, GATE_BATCH}; pg8::EpiInProj E8{WSP(bf16, WS_P), WSP(bf16, WS_G)};
                    pg8::gemm_phase_f8<pg8::EpiInProj, pg8::GateBatchOrder, true, F8_SP2>(lds + RING_OFF, g8, S8, E8);
                    continue; }
                gates_left = false;
                int it = (int)MISC[16];
                if (it >= 768) break;
                int lane_ = lane, tid_q = tid; asm volatile("" : "+v"(lane_), "+v"(tid_q));
                if (it < 512) {
                    const int b = it >> 7, h = (it >> 4) & 7, rq = it & 15;
                    na_wave_unit(P, WSP(bf16, WS_NAVT), KIN(kp, 6) + L * 8 * 15 * 31, BR, b, h, 4 * rq + (wave >> 2), wave & 3, lane_);
                    na_wave_unit(P, WSP(bf16, WS_NAVT), KIN(kp, 6) + L * 8 * 15 * 31, BR, b, h, 4 * rq + 2 + (wave >> 2), wave & 3, lane_);
                } else {
                    const int i2 = it - 512, tb = i2 >> 2, h = i2 & 3;
                    mem_wg_unit(lds + RING_OFF, P, WSP(bf16, WS_MK) + (size_t)L * 1024 * 512, WSP(bf16, WS_MVT) + (size_t)L * 4 * 4 * 128 * 256, BR + (size_t)4 * NT * 512, tb * 256, h, wave, lane_, tid_q);
                }
            }
            }
            if (FILL_TAIL && G >= 128 && rep_ == 0 && bx >= 144) { LAS float* scr = (LAS float*)(lds + RING_OFF + wave * 16384);
                moe_drain(KIN(kp, 28), KIN(kp, 29), KIN(kp, 30), ws, ctl + CW_CONVQ, ctl + CW_S2DONE + 64 * L, 96u, MISC + 20, scr, wave, lane, tid); }
        }
        SEAM(pb + 3);
        if (EN_PH(4) && IN(pb + 4)) for (int rep_ = 0; rep_ < REPS(4); ++rep_) { PHASE_VARS; LAYER_PTRS(lp); for (int t = gw; t < NT; t += NGW) post_token(lp, WSP(bf16, WS_P), WSP(bf16, WS_SOUT), WSP(bf16, WS_BR), t, lane);
            if (L == 1 && rep_ == 0) {
                bf16* MOE1 = WSP(bf16, WS_MOE1); bf16* MOE2 = WSP(bf16, WS_MOE2F); LAS float* scr = (LAS float*)(lds + RING_OFF + wave * 16384);
                if (FILL_TAIL && G >= 128) moe_drain(KIN(kp, 28), KIN(kp, 29), KIN(kp, 30), ws, ctl + CW_CONVQ, nullptr, 0u, MISC + 20, scr, wave, lane, tid);
                else { moe1_convert_all(KIN(kp, 28), KIN(kp, 29), (unsigned char*)MOE1, scr, gw, NGW, lane);
#pragma unroll 1
                    for (int e = 0; e < NEXP; ++e) transpose_job_f8(KIN(kp, 30) + (size_t)e * DFFE * DM, 64.0f, DFFE, DM, (unsigned char*)MOE2 + (size_t)e * DM * DFFE, scr, gw, NGW, lane, RmOff{0}); }
            }
        }
        SEAM(pb + 4);
        if (EN_PH(5) && IN(pb + 5)) { PHASE_VARS; pg8::Gemm g{WSP(bf16, WS_BR), WSP(bf16, WS_WBR) + (size_t)L * 5 * DM * 512, 5 * NT, 5 * DM, 512}; pg8::BranchOrder5 S{G, bx}; pg8::EpiBranchAcc E{WSP(bf16, WS_G), WSP(bf16, WS_HM)};
            pg8::gemm_phase<pg8::EpiBranchAcc, pg8::BranchOrder5, true, true>(lds + RING_OFF, g, S, E); }
        SEAM(pb + 5);
        if (EN_PH(7) && IN(pb + 7)) { PHASE_VARS; const float* xres = L ? (const float*)out : KIN(kp, 0);
            pg8::Gemm g{WSP(bf16, WS_HM), WSP(bf16, WS_WOUT) + (size_t)L * DM * DM, NT, DM, DM}; pg8::StaticOrder S; S.init(NT, DM, G, bx); pg8::EpiResF32 E{xres, out, DM, 1 << 20};
            pg8::gemm_phase<pg8::EpiResF32, pg8::StaticOrder, true, true>(lds + RING_OFF, g, S, E); }
        SEAM(pb + 7);
        if (L == 0) {
            if (EN_PH(8) && IN(pb + 8)) for (int rep_ = 0; rep_ < REPS(8); ++rep_) { PHASE_VARS; const float* gf = KIN(kp, 22) + L * DM; bf16* HM = WSP(bf16, WS_HM);
                for (int t = gw; t < NT; t += NGW) { f32x4 v[8]; rms_row(out + (size_t)t * DM, gf, HM + (size_t)t * DM, lane, v); } }
            SEAM(pb + 8);
            if (EN_PH(9) && IN(pb + 9)) for (int rep_ = 0; rep_ < REPS(9); ++rep_) { PHASE_VARS; pg8::Gemm g{WSP(bf16, WS_HM), WSP(bf16, WS_WGU), NT, 2 * DFF, DM}; pg8::StaticOrder S; S.init(NT, 2 * DFF, G, bx); pg8::EpiSwiGLU E{WSP(bf16, WS_HID), DFF, 1 << 20};
                GEMM_STAGGER(); pg8::gemm_phase<pg8::EpiSwiGLU, pg8::StaticOrder, true, true>(lds + RING_OFF, g, S, E); }
            SEAM(pb + 9);
            if (EN_PH(10) && IN(pb + 10)) { PHASE_VARS; pg8::Gemm g{WSP(bf16, WS_HID), WSP(bf16, WS_WDN), NT, DM, DFF}; pg8::StaticOrder S; S.init(NT, DM, G, bx); pg8::EpiResF32 E{out, out, DM, 1 << 20};
                pg8::gemm_phase<pg8::EpiResF32, pg8::StaticOrder, true, true>(lds + RING_OFF, g, S, E); }
            SEAM(pb + 10);
        } else {
            if (EN_PH(8) && IN(pb + 8)) { PHASE_VARS; gu32* cnt = ctl + CW_CNT; unsigned* ROUTE = WSP(unsigned, WS_ROUTE); bf16* HM = WSP(bf16, WS_HM);
                const float* wr = KIN(kp, 26); const float* brt = KIN(kp, 27); const float* gf = KIN(kp, 22) + L * DM;
                LAS unsigned* lcnt = (LAS unsigned*)(lds + RING_OFF); LAS unsigned* gbase = lcnt + 8;
                for (int blk = bx; blk < NT / 64; blk += G) {
                    __syncthreads(); if (tid < 8) lcnt[tid] = 0u; __syncthreads();
                    unsigned re0 = 0, re1 = 0, rp0 = 0, rp1 = 0; float rw0 = 0.f, rw1 = 0.f;
#pragma unroll 1
                    for (int tt = 0; tt < 8; ++tt) { const int t = blk * 64 + wave * 8 + tt; f32x4 v[8]; rms_row_f8(out + (size_t)t * DM, gf, (unsigned char*)HM + (size_t)t * DM, lane, v);
                        float lg[8];
#pragma unroll
                        for (int e = 0; e < 8; ++e) lg[e] = 0.f;
#pragma unroll
                        for (int j = 0; j < 8; ++j)
#pragma unroll
                            for (int q = 0; q < 4; ++q) { const float* wp = wr + (size_t)(4 * (lane + 64 * j) + q) * 8; const f32x4 w0 = *(const f32x4*)wp, w1 = *(const f32x4*)(wp + 4); const float hv = v[j][q];
                                lg[0] += hv * w0[0]; lg[1] += hv * w0[1]; lg[2] += hv * w0[2]; lg[3] += hv * w0[3]; lg[4] += hv * w1[0]; lg[5] += hv * w1[1]; lg[6] += hv * w1[2]; lg[7] += hv * w1[3]; }
#pragma unroll
                        for (int e = 0; e < 8; ++e) lg[e] = wave_sum(lg[e]) + brt[e];
                        int e0 = 0; float m0 = lg[0];
#pragma unroll
                        for (int e = 1; e < 8; ++e) if (lg[e] > m0) { m0 = lg[e]; e0 = e; }
                        int e1 = 0; float m1 = -3.0e38f;
#pragma unroll
                        for (int e = 0; e < 8; ++e) if (e != e0 && lg[e] > m1) { m1 = lg[e]; e1 = e; }
                        const float w0 = 1.0f / (1.0f + __expf(m1 - m0));
                        if (lane == tt) { re0 = e0; re1 = e1; rw0 = w0; rw1 = 1.0f - w0;
                            rp0 = __hip_atomic_fetch_add(&lcnt[e0], 1u, __ATOMIC_RELAXED, __HIP_MEMORY_SCOPE_WORKGROUP); rp1 = __hip_atomic_fetch_add(&lcnt[e1], 1u, __ATOMIC_RELAXED, __HIP_MEMORY_SCOPE_WORKGROUP); }
                    }
                    __syncthreads();
                    if (tid < 8) gbase[tid] = __hip_atomic_fetch_add(cnt + 64 * tid, lcnt[tid], RLX_AGENT);
                    __syncthreads();
                    if (lane < 8) { const int t = blk * 64 + wave * 8 + lane; unsigned* rr = ROUTE + (size_t)t * 8;
                        rr[0] = re0; rr[1] = re1; rr[2] = gbase[re0] + rp0; rr[3] = gbase[re1] + rp1; rr[4] = __float_as_uint(rw0); rr[5] = __float_as_uint(rw1); }
                }
            }
            SEAM(pb + 8);
            if (hi > pb + 9) { PHASE_VARS; gu32* cnt = ctl + CW_CNT;
                __syncthreads();
                if (tid == 0) { int acc = 0; for (int e = 0; e < 8; ++e) { const int c = (int)__hip_atomic_load(cnt + 64 * e, RLX_AGENT); const int nb = (c + 255) >> 8; TAB[e] = nb; TAB[8 + e] = acc; TAB[32 + e] = acc * 256; acc += nb; } TAB[40] = acc; }
                __syncthreads();
            }
            if (EN_PH(9) && IN(pb + 9)) for (int rep_ = 0; rep_ < REPS(9); ++rep_) { PHASE_VARS; bf16* XB = WSP(bf16, WS_XB); unsigned* ROUTE = WSP(unsigned, WS_ROUTE); const bf16* HM = WSP(bf16, WS_HM);
                for (int t = gw; t < NT; t += NGW) { unsigned* rr = ROUTE + (size_t)t * 8; const unsigned e0 = rr[0], e1 = rr[1]; const unsigned s0 = (unsigned)TAB[32 + e0] + rr[2], s1 = (unsigned)TAB[32 + e1] + rr[3];
                    if (lane == 0) { rr[6] = s0; rr[7] = s1; }
                    const v4u* src = (const v4u*)((const unsigned char*)HM + (size_t)t * DM) + lane; v4u* d0 = (v4u*)((unsigned char*)XB + (size_t)s0 * DM) + lane; v4u* d1 = (v4u*)((unsigned char*)XB + (size_t)s1 * DM) + lane;
#pragma unroll
                    for (int j = 0; j < 2; ++j) { const v4u x = src[64 * j]; d0[64 * j] = x; d1[64 * j] = x; } } }
            SEAM(pb + 9);
            if (EN_PH(10) && IN(pb + 10)) for (int rep_ = 0; rep_ < REPS(20); ++rep_) { PHASE_VARS; __syncthreads(); if (tid == 0) { for (int e = 0; e <= 8; ++e) TAB[16 + e] = (e < 8 ? TAB[8 + e] : TAB[40]) * 56; } __syncthreads();
                pg8::Gemm g{WSP(bf16, WS_XB), WSP(bf16, WS_MOE1), MAXSLOT, 8 * 2 * DFFE, DM / 2}; pg8::MoeOrder S{G, bx, 56, TAB[40] * 56, TAB}; pg8::EpiSwiGLU8 E{WSP(unsigned char, WS_HIDM), DFFE, 56};
                GEMM_STAGGER(); pg8::gemm_phase_f8<pg8::EpiSwiGLU8, pg8::MoeOrder, true, F8_SP2>(lds + RING_OFF, g, S, E); }
            SEAM(pb + 10);
            if (EN_PH(11) && IN(pb + 11)) for (int rep_ = 0; rep_ < REPS(11); ++rep_) { PHASE_VARS; __syncthreads(); if (tid == 0) { for (int e = 0; e <= 8; ++e) TAB[16 + e] = (e < 8 ? TAB[8 + e] : TAB[40]) * 8; } __syncthreads();
                pg8::Gemm g{WSP(bf16, WS_HIDM), WSP(bf16, WS_MOE2F), MAXSLOT, 8 * DM, DFFE / 2}; pg8::MoeOrder S{G, bx, 8, TAB[40] * 8, TAB}; pg8::EpiBf16Out E{WSP(bf16, WS_YB), DM, 8};
                GEMM_STAGGER(); pg8::gemm_phase_f8<pg8::EpiBf16Out, pg8::MoeOrder, true, F8_SP2>(lds + RING_OFF, g, S, E); }
            SEAM(pb + 11);
            if (EN_PH(12) && IN(pb + 12)) { PHASE_VARS; const bf16* YB = WSP(bf16, WS_YB); const unsigned* ROUTE = WSP(unsigned, WS_ROUTE);
                for (int t = gw; t < NT; t += NGW) { const unsigned* rr = ROUTE + (size_t)t * 8; const float w0 = __uint_as_float(rr[4]), w1 = __uint_as_float(rr[5]); const size_t s0 = rr[6], s1 = rr[7];
                    f32x4* o = (f32x4*)(out + (size_t)t * DM) + lane; const v2u* y0 = (const v2u*)(YB + s0 * DM) + lane; const v2u* y1 = (const v2u*)(YB + s1 * DM) + lane;
#pragma unroll
                    for (int j = 0; j < 8; ++j) { const v2u a = y0[64 * j], b = y1[64 * j];
                        o[64 * j] = o[64 * j] + w0 * (f32x4){bflo(a.x), bfhi(a.x), bflo(a.y), bfhi(a.y)} + w1 * (f32x4){bflo(b.x), bfhi(b.x), bflo(b.y), bfhi(b.y)}; } } }
        }
    }
#undef IN
#undef SEAM
}
extern "C" void kernel_launch(void* const* d_in, const int* in_sizes, int n_in, void* d_out, int out_size, void* d_ws, size_t ws_size, hipStream_t stream) {
    static int grid = 0;
    if (grid == 0) {
        if (n_in != 31 || in_sizes[0] != NT * DM || out_size != NT * DM || ws_size < WS_END) { fprintf(stderr, "kernel_launch: unexpected shapes (n_in %d, in0 %d, out %d, ws %zu < %zu); nothing launched\n", n_in, n_in > 0 ? in_sizes[0] : -1, out_size, ws_size, (size_t)WS_END); grid = -1; return; }
        int dev = 0, cus = 0, per_cu = 0;
        if (hipGetDevice(&dev) != hipSuccess || hipDeviceGetAttribute(&cus, hipDeviceAttributeMultiprocessorCount, dev) != hipSuccess) { grid = -1; return; }
        if (hipFuncSetAttribute((const void*)mega_fwd, hipFuncAttributeMaxDynamicSharedMemorySize, LDS_BYTES) != hipSuccess) { fprintf(stderr, "kernel_launch: hipFuncSetAttribute failed\n"); grid = -1; return; }
        if (hipOccupancyMaxActiveBlocksPerMultiprocessor(&per_cu, (const void*)mega_fwd, NWAVES * 64, LDS_BYTES) != hipSuccess || per_cu < 1) fprintf(stderr, "kernel_launch: occupancy query reports %d\n", per_cu);
        (void)hipGetLastError();
        grid = cus;
    }
    if (grid < 0) return;
    if (hipMemsetAsync((char*)d_ws + WS_CTL, 0, CTL_ZERO_BYTES, stream) != hipSuccess) return;
    Args a{};
    for (int i = 0; i < 31; ++i) a.in[i] = (const float*)d_in[i];
    a.out = (float*)d_out; a.ws = (unsigned char*)d_ws;
#if MK_SPLIT
    int ids[40]; int n = 0; ids[n++] = 0;
    for (int L = 0; L < 2; ++L) for (int k = 0; k < (L ? 13 : 11); ++k) { ids[n++] = 1 + 16 * L + k; if (k == 2) ids[n++] = 1 + 16 * L + 13; }
    for (int i = 0; i < n; ++i) { a.ph_lo = ids[i]; a.ph_hi = ids[i] + 1; hipLaunchKernelGGL(mega_fwd, dim3(grid), dim3(NWAVES * 64), LDS_BYTES, stream, a); }
#else
    a.ph_lo = 0; a.ph_hi = 64;
    hipLaunchKernelGGL(mega_fwd, dim3(grid), dim3(NWAVES * 64), LDS_BYTES, stream, a);
#endif
    const hipError_t le = hipPeekAtLastError();
    if (le != hipSuccess) fprintf(stderr, "kernel_launch: launch failed: %s\n", hipGetErrorName(le));
}
```

```cpp
#include <hip/hip_runtime.h>
#include <cstdio>
#include <cstdint>
__device__ __forceinline__ int pg8_tid();
namespace pg8 {
#define PG8_LAS __attribute__((address_space(3)))
typedef unsigned short bf16_t;
typedef short bf16x8 __attribute__((ext_vector_type(8)));
typedef float f32x4 __attribute__((ext_vector_type(4)));
typedef unsigned u32x4 __attribute__((ext_vector_type(4)));
constexpr int BM = 256, BK = 64, HALF = 128, HTB = HALF * BK * 2  , STAGE_BYTES = 8 * HTB, NXCD = 8, WGM = 8;

__host__ __device__ __forceinline__ int lds_byte(int r, int c) { const int st = (r >> 4) * 2 + (c >> 5), rr = r & 15, cc = c & 31, ob = rr * 64 + cc * 2; return st * 1024 + (ob ^ (((ob >> 9) & 1) << 5)); }
__host__ __device__ __forceinline__ void stage_rc(int b, int& R, int& C) { const int st = b / 1024, sb = b % 1024, swz = sb ^ (((sb >> 9) & 1) << 5); R = (st >> 1) * 16 + swz / 64; C = (st & 1) * 32 + (swz % 64) / 2; }
__host__ __device__ __forceinline__ int perm32(int rho) { const int n = rho >> 4, i = rho & 15; return 8 * (i >> 2) + 4 * n + (i & 3); }

struct Unit { int pm, pn; };
struct Gemm { const bf16_t* A; const bf16_t* Bt; int M, N, K; };

struct StaticOrder {
    int nM, nN, nwg, G, c;
    __host__ __device__ void init(int M, int N, int G_, int c_) { nM = M / BM; nN = N / BM; nwg = nM * nN; G = G_; c = c_; }
    __host__ __device__ bool next(int i, Unit& u) const {
        const long L = (long)i * G + c; if (L >= nwg) return false;
        int wgid = (int)L; { const int q = nwg / NXCD, r = nwg % NXCD, xcd = wgid % NXCD, off = wgid / NXCD; wgid = (xcd < r ? xcd * (q + 1) : r * (q + 1) + (xcd - r) * q) + off; }
        const int nig = WGM * nN, gid = wgid / nig, fm = gid * WGM, gsz = (nM - fm) < WGM ? (nM - fm) : WGM;
        u.pm = fm + ((wgid % nig) % gsz); u.pn = (wgid % nig) / gsz; return true;
    }
    __device__ __forceinline__ void a_ready(const Unit&) const {}
    __device__ __forceinline__ void done(const Unit&) const {}
};
__device__ __forceinline__ unsigned cvt_pk_bf16(float lo, float hi) { unsigned r; asm volatile("v_cvt_pk_bf16_f32 %0, %1, %2" : "=v"(r) : "v"(lo), "v"(hi)); return r; }
typedef float f32x2 __attribute__((ext_vector_type(2)));
__device__ __forceinline__ float sigm(float x) { return __builtin_amdgcn_rcpf(1.0f + __expf(-x)); }
struct EpiInProj {
    static constexpr bool PERM = true, AFTER_DRAIN = false, CARRY = false;
    bf16_t* P; bf16_t* G;
    __device__ __forceinline__ void operator()(const f32x4 (&acc)[2][2][4][2], const Unit& u, int wr, int wc, int fr, int fq) const {
        const int row0 = u.pm * BM + wr * 64 + fr; const bool isg = u.pn >= 33;
#if defined(SKIP_G)
        if (isg) return;
#endif
        bf16_t* base = isg ? G : P; const int ldc = isg ? 10240 : 8448; const int col0 = (isg ? (u.pn - 33) : u.pn) * BM + wc * 32 + 8 * fq;
#pragma unroll
        for (int ai = 0; ai < 2; ++ai)
#pragma unroll
            for (int m = 0; m < 4; ++m) { bf16_t* rowp = base + (size_t)(row0 + ai * HALF + m * 16) * ldc + col0;
#pragma unroll
                for (int bj = 0; bj < 2; ++bj) { f32x4 v0 = acc[ai][bj][m][0], v1 = acc[ai][bj][m][1];
                    if (isg) {
                        unsigned lo = 0u, hi = 0u;
#pragma unroll
                        for (int j = 0; j < 4; ++j) { lo = __builtin_amdgcn_cvt_pk_u8_f32(sigm(v0[j]) * 255.0f, j, lo); hi = __builtin_amdgcn_cvt_pk_u8_f32(sigm(v1[j]) * 255.0f, j, hi); }
                        typedef unsigned u32x2 __attribute__((ext_vector_type(2)));
                        *(u32x2*)((unsigned char*)G + (size_t)(row0 + ai * HALF + m * 16) * 10240 + col0 + bj * HALF) = (u32x2){lo, hi};
                    } else {
                    u32x4 w; w.x = cvt_pk_bf16(v0[0], v0[1]); w.y = cvt_pk_bf16(v0[2], v0[3]); w.z = cvt_pk_bf16(v1[0], v1[1]); w.w = cvt_pk_bf16(v1[2], v1[3]);
                    *(u32x4*)(rowp + bj * HALF) = w; } } }
    }
};
struct EpiGate {
    static constexpr bool PERM = true, AFTER_DRAIN = false, CARRY = false;
    bf16_t* G;
    __device__ __forceinline__ void operator()(const f32x4 (&acc)[2][2][4][2], const Unit& u, int wr, int wc, int fr, int fq) const {
        const int row0 = u.pm * BM + wr * 64 + fr, col0 = u.pn * BM + wc * 32 + 8 * fq;
#pragma unroll
        for (int ai = 0; ai < 2; ++ai)
#pragma unroll
            for (int m = 0; m < 4; ++m) { bf16_t* rowp = G + (size_t)(row0 + ai * HALF + m * 16) * 10240 + col0;
#pragma unroll
                for (int bj = 0; bj < 2; ++bj) { f32x4 v0 = acc[ai][bj][m][0], v1 = acc[ai][bj][m][1];
#pragma unroll
                    for (int j = 0; j < 4; ++j) { v0[j] = sigm(v0[j]); v1[j] = sigm(v1[j]); }
                    u32x4 w; w.x = cvt_pk_bf16(v0[0], v0[1]); w.y = cvt_pk_bf16(v0[2], v0[3]); w.z = cvt_pk_bf16(v1[0], v1[1]); w.w = cvt_pk_bf16(v1[2], v1[3]);
                    *(u32x4*)(rowp + bj * HALF) = w; } }
    }
};
struct EpiBranch {
    static constexpr bool PERM = true, AFTER_DRAIN = false, CARRY = false;
    bf16_t* G;
    __device__ __forceinline__ void operator()(const f32x4 (&acc)[2][2][4][2], const Unit& u, int wr, int wc, int fr, int fq) const {
        const int n = u.pn >> 3, j = u.pn & 7; const int row0 = (u.pm & 63) * BM + wr * 64 + fr, col0 = n * 2048 + j * BM + wc * 32 + 8 * fq;
#pragma unroll
        for (int ai = 0; ai < 2; ++ai)
#pragma unroll
            for (int m = 0; m < 4; ++m) { bf16_t* rowp = G + (size_t)(row0 + ai * HALF + m * 16) * 10240 + col0;
#pragma unroll
                for (int bj = 0; bj < 2; ++bj) { const u32x4 g = *(const u32x4*)(rowp + bj * HALF); const f32x4 v0 = acc[ai][bj][m][0], v1 = acc[ai][bj][m][1];
                    u32x4 w;
                    w.x = cvt_pk_bf16(v0[0] * __uint_as_float(g.x << 16), v0[1] * __uint_as_float(g.x & 0xffff0000u));
                    w.y = cvt_pk_bf16(v0[2] * __uint_as_float(g.y << 16), v0[3] * __uint_as_float(g.y & 0xffff0000u));
                    w.z = cvt_pk_bf16(v1[0] * __uint_as_float(g.z << 16), v1[1] * __uint_as_float(g.z & 0xffff0000u));
                    w.w = cvt_pk_bf16(v1[2] * __uint_as_float(g.w << 16), v1[3] * __uint_as_float(g.w & 0xffff0000u));
                    *(u32x4*)(rowp + bj * HALF) = w; } }
    }
};
struct EpiBranchAcc {
    static constexpr bool PERM = true, AFTER_DRAIN = false, CARRY = false;
    const bf16_t* G; bf16_t* Mg;
    __device__ __forceinline__ void operator()(const f32x4 (&acc)[2][2][4][2], const Unit& u, int wr, int wc, int fr, int fq) const {
        typedef unsigned u32x2 __attribute__((ext_vector_type(2)));
        const int n = u.pn >> 3, j = u.pn & 7; const int row0 = (u.pm & 63) * BM + wr * 64 + fr, gcol0 = n * 2048 + j * BM + wc * 32 + 8 * fq, mcol0 = j * BM + wc * 32 + 8 * fq;
#pragma unroll
        for (int ai = 0; ai < 2; ++ai) { u32x2 gg[4][2]; u32x4 ov[4][2];
#pragma unroll
            for (int m = 0; m < 4; ++m) { const unsigned char* gp = (const unsigned char*)G + (size_t)(row0 + ai * HALF + m * 16) * 10240 + gcol0; const bf16_t* mp = Mg + (size_t)(row0 + ai * HALF + m * 16) * 2048 + mcol0;
#pragma unroll
                for (int bj = 0; bj < 2; ++bj) { gg[m][bj] = *(const u32x2*)(gp + bj * HALF);
                    if (n) ov[m][bj] = *(const u32x4*)(mp + bj * HALF); } }
#pragma unroll
            for (int m = 0; m < 4; ++m) { bf16_t* mp = Mg + (size_t)(row0 + ai * HALF + m * 16) * 2048 + mcol0;
#pragma unroll
                for (int bj = 0; bj < 2; ++bj) { const u32x2 g = gg[m][bj]; const f32x4 v0 = acc[ai][bj][m][0] * (1.0f / 255.0f), v1 = acc[ai][bj][m][1] * (1.0f / 255.0f);
                    float z[8] = {v0[0] * (float)(g.x & 0xffu), v0[1] * (float)((g.x >> 8) & 0xffu), v0[2] * (float)((g.x >> 16) & 0xffu), v0[3] * (float)(g.x >> 24),
                                  v1[0] * (float)(g.y & 0xffu), v1[1] * (float)((g.y >> 8) & 0xffu), v1[2] * (float)((g.y >> 16) & 0xffu), v1[3] * (float)(g.y >> 24)};
                    if (n) { const unsigned w0 = ov[m][bj].x, w1 = ov[m][bj].y, w2 = ov[m][bj].z, w3 = ov[m][bj].w;
                        z[0] += __uint_as_float(w0 << 16); z[1] += __uint_as_float(w0 & 0xffff0000u); z[2] += __uint_as_float(w1 << 16); z[3] += __uint_as_float(w1 & 0xffff0000u);
                        z[4] += __uint_as_float(w2 << 16); z[5] += __uint_as_float(w2 & 0xffff0000u); z[6] += __uint_as_float(w3 << 16); z[7] += __uint_as_float(w3 & 0xffff0000u); }
                    u32x4 w; w.x = cvt_pk_bf16(z[0], z[1]); w.y = cvt_pk_bf16(z[2], z[3]); w.z = cvt_pk_bf16(z[4], z[5]); w.w = cvt_pk_bf16(z[6], z[7]);
                    *(u32x4*)(mp + bj * HALF) = w; } }
            asm volatile("" ::: "memory"); }
    }
};
struct EpiResF32 {
    static constexpr bool PERM = false, AFTER_DRAIN = false, CARRY = false;
    const float* R; float* O; int ldc; int ntn;
    __device__ __forceinline__ void operator()(const f32x4 (&acc)[2][2][4][2], const Unit& u, int wr, int wc, int fr, int fq) const {
        const int row0 = u.pm * BM + wr * 64 + fr, col0 = (u.pn % ntn) * BM + wc * 32 + 4 * fq;
#pragma unroll
        for (int ai = 0; ai < 2; ++ai) { f32x4 r[4][2][2];
            if (R) {
#pragma unroll
                for (int m = 0; m < 4; ++m) { const size_t off = (size_t)(row0 + ai * HALF + m * 16) * ldc + col0;
#pragma unroll
                    for (int bj = 0; bj < 2; ++bj)
#pragma unroll
                        for (int n = 0; n < 2; ++n) r[m][bj][n] = *(const f32x4*)(R + off + bj * HALF + n * 16); } }
#pragma unroll
            for (int m = 0; m < 4; ++m) { const size_t off = (size_t)(row0 + ai * HALF + m * 16) * ldc + col0;
#pragma unroll
                for (int bj = 0; bj < 2; ++bj)
#pragma unroll
                    for (int n = 0; n < 2; ++n) { f32x4 o = acc[ai][bj][m][n]; if (R) o = o + r[m][bj][n]; *(f32x4*)(O + off + bj * HALF + n * 16) = o; } }
            asm volatile("" ::: "memory"); }
    }
};
struct EpiBf16Out {
    static constexpr bool PERM = false, AFTER_DRAIN = false, CARRY = false;
    bf16_t* O; int ldc; int ntn;
    __device__ __forceinline__ void operator()(const f32x4 (&acc)[2][2][4][2], const Unit& u, int wr, int wc, int fr, int fq) const {
        typedef unsigned u32x2 __attribute__((ext_vector_type(2)));
        const int row0 = u.pm * BM + wr * 64 + fr, col0 = (u.pn % ntn) * BM + wc * 32 + 4 * fq;
#pragma unroll
        for (int ai = 0; ai < 2; ++ai)
#pragma unroll
            for (int m = 0; m < 4; ++m) { bf16_t* rowp = O + (size_t)(row0 + ai * HALF + m * 16) * ldc + col0;
#pragma unroll
                for (int bj = 0; bj < 2; ++bj)
#pragma unroll
                    for (int n = 0; n < 2; ++n) { const f32x4 v = acc[ai][bj][m][n]; *(u32x2*)(rowp + bj * HALF + n * 16) = (u32x2){cvt_pk_bf16(v[0], v[1]), cvt_pk_bf16(v[2], v[3])}; } }
    }
};
struct EpiSwiGLU {
    static constexpr bool PERM = true, AFTER_DRAIN = false, CARRY = false;
    bf16_t* H; int ldh; int tpg;
    __device__ __forceinline__ void operator()(const f32x4 (&acc)[2][2][4][2], const Unit& u, int wr, int wc, int fr, int fq) const {
        const int row0 = u.pm * BM + wr * 64 + fr, col0 = (u.pn % tpg) * HALF + wc * 32 + 8 * fq;
#pragma unroll
        for (int ai = 0; ai < 2; ++ai)
#pragma unroll
            for (int m = 0; m < 4; ++m) { bf16_t* rowp = H + (size_t)(row0 + ai * HALF + m * 16) * ldh + col0;
                f32x4 h0, h1;
#pragma unroll
                for (int j = 0; j < 4; ++j) { const float g0 = acc[ai][0][m][0][j], g1 = acc[ai][0][m][1][j]; h0[j] = g0 * sigm(g0) * acc[ai][1][m][0][j]; h1[j] = g1 * sigm(g1) * acc[ai][1][m][1][j]; }
                u32x4 w; w.x = cvt_pk_bf16(h0[0], h0[1]); w.y = cvt_pk_bf16(h0[2], h0[3]); w.z = cvt_pk_bf16(h1[0], h1[1]); w.w = cvt_pk_bf16(h1[2], h1[3]);
                *(u32x4*)rowp = w; }
    }
};
struct EpiNull {
    static constexpr bool PERM = true, AFTER_DRAIN = false, CARRY = false;
    __device__ __forceinline__ void operator()(const f32x4 (&acc)[2][2][4][2], const Unit&, int, int, int, int) const {
#pragma unroll
        for (int a = 0; a < 2; ++a)
#pragma unroll
            for (int b = 0; b < 2; ++b)
#pragma unroll
                for (int m = 0; m < 4; ++m)
#pragma unroll
                    for (int n = 0; n < 2; ++n) asm volatile("" :: "v"(acc[a][b][m][n]));
    }
};
struct EpiSwiGLU8 {
    static constexpr bool PERM = true, AFTER_DRAIN = false, CARRY = false;
    unsigned char* H; int ldh; int tpg;
    __device__ __forceinline__ void operator()(const f32x4 (&acc)[2][2][4][2], const Unit& u, int wr, int wc, int fr, int fq) const {
        const int row0 = u.pm * BM + wr * 64 + fr, col0 = (u.pn % tpg) * HALF + wc * 32 + 8 * fq;
#pragma unroll
        for (int ai = 0; ai < 2; ++ai)
#pragma unroll
            for (int m = 0; m < 4; ++m) { unsigned char* rowp = H + (size_t)(row0 + ai * HALF + m * 16) * ldh + col0;
                f32x4 h0, h1;
#pragma unroll
                for (int j = 0; j < 4; ++j) { const float g0 = acc[ai][0][m][0][j], g1 = acc[ai][0][m][1][j]; h0[j] = g0 * sigm(g0) * acc[ai][1][m][0][j]; h1[j] = g1 * sigm(g1) * acc[ai][1][m][1][j]; }
                int w0 = __builtin_amdgcn_cvt_pk_fp8_f32(h0[0], h0[1], 0, false); w0 = __builtin_amdgcn_cvt_pk_fp8_f32(h0[2], h0[3], w0, true);
                int w1 = __builtin_amdgcn_cvt_pk_fp8_f32(h1[0], h1[1], 0, false); w1 = __builtin_amdgcn_cvt_pk_fp8_f32(h1[2], h1[3], w1, true);
                typedef unsigned u32x2 __attribute__((ext_vector_type(2))); *(u32x2*)rowp = (u32x2){(unsigned)w0, (unsigned)w1}; }
    }
};
struct BranchOrder {
    int G, c;
    __device__ bool next(int i, Unit& u) const {
        const long L = (long)i * G + c; if (L >= 2560) return false;
        int w = (int)L; { const int xcd = w % NXCD, off = w / NXCD; w = xcd * 320 + off; }
        const int n = w / 512, rem = w % 512, gid = rem / 64, r2 = rem % 64;
        u.pm = n * 64 + gid * 8 + (r2 % 8); u.pn = n * 8 + r2 / 8; return true;
    }
    __device__ __forceinline__ void a_ready(const Unit&) const {}
    __device__ __forceinline__ void done(const Unit&) const {}
};
struct BranchOrder5 {
    int G, c;
    __device__ bool next(int i, Unit& u) const {
        const int tt = (i / 5) * G + c; if (tt >= 512) return false; const int n = i % 5;
        const int w = (tt % NXCD) * 64 + tt / NXCD, gid = w / 64, r2 = w % 64;
        u.pm = n * 64 + gid * 8 + (r2 % 8); u.pn = n * 8 + r2 / 8; return true;
    }
    __device__ __forceinline__ void a_ready(const Unit&) const {}
    __device__ __forceinline__ void done(const Unit&) const {}
};
struct GateOrder : StaticOrder {
    __device__ bool next(int i, Unit& u) const { if (!StaticOrder::next(i, u)) return false; u.pn += 33; return true; }
};
struct GateBatchOrder {
    int grp, base, n;
    __device__ bool next(int i, Unit& u) const { if (i >= n) return false; const int r = base + i; u.pm = grp * 8 + (r & 7); u.pn = 33 + (r >> 3); return true; }
    __device__ __forceinline__ void a_ready(const Unit&) const {}
    __device__ __forceinline__ void done(const Unit&) const {}
};
struct KvOrder {
    int c, c0;
    __device__ bool next(int i, Unit& u) const { const int w = c - c0; if (i != 0 || w < 0 || w >= 32) return false; u.pm = w >> 2; u.pn = (w >> 4) * 4 + (w & 3); return true; }
    __device__ __forceinline__ void a_ready(const Unit&) const {}
    __device__ __forceinline__ void done(const Unit&) const {}
};
struct MoeOrder {
    int G, c, tpe, total; const PG8_LAS int* tb;
    __device__ bool next(int i, Unit& u) const {
        const long L = (long)i * G + c; if (L >= total) return false;
        int w = (int)L; { const int q = total / NXCD, r = total % NXCD, xcd = w % NXCD, off = w / NXCD; w = (xcd < r ? xcd * (q + 1) : r * (q + 1) + (xcd - r) * q) + off; }
        int e = 0;
#pragma unroll
        for (int k = 1; k < 8; ++k) if (w >= tb[16 + k]) e = k;
        const int loc = w - tb[16 + e], nb = tb[e];
        u.pm = tb[8 + e] + loc % nb; u.pn = e * tpe + loc / nb; return true;
    }
    __device__ __forceinline__ void a_ready(const Unit&) const {}
    __device__ __forceinline__ void done(const Unit&) const {}
};
template <class Epi, class Sched, bool ALIGN_EPI = false, bool SP2 = false>
__device__ __forceinline__ void gemm_phase(PG8_LAS unsigned char* lds, const Gemm g, const Sched& S, const Epi& E) {
    int tid = pg8_tid(); asm volatile("" : "+v"(tid));
    const int wid = __builtin_amdgcn_readfirstlane(tid >> 6), lane = tid & 63, wr = wid >> 2, wc = wid & 3, fr = lane & 15, fq = lane >> 4;
    const int K = g.K, nt = K / BK;
    unsigned voffA[2], voffB[2];
#pragma unroll
    for (int i = 0; i < 2; ++i) { int R, C; stage_rc(tid * 16 + i * 8192, R, C); const int Rb = Epi::PERM ? ((R & ~31) + perm32(R & 31)) : R;
        voffA[i] = (unsigned)(R * K + C) * 2u; voffB[i] = (unsigned)(Rb * K + C) * 2u; }
    const size_t kstep = (size_t)(BK * 2);
    const size_t hstep = (size_t)HALF * K * 2;
    const size_t tstep = 2 * hstep;
    const unsigned ldsw = (unsigned)wid * 1024u;
    const int aoff = lds_byte(wr * 64 + fr, fq * 8), boff = lds_byte(wc * 32 + fr, fq * 8);
#define PG8_SA(b, h) (((b) * 2 + (h)) * HTB)
#define PG8_SB(b, h) ((4 + (b) * 2 + (h)) * HTB)
#define PG8_STAGE(bufoff, gbase, voff) do { _Pragma("unroll") for (int _i = 0; _i < 2; ++_i) \
        __builtin_amdgcn_global_load_lds((const unsigned*)((const char*)(gbase) + (voff)[_i]), (PG8_LAS unsigned*)(lds + (bufoff) + ldsw + _i * 8192), 16, 0, 0); } while (0)
#define PG8_LDA(dst, b, h) do { _Pragma("unroll") for (int m = 0; m < 4; ++m) _Pragma("unroll") for (int k = 0; k < 2; ++k) dst[m][k] = *(const PG8_LAS bf16x8*)(lds + PG8_SA(b, h) + aoff + m * 2048 + k * 1024); } while (0)
#define PG8_LDB(dst, b, h) do { _Pragma("unroll") for (int n = 0; n < 2; ++n) _Pragma("unroll") for (int k = 0; k < 2; ++k) dst[n][k] = *(const PG8_LAS bf16x8*)(lds + PG8_SB(b, h) + boff + n * 2048 + k * 1024); } while (0)
#define PG8_MMA(ai, bj, At, Bt) do { __builtin_amdgcn_s_setprio(1); _Pragma("unroll") for (int m = 0; m < 4; ++m) _Pragma("unroll") for (int n = 0; n < 2; ++n) _Pragma("unroll") for (int k = 0; k < 2; ++k) \
        acc[ai][bj][m][n] = __builtin_amdgcn_mfma_f32_16x16x32_bf16(Bt[n][k], At[m][k], acc[ai][bj][m][n], 0, 0, 0); __builtin_amdgcn_s_setprio(0); } while (0)
#define PG8_WAIT_V(n) asm volatile("s_waitcnt vmcnt(" #n ")" ::: "memory")
#define PG8_WAIT_L(n) asm volatile("s_waitcnt lgkmcnt(" #n ")" ::: "memory")
#define PG8_BAR __builtin_amdgcn_s_barrier()
#define PG8_SCHED __builtin_amdgcn_sched_barrier(0)
    Unit cur, nxt; int ui = 0;
    if (!S.next(0, cur)) return;
    f32x4 acc[2][2][4][2];
#pragma unroll
    for (int a = 0; a < 2; ++a)
#pragma unroll
        for (int b = 0; b < 2; ++b)
#pragma unroll
            for (int m = 0; m < 4; ++m)
#pragma unroll
                for (int n = 0; n < 2; ++n) acc[a][b][m][n] = (f32x4){0.f, 0.f, 0.f, 0.f};
    bf16x8 At[4][2], B0[2][2], B1[2][2];
    const char* cA = (const char*)g.A + (size_t)cur.pm * tstep; const char* cB = (const char*)g.Bt + (size_t)cur.pn * tstep;
    S.a_ready(cur);
    if constexpr (SP2) {
        PG8_STAGE(PG8_SB(0, 0), cB, voffB); PG8_STAGE(PG8_SB(0, 1), cB + hstep, voffB); PG8_STAGE(PG8_SA(0, 0), cA, voffA); PG8_STAGE(PG8_SA(0, 1), cA + hstep, voffA);
        if (wr == 1) PG8_BAR;
        PG8_WAIT_V(2); PG8_BAR;
        PG8_STAGE(PG8_SB(1, 0), cB + kstep, voffB); PG8_STAGE(PG8_SA(1, 0), cA + kstep, voffA); PG8_STAGE(PG8_SB(1, 1), cB + hstep + kstep, voffB);
        PG8_WAIT_V(6); PG8_BAR;
    } else {
        PG8_STAGE(PG8_SB(0, 0), cB, voffB); PG8_STAGE(PG8_SA(0, 0), cA, voffA); PG8_STAGE(PG8_SB(0, 1), cB + hstep, voffB); PG8_STAGE(PG8_SA(0, 1), cA + hstep, voffA);
        if (wr == 1) PG8_BAR;
        PG8_WAIT_V(4); PG8_BAR;
        PG8_STAGE(PG8_SB(1, 0), cB + kstep, voffB); PG8_STAGE(PG8_SA(1, 0), cA + kstep, voffA); PG8_STAGE(PG8_SB(1, 1), cB + hstep + kstep, voffB);
        PG8_WAIT_V(6); PG8_BAR;
    }
    for (;;) {
        const bool has_next = S.next(ui + 1, nxt);
        const char* nA = has_next ? (const char*)g.A + (size_t)nxt.pm * tstep : cA; const char* nB = has_next ? (const char*)g.Bt + (size_t)nxt.pn * tstep : cB;
        for (int t = 0; t < nt; t += 2) {
            const bool last = (t == nt - 2);
            const char* a1 = cA + (size_t)(t + 1) * kstep;
            const char* a2 = last ? nA : cA + (size_t)(t + 2) * kstep; const char* b2 = last ? nB : cB + (size_t)(t + 2) * kstep;
            const char* a3 = a2 + kstep; const char* b3 = b2 + kstep;
            if (last && has_next) S.a_ready(nxt);
            if constexpr (SP2) {
            PG8_LDB(B0, 0, 0); PG8_LDB(B1, 0, 1); PG8_SCHED; PG8_LDA(At, 0, 0); PG8_STAGE(PG8_SA(1, 1), a1 + hstep, voffA);
            PG8_WAIT_V(8); PG8_WAIT_L(0); PG8_BAR; PG8_MMA(0, 0, At, B0); PG8_MMA(0, 1, At, B1); PG8_BAR; PG8_SCHED;
            PG8_LDA(At, 0, 1); PG8_STAGE(PG8_SB(0, 0), b2, voffB); PG8_STAGE(PG8_SB(0, 1), b2 + hstep, voffB); PG8_STAGE(PG8_SA(0, 0), a2, voffA);
            PG8_WAIT_V(8); PG8_WAIT_L(0); PG8_BAR; PG8_MMA(1, 0, At, B0); PG8_MMA(1, 1, At, B1); PG8_BAR; PG8_SCHED;
            PG8_LDB(B0, 1, 0); PG8_LDB(B1, 1, 1); PG8_SCHED; PG8_LDA(At, 1, 0); PG8_STAGE(PG8_SA(0, 1), a2 + hstep, voffA);
            PG8_WAIT_V(8); PG8_WAIT_L(0); PG8_BAR; PG8_MMA(0, 0, At, B0); PG8_MMA(0, 1, At, B1); PG8_BAR; PG8_SCHED;
            PG8_LDA(At, 1, 1); PG8_STAGE(PG8_SB(1, 0), b3, voffB); PG8_STAGE(PG8_SB(1, 1), b3 + hstep, voffB); PG8_STAGE(PG8_SA(1, 0), a3, voffA);
            PG8_WAIT_V(8); PG8_WAIT_L(0); PG8_BAR; PG8_MMA(1, 0, At, B0); PG8_MMA(1, 1, At, B1); PG8_BAR; PG8_SCHED;
            } else {
            PG8_LDB(B0, 0, 0); PG8_SCHED; PG8_LDA(At, 0, 0); PG8_STAGE(PG8_SA(1, 1), a1 + hstep, voffA);
            PG8_WAIT_L(8); PG8_BAR; PG8_WAIT_L(0); PG8_MMA(0, 0, At, B0); PG8_BAR; PG8_SCHED;
            PG8_LDB(B1, 0, 1); PG8_STAGE(PG8_SB(0, 0), b2, voffB);
            PG8_BAR; PG8_WAIT_L(0); PG8_MMA(0, 1, At, B1); PG8_BAR;
            PG8_LDA(At, 0, 1); PG8_STAGE(PG8_SA(0, 0), a2, voffA);
            PG8_BAR; PG8_WAIT_L(0); PG8_MMA(1, 0, At, B0); PG8_BAR; PG8_SCHED;
            PG8_STAGE(PG8_SB(0, 1), b2 + hstep, voffB);
            PG8_WAIT_V(6); PG8_BAR; PG8_MMA(1, 1, At, B1); PG8_BAR;
            PG8_LDB(B0, 1, 0); PG8_SCHED; PG8_LDA(At, 1, 0); PG8_STAGE(PG8_SA(0, 1), a2 + hstep, voffA);
            PG8_WAIT_L(8); PG8_BAR; PG8_WAIT_L(0); PG8_MMA(0, 0, At, B0); PG8_BAR; PG8_SCHED;
            PG8_LDB(B1, 1, 1); PG8_STAGE(PG8_SB(1, 0), b3, voffB);
            PG8_BAR; PG8_WAIT_L(0); PG8_MMA(0, 1, At, B1); PG8_BAR;
            PG8_LDA(At, 1, 1); PG8_STAGE(PG8_SA(1, 0), a3, voffA);
            PG8_BAR; PG8_WAIT_L(0); PG8_MMA(1, 0, At, B0); PG8_BAR; PG8_SCHED;
            PG8_STAGE(PG8_SB(1, 1), b3 + hstep, voffB);
            PG8_WAIT_V(6); PG8_BAR; PG8_MMA(1, 1, At, B1); PG8_BAR;
            }
        }
        if constexpr (ALIGN_EPI) { if (wr == 0) PG8_BAR; }
        if constexpr (Epi::CARRY) { int fr_ = fr, fq_ = fq; asm volatile("" : "+v"(fr_), "+v"(fq_)); E.carry(acc, cur, wr, wc, fr_, fq_); S.done(cur); }
        else if constexpr (!Epi::AFTER_DRAIN) { E(acc, cur, wr, wc, fr, fq); S.done(cur); }
        if (!has_next) break;
        if constexpr (!Epi::CARRY)
#pragma unroll
        for (int a = 0; a < 2; ++a)
#pragma unroll
            for (int b = 0; b < 2; ++b)
#pragma unroll
                for (int m = 0; m < 4; ++m)
#pragma unroll
                    for (int n = 0; n < 2; ++n) acc[a][b][m][n] = (f32x4){0.f, 0.f, 0.f, 0.f};
        cur = nxt; cA = nA; cB = nB; ++ui;
        if constexpr (ALIGN_EPI) { if (wr == 1) PG8_BAR; }
    }
    PG8_WAIT_V(0);
    if constexpr (!ALIGN_EPI) { if (wr == 0) PG8_BAR; }
    PG8_BAR;
    if constexpr (Epi::AFTER_DRAIN) { E.fused(acc, cur, wr, wc, fr, fq, lds, wid, lane); S.done(cur); }
#undef PG8_SA
#undef PG8_SB
#undef PG8_STAGE
#undef PG8_LDA
#undef PG8_LDB
#undef PG8_MMA
#undef PG8_WAIT_V
#undef PG8_WAIT_L
#undef PG8_BAR
#undef PG8_SCHED
}
typedef int i32x8 __attribute__((ext_vector_type(8)));
typedef int i32x8a __attribute__((ext_vector_type(8), aligned(16)));
template <class Epi, class Sched, bool ALIGN_EPI = false, bool SP2 = true>
__device__ __forceinline__ void gemm_phase_f8(PG8_LAS unsigned char* lds, const Gemm g, const Sched& S, const Epi& E) {
    int tid = pg8_tid(); asm volatile("" : "+v"(tid));
    const int wid = __builtin_amdgcn_readfirstlane(tid >> 6), lane = tid & 63, wr = wid >> 2, wc = wid & 3, fr = lane & 15, fq = lane >> 4;
    const int K = g.K, nt = K / BK;
    unsigned voffA[2], voffB[2];
#pragma unroll
    for (int i = 0; i < 2; ++i) { int R, C; stage_rc(tid * 16 + i * 8192, R, C); const int Rb = Epi::PERM ? ((R & ~31) + perm32(R & 31)) : R;
        voffA[i] = (unsigned)(R * K + C) * 2u; voffB[i] = (unsigned)(Rb * K + C) * 2u; }
    const size_t kstep = (size_t)(BK * 2);
    const size_t hstep = (size_t)HALF * K * 2;
    const size_t tstep = 2 * hstep;
    const unsigned ldsw = (unsigned)wid * 1024u;
    const int aoff = lds_byte(wr * 64 + fr, fq * 8), boff = lds_byte(wc * 32 + fr, fq * 8);
#define PG8_SA(b, h) (((b) * 2 + (h)) * HTB)
#define PG8_SB(b, h) ((4 + (b) * 2 + (h)) * HTB)
#define PG8_STAGE(bufoff, gbase, voff) do { _Pragma("unroll") for (int _i = 0; _i < 2; ++_i) \
        __builtin_amdgcn_global_load_lds((const unsigned*)((const char*)(gbase) + (voff)[_i]), (PG8_LAS unsigned*)(lds + (bufoff) + ldsw + _i * 8192), 16, 0, 0); } while (0)
#define PG8_LDA(dst, b, h) do { _Pragma("unroll") for (int m = 0; m < 4; ++m) { const u32x4 lo_ = *(const PG8_LAS u32x4*)(lds + PG8_SA(b, h) + aoff + m * 2048), hi_ = *(const PG8_LAS u32x4*)(lds + PG8_SA(b, h) + aoff + m * 2048 + 1024); dst[m] = (i32x8){(int)lo_.x, (int)lo_.y, (int)lo_.z, (int)lo_.w, (int)hi_.x, (int)hi_.y, (int)hi_.z, (int)hi_.w}; } } while (0)
#define PG8_LDB(dst, b, h) do { _Pragma("unroll") for (int n = 0; n < 2; ++n) { const u32x4 lo_ = *(const PG8_LAS u32x4*)(lds + PG8_SB(b, h) + boff + n * 2048), hi_ = *(const PG8_LAS u32x4*)(lds + PG8_SB(b, h) + boff + n * 2048 + 1024); dst[n] = (i32x8){(int)lo_.x, (int)lo_.y, (int)lo_.z, (int)lo_.w, (int)hi_.x, (int)hi_.y, (int)hi_.z, (int)hi_.w}; } } while (0)
#define PG8_MMA(ai, bj, At, Bt) do { __builtin_amdgcn_s_setprio(1); _Pragma("unroll") for (int m = 0; m < 4; ++m) _Pragma("unroll") for (int n = 0; n < 2; ++n) \
        asm volatile("s_nop 1\n\tv_mfma_scale_f32_16x16x128_f8f6f4 %0, %1, %2, %0, %3, %4 op_sel_hi:[0,0,0]" : "+v"(acc[ai][bj][m][n]) : "v"(Bt[n]), "v"(At[m]), "v"(sc_w), "v"(sc_a)); __builtin_amdgcn_s_setprio(0); } while (0)
#define PG8_WAIT_V(n) asm volatile("s_waitcnt vmcnt(" #n ")" ::: "memory")
#define PG8_WAIT_L(n) asm volatile("s_waitcnt lgkmcnt(" #n ")" ::: "memory")
#define PG8_BAR __builtin_amdgcn_s_barrier()
#define PG8_SCHED __builtin_amdgcn_sched_barrier(0)
    Unit cur, nxt; int ui = 0;
    if (!S.next(0, cur)) return;
    f32x4 acc[2][2][4][2];
#pragma unroll
    for (int a = 0; a < 2; ++a)
#pragma unroll
        for (int b = 0; b < 2; ++b)
#pragma unroll
            for (int m = 0; m < 4; ++m)
#pragma unroll
                for (int n = 0; n < 2; ++n) acc[a][b][m][n] = (f32x4){0.f, 0.f, 0.f, 0.f};
    i32x8 At[4], B0[2], B1[2];
    int sc_w = 0x79797979, sc_a = 0x7F7F7F7F;
    asm volatile("" : "+v"(sc_w), "+v"(sc_a));
    const char* cA = (const char*)g.A + (size_t)cur.pm * tstep; const char* cB = (const char*)g.Bt + (size_t)cur.pn * tstep;
    S.a_ready(cur);
    if constexpr (SP2) {
        PG8_STAGE(PG8_SB(0, 0), cB, voffB); PG8_STAGE(PG8_SB(0, 1), cB + hstep, voffB); PG8_STAGE(PG8_SA(0, 0), cA, voffA); PG8_STAGE(PG8_SA(0, 1), cA + hstep, voffA);
        if (wr == 1) PG8_BAR;
        PG8_WAIT_V(2); PG8_BAR;
        PG8_STAGE(PG8_SB(1, 0), cB + kstep, voffB); PG8_STAGE(PG8_SA(1, 0), cA + kstep, voffA); PG8_STAGE(PG8_SB(1, 1), cB + hstep + kstep, voffB);
        PG8_WAIT_V(6); PG8_BAR;
    } else {
        PG8_STAGE(PG8_SB(0, 0), cB, voffB); PG8_STAGE(PG8_SA(0, 0), cA, voffA); PG8_STAGE(PG8_SB(0, 1), cB + hstep, voffB); PG8_STAGE(PG8_SA(0, 1), cA + hstep, voffA);
        if (wr == 1) PG8_BAR;
        PG8_WAIT_V(4); PG8_BAR;
        PG8_STAGE(PG8_SB(1, 0), cB + kstep, voffB); PG8_STAGE(PG8_SA(1, 0), cA + kstep, voffA); PG8_STAGE(PG8_SB(1, 1), cB + hstep + kstep, voffB);
        PG8_WAIT_V(6); PG8_BAR;
    }
    for (;;) {
        const bool has_next = S.next(ui + 1, nxt);
        const char* nA = has_next ? (const char*)g.A + (size_t)nxt.pm * tstep : cA; const char* nB = has_next ? (const char*)g.Bt + (size_t)nxt.pn * tstep : cB;
        for (int t = 0; t < nt; t += 2) {
            const bool last = (t == nt - 2);
            const char* a1 = cA + (size_t)(t + 1) * kstep;
            const char* a2 = last ? nA : cA + (size_t)(t + 2) * kstep; const char* b2 = last ? nB : cB + (size_t)(t + 2) * kstep;
            const char* a3 = a2 + kstep; const char* b3 = b2 + kstep;
            if (last && has_next) S.a_ready(nxt);
            if constexpr (SP2) {
            PG8_LDB(B0, 0, 0); PG8_LDB(B1, 0, 1); PG8_SCHED; PG8_LDA(At, 0, 0); PG8_STAGE(PG8_SA(1, 1), a1 + hstep, voffA);
            PG8_WAIT_V(8); PG8_WAIT_L(0); PG8_BAR; PG8_MMA(0, 0, At, B0); PG8_MMA(0, 1, At, B1); PG8_BAR; PG8_SCHED;
            PG8_LDA(At, 0, 1); PG8_STAGE(PG8_SB(0, 0), b2, voffB); PG8_STAGE(PG8_SB(0, 1), b2 + hstep, voffB); PG8_STAGE(PG8_SA(0, 0), a2, voffA);
            PG8_WAIT_V(8); PG8_WAIT_L(0); PG8_BAR; PG8_MMA(1, 0, At, B0); PG8_MMA(1, 1, At, B1); PG8_BAR; PG8_SCHED;
            PG8_LDB(B0, 1, 0); PG8_LDB(B1, 1, 1); PG8_SCHED; PG8_LDA(At, 1, 0); PG8_STAGE(PG8_SA(0, 1), a2 + hstep, voffA);
            PG8_WAIT_V(8); PG8_WAIT_L(0); PG8_BAR; PG8_MMA(0, 0, At, B0); PG8_MMA(0, 1, At, B1); PG8_BAR; PG8_SCHED;
            PG8_LDA(At, 1, 1); PG8_STAGE(PG8_SB(1, 0), b3, voffB); PG8_STAGE(PG8_SB(1, 1), b3 + hstep, voffB); PG8_STAGE(PG8_SA(1, 0), a3, voffA);
            PG8_WAIT_V(8); PG8_WAIT_L(0); PG8_BAR; PG8_MMA(1, 0, At, B0); PG8_MMA(1, 1, At, B1); PG8_BAR; PG8_SCHED;
            } else {
            PG8_LDB(B0, 0, 0); PG8_SCHED; PG8_LDA(At, 0, 0); PG8_STAGE(PG8_SA(1, 1), a1 + hstep, voffA);
            PG8_WAIT_L(8); PG8_BAR; PG8_WAIT_L(0); PG8_MMA(0, 0, At, B0); PG8_BAR; PG8_SCHED;
            PG8_LDB(B1, 0, 1); PG8_STAGE(PG8_SB(0, 0), b2, voffB);
            PG8_BAR; PG8_WAIT_L(0); PG8_MMA(0, 1, At, B1); PG8_BAR;
            PG8_LDA(At, 0, 1); PG8_STAGE(PG8_SA(0, 0), a2, voffA);
            PG8_BAR; PG8_WAIT_L(0); PG8_MMA(1, 0, At, B0); PG8_BAR; PG8_SCHED;
            PG8_STAGE(PG8_SB(0, 1), b2 + hstep, voffB);
            PG8_WAIT_V(6); PG8_BAR; PG8_MMA(1, 1, At, B1); PG8_BAR;
            PG8_LDB(B0, 1, 0); PG8_SCHED; PG8_LDA(At, 1, 0); PG8_STAGE(PG8_SA(0, 1), a2 + hstep, voffA);
            PG8_WAIT_L(8); PG8_BAR; PG8_WAIT_L(0); PG8_MMA(0, 0, At, B0); PG8_BAR; PG8_SCHED;
            PG8_LDB(B1, 1, 1); PG8_STAGE(PG8_SB(1, 0), b3, voffB);
            PG8_BAR; PG8_WAIT_L(0); PG8_MMA(0, 1, At, B1); PG8_BAR;
            PG8_LDA(At, 1, 1); PG8_STAGE(PG8_SA(1, 0), a3, voffA);
            PG8_BAR; PG8_WAIT_L(0); PG8_MMA(1, 0, At, B0); PG8_BAR; PG8_SCHED;
            PG8_STAGE(PG8_SB(1, 1), b3 + hstep, voffB);
            PG8_WAIT_V(6); PG8_BAR; PG8_MMA(1, 1, At, B1); PG8_BAR;
            }
        }
        if constexpr (ALIGN_EPI) { if (wr == 0) PG8_BAR; }
#pragma unroll
        for (int a_ = 0; a_ < 2; ++a_)
#pragma unroll
            for (int b_ = 0; b_ < 2; ++b_) asm volatile("s_nop 15\n\ts_nop 15" : "+v"(acc[a_][b_][0][0]), "+v"(acc[a_][b_][0][1]), "+v"(acc[a_][b_][1][0]), "+v"(acc[a_][b_][1][1]), "+v"(acc[a_][b_][2][0]), "+v"(acc[a_][b_][2][1]), "+v"(acc[a_][b_][3][0]), "+v"(acc[a_][b_][3][1]));
        if constexpr (!Epi::AFTER_DRAIN) { int fr_ = fr, fq_ = fq; asm volatile("" : "+v"(fr_), "+v"(fq_));
            E(acc, cur, wr, wc, fr_, fq_); S.done(cur); }
        if (!has_next) break;
#pragma unroll
        for (int a = 0; a < 2; ++a)
#pragma unroll
            for (int b = 0; b < 2; ++b)
#pragma unroll
                for (int m = 0; m < 4; ++m)
#pragma unroll
                    for (int n = 0; n < 2; ++n) acc[a][b][m][n] = (f32x4){0.f, 0.f, 0.f, 0.f};
        cur = nxt; cA = nA; cB = nB; ++ui;
        if constexpr (ALIGN_EPI) { if (wr == 1) PG8_BAR; }
    }
    PG8_WAIT_V(0);
    if constexpr (!ALIGN_EPI) { if (wr == 0) PG8_BAR; }
    PG8_BAR;
    if constexpr (Epi::AFTER_DRAIN) { E.fused(acc, cur, wr, wc, fr, fq, lds, wid, lane); S.done(cur); }
#undef PG8_SA
#undef PG8_SB
#undef PG8_STAGE
#undef PG8_LDA
#undef PG8_LDB
#undef PG8_MMA
#undef PG8_WAIT_V
#undef PG8_WAIT_L
#undef PG8_BAR
#undef PG8_SCHED
}
}
constexpr int NT = 16384, DM = 2048, SEQ = 4096, NBATCH = 4, NLAYER = 2;
constexpr int LDP = 8448, NGATE = 10240, NIN = 18688, PIN = 18480;
constexpr int C_NAQ = 0, C_NAK = 512, C_NAV = 1024, C_GLQ = 1536, C_GLK = 1792, C_GLV = 2048, C_GLLR = 2560, C_GLOG = 2592, C_GDQKV = 3104, C_GDA = 4640, C_GDB = 4648,
              C_GDOG = 4656, C_HGQ = 5168, C_HGF = 5680, C_HGI = 6704, C_HGOG = 7216, C_MQ = 7728, C_PEND = 8240;
constexpr int DFF = 5632, DFFE = 7168, NEXP = 8, MAXSLOT = 34816;
constexpr float RMS_EPS = 1e-6f;
constexpr size_t MiB = 1u << 20;
constexpr size_t WS_CTL = 0, CTL_ZERO_BYTES = 1 * MiB;
constexpr size_t WS_ROUTE = 1 * MiB;
constexpr size_t WS_MK = 2 * MiB;
constexpr size_t WS_MVT = 4 * MiB;
constexpr size_t WS_KVRAW = 6 * MiB;
constexpr size_t WS_MEMN = 14 * MiB;
constexpr size_t WS_WIN = 24 * MiB;
constexpr size_t WS_WBR = WS_WIN + 146 * MiB;
constexpr size_t WS_WOUT = WS_WBR + 20 * MiB;
constexpr size_t WS_WMKV = WS_WOUT + 16 * MiB;
constexpr size_t WS_WGU = WS_WMKV + 8 * MiB;
constexpr size_t WS_WDN = WS_WGU + 44 * MiB;
constexpr size_t WS_MOE1 = WS_WDN + 22 * MiB;
constexpr size_t WS_MOE2 = WS_MOE1 + 448 * MiB;
constexpr size_t WS_OA = WS_MOE1 + 224 * MiB, WS_MOE2F = WS_MOE2 + 112 * MiB;
constexpr size_t WS_HM = WS_MOE2 + 224 * MiB;
constexpr size_t WS_P = WS_HM + 64 * MiB;
constexpr size_t WS_G = WS_P + 264 * MiB;
constexpr size_t WS_GLG = WS_G + 320 * MiB;
constexpr size_t WS_GQ = WS_GLG + 32 * MiB;
constexpr size_t WS_GAB = WS_GQ + 48 * MiB;
constexpr size_t WS_HQ = WS_GAB + 1 * MiB;
constexpr size_t WS_HF = WS_HQ + 16 * MiB;
constexpr size_t WS_NAVT = WS_HF + 64 * MiB;
constexpr size_t WS_SOUT = WS_NAVT + 16 * MiB;
constexpr size_t WS_BR = WS_SOUT + 96 * MiB;
constexpr size_t WS_H8 = WS_BR + 80 * MiB;
constexpr size_t WS_END = WS_H8 + 32 * MiB;
constexpr size_t WS_HID = WS_P;
constexpr size_t WS_XB = WS_P;
constexpr size_t WS_HIDM = WS_XB + 136 * MiB;
constexpr size_t WS_YB = WS_HIDM + 476 * MiB;
static_assert(WS_YB + 272 * MiB <= WS_END, "MoE overlay fits");
static_assert(WS_END <= 2085645600ull, "workspace map fits sum(inputs)");
constexpr int CW_TMO = 0, CW_CODE = 1, CW_BAR = 4096, CW_WQ = 8192, CW_CNT = 8192 + 1024, CW_CONVQ = 8192 + 2048, CW_S2DONE = 8192 + 2048 + 64, CW_GQ = 16384;
constexpr int RING_OFF = 0, RING_BYTES = 131072, LDSCTL_OFF = RING_BYTES, MISC_OFF = LDSCTL_OFF + 320, TAB_OFF = LDSCTL_OFF + 512, LDS_BYTES = 147456;
constexpr int NWAVES = 8;
#ifndef MK_SPLIT
#define MK_SPLIT 0
#endif
#define GAS __attribute__((address_space(1)))
#define LAS __attribute__((address_space(3)))
typedef unsigned short bf16;
typedef unsigned v4u __attribute__((ext_vector_type(4)));
typedef float f32x4 __attribute__((ext_vector_type(4)));
typedef short bf16x8 __attribute__((ext_vector_type(8)));
typedef GAS unsigned gu32;
typedef GAS unsigned long long gu64;
#define RLX_AGENT __ATOMIC_RELAXED, __HIP_MEMORY_SCOPE_AGENT
#define LDS_WAIT() asm volatile("s_waitcnt lgkmcnt(0)" ::: "memory")
#define VM_WAIT() asm volatile("s_waitcnt vmcnt(0)" ::: "memory")
__device__ __forceinline__ unsigned long long rt() { return __builtin_amdgcn_s_memrealtime(); }
__device__ __forceinline__ unsigned f2bf(float f) { unsigned u = __builtin_bit_cast(unsigned, f); return (u + 0x7fffu + ((u >> 16) & 1u)) >> 16; }
__device__ __forceinline__ unsigned pk2(float lo, float hi) { return f2bf(lo) | (f2bf(hi) << 16); }
constexpr int WAVETAB_OFF = 131072 + 1024;
__device__ __forceinline__ unsigned hw_slot() { return (unsigned)__builtin_amdgcn_s_getreg((5 << 11) | 4) & 63u; }
__device__ __forceinline__ int mk_lane() { return (int)__builtin_amdgcn_mbcnt_hi(~0u, __builtin_amdgcn_mbcnt_lo(~0u, 0u)); }
__device__ __forceinline__ int mk_wave() { extern __shared__ __attribute__((aligned(16))) unsigned char lds_raw_[]; const volatile LAS int* tab = (const volatile LAS int*)((LAS unsigned char*)lds_raw_ + WAVETAB_OFF); return __builtin_amdgcn_readfirstlane(tab[hw_slot()]); }
__device__ __forceinline__ int mk_tid() { return mk_wave() * 64 + mk_lane(); }
__device__ __forceinline__ int pg8_tid() { return mk_tid(); }
#define XB_TMO      128
#define XB_XCNT(j)  (256  + 64 * (j))
#define XB_XSUB(j)  (1280 + 64 * (j))
#define XB_XGEN(j)  (2304 + 64 * (j))
#define XB_TOP      3328
#define XB_TOPGEN   3392
#define XCD_BAR_WORDS 3456
#define XB_SPIN_CAP (1u << 22)

__device__ __forceinline__ unsigned xb_ld(unsigned* p)              { return __hip_atomic_load(p, __ATOMIC_RELAXED, __HIP_MEMORY_SCOPE_AGENT); }
__device__ __forceinline__ unsigned xb_add(unsigned* p, unsigned v) { return __hip_atomic_fetch_add(p, v, __ATOMIC_RELAXED, __HIP_MEMORY_SCOPE_AGENT); }
__device__ __forceinline__ unsigned xb_xcc_id() { return (unsigned)__builtin_amdgcn_s_getreg((3 << 11) | 20) & 0xFu; }
#define XB_SPIN(cond, bar) do { unsigned _sp = 0; while (cond) { __builtin_amdgcn_s_sleep(1); \
    if ((++_sp & 255u) == 0u) { if (xb_ld(&(bar)[XB_TMO])) break; if (_sp > XB_SPIN_CAP) { atomicAdd(&(bar)[XB_TMO], 1u); break; } } } } while (0)

struct XcdBarrier {
    unsigned* bar; unsigned x;
    volatile LAS unsigned* st;
};

__device__ __forceinline__ XcdBarrier xcd_barrier_post(unsigned* bar, volatile LAS unsigned* st) {
    XcdBarrier b; b.bar = bar; b.x = xb_xcc_id(); b.st = st;
    if (mk_tid() == 0) (void)xb_add(&bar[XB_XCNT(b.x)], 1u);
    return b;
}
__device__ __forceinline__ void xcd_barrier_complete(unsigned* bar, unsigned x, unsigned& nloc, unsigned& nx) {
    const unsigned G = gridDim.x * gridDim.y * gridDim.z;
    unsigned sum, cnt, mine, sp = 0u;
    for (;;) {
        sum = 0u; cnt = 0u; mine = 0u;
#pragma unroll
        for (unsigned j = 0; j < 16; ++j) { const unsigned c = xb_ld(&bar[XB_XCNT(j)]); sum += c; cnt += (c > 0u) ? 1u : 0u; mine = (j == x) ? c : mine; }
        if (sum == G) break;
        __builtin_amdgcn_s_sleep(1);
        if ((++sp & 255u) == 0u) { if (xb_ld(&bar[XB_TMO])) break; if (sp > XB_SPIN_CAP) { atomicAdd(&bar[XB_TMO], 1u); break; } }
    }
    nloc = mine > 0u ? mine : 1u; nx = cnt > 0u ? cnt : 1u;
}

__device__ __forceinline__ void xcd_barrier(const XcdBarrier& b) {
    asm volatile("s_waitcnt vmcnt(0)" ::: "memory");
    __syncthreads();
    if (mk_tid() == 0) {
        unsigned* bar = b.bar;
        __builtin_amdgcn_s_waitcnt(0);
        unsigned nloc = b.st[0], nx = b.st[1];
        if (nloc == 0u) { xcd_barrier_complete(bar, b.x, nloc, nx); b.st[0] = nloc; b.st[1] = nx; }
        const unsigned old = xb_add(&bar[XB_XSUB(b.x)], 1u);
        const unsigned gen = old / nloc;
        if (old + 1u == (gen + 1u) * nloc) {
            __builtin_amdgcn_fence(__ATOMIC_RELEASE, "agent");
            asm volatile("s_waitcnt vmcnt(0)" ::: "memory");
            const unsigned og = xb_add(&bar[XB_TOP], 1u);
            const unsigned tg = og / nx;
            if (og + 1u == (tg + 1u) * nx) xb_add(&bar[XB_TOPGEN], 1u);
            else XB_SPIN(xb_ld(&bar[XB_TOPGEN]) == tg, bar);
            __builtin_amdgcn_fence(__ATOMIC_ACQUIRE, "agent");
            xb_add(&bar[XB_XGEN(b.x)], 1u);
            asm volatile("s_waitcnt vmcnt(0)" ::: "memory");
        } else {
            XB_SPIN(xb_ld(&bar[XB_XGEN(b.x)]) == gen, bar);
            __builtin_amdgcn_fence(__ATOMIC_ACQUIRE, "agent");
            asm volatile("s_waitcnt vmcnt(0)" ::: "memory");
        }
    }
    __syncthreads();
}
typedef unsigned v2u __attribute__((ext_vector_type(2)));
typedef float f32x2v __attribute__((ext_vector_type(2)));
__device__ __forceinline__ float bflo(unsigned w) { return __uint_as_float(w << 16); }
__device__ __forceinline__ float bfhi(unsigned w) { return __uint_as_float(w & 0xffff0000u); }
__device__ __forceinline__ float bf1(bf16 h) { return __uint_as_float(((unsigned)h) << 16); }
typedef __bf16 bf16x2_t __attribute__((ext_vector_type(2)));
__device__ __forceinline__ unsigned pkbf(float lo, float hi) { const f32x2v v = {lo, hi}; return __builtin_bit_cast(unsigned, __builtin_convertvector(v, bf16x2_t)); }
__device__ __forceinline__ void unpack8(const v4u w, float (&f)[8]) { f[0] = bflo(w.x); f[1] = bfhi(w.x); f[2] = bflo(w.y); f[3] = bfhi(w.y); f[4] = bflo(w.z); f[5] = bfhi(w.z); f[6] = bflo(w.w); f[7] = bfhi(w.w); }
__device__ __forceinline__ v4u pack8(const float (&f)[8]) { v4u w; w.x = pkbf(f[0], f[1]); w.y = pkbf(f[2], f[3]); w.z = pkbf(f[4], f[5]); w.w = pkbf(f[6], f[7]); return w; }
__device__ __forceinline__ float sigmf(float x) { return __builtin_amdgcn_rcpf(1.0f + __expf(-x)); }
__device__ __forceinline__ float siluf(float x) { return x * __builtin_amdgcn_rcpf(1.0f + __expf(-x)); }
__device__ __forceinline__ float softplusf(float x) { return fmaxf(x, 0.f) + __logf(1.0f + __expf(-fabsf(x))); }
#define DPP_ADD(v, ctrl) ((v) + __int_as_float(__builtin_amdgcn_update_dpp(0, __float_as_int(v), (ctrl), 0xF, 0xF, true)))
__device__ __forceinline__ float row16_sum(float v) { v = DPP_ADD(v, 0xB1); v = DPP_ADD(v, 0x4E); v = DPP_ADD(v, 0x141); v = DPP_ADD(v, 0x140); return v; }
__device__ __forceinline__ float wave_sum(float v) { v = row16_sum(v); v += __shfl_xor(v, 16); v += __shfl_xor(v, 32); return v; }
template <int N> __device__ __forceinline__ float group_sum(float v) {
    v = DPP_ADD(v, 0xB1); v = DPP_ADD(v, 0x4E); v = DPP_ADD(v, 0x141); if (N == 16) v = DPP_ADD(v, 0x140);
    return v;
}
template <int KL> __device__ __forceinline__ float kl_sum(float v) {
    v = DPP_ADD(v, 0xB1); v = DPP_ADD(v, 0x4E); v = DPP_ADD(v, 0x141);
    if (KL == 16) v = DPP_ADD(v, 0x140);
    return v;
}
__device__ __forceinline__ unsigned pk4_f8(float a, float b, float c, float d);
__device__ __forceinline__ void rms_row(const float* xrow, const float* gain, bf16* orow, int lane, f32x4 (&v)[8], unsigned char* o8row = nullptr) {
    const f32x4* xr = (const f32x4*)xrow + lane; float s = 0.f;
#pragma unroll
    for (int j = 0; j < 8; ++j) { v[j] = xr[64 * j]; s += (v[j].x * v[j].x + v[j].y * v[j].y) + (v[j].z * v[j].z + v[j].w * v[j].w); }
    const float sc = rsqrtf(wave_sum(s) * (1.0f / DM) + RMS_EPS);
    const f32x4* gr = (const f32x4*)gain + lane; v2u* o8 = (v2u*)orow + lane;
#pragma unroll
    for (int j = 0; j < 8; ++j) { v[j] = v[j] * sc * gr[64 * j]; v2u w; w.x = pkbf(v[j].x, v[j].y); w.y = pkbf(v[j].z, v[j].w); o8[64 * j] = w;
        if (o8row) ((unsigned*)o8row)[lane + 64 * j] = pk4_f8(v[j].x, v[j].y, v[j].z, v[j].w); }
}
__device__ __forceinline__ unsigned pk4_f8(float a, float b, float c, float d);
__device__ __forceinline__ void rms_row_f8(const float* xrow, const float* gain, unsigned char* orow, int lane, f32x4 (&v)[8]) {
    const f32x4* xr = (const f32x4*)xrow + lane; float s = 0.f;
#pragma unroll
    for (int j = 0; j < 8; ++j) { v[j] = xr[64 * j]; s += (v[j].x * v[j].x + v[j].y * v[j].y) + (v[j].z * v[j].z + v[j].w * v[j].w); }
    const float sc = rsqrtf(wave_sum(s) * (1.0f / DM) + RMS_EPS);
    const f32x4* gr = (const f32x4*)gain + lane; unsigned* o4 = (unsigned*)orow + lane;
#pragma unroll
    for (int j = 0; j < 8; ++j) { v[j] = v[j] * sc * gr[64 * j]; o4[64 * j] = pk4_f8(v[j].x, v[j].y, v[j].z, v[j].w); }
}
__device__ __forceinline__ unsigned pk4_f8(float a, float b, float c, float d) { int w = __builtin_amdgcn_cvt_pk_fp8_f32(a, b, 0, false); w = __builtin_amdgcn_cvt_pk_fp8_f32(c, d, w, true); return (unsigned)w; }
struct RmOff { int off; __device__ __forceinline__ int operator()(int n) const { return n + off; } };
struct RmWin { __device__ __forceinline__ int operator()(int n) const { return n < C_PEND ? n : n + (LDP - C_PEND); } };
struct RmGU { int up; __device__ __forceinline__ int operator()(int n) const { return (n >> 7) * 256 + (n & 127) + up * 128; } };
__device__ __forceinline__ void tr_load(float (&v)[64], const float* W, int ldw, int N, int nblk, int it, int lane) {
    const int kb = it / nblk, nb = it % nblk; const int n = 64 * nb + lane; const bool ok = n < N; const float* p = W + (size_t)(64 * kb) * ldw + (ok ? n : 0);
#pragma unroll
    for (int kk = 0; kk < 64; ++kk) v[kk] = p[(size_t)kk * ldw];
    if (!ok) {
#pragma unroll
        for (int kk = 0; kk < 64; ++kk) v[kk] = 0.f; }
}
template <class RowMap> __device__ __forceinline__ void tr_store(const float (&v)[64], int K, int N, int nblk, int it, bf16* WT, LAS unsigned* scr, int lane, const RowMap& rm) {
    const int kb = it / nblk, nb = it % nblk;
#pragma unroll
    for (int kp = 0; kp < 32; ++kp) scr[lane * 33 + kp] = pkbf(v[2 * kp], v[2 * kp + 1]);
    LDS_WAIT(); asm volatile("" ::: "memory");
    const int c = lane & 7;
#pragma unroll
    for (int j = 0; j < 8; ++j) { const int nl = (lane >> 3) + 8 * j; const LAS unsigned* s = scr + nl * 33 + 4 * c; v4u o; o.x = s[0]; o.y = s[1]; o.z = s[2]; o.w = s[3];
        const int n = 64 * nb + nl; if (n < N) *(GAS v4u*)(WT + (size_t)rm(n) * K + 64 * kb + 8 * c) = o; }
    LDS_WAIT(); asm volatile("" ::: "memory");
}
template <class RowMap> __device__ __forceinline__ void transpose_job(const float* W, int K, int N, bf16* WT, LAS float* scr_f, int gw, int NGW, int lane, const RowMap& rm, int ldw = 0) {
    if (!ldw) ldw = N;
    LAS unsigned* scr = (LAS unsigned*)scr_f; const int nblk = (N + 63) / 64, nit = (K / 64) * nblk;
    float va[64], vb[64]; int it = gw;
    if (it < nit) tr_load(va, W, ldw, N, nblk, it, lane);
#pragma unroll 1
    for (; it < nit; it += 2 * NGW) { const int it2 = it + NGW, it3 = it2 + NGW;
        if (it2 < nit) tr_load(vb, W, ldw, N, nblk, it2, lane);
        tr_store(va, K, N, nblk, it, WT, scr, lane, rm);
        if (it3 < nit) tr_load(va, W, ldw, N, nblk, it3, lane);
        if (it2 < nit) tr_store(vb, K, N, nblk, it2, WT, scr, lane, rm);
    }
}
template <class RowMap> __device__ __forceinline__ void tr_store_f8(const float (&v)[64], float scale, int K, int N, int nblk, int it, unsigned char* WT, LAS unsigned* scr, int lane, const RowMap& rm) {
    const int kb = it / nblk, nb = it % nblk;
#pragma unroll
    for (int q = 0; q < 16; ++q) scr[lane * 17 + q] = pk4_f8(v[4 * q] * scale, v[4 * q + 1] * scale, v[4 * q + 2] * scale, v[4 * q + 3] * scale);
    LDS_WAIT(); asm volatile("" ::: "memory");
    const int c = lane & 3;
#pragma unroll
    for (int j = 0; j < 4; ++j) { const int nl = (lane >> 2) + 16 * j; const LAS unsigned* s = scr + nl * 17 + 4 * c; v4u o; o.x = s[0]; o.y = s[1]; o.z = s[2]; o.w = s[3];
        const int n = 64 * nb + nl; if (n < N) *(GAS v4u*)(WT + (size_t)rm(n) * K + 64 * kb + 16 * c) = o; }
    LDS_WAIT(); asm volatile("" ::: "memory");
}
template <class RowMap> __device__ __forceinline__ void transpose_job_f8(const float* W, float scale, int K, int N, unsigned char* WT, LAS float* scr_f, int gw, int NGW, int lane, const RowMap& rm, int ldw = 0) {
    if (!ldw) ldw = N;
    LAS unsigned* scr = (LAS unsigned*)scr_f; const int nblk = (N + 63) / 64, nit = (K / 64) * nblk;
    float va[64], vb[64]; int it = gw;
    if (it < nit) tr_load(va, W, ldw, N, nblk, it, lane);
#pragma unroll 1
    for (; it < nit; it += 2 * NGW) { const int it2 = it + NGW, it3 = it2 + NGW;
        if (it2 < nit) tr_load(vb, W, ldw, N, nblk, it2, lane);
        tr_store_f8(va, scale, K, N, nblk, it, WT, scr, lane, rm);
        if (it3 < nit) tr_load(va, W, ldw, N, nblk, it3, lane);
        if (it2 < nit) tr_store_f8(vb, scale, K, N, nblk, it2, WT, scr, lane, rm);
    }
}
__device__ __forceinline__ void moe1_convert_all(const float* wg, const float* wu, unsigned char* MOE1, LAS float* scr_f, int gw, int NGW, int lane) {
    LAS unsigned* scr = (LAS unsigned*)scr_f; constexpr int NB = DFFE / 64, TPJ = (DM / 64) * NB, NIT = 16 * TPJ;
    float va[64], vb[64]; int it = gw;
#define M1_SRC(t) (((((t) / TPJ) & 1) ? wu : wg) + (size_t)(((t) / TPJ) >> 1) * DM * DFFE)
#define M1_DST(t) (MOE1 + (size_t)(((t) / TPJ) >> 1) * 2 * DFFE * DM)
    if (it < NIT) tr_load(va, M1_SRC(it), DFFE, DFFE, NB, it % TPJ, lane);
#pragma unroll 1
    for (; it < NIT; it += 2 * NGW) { const int it2 = it + NGW, it3 = it2 + NGW;
        if (it2 < NIT) tr_load(vb, M1_SRC(it2), DFFE, DFFE, NB, it2 % TPJ, lane);
        tr_store_f8(va, 64.0f, DM, DFFE, NB, it % TPJ, M1_DST(it), scr, lane, RmGU{(it / TPJ) & 1});
        if (it3 < NIT) tr_load(va, M1_SRC(it3), DFFE, DFFE, NB, it3 % TPJ, lane);
        if (it2 < NIT) tr_store_f8(vb, 64.0f, DM, DFFE, NB, it2 % TPJ, M1_DST(it2), scr, lane, RmGU{(it2 / TPJ) & 1});
    }
#undef M1_SRC
#undef M1_DST
}
struct RmGen { int kind, off; __device__ __forceinline__ int operator()(int n) const { return kind ? (n >> 7) * 256 + (n & 127) + off * 128 : n + off; } };
struct P0Job { const float* W; int ldw, N, K, nblk, loc, f8; unsigned char* WT; RmGen rm; };
__device__ __forceinline__ P0Job p0_job(int t, const float* w_in, const float* w_br, const float* w_out, const float* w_kv, const float* f_gate, const float* f_up, const float* f_down, unsigned char* ws) {
    P0Job j; j.f8 = 0; j.rm = RmGen{0, 0};
    constexpr int T_P = 32 * 129, T_G = 32 * 160, T_B = 8 * 32, T_O = 32 * 32, T_K = 32 * 16, T_L = T_P + T_G + 5 * T_B + T_O + T_K, T_D = 32 * 88;
    if (t < 2 * T_L) { const int L = t / T_L; int r = t % T_L;
        if (r < T_P) { j.W = w_in + (size_t)L * DM * PIN; j.ldw = PIN; j.N = C_PEND; j.K = DM; j.nblk = 129; j.loc = r; j.WT = ws + WS_WIN + (size_t)L * NIN * DM * 2; return j; } r -= T_P;
        if (r < T_G) { j.W = w_in + (size_t)L * DM * PIN + C_PEND; j.ldw = PIN; j.N = NGATE; j.K = DM; j.nblk = 160; j.loc = r; j.f8 = 1; j.WT = ws + WS_WIN + ((size_t)L * NIN + LDP) * DM * 2; return j; } r -= T_G;
        if (r < 5 * T_B) { const int n = r / T_B; j.W = w_br + (size_t)(L * 5 + n) * 512 * DM; j.ldw = DM; j.N = DM; j.K = 512; j.nblk = 32; j.loc = r % T_B; j.WT = ws + WS_WBR + (size_t)(L * 5 + n) * DM * 512 * 2; return j; } r -= 5 * T_B;
        if (r < T_O) { j.W = w_out + (size_t)L * DM * DM; j.ldw = DM; j.N = DM; j.K = DM; j.nblk = 32; j.loc = r; j.WT = ws + WS_WOUT + (size_t)L * DM * DM * 2; return j; } r -= T_O;
        j.W = w_kv + (size_t)L * DM * 1024; j.ldw = 1024; j.N = 1024; j.K = DM; j.nblk = 16; j.loc = r; j.WT = ws + WS_WMKV + (size_t)L * 1024 * DM * 2; return j; }
    int r = t - 2 * T_L;
    if (r < 2 * T_D) { const int up = r / T_D; j.W = up ? f_up : f_gate; j.ldw = DFF; j.N = DFF; j.K = DM; j.nblk = 88; j.loc = r % T_D; j.WT = ws + WS_WGU; j.rm = RmGen{1, up}; return j; } r -= 2 * T_D;
    j.W = f_down; j.ldw = DM; j.N = DM; j.K = DFF; j.nblk = 32; j.loc = r; j.WT = ws + WS_WDN; return j;
}
constexpr int P0_TILES = 2 * (32 * 129 + 32 * 160 + 5 * 8 * 32 + 32 * 32 + 32 * 16) + 3 * 32 * 88;
__device__ __forceinline__ void p0_store(const float (&v)[64], const P0Job& j, LAS unsigned* scr, int lane) {
    if (j.f8) tr_store_f8(v, 64.0f, j.K, j.N, j.nblk, j.loc, j.WT, scr, lane, j.rm); else tr_store(v, j.K, j.N, j.nblk, j.loc, (bf16*)j.WT, scr, lane, j.rm);
}
__device__ __forceinline__ void phase0_convert_all(const float* w_in, const float* w_br, const float* w_out, const float* w_kv, const float* f_gate, const float* f_up, const float* f_down, unsigned char* ws, LAS float* scr_f, int gw, int NGW, int lane) {
    LAS unsigned* scr = (LAS unsigned*)scr_f; float va[64], vb[64]; int it = gw;
    P0Job ja = p0_job(it < P0_TILES ? it : 0, w_in, w_br, w_out, w_kv, f_gate, f_up, f_down, ws), jb = ja;
    if (it < P0_TILES) tr_load(va, ja.W, ja.ldw, ja.N, ja.nblk, ja.loc, lane);
#pragma unroll 1
    for (; it < P0_TILES; it += 2 * NGW) { const int it2 = it + NGW, it3 = it2 + NGW;
        if (it2 < P0_TILES) { jb = p0_job(it2, w_in, w_br, w_out, w_kv, f_gate, f_up, f_down, ws); tr_load(vb, jb.W, jb.ldw, jb.N, jb.nblk, jb.loc, lane); }
        p0_store(va, ja, scr, lane);
        if (it3 < P0_TILES) { ja = p0_job(it3, w_in, w_br, w_out, w_kv, f_gate, f_up, f_down, ws); tr_load(va, ja.W, ja.ldw, ja.N, ja.nblk, ja.loc, lane); }
        if (it2 < P0_TILES) p0_store(vb, jb, scr, lane);
    }
}
constexpr int MQ_GU = 16 * 32 * 112, MQ_TILES = MQ_GU + 2 * 112 * 32, MQ_GRAB = 16;
__device__ __forceinline__ P0Job moe_job(int t, const float* wg, const float* wu, const float* wd, unsigned char* ws) {
    P0Job j; j.f8 = 1; constexpr int TPJ = 32 * 112;
    if (t < MQ_GU) { const int jb = t / TPJ, e = jb >> 1, up = jb & 1; j.W = (up ? wu : wg) + (size_t)e * DM * DFFE; j.ldw = DFFE; j.N = DFFE; j.K = DM; j.nblk = 112; j.loc = t % TPJ; j.WT = ws + WS_MOE1 + (size_t)e * 2 * DFFE * DM; j.rm = RmGen{1, up}; return j; }
    const int r = t - MQ_GU, e = 6 + r / TPJ; j.W = wd + (size_t)e * DFFE * DM; j.ldw = DM; j.N = DM; j.K = DFFE; j.nblk = 32; j.loc = r % TPJ; j.WT = ws + WS_MOE2F + (size_t)e * DM * DFFE; j.rm = RmGen{0, 0}; return j;
}
__device__ __forceinline__ unsigned mq_grab(gu32* q, const gu32* stop, unsigned stop_val) {
    if (stop && __hip_atomic_load(stop, RLX_AGENT) >= stop_val) return 0x7fffffffu;
    return __hip_atomic_fetch_add(q, (unsigned)MQ_GRAB, RLX_AGENT);
}
__device__ __forceinline__ void moe_drain(const float* wg, const float* wu, const float* wd, unsigned char* ws, gu32* q, const gu32* stop, unsigned stop_val, volatile LAS unsigned* slot, LAS float* scr_f, int wave, int lane, int tid) {
    LAS unsigned* scr = (LAS unsigned*)scr_f; float va[64], vb[64];
    __syncthreads();
    if (tid == 0) slot[0] = mq_grab(q, stop, stop_val);
    __syncthreads();
    unsigned t = slot[0]; int i = 0; P0Job ja, jb;
    if (t < (unsigned)MQ_TILES) { ja = moe_job((int)t + 2 * wave, wg, wu, wd, ws); tr_load(va, ja.W, ja.ldw, ja.N, ja.nblk, ja.loc, lane); jb = moe_job((int)t + 2 * wave + 1, wg, wu, wd, ws); tr_load(vb, jb.W, jb.ldw, jb.N, jb.nblk, jb.loc, lane); }
#pragma unroll 1
    while (t < (unsigned)MQ_TILES) {
        if (tid == 0) slot[(i + 1) & 1] = mq_grab(q, stop, stop_val);
        tr_store_f8(va, 64.0f, ja.K, ja.N, ja.nblk, ja.loc, ja.WT, scr, lane, ja.rm);
        __syncthreads();
        const unsigned tn = slot[(i + 1) & 1];
        if (tn < (unsigned)MQ_TILES) { ja = moe_job((int)tn + 2 * wave, wg, wu, wd, ws); tr_load(va, ja.W, ja.ldw, ja.N, ja.nblk, ja.loc, lane); }
        tr_store_f8(vb, 64.0f, jb.K, jb.N, jb.nblk, jb.loc, jb.WT, scr, lane, jb.rm);
        if (tn < (unsigned)MQ_TILES) { jb = moe_job((int)tn + 2 * wave + 1, wg, wu, wd, ws); tr_load(vb, jb.W, jb.ldw, jb.N, jb.nblk, jb.loc, lane); }
        t = tn; ++i;
    }
}
struct LayerPtrs {
    const float *g_mix, *na_q_gain, *na_k_gain, *na_rel_bias, *gla_w_up, *gla_b, *gla_norm, *conv_w, *a_log, *dt_bias, *gdn_norm, *lb_raw0, *lb_raw1, *hg_norm, *mem_q_gain, *g_ffn;
};
__device__ __forceinline__ void prep_unit(int L, const LayerPtrs& lp, const LAS float* glaw, bf16* P, float* GLG, bf16* GQ, float* GAB, bf16* HQ, float* HF, bf16* NAVT, int t0, int lane) {
    const int b = t0 >> 12, s0 = t0 & 4095;
    const float* bb_ = lp.gla_b + (lane >> 5) * 256 + (lane & 31) * 8; const f32x4 glb0 = *(const f32x4*)bb_, glb1 = *(const f32x4*)(bb_ + 4);
    const float ealog = __expf(lp.a_log[lane & 7]), dtb = lp.dt_bias[lane & 7];
    float lbv[2][8];
#pragma unroll
    for (int d = 0; d < 2; ++d)
#pragma unroll
        for (int i = 0; i < 8; ++i) { const int c = d * 512 + lane * 8 + i; lbv[d][i] = L ? sigmf(lp.lb_raw1[c] - lp.lb_raw0[c]) : 0.f; }
#pragma unroll 1
    for (int tt = 0; tt < 8; ++tt) { bf16* pr = P + (size_t)(t0 + tt) * LDP;
        const v4u rq = *(const v4u*)(pr + C_NAQ + lane * 8), rk = *(const v4u*)(pr + C_NAK + lane * 8), rm = *(const v4u*)(pr + C_MQ + lane * 8), rh = *(const v4u*)(pr + C_HGQ + lane * 8),
                  rf0 = *(const v4u*)(pr + C_HGF + lane * 8), rf1 = *(const v4u*)(pr + C_HGF + 512 + lane * 8), rl0 = *(const v4u*)(pr + C_GLLR + (lane >> 5) * 16), rl1 = *(const v4u*)(pr + C_GLLR + (lane >> 5) * 16 + 8);
        const bf16 ra = pr[C_GDA + (lane & 15)];
#pragma unroll
        for (int qk = 0; qk < 2; ++qk) { bf16* p = pr + (qk ? C_NAK : C_NAQ) + lane * 8; float f[8]; unpack8(qk ? rk : rq, f);
            float ss = 0.f;
#pragma unroll
            for (int i = 0; i < 8; ++i) ss += f[i] * f[i];
            ss = group_sum<8>(ss); const float sc = rsqrtf(ss * (1.0f / 64.0f) + RMS_EPS) * (qk ? 1.0f : 0.125f);
            const float* gn = (qk ? lp.na_k_gain : lp.na_q_gain) + (lane & 7) * 8;
#pragma unroll
            for (int i = 0; i < 8; ++i) f[i] = f[i] * sc * gn[i];
            *(v4u*)p = pack8(f); }
        { bf16* p = pr + C_MQ + lane * 8; float f[8]; unpack8(rm, f); float ss = 0.f;
#pragma unroll
            for (int i = 0; i < 8; ++i) ss += f[i] * f[i];
            ss = group_sum<16>(ss); const float sc = rsqrtf(ss * (1.0f / 128.0f) + RMS_EPS) * 0.08838834764831845f; const float* gn = lp.mem_q_gain + (lane & 15) * 8;
#pragma unroll
            for (int i = 0; i < 8; ++i) f[i] = f[i] * sc * gn[i];
            *(v4u*)p = pack8(f); }
        { float f[8]; unpack8(rh, f);
#pragma unroll
            for (int i = 0; i < 8; ++i) f[i] = siluf(f[i]);
            *(v4u*)(HQ + (size_t)(t0 + tt) * 512 + lane * 8) = pack8(f);
#pragma unroll
            for (int d = 0; d < 2; ++d) { float z[8]; unpack8(d ? rf1 : rf0, z); float o[8];
#pragma unroll
                for (int i = 0; i < 8; ++i) { if (L) { const float lb = lbv[d][i]; o[i] = __logf(lb + (1.0f - lb) * sigmf(z[i])); } else o[i] = -softplusf(-z[i]); }
                float* hf = HF + (size_t)(t0 + tt) * 1024 + d * 512 + lane * 8;
                *(f32x4*)hf = (f32x4){o[0], o[1], o[2], o[3]}; *(f32x4*)(hf + 4) = (f32x4){o[4], o[5], o[6], o[7]}; } }
        { const int dir = lane >> 5, c8 = (lane & 31) * 8; float lr[16];
            { float t8[8]; unpack8(rl0, t8);
#pragma unroll
              for (int i = 0; i < 8; ++i) lr[i] = t8[i];
              unpack8(rl1, t8);
#pragma unroll
              for (int i = 0; i < 8; ++i) lr[8 + i] = t8[i]; }
            f32x4 a0 = glb0, a1 = glb1;
            int c8l = c8; asm volatile("" : "+v"(c8l));
#pragma unroll
            for (int r = 0; r < 16; ++r) { const LAS float* wp = glaw + (dir * 16 + r) * 256 + c8l; a0 = a0 + lr[r] * *(const LAS f32x4*)wp; a1 = a1 + lr[r] * *(const LAS f32x4*)(wp + 4); }
            f32x4 g0, g1;
#pragma unroll
            for (int i = 0; i < 4; ++i) { g0[i] = -softplusf(-a0[i]) * 0.0625f; g1[i] = -softplusf(-a1[i]) * 0.0625f; }
            float* gp = GLG + (size_t)(t0 + tt) * 512 + dir * 256 + c8; *(f32x4*)gp = g0; *(f32x4*)(gp + 4) = g1; }
        if (lane < 16) { const float val = bf1(ra); float o;
            if (lane < 8) o = -ealog * softplusf(val + dtb); else o = sigmf(val);
            GAB[(size_t)(t0 + tt) * 16 + lane] = o; }
    }
#pragma unroll 1
    for (int j = 0; j < 3; ++j) { const int col = j * 512 + lane * 8; float w[5][8];
#pragma unroll
        for (int tap = 0; tap < 5; ++tap) { const float* wp = lp.conv_w + tap * 1536 + col; const f32x4 w0 = *(const f32x4*)wp, w1 = *(const f32x4*)(wp + 4);
            w[tap][0] = w0[0]; w[tap][1] = w0[1]; w[tap][2] = w0[2]; w[tap][3] = w0[3]; w[tap][4] = w1[0]; w[tap][5] = w1[1]; w[tap][6] = w1[2]; w[tap][7] = w1[3]; }
#pragma unroll 1
        for (int hf = 0; hf < 2; ++hf) {
        v4u xr[8];
#pragma unroll
        for (int r = 0; r < 8; ++r) { const int s = s0 + hf * 4 + r - 2; xr[r] = (v4u){0u, 0u, 0u, 0u}; if (s >= 0 && s < SEQ) xr[r] = *(const v4u*)(P + (size_t)((b << 12) + s) * LDP + C_GDQKV + col); }
#pragma unroll
        for (int t4 = 0; t4 < 4; ++t4) { const int tt = hf * 4 + t4; float acc[8]; __builtin_amdgcn_sched_barrier(0);
#pragma unroll
            for (int i = 0; i < 8; ++i) acc[i] = 0.f;
#pragma unroll
            for (int tap = 0; tap < 5; ++tap) { float x[8]; unpack8(xr[t4 + tap], x);
#pragma unroll
                for (int i = 0; i < 8; ++i) acc[i] += w[tap][i] * x[i]; }
#pragma unroll
            for (int i = 0; i < 8; ++i) acc[i] = siluf(acc[i]);
            if (j < 2) { float ss = 0.f;
#pragma unroll
                for (int i = 0; i < 8; ++i) ss += acc[i] * acc[i];
                ss = group_sum<16>(ss); const float sc = rsqrtf(ss + 1e-6f) * (j == 0 ? 0.08838834764831845f : 1.0f);
#pragma unroll
                for (int i = 0; i < 8; ++i) acc[i] *= sc; }
            *(v4u*)(GQ + (size_t)(t0 + tt) * 1536 + col) = pack8(acc); } } }
    { unsigned vw[8][4];
#pragma unroll
        for (int tt = 0; tt < 8; ++tt) { const v4u x = *(const v4u*)(P + (size_t)(t0 + tt) * LDP + C_NAV + lane * 8); vw[tt][0] = x.x; vw[tt][1] = x.y; vw[tt][2] = x.z; vw[tt][3] = x.w; }
#pragma unroll
        for (int i = 0; i < 8; ++i) { unsigned e[8];
#pragma unroll
            for (int tt = 0; tt < 8; ++tt) e[tt] = (i & 1) ? (vw[tt][i >> 1] >> 16) : (vw[tt][i >> 1] & 0xffffu);
            v4u o; o.x = e[0] | (e[1] << 16); o.y = e[2] | (e[3] << 16); o.z = e[4] | (e[5] << 16); o.w = e[6] | (e[7] << 16);
            *(v4u*)(NAVT + ((size_t)((b * 8 + (lane >> 3)) * 64 + (lane & 7) * 8 + i)) * SEQ + s0) = o; } }
}
__device__ __forceinline__ void post_token(const LayerPtrs& lp, const bf16* P, const bf16* SOUT, bf16* BR, int t, int lane) {
    const bf16* pr = P + (size_t)t * LDP;
#pragma unroll
    for (int br = 0; br < 3; ++br) {
        float a[8], c[8], og[8];
        unpack8(*(const v4u*)(SOUT + ((size_t)(br * 2 + 0) * NT + t) * 512 + lane * 8), a);
        unpack8(*(const v4u*)(SOUT + ((size_t)(br * 2 + 1) * NT + t) * 512 + lane * 8), c);
        unpack8(*(const v4u*)(pr + (br == 0 ? C_GLOG : br == 1 ? C_GDOG : C_HGOG) + lane * 8), og);
        const float qs = br == 0 ? 0.125f : 1.0f; float ss = 0.f;
#pragma unroll
        for (int i = 0; i < 8; ++i) { a[i] = (a[i] + c[i]) * qs; ss += a[i] * a[i]; }
        ss = group_sum<16>(ss); const float sc = rsqrtf(ss * (1.0f / 128.0f) + RMS_EPS);
        const float* gn = (br == 0 ? lp.gla_norm : br == 1 ? lp.gdn_norm : lp.hg_norm) + (lane & 15) * 8;
#pragma unroll
        for (int i = 0; i < 8; ++i) a[i] = a[i] * sc * gn[i] * (br == 2 ? sigmf(og[i]) : siluf(og[i]));
        *(v4u*)(BR + ((size_t)(1 + br) * NT + t) * 512 + lane * 8) = pack8(a);
    }
}
typedef short bf16x8 __attribute__((ext_vector_type(8)));
__device__ __forceinline__ bf16x8 as_bf16x8(v4u w) { return __builtin_bit_cast(bf16x8, w); }
#define MFMA16(a, b, c) __builtin_amdgcn_mfma_f32_16x16x32_bf16((a), (b), (c), 0, 0, 0)
typedef short bf16x4 __attribute__((ext_vector_type(4)));
__device__ __forceinline__ bf16x4 as_bf16x4(v2u w) { return __builtin_bit_cast(bf16x4, w); }
#define MFMA16K16(a, b, c) __builtin_amdgcn_mfma_f32_16x16x16bf16_1k((a), (b), (c), 0, 0, 0)
__device__ __forceinline__ void na_wave_unit(const bf16* P, const bf16* NAVT, const float* rel_bias, bf16* BR0, int b, int h, int r, int qc, int lane) {
    const int fr = lane & 15, g = lane >> 4; const int c = qc * 16 + fr;
    const int kc_lo = qc == 0 ? 0 : qc == 1 ? 8 : qc == 2 ? 24 : 32;
    const int cs = min(max(c - 8, 0), 48), rbase = min(max(r - 4, 0), 56);
    const size_t tq = (size_t)(b << 12) + r * 64 + c;
    bf16x8 qf[2];
#pragma unroll
    for (int ks = 0; ks < 2; ++ks) qf[ks] = as_bf16x8(*(const v4u*)(P + tq * LDP + C_NAQ + h * 64 + ks * 32 + g * 8));
    f32x4 s[8][2]; float mx = -3.0e38f;
    v4u kf[8][2][2];
#pragma unroll
    for (int i = 0; i < 8; ++i)
#pragma unroll
        for (int kt = 0; kt < 2; ++kt) { const bf16* kp = P + ((size_t)(b << 12) + (rbase + i) * 64 + kc_lo + (fr >> 2) * 8 + kt * 4 + (fr & 3)) * LDP + C_NAK + h * 64 + g * 8; kf[i][kt][0] = *(const v4u*)kp; kf[i][kt][1] = *(const v4u*)(kp + 32); }
#pragma unroll
    for (int i = 0; i < 8; ++i) { const float* bp = rel_bias + (h * 15 + (rbase + i - r + 7)) * 31;
#pragma unroll
        for (int kt = 0; kt < 2; ++kt) {
            f32x4 a = {0.f, 0.f, 0.f, 0.f}; a = MFMA16(as_bf16x8(kf[i][kt][0]), qf[0], a); a = MFMA16(as_bf16x8(kf[i][kt][1]), qf[1], a);
            const int ck0 = kc_lo + 8 * g + 4 * kt, dc0 = ck0 - c + 15, dcl = min(max(dc0, 0), 27); const f32x4 b4 = *(const f32x4*)(bp + dcl);
#pragma unroll
            for (int jj = 0; jj < 4; ++jj) { const int ck = ck0 + jj; const bool inw = (ck >= cs) && (ck < cs + 16); const int sh = dc0 + jj - dcl;
                const float bv = sh == 0 ? b4[0] : sh == 1 ? b4[1] : sh == 2 ? b4[2] : b4[3];
                a[jj] = inw ? a[jj] + bv : -1.0e30f; mx = fmaxf(mx, a[jj]); }
            s[i][kt] = a; } }
    mx = fmaxf(mx, __shfl_xor(mx, 16)); mx = fmaxf(mx, __shfl_xor(mx, 32));
    float l = 0.f;
#pragma unroll
    for (int i = 0; i < 8; ++i)
#pragma unroll
        for (int kt = 0; kt < 2; ++kt)
#pragma unroll
            for (int jj = 0; jj < 4; ++jj) { const float p = __expf(s[i][kt][jj] - mx); s[i][kt][jj] = p; l += p; }
    l += __shfl_xor(l, 16); l += __shfl_xor(l, 32);
    f32x4 o[4];
#pragma unroll
    for (int dt = 0; dt < 4; ++dt) o[dt] = (f32x4){0.f, 0.f, 0.f, 0.f};
#pragma unroll
    for (int hh = 0; hh < 2; ++hh) { v4u vv[4][4];
#pragma unroll
        for (int i4 = 0; i4 < 4; ++i4)
#pragma unroll
            for (int dt = 0; dt < 4; ++dt) { const bf16* vp = NAVT + ((size_t)((b * 8 + h) * 64 + dt * 16 + fr)) * SEQ + (rbase + hh * 4 + i4) * 64 + kc_lo + 8 * g; vv[i4][dt] = *(const v4u*)vp; }
#pragma unroll
        for (int i4 = 0; i4 < 4; ++i4) { const int i = hh * 4 + i4; v4u pw; pw.x = pkbf(s[i][0][0], s[i][0][1]); pw.y = pkbf(s[i][0][2], s[i][0][3]); pw.z = pkbf(s[i][1][0], s[i][1][1]); pw.w = pkbf(s[i][1][2], s[i][1][3]);
            const bf16x8 pf = as_bf16x8(pw);
#pragma unroll
            for (int dt = 0; dt < 4; ++dt) o[dt] = MFMA16(as_bf16x8(vv[i4][dt]), pf, o[dt]); } }
    const float inv = 1.0f / l;
#pragma unroll
    for (int dt = 0; dt < 4; ++dt) { v2u w; w.x = pkbf(o[dt][0] * inv, o[dt][1] * inv); w.y = pkbf(o[dt][2] * inv, o[dt][3] * inv);
        *(v2u*)(BR0 + tq * 512 + h * 64 + dt * 16 + 4 * g) = w; }
}
__device__ __forceinline__ void mem_wave_unit(const bf16* P, const bf16* MK, const bf16* MVT, bf16* BR4, int t0, int h, int lane) {
    const int fr = lane & 15, g = lane >> 4, b = t0 >> 12; const size_t tq = (size_t)t0 + fr;
    bf16x8 qf[4];
#pragma unroll
    for (int ks = 0; ks < 4; ++ks) qf[ks] = as_bf16x8(*(const v4u*)(P + tq * LDP + C_MQ + h * 128 + ks * 32 + g * 8));
    f32x4 s[16]; float mx = -3.0e38f;
#pragma unroll
    for (int m4 = 0; m4 < 2; ++m4) { v4u kf[8][4];
#pragma unroll
        for (int mm = 0; mm < 8; ++mm)
#pragma unroll
            for (int ks = 0; ks < 4; ++ks) kf[mm][ks] = *(const v4u*)(MK + ((size_t)(b * 256 + (m4 * 8 + mm) * 16 + fr)) * 512 + h * 128 + g * 8 + ks * 32);
#pragma unroll
        for (int mm = 0; mm < 8; ++mm) { f32x4 a = {0.f, 0.f, 0.f, 0.f};
#pragma unroll
            for (int ks = 0; ks < 4; ++ks) a = MFMA16(as_bf16x8(kf[mm][ks]), qf[ks], a);
#pragma unroll
            for (int jj = 0; jj < 4; ++jj) mx = fmaxf(mx, a[jj]);
            s[m4 * 8 + mm] = a; } }
    mx = fmaxf(mx, __shfl_xor(mx, 16)); mx = fmaxf(mx, __shfl_xor(mx, 32));
    float l = 0.f;
#pragma unroll
    for (int mt = 0; mt < 16; ++mt)
#pragma unroll
        for (int jj = 0; jj < 4; ++jj) { const float p = __expf(s[mt][jj] - mx); s[mt][jj] = p; l += p; }
    l += __shfl_xor(l, 16); l += __shfl_xor(l, 32);
    f32x4 o[8];
#pragma unroll
    for (int dt = 0; dt < 8; ++dt) o[dt] = (f32x4){0.f, 0.f, 0.f, 0.f};
#pragma unroll
    for (int k4 = 0; k4 < 4; ++k4) { v2u vv[2][8][2];
#pragma unroll
        for (int k2 = 0; k2 < 2; ++k2)
#pragma unroll
            for (int dt = 0; dt < 8; ++dt) { const bf16* vp = MVT + ((size_t)((b * 4 + h) * 128 + dt * 16 + fr)) * 256 + (k4 * 2 + k2) * 32 + 4 * g; vv[k2][dt][0] = *(const v2u*)vp; vv[k2][dt][1] = *(const v2u*)(vp + 16); }
#pragma unroll
        for (int k2 = 0; k2 < 2; ++k2) { const int kb = k4 * 2 + k2; v4u pw; pw.x = pkbf(s[2 * kb][0], s[2 * kb][1]); pw.y = pkbf(s[2 * kb][2], s[2 * kb][3]); pw.z = pkbf(s[2 * kb + 1][0], s[2 * kb + 1][1]); pw.w = pkbf(s[2 * kb + 1][2], s[2 * kb + 1][3]);
            const bf16x8 pf = as_bf16x8(pw);
#pragma unroll
            for (int dt = 0; dt < 8; ++dt) { v4u vw; vw.x = vv[k2][dt][0].x; vw.y = vv[k2][dt][0].y; vw.z = vv[k2][dt][1].x; vw.w = vv[k2][dt][1].y; o[dt] = MFMA16(as_bf16x8(vw), pf, o[dt]); } } }
    const float inv = 1.0f / l;
#pragma unroll
    for (int dt = 0; dt < 8; ++dt) { v2u w; w.x = pkbf(o[dt][0] * inv, o[dt][1] * inv); w.y = pkbf(o[dt][2] * inv, o[dt][3] * inv);
        *(v2u*)(BR4 + tq * 512 + h * 128 + dt * 16 + 4 * g) = w; }
}
__device__ __forceinline__ void mem_wg_unit(LAS unsigned char* ring, const bf16* P, const bf16* MK, const bf16* MVT, bf16* BR4, int t0, int h, int wave, int lane, int tid) {
    const int fr = lane & 15, g = lane >> 4, b = t0 >> 12;
    { const bf16* ksrc = MK + (size_t)(b * 256) * 512 + h * 128;
#pragma unroll
      for (int i = 0; i < 8; ++i) { const int idx = i * 512 + tid, key = idx >> 4, c = idx & 15; const v4u w = *(const v4u*)(ksrc + (size_t)key * 512 + c * 8); *(LAS v4u*)(ring + key * 256 + ((c ^ (key & 15)) << 4)) = w; }
      const bf16* vsrc = MVT + (size_t)((b * 4 + h) * 128) * 256;
#pragma unroll
      for (int i = 0; i < 2; ++i) { const int idx = i * 512 + tid, d = idx >> 3, kb = idx & 7; const v4u* p = (const v4u*)(vsrc + (size_t)d * 256 + kb * 32); const v4u u0 = p[0], u1 = p[1], u2 = p[2], u3 = p[3];
          LAS unsigned char* row = ring + 65536 + d * 512; const int sw = d & 15;
          v4u c0, c1, c2, c3; c0.x = u0.x; c0.y = u0.y; c0.z = u2.x; c0.w = u2.y; c1.x = u0.z; c1.y = u0.w; c1.z = u2.z; c1.w = u2.w; c2.x = u1.x; c2.y = u1.y; c2.z = u3.x; c2.w = u3.y; c3.x = u1.z; c3.y = u1.w; c3.z = u3.z; c3.w = u3.w;
          *(LAS v4u*)(row + (((kb * 4 + 0) ^ sw) << 4)) = c0; *(LAS v4u*)(row + (((kb * 4 + 1) ^ sw) << 4)) = c1; *(LAS v4u*)(row + (((kb * 4 + 2) ^ sw) << 4)) = c2; *(LAS v4u*)(row + (((kb * 4 + 3) ^ sw) << 4)) = c3; } }
    __syncthreads();
#pragma unroll 1
    for (int sub = 0; sub < 2; ++sub) { const size_t tq = (size_t)t0 + sub * 128 + wave * 16 + fr;
        int fo = fr; asm volatile("" : "+v"(fo));
        bf16x8 qf[4];
#pragma unroll
        for (int ks = 0; ks < 4; ++ks) qf[ks] = as_bf16x8(*(const v4u*)(P + tq * LDP + C_MQ + h * 128 + ks * 32 + g * 8));
        f32x4 s[16]; float mx = -3.0e38f;
#pragma unroll
        for (int mt = 0; mt < 16; ++mt) { f32x4 a = {0.f, 0.f, 0.f, 0.f}; const LAS unsigned char* kr = ring + (mt * 16 + fo) * 256;
#pragma unroll
            for (int ks = 0; ks < 4; ++ks) a = MFMA16(as_bf16x8(*(const LAS v4u*)(kr + (((ks * 4 + g) ^ fo) << 4))), qf[ks], a);
#pragma unroll
            for (int jj = 0; jj < 4; ++jj) mx = fmaxf(mx, a[jj]);
            s[mt] = a; }
        mx = fmaxf(mx, __shfl_xor(mx, 16)); mx = fmaxf(mx, __shfl_xor(mx, 32));
        float l = 0.f;
#pragma unroll
        for (int mt = 0; mt < 16; ++mt)
#pragma unroll
            for (int jj = 0; jj < 4; ++jj) { const float p = __expf(s[mt][jj] - mx); s[mt][jj] = p; l += p; }
        l += __shfl_xor(l, 16); l += __shfl_xor(l, 32);
        f32x4 o[8];
#pragma unroll
        for (int dt = 0; dt < 8; ++dt) o[dt] = (f32x4){0.f, 0.f, 0.f, 0.f};
#pragma unroll
        for (int kb = 0; kb < 8; ++kb) { v4u pw; pw.x = pkbf(s[2 * kb][0], s[2 * kb][1]); pw.y = pkbf(s[2 * kb][2], s[2 * kb][3]); pw.z = pkbf(s[2 * kb + 1][0], s[2 * kb + 1][1]); pw.w = pkbf(s[2 * kb + 1][2], s[2 * kb + 1][3]);
            const bf16x8 pf = as_bf16x8(pw);
#pragma unroll
            for (int dt = 0; dt < 8; ++dt) o[dt] = MFMA16(as_bf16x8(*(const LAS v4u*)(ring + 65536 + (dt * 16 + fo) * 512 + (((kb * 4 + g) ^ fo) << 4))), pf, o[dt]); }
        const float inv = 1.0f / l;
#pragma unroll
        for (int dt = 0; dt < 8; ++dt) { v2u w; w.x = pkbf(o[dt][0] * inv, o[dt][1] * inv); w.y = pkbf(o[dt][2] * inv, o[dt][3] * inv);
            *(v2u*)(BR4 + tq * 512 + h * 128 + dt * 16 + 4 * g) = w; }
    }
}
#define CH_TOK(n, i) ((size_t)(dir ? (SEQ - 1 - ((n) * 16 + (i))) : ((n) * 16 + (i))))
__device__ __forceinline__ bf16 tobf(float x) { return (bf16)(pkbf(x, 0.f) & 0xffffu); }
constexpr size_t OA_GW = 0, OA_GU = 32 * MiB, OA_GKT = 64 * MiB, OA_GP = 96 * MiB, OA_GS = 100 * MiB, OA_HQD = 104 * MiB, OA_HKDT = 136 * MiB, OA_HP = 168 * MiB, OA_HV = 172 * MiB,
                 OA_LQD = 184 * MiB, OA_LKDT = 200 * MiB, OA_LP = 216 * MiB, OA_LV = 220 * MiB, OA_END = 226 * MiB;
struct DiagSrc { const bf16* q; int qp; const bf16* k; int kp; const float* lg; int lgp; const bf16* v; int vp; };
template <int K, int HG> __device__ __forceinline__ void s1_diag(LAS unsigned char* scr, const DiagSrc& S, int dir, int n, bf16* QD, bf16* KDT, bf16* PP, float* EB, int lane) {
    constexpr int NK = K / 64, LPI = K + 8;
    LAS bf16* QDs = (LAS bf16*)scr; LAS bf16* KDs = QDs + 16 * LPI;
#pragma unroll
    for (int c = 0; c < NK; ++c) { const int k = lane + 64 * c; float bi[16], lgv[16]; float b = 0.f;
#pragma unroll
        for (int i = 0; i < 16; ++i) { lgv[i] = S.lg[CH_TOK(n, i) * S.lgp + k]; b += lgv[i]; bi[i] = b; }
        unsigned kdw[8];
#pragma unroll
        for (int i = 0; i < 16; ++i) { const size_t tok = CH_TOK(n, i); const float qv = bf1(S.q[tok * S.qp + k]); float kv;
            if (HG) kv = 1.0f - __expf(lgv[i]); else kv = bf1(S.k[tok * S.kp + k]);
            const bf16 qh = tobf(qv * __expf(bi[i])), kh = tobf(kv * __expf(-bi[i]));
            QD[i * K + k] = qh; QDs[i * LPI + k] = qh; KDs[i * LPI + k] = kh;
            if (i & 1) kdw[i >> 1] |= ((unsigned)kh) << 16; else kdw[i >> 1] = kh; }
        *(v4u*)(KDT + k * 16) = (v4u){kdw[0], kdw[1], kdw[2], kdw[3]}; *(v4u*)(KDT + k * 16 + 8) = (v4u){kdw[4], kdw[5], kdw[6], kdw[7]};
        EB[k] = __expf(bi[15]); }
    LDS_WAIT(); asm volatile("" ::: "memory");
    const int fr = lane & 15, g = lane >> 4; f32x4 acc = {0.f, 0.f, 0.f, 0.f};
#pragma unroll
    for (int ks = 0; ks < K / 32; ++ks) { const bf16x8 qf = as_bf16x8(*(const LAS v4u*)(QDs + fr * LPI + 32 * ks + 8 * g)), kf = as_bf16x8(*(const LAS v4u*)(KDs + fr * LPI + 32 * ks + 8 * g)); acc = MFMA16(qf, kf, acc); }
#pragma unroll
    for (int jj = 0; jj < 4; ++jj) { const int i = 4 * g + jj; PP[i * 16 + fr] = tobf(fr <= i ? acc[jj] : 0.f); }
    LDS_WAIT(); asm volatile("" ::: "memory");
}
#define S2_BAR() do { asm volatile("s_waitcnt lgkmcnt(0)" ::: "memory"); __builtin_amdgcn_s_barrier(); asm volatile("" ::: "memory"); } while (0)
template <int K> struct DiagStage { v4u qd[K / 64], kdt[K / 64], v[2], p, eb; };
template <int K> struct DiagLds { static constexpr int QP = 2 * K + 16, LQD = 0, LKDT = 64 * QP, LV = LKDT + 4 * K * 32, LP = LV + 64 * 256, LEB = LP + 2048, BYTES = LEB + 4 * K * 4; };
template <int K> __device__ __forceinline__ void s2d_load(DiagStage<K>& R, const bf16* QD0, const bf16* KDT0, const bf16* PP0, const float* EB0, const bf16* vsrc, int vp, int dir, int grp, int tid) {
    const size_t c0 = (size_t)grp * 4;
#pragma unroll
    for (int j = 0; j < K / 64; ++j) { const int e = tid + 512 * j; R.qd[j] = *(const v4u*)(QD0 + c0 * 16 * K + (size_t)e * 8); R.kdt[j] = *(const v4u*)(KDT0 + c0 * 16 * K + (size_t)e * 8); }
#pragma unroll
    for (int j = 0; j < 2; ++j) { const int e = tid + 512 * j, row = e >> 4, col = e & 15; R.v[j] = *(const v4u*)(vsrc + CH_TOK(grp * 4 + (row >> 4), row & 15) * vp + col * 8); }
    if (tid < 128) R.p = *(const v4u*)(PP0 + c0 * 256 + tid * 8);
    else if (tid < 128 + K) R.eb = *(const v4u*)(EB0 + c0 * K + (tid - 128) * 4);
}
template <int K> __device__ __forceinline__ void s2d_store(const DiagStage<K>& R, LAS unsigned char* lds, int tid) {
    typedef DiagLds<K> L;
#pragma unroll
    for (int j = 0; j < K / 64; ++j) { const int e = tid + 512 * j, row = e / (K / 8), col = e % (K / 8); *(LAS v4u*)(lds + L::LQD + row * L::QP + col * 16) = R.qd[j]; *(LAS v4u*)(lds + L::LKDT + e * 16) = R.kdt[j]; }
#pragma unroll
    for (int j = 0; j < 2; ++j) { const int e = tid + 512 * j; *(LAS v4u*)(lds + L::LV + e * 16) = R.v[j]; }
    if (tid < 128) *(LAS v4u*)(lds + L::LP + tid * 16) = R.p;
    else if (tid < 128 + K) *(LAS v4u*)(lds + L::LEB + (tid - 128) * 16) = R.eb;
}
template <int K> __device__ __forceinline__ void s2d_chunk(LAS unsigned char* lds, int c, f32x4 (&S)[K / 16], bf16* osrc, int op, int dir, int n, int vt, int lane) {
    typedef DiagLds<K> L; const int fr = lane & 15, g = lane >> 4;
    f32x4 o = {0.f, 0.f, 0.f, 0.f};
#pragma unroll
    for (int ks = 0; ks < K / 32; ++ks) { const LAS unsigned char* qp = lds + L::LQD + (c * 16 + fr) * L::QP + (32 * ks + 4 * g) * 2; const v2u a = *(const LAS v2u*)qp, b = *(const LAS v2u*)(qp + 32);
        v4u sb; sb.x = pkbf(S[2 * ks][0], S[2 * ks][1]); sb.y = pkbf(S[2 * ks][2], S[2 * ks][3]); sb.z = pkbf(S[2 * ks + 1][0], S[2 * ks + 1][1]); sb.w = pkbf(S[2 * ks + 1][2], S[2 * ks + 1][3]);
        o = MFMA16(as_bf16x8((v4u){a.x, a.y, b.x, b.y}), as_bf16x8(sb), o); }
    unsigned vr[4];
#pragma unroll
    for (int jj = 0; jj < 4; ++jj) vr[jj] = *(const LAS unsigned short*)(lds + L::LV + ((c * 16 + 4 * g + jj) * 128 + vt * 16 + fr) * 2);
    const bf16x8 vf = as_bf16x8((v4u){vr[0] | (vr[1] << 16), vr[2] | (vr[3] << 16), 0u, 0u});
    { const v2u pp = *(const LAS v2u*)(lds + L::LP + (c * 256 + fr * 16 + 4 * g) * 2); o = MFMA16(as_bf16x8((v4u){pp.x, pp.y, 0u, 0u}), vf, o); }
#pragma unroll
    for (int kt = 0; kt < K / 16; ++kt) { const v2u kd = *(const LAS v2u*)(lds + L::LKDT + ((c * K + kt * 16 + fr) * 16 + 4 * g) * 2); const f32x4 eb = *(const LAS f32x4*)(lds + L::LEB + (c * K + kt * 16 + 4 * g) * 4);
        S[kt] = MFMA16(as_bf16x8((v4u){kd.x, kd.y, 0u, 0u}), vf, S[kt]); S[kt] = S[kt] * eb; }
#pragma unroll
    for (int jj = 0; jj < 4; ++jj) osrc[CH_TOK(n, 4 * g + jj) * op + vt * 16 + fr] = tobf(o[jj]);
}
template <int K> __device__ __forceinline__ void s2_diag(LAS unsigned char* lds, const bf16* QD0, const bf16* KDT0, const bf16* PP0, const float* EB0, const bf16* vsrc, int vp, bf16* osrc, int op, int dir, int vt, int lane, int tid) {
    static_assert(DiagLds<K>::BYTES <= RING_BYTES, "S2 LDS");
    f32x4 S[K / 16];
#pragma unroll
    for (int kt = 0; kt < K / 16; ++kt) S[kt] = (f32x4){0.f, 0.f, 0.f, 0.f};
    DiagStage<K> Ra, Rb;
    s2d_load<K>(Ra, QD0, KDT0, PP0, EB0, vsrc, vp, dir, 0, tid); s2d_load<K>(Rb, QD0, KDT0, PP0, EB0, vsrc, vp, dir, 1, tid);
#pragma unroll 1
    for (int grp = 0; grp < SEQ / 64; grp += 2) {
        S2_BAR(); s2d_store<K>(Ra, lds, tid); S2_BAR();
        s2d_load<K>(Ra, QD0, KDT0, PP0, EB0, vsrc, vp, dir, grp + 2 < SEQ / 64 ? grp + 2 : grp, tid);
#pragma unroll 2
        for (int c = 0; c < 4; ++c) s2d_chunk<K>(lds, c, S, osrc, op, dir, grp * 4 + c, vt, lane);
        S2_BAR(); s2d_store<K>(Rb, lds, tid); S2_BAR();
        s2d_load<K>(Rb, QD0, KDT0, PP0, EB0, vsrc, vp, dir, grp + 3 < SEQ / 64 ? grp + 3 : grp + 1, tid);
#pragma unroll 2
        for (int c = 0; c < 4; ++c) s2d_chunk<K>(lds, c, S, osrc, op, dir, (grp + 1) * 4 + c, vt, lane);
    }
    S2_BAR();
}
__device__ __forceinline__ void s1_gdn(LAS unsigned char* scr, const bf16* GQb, const float* GABb, int h, int dir, int n, bf16* GW, bf16* GU, bf16* GKT, bf16* GP, float* GS, int lane) {
    const int fr = lane & 15, g = lane >> 4;
    LAS float* AT = (LAS float*)scr;
    float c[16], be[16]; float cs = 0.f;
#pragma unroll
    for (int i = 0; i < 16; ++i) { const size_t tok = CH_TOK(n, i); cs += GABb[tok * 16]; c[i] = cs; be[i] = GABb[tok * 16 + 8]; }
    const size_t tr = CH_TOK(n, fr);
    f32x4 kk = {0.f, 0.f, 0.f, 0.f}, qk = {0.f, 0.f, 0.f, 0.f};
#pragma unroll
    for (int ks = 0; ks < 4; ++ks) { const bf16x8 kf = as_bf16x8(*(const v4u*)(GQb + tr * 1536 + 512 + h * 128 + 32 * ks + 8 * g)), qf = as_bf16x8(*(const v4u*)(GQb + tr * 1536 + h * 128 + 32 * ks + 8 * g));
        kk = MFMA16(kf, kf, kk); qk = MFMA16(qf, kf, qk); }
    float cj = 0.f;
#pragma unroll
    for (int i = 0; i < 16; ++i) cj = (fr == i) ? c[i] : cj;
    f32x4 av;
#pragma unroll
    for (int jj = 0; jj < 4; ++jj) { float ci = 0.f, bi = 0.f;
#pragma unroll
        for (int gg = 0; gg < 4; ++gg) { ci = (g == gg) ? c[4 * gg + jj] : ci; bi = (g == gg) ? be[4 * gg + jj] : bi; }
        const int i = 4 * g + jj; const float dec = __expf(ci - cj);
        av[jj] = (fr < i) ? bi * kk[jj] * dec : 0.f;
        GP[i * 16 + fr] = tobf(fr <= i ? qk[jj] * dec : 0.f); }
    *(LAS f32x4*)(AT + fr * 16 + 4 * g) = av;
    if (lane < 16) { GS[lane] = __expf(cj); GS[16 + lane] = __expf(c[15] - cj); } if (lane == 16) GS[32] = __expf(c[15]);
    LDS_WAIT(); asm volatile("" ::: "memory");
    float t[16];
#pragma unroll
    for (int j = 15; j >= 0; --j) { float a = (fr == j) ? 1.f : 0.f;
        if (j < 15) { f32x4 col[4];
#pragma unroll
            for (int q4 = 0; q4 < 4; ++q4) col[q4] = *(const LAS f32x4*)(AT + j * 16 + 4 * q4);
#pragma unroll
            for (int i = j + 1; i < 16; ++i) a -= t[i] * col[i >> 2][i & 3]; }
        t[j] = a; }
    float tf[4];
#pragma unroll
    for (int e = 0; e < 4; ++e) { float x = 0.f;
#pragma unroll
        for (int gg = 0; gg < 4; ++gg) x = (g == gg) ? t[4 * gg + e] : x;
        tf[e] = x; }
    const bf16x8 tfrag = as_bf16x8((v4u){pkbf(tf[0], tf[1]), pkbf(tf[2], tf[3]), 0u, 0u});
    float bj[4], bgj[4]; size_t tj[4];
#pragma unroll
    for (int e = 0; e < 4; ++e) { float cc = 0.f, bb = 0.f;
#pragma unroll
        for (int gg = 0; gg < 4; ++gg) { cc = (g == gg) ? c[4 * gg + e] : cc; bb = (g == gg) ? be[4 * gg + e] : bb; }
        bj[e] = bb; bgj[e] = bb * __expf(cc); tj[e] = CH_TOK(n, 4 * g + e); }
#pragma unroll 2
    for (int ct = 0; ct < 8; ++ct) {
        float vv[4], kv[4];
#pragma unroll
        for (int e = 0; e < 4; ++e) { vv[e] = bf1(GQb[tj[e] * 1536 + 1024 + h * 128 + ct * 16 + fr]); kv[e] = bf1(GQb[tj[e] * 1536 + 512 + h * 128 + ct * 16 + fr]); }
        const bf16x8 vb = as_bf16x8((v4u){pkbf(vv[0] * bj[0], vv[1] * bj[1]), pkbf(vv[2] * bj[2], vv[3] * bj[3]), 0u, 0u});
        const bf16x8 kb = as_bf16x8((v4u){pkbf(kv[0] * bgj[0], kv[1] * bgj[1]), pkbf(kv[2] * bgj[2], kv[3] * bgj[3]), 0u, 0u});
        const f32x4 z = {0.f, 0.f, 0.f, 0.f}; const f32x4 u = MFMA16(tfrag, vb, z), w = MFMA16(tfrag, kb, z);
#pragma unroll
        for (int jj = 0; jj < 4; ++jj) { GU[(4 * g + jj) * 128 + ct * 16 + fr] = tobf(u[jj]); GW[(4 * g + jj) * 128 + ct * 16 + fr] = tobf(w[jj]); }
        *(v2u*)(GKT + (ct * 16 + fr) * 16 + 4 * g) = (v2u){pkbf(kv[0], kv[1]), pkbf(kv[2], kv[3])};
    }
    LDS_WAIT(); asm volatile("" ::: "memory");
}
struct GdnStage { v4u w[2], q[2], kt[2], u[2], p, s; };
struct GdnLds { static constexpr int WP = 272, LW = 0, LQ = 64 * WP, LKT = 2 * 64 * WP, LU = LKT + 16384, LP = LU + 16384, LS = LP + 2048, BYTES = LS + 1024; };
__device__ __forceinline__ void s2g_load(GdnStage& R, const bf16* GW0, const bf16* GU0, const bf16* GKT0, const bf16* GP0, const float* GS0, const bf16* qsrc, int dir, int grp, int tid) {
    const size_t c0 = (size_t)grp * 4;
#pragma unroll
    for (int j = 0; j < 2; ++j) { const int e = tid + 512 * j, row = e >> 4, col = e & 15;
        R.w[j] = *(const v4u*)(GW0 + c0 * 2048 + (size_t)e * 8); R.kt[j] = *(const v4u*)(GKT0 + c0 * 2048 + (size_t)e * 8); R.u[j] = *(const v4u*)(GU0 + c0 * 2048 + (size_t)e * 8);
        R.q[j] = *(const v4u*)(qsrc + CH_TOK(grp * 4 + (row >> 4), row & 15) * 1536 + col * 8); }
    if (tid < 128) R.p = *(const v4u*)(GP0 + c0 * 256 + tid * 8);
    else if (tid < 192) R.s = *(const v4u*)(GS0 + c0 * 64 + (tid - 128) * 4);
}
__device__ __forceinline__ void s2g_store(const GdnStage& R, LAS unsigned char* lds, int tid) {
    typedef GdnLds L;
#pragma unroll
    for (int j = 0; j < 2; ++j) { const int e = tid + 512 * j, row = e >> 4, col = e & 15;
        *(LAS v4u*)(lds + L::LW + row * L::WP + col * 16) = R.w[j]; *(LAS v4u*)(lds + L::LQ + row * L::WP + col * 16) = R.q[j]; *(LAS v4u*)(lds + L::LKT + e * 16) = R.kt[j]; *(LAS v4u*)(lds + L::LU + e * 16) = R.u[j]; }
    if (tid < 128) *(LAS v4u*)(lds + L::LP + tid * 16) = R.p;
    else if (tid < 192) *(LAS v4u*)(lds + L::LS + (tid - 128) * 16) = R.s;
}
__device__ __forceinline__ void s2g_chunk(LAS unsigned char* lds, int c, f32x4 (&S)[8], bf16* osrc, int dir, int n, int vt, int lane) {
    typedef GdnLds L; const int fr = lane & 15, g = lane >> 4;
    f32x4 ws = {0.f, 0.f, 0.f, 0.f}, qs = {0.f, 0.f, 0.f, 0.f};
#pragma unroll
    for (int ks = 0; ks < 4; ++ks) { const int off = (c * 16 + fr) * L::WP + (32 * ks + 4 * g) * 2;
        const v2u a = *(const LAS v2u*)(lds + L::LW + off), b = *(const LAS v2u*)(lds + L::LW + off + 32), qa = *(const LAS v2u*)(lds + L::LQ + off), qb = *(const LAS v2u*)(lds + L::LQ + off + 32);
        v4u sb; sb.x = pkbf(S[2 * ks][0], S[2 * ks][1]); sb.y = pkbf(S[2 * ks][2], S[2 * ks][3]); sb.z = pkbf(S[2 * ks + 1][0], S[2 * ks + 1][1]); sb.w = pkbf(S[2 * ks + 1][2], S[2 * ks + 1][3]);
        const bf16x8 sbf = as_bf16x8(sb); ws = MFMA16(as_bf16x8((v4u){a.x, a.y, b.x, b.y}), sbf, ws); qs = MFMA16(as_bf16x8((v4u){qa.x, qa.y, qb.x, qb.y}), sbf, qs); }
    f32x4 vn;
#pragma unroll
    for (int jj = 0; jj < 4; ++jj) vn[jj] = bf1(*(const LAS unsigned short*)(lds + L::LU + ((c * 16 + 4 * g + jj) * 128 + vt * 16 + fr) * 2)) - ws[jj];
    const f32x4 gam = *(const LAS f32x4*)(lds + L::LS + (c * 64 + 4 * g) * 4), gdec = *(const LAS f32x4*)(lds + L::LS + (c * 64 + 16 + 4 * g) * 4); const float Gam = *(const LAS float*)(lds + L::LS + (c * 64 + 32) * 4);
    const bf16x8 vnf = as_bf16x8((v4u){pkbf(vn[0], vn[1]), pkbf(vn[2], vn[3]), 0u, 0u});
    f32x4 o = qs * gam; { const v2u pp = *(const LAS v2u*)(lds + L::LP + (c * 256 + fr * 16 + 4 * g) * 2); o = MFMA16(as_bf16x8((v4u){pp.x, pp.y, 0u, 0u}), vnf, o); }
    const f32x4 vd = vn * gdec; const bf16x8 vdf = as_bf16x8((v4u){pkbf(vd[0], vd[1]), pkbf(vd[2], vd[3]), 0u, 0u});
#pragma unroll
    for (int kt = 0; kt < 8; ++kt) { const v2u kk = *(const LAS v2u*)(lds + L::LKT + ((c * 128 + kt * 16 + fr) * 16 + 4 * g) * 2); S[kt] = S[kt] * Gam; S[kt] = MFMA16(as_bf16x8((v4u){kk.x, kk.y, 0u, 0u}), vdf, S[kt]); }
#pragma unroll
    for (int jj = 0; jj < 4; ++jj) osrc[CH_TOK(n, 4 * g + jj) * 512 + vt * 16 + fr] = tobf(o[jj]);
}
__device__ __forceinline__ void s2_gdn(LAS unsigned char* lds, const bf16* GW0, const bf16* GU0, const bf16* GKT0, const bf16* GP0, const float* GS0, const bf16* qsrc, bf16* osrc, int dir, int vt, int lane, int tid) {
    static_assert(GdnLds::BYTES <= RING_BYTES, "S2 LDS");
    f32x4 S[8];
#pragma unroll
    for (int kt = 0; kt < 8; ++kt) S[kt] = (f32x4){0.f, 0.f, 0.f, 0.f};
    GdnStage Ra, Rb;
    s2g_load(Ra, GW0, GU0, GKT0, GP0, GS0, qsrc, dir, 0, tid); s2g_load(Rb, GW0, GU0, GKT0, GP0, GS0, qsrc, dir, 1, tid);
#pragma unroll 1
    for (int grp = 0; grp < SEQ / 64; grp += 2) {
        S2_BAR(); s2g_store(Ra, lds, tid); S2_BAR();
        s2g_load(Ra, GW0, GU0, GKT0, GP0, GS0, qsrc, dir, grp + 2 < SEQ / 64 ? grp + 2 : grp, tid);
#pragma unroll 2
        for (int c = 0; c < 4; ++c) s2g_chunk(lds, c, S, osrc, dir, grp * 4 + c, vt, lane);
        S2_BAR(); s2g_store(Rb, lds, tid); S2_BAR();
        s2g_load(Rb, GW0, GU0, GKT0, GP0, GS0, qsrc, dir, grp + 3 < SEQ / 64 ? grp + 3 : grp + 1, tid);
#pragma unroll 2
        for (int c = 0; c < 4; ++c) s2g_chunk(lds, c, S, osrc, dir, (grp + 1) * 4 + c, vt, lane);
    }
    S2_BAR();
}
struct Args { const float* in[31]; float* out; unsigned char* ws; int ph_lo, ph_hi; };
static_assert(sizeof(Args) == 31 * 8 + 8 + 8 + 8, "Args has no padding");
typedef const __attribute__((address_space(4))) unsigned char* kptr_t;
typedef const float* cfptr_t; typedef float* fptr_t; typedef unsigned char* ucptr_t;
__device__ __forceinline__ kptr_t kargs() { kptr_t p = (kptr_t)__builtin_amdgcn_kernarg_segment_ptr(); asm volatile("" : "+s"(p)); return p; }
#define KIN(p, i) (*(const __attribute__((address_space(4))) cfptr_t*)((p) + 8 * (i)))
#define KOUT(p) (*(const __attribute__((address_space(4))) fptr_t*)((p) + 248))
#define KWS(p) (*(const __attribute__((address_space(4))) ucptr_t*)((p) + 256))

#ifndef STAGGER_TICKS
#define STAGGER_TICKS 0
#endif
#define GEMM_STAGGER() do { if (STAGGER_TICKS) { const unsigned long long t0_ = __builtin_amdgcn_s_memrealtime(); const unsigned long long dl_ = (unsigned long long)((bx & 15) * STAGGER_TICKS); while (__builtin_amdgcn_s_memrealtime() - t0_ < dl_) __builtin_amdgcn_s_sleep(4); } } while (0)
#ifndef FILL_TAIL
#define FILL_TAIL 1
#endif
#ifndef GATE_BATCH
#define GATE_BATCH 4
#endif
#ifndef F8_SP2
#define F8_SP2 true
#endif
#ifndef EN_MASK
#define EN_MASK 0xffffffffu
#endif
#define EN_PH(k) ((EN_MASK >> (k)) & 1u)
#ifndef REP_MASK
#define REP_MASK 0u
#endif
#define REPS(k) (((REP_MASK >> (k)) & 1u) ? 2 : 1)
#ifndef REP_S2
#define REP_S2 1
#define REP_ATT 1
#endif
__global__ void __launch_bounds__(NWAVES * 64, 2) mega_fwd(Args args) {
    extern __shared__ __attribute__((aligned(16))) unsigned char lds_raw[];
    LAS unsigned char* lds = (LAS unsigned char*)lds_raw;
    volatile LAS unsigned* MISC = (volatile LAS unsigned*)(lds + MISC_OFF);
    LAS int* TAB = (LAS int*)(lds + TAB_OFF);
    for (int u = threadIdx.x; u < (LDS_BYTES - LDSCTL_OFF) / 4; u += NWAVES * 64) ((LAS unsigned*)(lds + LDSCTL_OFF))[u] = 0u;
    __syncthreads();
    if ((threadIdx.x & 63) == 0) ((volatile LAS int*)(lds + WAVETAB_OFF))[hw_slot()] = (int)(threadIdx.x >> 6);
    __syncthreads();
    XcdBarrier bar; bar.bar = (unsigned*)(args.ws + WS_CTL) + CW_BAR; bar.x = 0; bar.st = nullptr;
    if (!MK_SPLIT) bar = xcd_barrier_post((unsigned*)(args.ws + WS_CTL) + CW_BAR, MISC + 8);
    const int lo = args.ph_lo, hi = args.ph_hi;
#define IN(k) (lo <= (k) && (k) < hi)
#define SEAM(k) do { if ((k) + 1 < hi) { if (MK_SPLIT) { if (mk_tid() == 0) __hip_atomic_store((gu32*)(args.ws + WS_CTL) + CW_TMO, 0xBADBA0u, RLX_AGENT); } else xcd_barrier(bar); } } while (0)
#define PHASE_VARS \
    const kptr_t kp = kargs(); unsigned char* const ws = KWS(kp); float* const out = KOUT(kp); (void)out; \
    int tid_ = mk_tid(); asm volatile("" : "+v"(tid_)); const int tid = tid_, lane = tid & 63, wave = __builtin_amdgcn_readfirstlane(tid >> 6); (void)lane; (void)wave; \
    int G_ = gridDim.x, bx_ = blockIdx.x; asm volatile("" : "+s"(G_), "+s"(bx_)); const int G = G_, bx = bx_; const int vcu = (G % 8 == 0) ? (bx % 8) * (G / 8) + bx / 8 : bx; const int gw = vcu * NWAVES + wave, NGW = G * NWAVES; (void)gw; (void)NGW; \
    gu32* const ctl = (gu32*)(ws + WS_CTL); (void)ctl
#define LAYER_PTRS(lp) LayerPtrs lp; \
        lp.g_mix = KIN(kp, 2) + L * DM; lp.na_q_gain = KIN(kp, 4) + L * 64; lp.na_k_gain = KIN(kp, 5) + L * 64; lp.na_rel_bias = KIN(kp, 6) + L * 8 * 15 * 31; \
        lp.gla_w_up = KIN(kp, 7) + L * 2 * 16 * 256; lp.gla_b = KIN(kp, 8) + L * 512; lp.gla_norm = KIN(kp, 9) + L * 128; lp.conv_w = KIN(kp, 10) + L * 5 * 1536; \
        lp.a_log = KIN(kp, 11) + L * 8; lp.dt_bias = KIN(kp, 12) + L * 8; lp.gdn_norm = KIN(kp, 13) + L * 128; lp.lb_raw0 = KIN(kp, 14); lp.lb_raw1 = KIN(kp, 14) + 1024; \
        lp.hg_norm = KIN(kp, 15) + L * 128; lp.mem_q_gain = KIN(kp, 18) + L * 128; lp.g_ffn = KIN(kp, 22) + L * DM
#define WSP(T, off) ((T*)(ws + (off)))

    if (EN_PH(31) && IN(0)) for (int rep_ = 0; rep_ < REPS(31); ++rep_) { PHASE_VARS;
        bf16* WIN = WSP(bf16, WS_WIN); bf16* WBR = WSP(bf16, WS_WBR); bf16* WOUT = WSP(bf16, WS_WOUT); bf16* WMKV = WSP(bf16, WS_WMKV);
        bf16* WGU = WSP(bf16, WS_WGU); bf16* WDN = WSP(bf16, WS_WDN); bf16* MOE1 = WSP(bf16, WS_MOE1); bf16* MOE2 = WSP(bf16, WS_MOE2F);
        LAS float* scr = (LAS float*)(lds + RING_OFF + wave * 16384);
        phase0_convert_all(KIN(kp, 3), KIN(kp, 20), KIN(kp, 21), KIN(kp, 17), KIN(kp, 23), KIN(kp, 24), KIN(kp, 25), ws, scr, gw, NGW, lane);
        for (int i = gw * 64 + lane; i < 2 * (LDP - C_PEND) * DM / 8; i += NGW * 64) { const int L = i / ((LDP - C_PEND) * DM / 8), r = i % ((LDP - C_PEND) * DM / 8);
            *(v4u*)(WIN + ((size_t)L * NIN + C_PEND) * DM + (size_t)r * 8) = (v4u){0u, 0u, 0u, 0u}; }
        const float* mem = KIN(kp, 1); bf16* MEMN = WSP(bf16, WS_MEMN);
        for (int row = gw; row < 2 * 1024; row += NGW) { const int L = row >> 10, m = row & 1023; f32x4 v[8]; rms_row(mem + (size_t)m * DM, KIN(kp, 16) + L * DM, MEMN + (size_t)row * DM, lane, v); }
    }

#pragma unroll 1
    for (int L = 0; L < NLAYER; ++L) {
        const int pb = 1 + 16 * L;
        if (EN_PH(0) && IN(pb + 0)) for (int rep_ = 0; rep_ < REPS(0); ++rep_) { PHASE_VARS; const float* xres = L ? (const float*)out : KIN(kp, 0); const float* gm = KIN(kp, 2) + L * DM; bf16* HM = WSP(bf16, WS_HM);
            for (int t = gw; t < NT; t += NGW) { f32x4 v[8]; rms_row(xres + (size_t)t * DM, gm, HM + (size_t)t * DM, lane, v, WSP(unsigned char, WS_H8) + (size_t)t * DM); } }
        SEAM(pb + 0);
        if (EN_PH(1) && IN(pb + 1)) for (int rep_ = 0; rep_ < REPS(1); ++rep_) {
            { PHASE_VARS; pg8::Gemm g{WSP(bf16, WS_HM), WSP(bf16, WS_WIN) + (size_t)L * NIN * DM, NT, LDP, DM}; pg8::StaticOrder S; S.init(NT, LDP, G, bx); pg8::EpiInProj E{WSP(bf16, WS_P), WSP(bf16, WS_G)};
#if defined(PROBE_NULL_EPI)
              if (rep_) { pg8::EpiNull EN; pg8::gemm_phase<pg8::EpiNull, pg8::StaticOrder, true, true>(lds + RING_OFF, g, S, EN); } else
#endif
              { GEMM_STAGGER(); pg8::gemm_phase<pg8::EpiInProj, pg8::StaticOrder, true, true>(lds + RING_OFF, g, S, E); } }
            if (L == 0) { PHASE_VARS; pg8::Gemm g{WSP(bf16, WS_MEMN), WSP(bf16, WS_WMKV), 2048, 2048, DM}; pg8::KvOrder S{bx, G >= 96 ? 64 : 0}; pg8::EpiResF32 E{nullptr, WSP(float, WS_KVRAW), 1024, 4};
              pg8::gemm_phase<pg8::EpiResF32, pg8::KvOrder, false, true>(lds + RING_OFF, g, S, E); }
            { PHASE_VARS; const int f0 = L ? 64 : 96;
              if (FILL_TAIL && G >= 128 && bx >= f0 && rep_ == 0) { LAS float* scr = (LAS float*)(lds + RING_OFF + wave * 16384); const int gwf = (bx - f0) * NWAVES + wave, ngwf = (G - f0) * NWAVES;
#pragma unroll 1
                  for (int e = 3 * L; e < 3 * L + 3; ++e) transpose_job_f8(KIN(kp, 30) + (size_t)e * DFFE * DM, 64.0f, DFFE, DM, WSP(unsigned char, WS_MOE2F) + (size_t)e * DM * DFFE, scr, gwf, ngwf, lane, RmOff{0}); } }
        }
        SEAM(pb + 1);
        if (EN_PH(2) && IN(pb + 2)) { PHASE_VARS; LAYER_PTRS(lp);
            { LAS float* glaw = (LAS float*)(lds + RING_OFF); __syncthreads();
#pragma unroll
              for (int i = 0; i < 4; ++i) { const int e = (i * 512 + tid) * 4; *(LAS f32x4*)(glaw + e) = *(const f32x4*)(lp.gla_w_up + e); }
              __syncthreads(); }
            for (int u = gw; u < NT / 8; u += NGW) prep_unit(L, lp, (const LAS float*)(lds + RING_OFF), WSP(bf16, WS_P), WSP(float, WS_GLG), WSP(bf16, WS_GQ), WSP(float, WS_GAB), WSP(bf16, WS_HQ), WSP(float, WS_HF), WSP(bf16, WS_NAVT), u * 8, lane);
            if (L == 0) { const float* KVRAW = WSP(float, WS_KVRAW); bf16* MK = WSP(bf16, WS_MK); bf16* MVT = WSP(bf16, WS_MVT); const float* mkg = KIN(kp, 19);
                for (int row = gw; row < 2048; row += NGW) {
                    const int LL = row >> 10; const float* kr = KVRAW + (size_t)row * 1024;
                    const f32x4 k0 = *(const f32x4*)(kr + lane * 8), k1 = *(const f32x4*)(kr + lane * 8 + 4);
                    float f[8] = {k0[0], k0[1], k0[2], k0[3], k1[0], k1[1], k1[2], k1[3]}; float ss = 0.f;
#pragma unroll
                    for (int i = 0; i < 8; ++i) ss += f[i] * f[i];
                    ss = group_sum<16>(ss); const float sc = rsqrtf(ss * (1.0f / 128.0f) + RMS_EPS); const float* gn = mkg + LL * 128 + (lane & 15) * 8;
#pragma unroll
                    for (int i = 0; i < 8; ++i) f[i] = f[i] * sc * gn[i];
                    *(v4u*)(MK + (size_t)row * 512 + lane * 8) = pack8(f);
                    const int b = (row >> 8) & 3, m = row & 255; const float* vr = kr + 512;
#pragma unroll
                    for (int i = 0; i < 8; ++i) { const int cidx = lane * 8 + i; const int h = cidx >> 7, d = cidx & 127;
                        MVT[((size_t)((LL * 4 + b) * 4 + h) * 128 + d) * 256 + m] = (bf16)(pkbf(vr[cidx], 0.f) & 0xffffu); }
                }
            }
        }
        SEAM(pb + 2);
        if (EN_PH(13) && IN(pb + 13)) for (int rep_ = 0; rep_ < REPS(13); ++rep_) { PHASE_VARS;
            LAS unsigned char* scr = lds + RING_OFF + wave * 16384; unsigned char* oa = ws + WS_OA; bf16* P = WSP(bf16, WS_P);
#pragma unroll 1
            for (int u = gw; u < 3 * 8192; u += NGW) { const int br = u >> 13, cu = u & 8191, seq = cu >> 8, n = cu & 255, b = seq >> 3, h = (seq >> 1) & 3, dir = seq & 1; const size_t r0 = (size_t)b << 12;
                if (br == 0) s1_gdn(scr, WSP(bf16, WS_GQ) + r0 * 1536, WSP(float, WS_GAB) + r0 * 16 + dir * 4 + h, h, dir, n, (bf16*)(oa + OA_GW) + (size_t)cu * 2048, (bf16*)(oa + OA_GU) + (size_t)cu * 2048,
                                    (bf16*)(oa + OA_GKT) + (size_t)cu * 2048, (bf16*)(oa + OA_GP) + (size_t)cu * 256, (float*)(oa + OA_GS) + (size_t)cu * 64, lane);
                else if (br == 1) { DiagSrc S{WSP(bf16, WS_HQ) + r0 * 512 + h * 128, 512, nullptr, 0, WSP(float, WS_HF) + r0 * 1024 + dir * 512 + h * 128, 1024, nullptr, 0};
                    s1_diag<128, 1>(scr, S, dir, n, (bf16*)(oa + OA_HQD) + (size_t)cu * 2048, (bf16*)(oa + OA_HKDT) + (size_t)cu * 2048, (bf16*)(oa + OA_HP) + (size_t)cu * 256, (float*)(oa + OA_HV) + (size_t)cu * 128, lane); }
                else { DiagSrc S{P + r0 * LDP + C_GLQ + h * 64, LDP, P + r0 * LDP + C_GLK + h * 64, LDP, WSP(float, WS_GLG) + r0 * 512 + dir * 256 + h * 64, 512, nullptr, 0};
                    s1_diag<64, 0>(scr, S, dir, n, (bf16*)(oa + OA_LQD) + (size_t)cu * 1024, (bf16*)(oa + OA_LKDT) + (size_t)cu * 1024, (bf16*)(oa + OA_LP) + (size_t)cu * 256, (float*)(oa + OA_LV) + (size_t)cu * 64, lane); }
            }
        }
        SEAM(pb + 13);
        if (EN_PH(3) && IN(pb + 3)) for (int rep_ = 0; rep_ < REPS(3); ++rep_) { PHASE_VARS;
            gu32* wq = ctl + CW_WQ + 64 * (L + 2 * rep_); gu32* gq = ctl + CW_GQ + 64 * 8 * (L + 2 * rep_);
            bf16* P = WSP(bf16, WS_P); bf16* SOUT = WSP(bf16, WS_SOUT); bf16* BR = WSP(bf16, WS_BR); unsigned char* oa = ws + WS_OA;
            if (!rep_ || REP_S2) {
#pragma unroll 1
                for (int seq = bx; seq < 32; seq += G) { const int b = seq >> 3, h = (seq >> 1) & 3, dir = seq & 1; const size_t r0 = (size_t)b << 12, c0 = (size_t)seq * 256;
                    s2_gdn(lds + RING_OFF, (const bf16*)(oa + OA_GW) + c0 * 2048, (const bf16*)(oa + OA_GU) + c0 * 2048, (const bf16*)(oa + OA_GKT) + c0 * 2048, (const bf16*)(oa + OA_GP) + c0 * 256, (const float*)(oa + OA_GS) + c0 * 64,
                           WSP(bf16, WS_GQ) + r0 * 1536 + h * 128, SOUT + ((size_t)(1 * 2 + dir) * NT + r0) * 512 + h * 128, dir, wave, lane, tid); }
#pragma unroll 1
                for (int i2 = bx; i2 < 64; i2 += G) if (i2 >= 32) { const int seq = i2 - 32, b = seq >> 3, h = (seq >> 1) & 3, dir = seq & 1; const size_t r0 = (size_t)b << 12, c0 = (size_t)seq * 256;
                    s2_diag<128>(lds + RING_OFF, (const bf16*)(oa + OA_HQD) + c0 * 2048, (const bf16*)(oa + OA_HKDT) + c0 * 2048, (const bf16*)(oa + OA_HP) + c0 * 256, (const float*)(oa + OA_HV) + c0 * 128,
                                 P + r0 * LDP + C_HGI + h * 128, LDP, SOUT + ((size_t)(2 * 2 + dir) * NT + r0) * 512 + h * 128, 512, dir, wave, lane, tid); }
#pragma unroll 1
                for (int i2 = bx; i2 < 96; i2 += G) if (i2 >= 64) { const int seq = i2 - 64, b = seq >> 3, h = (seq >> 1) & 3, dir = seq & 1; const size_t r0 = (size_t)b << 12, c0 = (size_t)seq * 256;
                    s2_diag<64>(lds + RING_OFF, (const bf16*)(oa + OA_LQD) + c0 * 1024, (const bf16*)(oa + OA_LKDT) + c0 * 1024, (const bf16*)(oa + OA_LP) + c0 * 256, (const float*)(oa + OA_LV) + c0 * 64,
                                P + r0 * LDP + C_GLV + h * 128, LDP, SOUT + ((size_t)(0 * 2 + dir) * NT + r0) * 512 + h * 128, 512, dir, wave, lane, tid); }
            }
            if (bx < 96 && rep_ == 0) { __syncthreads(); if (tid == 0) __hip_atomic_fetch_add(ctl + CW_S2DONE + 64 * L, 1u, RLX_AGENT); }
            if (!rep_ || REP_ATT) {
            bool gates_left = true;
            for (;;) {
                __syncthreads();
                if (tid == 0) { unsigned v = 0xffffffffu;
                    if (gates_left) for (int k8 = 0; k8 < 8; ++k8) { const int x = (bx + k8) & 7; const unsigned b0 = __hip_atomic_fetch_add(gq + 64 * x, 1u, RLX_AGENT); if (b0 < (unsigned)(320 / GATE_BATCH)) { v = (unsigned)x * 4096u + b0; break; } }
                    MISC[17] = v; if (v == 0xffffffffu) MISC[16] = __hip_atomic_fetch_add(wq, 1u, RLX_AGENT); }
                __syncthreads();
                const unsigned gsel = MISC[17];
                if (gsel != 0xffffffffu) {
                    const unsigned char* g8b = (const unsigned char*)(WSP(bf16, WS_WIN) + ((size_t)L * NIN + LDP) * DM) - (size_t)33 * 256 * DM;
                    pg8::Gemm g8{WSP(bf16, WS_H8), (const bf16*)g8b, NT, NIN, DM / 2}; pg8::GateBatchOrder S8{(int)(gsel >> 12), (int)(gsel & 4095u) * GATE_BATCH, GATE_BATCH}; pg8::EpiInProj E8{WSP(bf16, WS_P), WSP(bf16, WS_G)};
                    pg8::gemm_phase_f8<pg8::EpiInProj, pg8::GateBatchOrder, true, F8_SP2>(lds + RING_OFF, g8, S8, E8);
                    continue; }
                gates_left = false;
                int it = (int)MISC[16];
                if (it >= 768) break;
                int lane_ = lane, tid_q = tid; asm volatile("" : "+v"(lane_), "+v"(tid_q));
                if (it < 512) {
                    const int b = it >> 7, h = (it >> 4) & 7, rq = it & 15;
                    na_wave_unit(P, WSP(bf16, WS_NAVT), KIN(kp, 6) + L * 8 * 15 * 31, BR, b, h, 4 * rq + (wave >> 2), wave & 3, lane_);
                    na_wave_unit(P, WSP(bf16, WS_NAVT), KIN(kp, 6) + L * 8 * 15 * 31, BR, b, h, 4 * rq + 2 + (wave >> 2), wave & 3, lane_);
                } else {
                    const int i2 = it - 512, tb = i2 >> 2, h = i2 & 3;
                    mem_wg_unit(lds + RING_OFF, P, WSP(bf16, WS_MK) + (size_t)L * 1024 * 512, WSP(bf16, WS_MVT) + (size_t)L * 4 * 4 * 128 * 256, BR + (size_t)4 * NT * 512, tb * 256, h, wave, lane_, tid_q);
                }
            }
            }
            if (FILL_TAIL && G >= 128 && rep_ == 0 && bx >= 144) { LAS float* scr = (LAS float*)(lds + RING_OFF + wave * 16384);
                moe_drain(KIN(kp, 28), KIN(kp, 29), KIN(kp, 30), ws, ctl + CW_CONVQ, ctl + CW_S2DONE + 64 * L, 96u, MISC + 20, scr, wave, lane, tid); }
        }
        SEAM(pb + 3);
        if (EN_PH(4) && IN(pb + 4)) for (int rep_ = 0; rep_ < REPS(4); ++rep_) { PHASE_VARS; LAYER_PTRS(lp); for (int t = gw; t < NT; t += NGW) post_token(lp, WSP(bf16, WS_P), WSP(bf16, WS_SOUT), WSP(bf16, WS_BR), t, lane);
            if (L == 1 && rep_ == 0) {
                bf16* MOE1 = WSP(bf16, WS_MOE1); bf16* MOE2 = WSP(bf16, WS_MOE2F); LAS float* scr = (LAS float*)(lds + RING_OFF + wave * 16384);
                if (FILL_TAIL && G >= 128) moe_drain(KIN(kp, 28), KIN(kp, 29), KIN(kp, 30), ws, ctl + CW_CONVQ, nullptr, 0u, MISC + 20, scr, wave, lane, tid);
                else { moe1_convert_all(KIN(kp, 28), KIN(kp, 29), (unsigned char*)MOE1, scr, gw, NGW, lane);
#pragma unroll 1
                    for (int e = 0; e < NEXP; ++e) transpose_job_f8(KIN(kp, 30) + (size_t)e * DFFE * DM, 64.0f, DFFE, DM, (unsigned char*)MOE2 + (size_t)e * DM * DFFE, scr, gw, NGW, lane, RmOff{0}); }
            }
        }
        SEAM(pb + 4);
        if (EN_PH(5) && IN(pb + 5)) { PHASE_VARS; pg8::Gemm g{WSP(bf16, WS_BR), WSP(bf16, WS_WBR) + (size_t)L * 5 * DM * 512, 5 * NT, 5 * DM, 512}; pg8::BranchOrder5 S{G, bx}; pg8::EpiBranchAcc E{WSP(bf16, WS_G), WSP(bf16, WS_HM)};
            pg8::gemm_phase<pg8::EpiBranchAcc, pg8::BranchOrder5, true, true>(lds + RING_OFF, g, S, E); }
        SEAM(pb + 5);
        if (EN_PH(7) && IN(pb + 7)) { PHASE_VARS; const float* xres = L ? (const float*)out : KIN(kp, 0);
            pg8::Gemm g{WSP(bf16, WS_HM), WSP(bf16, WS_WOUT) + (size_t)L * DM * DM, NT, DM, DM}; pg8::StaticOrder S; S.init(NT, DM, G, bx); pg8::EpiResF32 E{xres, out, DM, 1 << 20};
            pg8::gemm_phase<pg8::EpiResF32, pg8::StaticOrder, true, true>(lds + RING_OFF, g, S, E); }
        SEAM(pb + 7);
        if (L == 0) {
            if (EN_PH(8) && IN(pb + 8)) for (int rep_ = 0; rep_ < REPS(8); ++rep_) { PHASE_VARS; const float* gf = KIN(kp, 22) + L * DM; bf16* HM = WSP(bf16, WS_HM);
                for (int t = gw; t < NT; t += NGW) { f32x4 v[8]; rms_row(out + (size_t)t * DM, gf, HM + (size_t)t * DM, lane, v); } }
            SEAM(pb + 8);
            if (EN_PH(9) && IN(pb + 9)) for (int rep_ = 0; rep_ < REPS(9); ++rep_) { PHASE_VARS; pg8::Gemm g{WSP(bf16, WS_HM), WSP(bf16, WS_WGU), NT, 2 * DFF, DM}; pg8::StaticOrder S; S.init(NT, 2 * DFF, G, bx); pg8::EpiSwiGLU E{WSP(bf16, WS_HID), DFF, 1 << 20};
                GEMM_STAGGER(); pg8::gemm_phase<pg8::EpiSwiGLU, pg8::StaticOrder, true, true>(lds + RING_OFF, g, S, E); }
            SEAM(pb + 9);
            if (EN_PH(10) && IN(pb + 10)) { PHASE_VARS; pg8::Gemm g{WSP(bf16, WS_HID), WSP(bf16, WS_WDN), NT, DM, DFF}; pg8::StaticOrder S; S.init(NT, DM, G, bx); pg8::EpiResF32 E{out, out, DM, 1 << 20};
                pg8::gemm_phase<pg8::EpiResF32, pg8::StaticOrder, true, true>(lds + RING_OFF, g, S, E); }
            SEAM(pb + 10);
        } else {
            if (EN_PH(8) && IN(pb + 8)) { PHASE_VARS; gu32* cnt = ctl + CW_CNT; unsigned* ROUTE = WSP(unsigned, WS_ROUTE); bf16* HM = WSP(bf16, WS_HM);
                const float* wr = KIN(kp, 26); const float* brt = KIN(kp, 27); const float* gf = KIN(kp, 22) + L * DM;
                LAS unsigned* lcnt = (LAS unsigned*)(lds + RING_OFF); LAS unsigned* gbase = lcnt + 8;
                LAS f32x4* wl = (LAS f32x4*)(lds + RING_OFF + 4096);
                __syncthreads();
#pragma unroll
                for (int i = 0; i < 8; ++i) { const int idx = i * 512 + tid, ln = idx & 63, r = idx >> 6, half = r & 1, q = (r >> 1) & 3, j = r >> 3; wl[idx] = *(const f32x4*)(wr + (size_t)(4 * (ln + 64 * j) + q) * 8 + half * 4); }
                for (int blk = bx; blk < NT / 64; blk += G) {
                    __syncthreads(); if (tid < 8) lcnt[tid] = 0u; __syncthreads();
                    unsigned re0 = 0, re1 = 0, rp0 = 0, rp1 = 0; float rw0 = 0.f, rw1 = 0.f;
#pragma unroll 1
                    for (int tt = 0; tt < 8; ++tt) { const int t = blk * 64 + wave * 8 + tt; f32x4 v[8]; rms_row_f8(out + (size_t)t * DM, gf, (unsigned char*)HM + (size_t)t * DM, lane, v);
                        float lg[8]; int ll = lane; asm volatile("" : "+v"(ll));
#pragma unroll
                        for (int e = 0; e < 8; ++e) lg[e] = 0.f;
#pragma unroll
                        for (int j = 0; j < 8; ++j)
#pragma unroll
                            for (int q = 0; q < 4; ++q) { const f32x4 w0 = wl[((j * 4 + q) * 2 + 0) * 64 + ll], w1 = wl[((j * 4 + q) * 2 + 1) * 64 + ll]; const float hv = v[j][q];
                                lg[0] += hv * w0[0]; lg[1] += hv * w0[1]; lg[2] += hv * w0[2]; lg[3] += hv * w0[3]; lg[4] += hv * w1[0]; lg[5] += hv * w1[1]; lg[6] += hv * w1[2]; lg[7] += hv * w1[3]; }
#pragma unroll
                        for (int e = 0; e < 8; ++e) lg[e] = wave_sum(lg[e]) + brt[e];
                        int e0 = 0; float m0 = lg[0];
#pragma unroll
                        for (int e = 1; e < 8; ++e) if (lg[e] > m0) { m0 = lg[e]; e0 = e; }
                        int e1 = 0; float m1 = -3.0e38f;
#pragma unroll
                        for (int e = 0; e < 8; ++e) if (e != e0 && lg[e] > m1) { m1 = lg[e]; e1 = e; }
                        const float w0 = 1.0f / (1.0f + __expf(m1 - m0));
                        if (lane == tt) { re0 = e0; re1 = e1; rw0 = w0; rw1 = 1.0f - w0;
                            rp0 = __hip_atomic_fetch_add(&lcnt[e0], 1u, __ATOMIC_RELAXED, __HIP_MEMORY_SCOPE_WORKGROUP); rp1 = __hip_atomic_fetch_add(&lcnt[e1], 1u, __ATOMIC_RELAXED, __HIP_MEMORY_SCOPE_WORKGROUP); }
                    }
                    __syncthreads();
                    if (tid < 8) gbase[tid] = __hip_atomic_fetch_add(cnt + 64 * tid, lcnt[tid], RLX_AGENT);
                    __syncthreads();
                    if (lane < 8) { const int t = blk * 64 + wave * 8 + lane; unsigned* rr = ROUTE + (size_t)t * 8;
                        rr[0] = re0; rr[1] = re1; rr[2] = gbase[re0] + rp0; rr[3] = gbase[re1] + rp1; rr[4] = __float_as_uint(rw0); rr[5] = __float_as_uint(rw1); }
                }
            }
            SEAM(pb + 8);
            if (hi > pb + 9) { PHASE_VARS; gu32* cnt = ctl + CW_CNT;
                __syncthreads();
                if (tid == 0) { int acc = 0; for (int e = 0; e < 8; ++e) { const int c = (int)__hip_atomic_load(cnt + 64 * e, RLX_AGENT); const int nb = (c + 255) >> 8; TAB[e] = nb; TAB[8 + e] = acc; TAB[32 + e] = acc * 256; acc += nb; } TAB[40] = acc; }
                __syncthreads();
            }
            if (EN_PH(9) && IN(pb + 9)) for (int rep_ = 0; rep_ < REPS(9); ++rep_) { PHASE_VARS; bf16* XB = WSP(bf16, WS_XB); unsigned* ROUTE = WSP(unsigned, WS_ROUTE); const bf16* HM = WSP(bf16, WS_HM);
                for (int t = gw; t < NT; t += NGW) { unsigned* rr = ROUTE + (size_t)t * 8; const unsigned e0 = rr[0], e1 = rr[1]; const unsigned s0 = (unsigned)TAB[32 + e0] + rr[2], s1 = (unsigned)TAB[32 + e1] + rr[3];
                    if (lane == 0) { rr[6] = s0; rr[7] = s1; }
                    const v4u* src = (const v4u*)((const unsigned char*)HM + (size_t)t * DM) + lane; v4u* d0 = (v4u*)((unsigned char*)XB + (size_t)s0 * DM) + lane; v4u* d1 = (v4u*)((unsigned char*)XB + (size_t)s1 * DM) + lane;
#pragma unroll
                    for (int j = 0; j < 2; ++j) { const v4u x = src[64 * j]; d0[64 * j] = x; d1[64 * j] = x; } } }
            SEAM(pb + 9);
            if (EN_PH(10) && IN(pb + 10)) for (int rep_ = 0; rep_ < REPS(20); ++rep_) { PHASE_VARS; __syncthreads(); if (tid == 0) { for (int e = 0; e <= 8; ++e) TAB[16 + e] = (e < 8 ? TAB[8 + e] : TAB[40]) * 56; } __syncthreads();
                pg8::Gemm g{WSP(bf16, WS_XB), WSP(bf16, WS_MOE1), MAXSLOT, 8 * 2 * DFFE, DM / 2}; pg8::MoeOrder S{G, bx, 56, TAB[40] * 56, TAB}; pg8::EpiSwiGLU8 E{WSP(unsigned char, WS_HIDM), DFFE, 56};
                GEMM_STAGGER(); pg8::gemm_phase_f8<pg8::EpiSwiGLU8, pg8::MoeOrder, true, F8_SP2>(lds + RING_OFF, g, S, E); }
            SEAM(pb + 10);
            if (EN_PH(11) && IN(pb + 11)) for (int rep_ = 0; rep_ < REPS(11); ++rep_) { PHASE_VARS; __syncthreads(); if (tid == 0) { for (int e = 0; e <= 8; ++e) TAB[16 + e] = (e < 8 ? TAB[8 + e] : TAB[40]) * 8; } __syncthreads();
                pg8::Gemm g{WSP(bf16, WS_HIDM), WSP(bf16, WS_MOE2F), MAXSLOT, 8 * DM, DFFE / 2}; pg8::MoeOrder S{G, bx, 8, TAB[40] * 8, TAB}; pg8::EpiBf16Out E{WSP(bf16, WS_YB), DM, 8};
                GEMM_STAGGER(); pg8::gemm_phase_f8<pg8::EpiBf16Out, pg8::MoeOrder, true, F8_SP2>(lds + RING_OFF, g, S, E); }
            SEAM(pb + 11);
            if (EN_PH(12) && IN(pb + 12)) { PHASE_VARS; const bf16* YB = WSP(bf16, WS_YB); const unsigned* ROUTE = WSP(unsigned, WS_ROUTE);
                for (int t = gw; t < NT; t += NGW) { const unsigned* rr = ROUTE + (size_t)t * 8; const float w0 = __uint_as_float(rr[4]), w1 = __uint_as_float(rr[5]); const size_t s0 = rr[6], s1 = rr[7];
                    f32x4* o = (f32x4*)(out + (size_t)t * DM) + lane; const v2u* y0 = (const v2u*)(YB + s0 * DM) + lane; const v2u* y1 = (const v2u*)(YB + s1 * DM) + lane;
#pragma unroll
                    for (int j = 0; j < 8; ++j) { const v2u a = y0[64 * j], b = y1[64 * j];
                        o[64 * j] = o[64 * j] + w0 * (f32x4){bflo(a.x), bfhi(a.x), bflo(a.y), bfhi(a.y)} + w1 * (f32x4){bflo(b.x), bfhi(b.x), bflo(b.y), bfhi(b.y)}; } } }
        }
    }
#undef IN
#undef SEAM
}
extern "C" void kernel_launch(void* const* d_in, const int* in_sizes, int n_in, void* d_out, int out_size, void* d_ws, size_t ws_size, hipStream_t stream) {
    static int grid = 0;
    if (grid == 0) {
        if (n_in != 31 || in_sizes[0] != NT * DM || out_size != NT * DM || ws_size < WS_END) { fprintf(stderr, "kernel_launch: unexpected shapes (n_in %d, in0 %d, out %d, ws %zu < %zu); nothing launched\n", n_in, n_in > 0 ? in_sizes[0] : -1, out_size, ws_size, (size_t)WS_END); grid = -1; return; }
        int dev = 0, cus = 0, per_cu = 0;
        if (hipGetDevice(&dev) != hipSuccess || hipDeviceGetAttribute(&cus, hipDeviceAttributeMultiprocessorCount, dev) != hipSuccess) { grid = -1; return; }
        if (hipFuncSetAttribute((const void*)mega_fwd, hipFuncAttributeMaxDynamicSharedMemorySize, LDS_BYTES) != hipSuccess) { fprintf(stderr, "kernel_launch: hipFuncSetAttribute failed\n"); grid = -1; return; }
        if (hipOccupancyMaxActiveBlocksPerMultiprocessor(&per_cu, (const void*)mega_fwd, NWAVES * 64, LDS_BYTES) != hipSuccess || per_cu < 1) fprintf(stderr, "kernel_launch: occupancy query reports %d\n", per_cu);
        (void)hipGetLastError();
        grid = cus;
    }
    if (grid < 0) return;
    if (hipMemsetAsync((char*)d_ws + WS_CTL, 0, CTL_ZERO_BYTES, stream) != hipSuccess) return;
    Args a{};
    for (int i = 0; i < 31; ++i) a.in[i] = (const float*)d_in[i];
    a.out = (float*)d_out; a.ws = (unsigned char*)d_ws;
#if MK_SPLIT
    int ids[40]; int n = 0; ids[n++] = 0;
    for (int L = 0; L < 2; ++L) for (int k = 0; k < (L ? 13 : 11); ++k) { ids[n++] = 1 + 16 * L + k; if (k == 2) ids[n++] = 1 + 16 * L + 13; }
    for (int i = 0; i < n; ++i) { a.ph_lo = ids[i]; a.ph_hi = ids[i] + 1; hipLaunchKernelGGL(mega_fwd, dim3(grid), dim3(NWAVES * 64), LDS_BYTES, stream, a); }
#else
    a.ph_lo = 0; a.ph_hi = 64;
    hipLaunchKernelGGL(mega_fwd, dim3(grid), dim3(NWAVES * 64), LDS_BYTES, stream, a);
#endif
    const hipError_t le = hipPeekAtLastError();
    if (le != hipSuccess) fprintf(stderr, "kernel_launch: launch failed: %s\n", hipGetErrorName(le));
}
```

```cpp
#include <hip/hip_runtime.h>
#include <cstdio>
#include <cstdint>
__device__ __forceinline__ int pg8_tid();
namespace pg8 {
#define PG8_LAS __attribute__((address_space(3)))
typedef unsigned short bf16_t;
typedef short bf16x8 __attribute__((ext_vector_type(8)));
typedef float f32x4 __attribute__((ext_vector_type(4)));
typedef unsigned u32x4 __attribute__((ext_vector_type(4)));
constexpr int BM = 256, BK = 64, HALF = 128, HTB = HALF * BK * 2  , STAGE_BYTES = 8 * HTB, NXCD = 8, WGM = 8;

__host__ __device__ __forceinline__ int lds_byte(int r, int c) { const int st = (r >> 4) * 2 + (c >> 5), rr = r & 15, cc = c & 31, ob = rr * 64 + cc * 2; return st * 1024 + (ob ^ (((ob >> 9) & 1) << 5)); }
__host__ __device__ __forceinline__ void stage_rc(int b, int& R, int& C) { const int st = b / 1024, sb = b % 1024, swz = sb ^ (((sb >> 9) & 1) << 5); R = (st >> 1) * 16 + swz / 64; C = (st & 1) * 32 + (swz % 64) / 2; }
__host__ __device__ __forceinline__ int perm32(int rho) { const int n = rho >> 4, i = rho & 15; return 8 * (i >> 2) + 4 * n + (i & 3); }

struct Unit { int pm, pn; };
struct Gemm { const bf16_t* A; const bf16_t* Bt; int M, N, K; };

struct StaticOrder {
    int nM, nN, nwg, G, c;
    __host__ __device__ void init(int M, int N, int G_, int c_) { nM = M / BM; nN = N / BM; nwg = nM * nN; G = G_; c = c_; }
    __host__ __device__ bool next(int i, Unit& u) const {
        const long L = (long)i * G + c; if (L >= nwg) return false;
        int wgid = (int)L; { const int q = nwg / NXCD, r = nwg % NXCD, xcd = wgid % NXCD, off = wgid / NXCD; wgid = (xcd < r ? xcd * (q + 1) : r * (q + 1) + (xcd - r) * q) + off; }
        const int nig = WGM * nN, gid = wgid / nig, fm = gid * WGM, gsz = (nM - fm) < WGM ? (nM - fm) : WGM;
        u.pm = fm + ((wgid % nig) % gsz); u.pn = (wgid % nig) / gsz; return true;
    }
    __device__ __forceinline__ void a_ready(const Unit&) const {}
    __device__ __forceinline__ void done(const Unit&) const {}
};
__device__ __forceinline__ unsigned cvt_pk_bf16(float lo, float hi) { unsigned r; asm volatile("v_cvt_pk_bf16_f32 %0, %1, %2" : "=v"(r) : "v"(lo), "v"(hi)); return r; }
typedef float f32x2 __attribute__((ext_vector_type(2)));
__device__ __forceinline__ float sigm(float x) { return __builtin_amdgcn_rcpf(1.0f + __expf(-x)); }
struct EpiInProj {
    static constexpr bool PERM = true, AFTER_DRAIN = false, CARRY = false;
    bf16_t* P; bf16_t* G;
    __device__ __forceinline__ void operator()(const f32x4 (&acc)[2][2][4][2], const Unit& u, int wr, int wc, int fr, int fq) const {
        const int row0 = u.pm * BM + wr * 64 + fr; const bool isg = u.pn >= 33;
#if defined(SKIP_G)
        if (isg) return;
#endif
        bf16_t* base = isg ? G : P; const int ldc = isg ? 10240 : 8448; const int col0 = (isg ? (u.pn - 33) : u.pn) * BM + wc * 32 + 8 * fq;
#pragma unroll
        for (int ai = 0; ai < 2; ++ai)
#pragma unroll
            for (int m = 0; m < 4; ++m) { bf16_t* rowp = base + (size_t)(row0 + ai * HALF + m * 16) * ldc + col0;
#pragma unroll
                for (int bj = 0; bj < 2; ++bj) { f32x4 v0 = acc[ai][bj][m][0], v1 = acc[ai][bj][m][1];
                    if (isg) {
                        unsigned lo = 0u, hi = 0u;
#pragma unroll
                        for (int j = 0; j < 4; ++j) { lo = __builtin_amdgcn_cvt_pk_u8_f32(sigm(v0[j]) * 255.0f, j, lo); hi = __builtin_amdgcn_cvt_pk_u8_f32(sigm(v1[j]) * 255.0f, j, hi); }
                        typedef unsigned u32x2 __attribute__((ext_vector_type(2)));
                        *(u32x2*)((unsigned char*)G + (size_t)(row0 + ai * HALF + m * 16) * 10240 + col0 + bj * HALF) = (u32x2){lo, hi};
                    } else {
                    u32x4 w; w.x = cvt_pk_bf16(v0[0], v0[1]); w.y = cvt_pk_bf16(v0[2], v0[3]); w.z = cvt_pk_bf16(v1[0], v1[1]); w.w = cvt_pk_bf16(v1[2], v1[3]);
                    *(u32x4*)(rowp + bj * HALF) = w; } } }
    }
};
struct EpiGate {
    static constexpr bool PERM = true, AFTER_DRAIN = false, CARRY = false;
    bf16_t* G;
    __device__ __forceinline__ void operator()(const f32x4 (&acc)[2][2][4][2], const Unit& u, int wr, int wc, int fr, int fq) const {
        const int row0 = u.pm * BM + wr * 64 + fr, col0 = u.pn * BM + wc * 32 + 8 * fq;
#pragma unroll
        for (int ai = 0; ai < 2; ++ai)
#pragma unroll
            for (int m = 0; m < 4; ++m) { bf16_t* rowp = G + (size_t)(row0 + ai * HALF + m * 16) * 10240 + col0;
#pragma unroll
                for (int bj = 0; bj < 2; ++bj) { f32x4 v0 = acc[ai][bj][m][0], v1 = acc[ai][bj][m][1];
#pragma unroll
                    for (int j = 0; j < 4; ++j) { v0[j] = sigm(v0[j]); v1[j] = sigm(v1[j]); }
                    u32x4 w; w.x = cvt_pk_bf16(v0[0], v0[1]); w.y = cvt_pk_bf16(v0[2], v0[3]); w.z = cvt_pk_bf16(v1[0], v1[1]); w.w = cvt_pk_bf16(v1[2], v1[3]);
                    *(u32x4*)(rowp + bj * HALF) = w; } }
    }
};
struct EpiBranch {
    static constexpr bool PERM = true, AFTER_DRAIN = false, CARRY = false;
    bf16_t* G;
    __device__ __forceinline__ void operator()(const f32x4 (&acc)[2][2][4][2], const Unit& u, int wr, int wc, int fr, int fq) const {
        const int n = u.pn >> 3, j = u.pn & 7; const int row0 = (u.pm & 63) * BM + wr * 64 + fr, col0 = n * 2048 + j * BM + wc * 32 + 8 * fq;
#pragma unroll
        for (int ai = 0; ai < 2; ++ai)
#pragma unroll
            for (int m = 0; m < 4; ++m) { bf16_t* rowp = G + (size_t)(row0 + ai * HALF + m * 16) * 10240 + col0;
#pragma unroll
                for (int bj = 0; bj < 2; ++bj) { const u32x4 g = *(const u32x4*)(rowp + bj * HALF); const f32x4 v0 = acc[ai][bj][m][0], v1 = acc[ai][bj][m][1];
                    u32x4 w;
                    w.x = cvt_pk_bf16(v0[0] * __uint_as_float(g.x << 16), v0[1] * __uint_as_float(g.x & 0xffff0000u));
                    w.y = cvt_pk_bf16(v0[2] * __uint_as_float(g.y << 16), v0[3] * __uint_as_float(g.y & 0xffff0000u));
                    w.z = cvt_pk_bf16(v1[0] * __uint_as_float(g.z << 16), v1[1] * __uint_as_float(g.z & 0xffff0000u));
                    w.w = cvt_pk_bf16(v1[2] * __uint_as_float(g.w << 16), v1[3] * __uint_as_float(g.w & 0xffff0000u));
                    *(u32x4*)(rowp + bj * HALF) = w; } }
    }
};
struct EpiBranchAcc {
    static constexpr bool PERM = true, AFTER_DRAIN = false, CARRY = false;
    const bf16_t* G; bf16_t* Mg;
    __device__ __forceinline__ void operator()(const f32x4 (&acc)[2][2][4][2], const Unit& u, int wr, int wc, int fr, int fq) const {
        typedef unsigned u32x2 __attribute__((ext_vector_type(2)));
        const int n = u.pn >> 3, j = u.pn & 7; const int row0 = (u.pm & 63) * BM + wr * 64 + fr, gcol0 = n * 2048 + j * BM + wc * 32 + 8 * fq, mcol0 = j * BM + wc * 32 + 8 * fq;
#pragma unroll
        for (int ai = 0; ai < 2; ++ai) { u32x2 gg[4][2]; u32x4 ov[4][2];
#pragma unroll
            for (int m = 0; m < 4; ++m) { const unsigned char* gp = (const unsigned char*)G + (size_t)(row0 + ai * HALF + m * 16) * 10240 + gcol0; const bf16_t* mp = Mg + (size_t)(row0 + ai * HALF + m * 16) * 2048 + mcol0;
#pragma unroll
                for (int bj = 0; bj < 2; ++bj) { gg[m][bj] = *(const u32x2*)(gp + bj * HALF);
                    if (n) ov[m][bj] = *(const u32x4*)(mp + bj * HALF); } }
#pragma unroll
            for (int m = 0; m < 4; ++m) { bf16_t* mp = Mg + (size_t)(row0 + ai * HALF + m * 16) * 2048 + mcol0;
#pragma unroll
                for (int bj = 0; bj < 2; ++bj) { const u32x2 g = gg[m][bj]; const f32x4 v0 = acc[ai][bj][m][0] * (1.0f / 255.0f), v1 = acc[ai][bj][m][1] * (1.0f / 255.0f);
                    float z[8] = {v0[0] * (float)(g.x & 0xffu), v0[1] * (float)((g.x >> 8) & 0xffu), v0[2] * (float)((g.x >> 16) & 0xffu), v0[3] * (float)(g.x >> 24),
                                  v1[0] * (float)(g.y & 0xffu), v1[1] * (float)((g.y >> 8) & 0xffu), v1[2] * (float)((g.y >> 16) & 0xffu), v1[3] * (float)(g.y >> 24)};
                    if (n) { const unsigned w0 = ov[m][bj].x, w1 = ov[m][bj].y, w2 = ov[m][bj].z, w3 = ov[m][bj].w;
                        z[0] += __uint_as_float(w0 << 16); z[1] += __uint_as_float(w0 & 0xffff0000u); z[2] += __uint_as_float(w1 << 16); z[3] += __uint_as_float(w1 & 0xffff0000u);
                        z[4] += __uint_as_float(w2 << 16); z[5] += __uint_as_float(w2 & 0xffff0000u); z[6] += __uint_as_float(w3 << 16); z[7] += __uint_as_float(w3 & 0xffff0000u); }
                    u32x4 w; w.x = cvt_pk_bf16(z[0], z[1]); w.y = cvt_pk_bf16(z[2], z[3]); w.z = cvt_pk_bf16(z[4], z[5]); w.w = cvt_pk_bf16(z[6], z[7]);
                    *(u32x4*)(mp + bj * HALF) = w; } }
            asm volatile("" ::: "memory"); }
    }
};
struct EpiResF32 {
    static constexpr bool PERM = false, AFTER_DRAIN = false, CARRY = false;
    const float* R; float* O; int ldc; int ntn;
    __device__ __forceinline__ void operator()(const f32x4 (&acc)[2][2][4][2], const Unit& u, int wr, int wc, int fr, int fq) const {
        const int row0 = u.pm * BM + wr * 64 + fr, col0 = (u.pn % ntn) * BM + wc * 32 + 4 * fq;
#pragma unroll
        for (int ai = 0; ai < 2; ++ai) { f32x4 r[4][2][2];
            if (R) {
#pragma unroll
                for (int m = 0; m < 4; ++m) { const size_t off = (size_t)(row0 + ai * HALF + m * 16) * ldc + col0;
#pragma unroll
                    for (int bj = 0; bj < 2; ++bj)
#pragma unroll
                        for (int n = 0; n < 2; ++n) r[m][bj][n] = *(const f32x4*)(R + off + bj * HALF + n * 16); } }
#pragma unroll
            for (int m = 0; m < 4; ++m) { const size_t off = (size_t)(row0 + ai * HALF + m * 16) * ldc + col0;
#pragma unroll
                for (int bj = 0; bj < 2; ++bj)
#pragma unroll
                    for (int n = 0; n < 2; ++n) { f32x4 o = acc[ai][bj][m][n]; if (R) o = o + r[m][bj][n]; *(f32x4*)(O + off + bj * HALF + n * 16) = o; } }
            asm volatile("" ::: "memory"); }
    }
};
struct EpiBf16Out {
    static constexpr bool PERM = false, AFTER_DRAIN = false, CARRY = false;
    bf16_t* O; int ldc; int ntn;
    __device__ __forceinline__ void operator()(const f32x4 (&acc)[2][2][4][2], const Unit& u, int wr, int wc, int fr, int fq) const {
        typedef unsigned u32x2 __attribute__((ext_vector_type(2)));
        const int row0 = u.pm * BM + wr * 64 + fr, col0 = (u.pn % ntn) * BM + wc * 32 + 4 * fq;
#pragma unroll
        for (int ai = 0; ai < 2; ++ai)
#pragma unroll
            for (int m = 0; m < 4; ++m) { bf16_t* rowp = O + (size_t)(row0 + ai * HALF + m * 16) * ldc + col0;
#pragma unroll
                for (int bj = 0; bj < 2; ++bj)
#pragma unroll
                    for (int n = 0; n < 2; ++n) { const f32x4 v = acc[ai][bj][m][n]; *(u32x2*)(rowp + bj * HALF + n * 16) = (u32x2){cvt_pk_bf16(v[0], v[1]), cvt_pk_bf16(v[2], v[3])}; } }
    }
};
struct EpiSwiGLU {
    static constexpr bool PERM = true, AFTER_DRAIN = false, CARRY = false;
    bf16_t* H; int ldh; int tpg;
    __device__ __forceinline__ void operator()(const f32x4 (&acc)[2][2][4][2], const Unit& u, int wr, int wc, int fr, int fq) const {
        const int row0 = u.pm * BM + wr * 64 + fr, col0 = (u.pn % tpg) * HALF + wc * 32 + 8 * fq;
#pragma unroll
        for (int ai = 0; ai < 2; ++ai)
#pragma unroll
            for (int m = 0; m < 4; ++m) { bf16_t* rowp = H + (size_t)(row0 + ai * HALF + m * 16) * ldh + col0;
                f32x4 h0, h1;
#pragma unroll
                for (int j = 0; j < 4; ++j) { const float g0 = acc[ai][0][m][0][j], g1 = acc[ai][0][m][1][j]; h0[j] = g0 * sigm(g0) * acc[ai][1][m][0][j]; h1[j] = g1 * sigm(g1) * acc[ai][1][m][1][j]; }
                u32x4 w; w.x = cvt_pk_bf16(h0[0], h0[1]); w.y = cvt_pk_bf16(h0[2], h0[3]); w.z = cvt_pk_bf16(h1[0], h1[1]); w.w = cvt_pk_bf16(h1[2], h1[3]);
                *(u32x4*)rowp = w; }
    }
};
struct EpiNull {
    static constexpr bool PERM = true, AFTER_DRAIN = false, CARRY = false;
    __device__ __forceinline__ void operator()(const f32x4 (&acc)[2][2][4][2], const Unit&, int, int, int, int) const {
#pragma unroll
        for (int a = 0; a < 2; ++a)
#pragma unroll
            for (int b = 0; b < 2; ++b)
#pragma unroll
                for (int m = 0; m < 4; ++m)
#pragma unroll
                    for (int n = 0; n < 2; ++n) asm volatile("" :: "v"(acc[a][b][m][n]));
    }
};
struct EpiSwiGLU8 {
    static constexpr bool PERM = true, AFTER_DRAIN = false, CARRY = false;
    unsigned char* H; int ldh; int tpg;
    __device__ __forceinline__ void operator()(const f32x4 (&acc)[2][2][4][2], const Unit& u, int wr, int wc, int fr, int fq) const {
        const int row0 = u.pm * BM + wr * 64 + fr, col0 = (u.pn % tpg) * HALF + wc * 32 + 8 * fq;
#pragma unroll
        for (int ai = 0; ai < 2; ++ai)
#pragma unroll
            for (int m = 0; m < 4; ++m) { unsigned char* rowp = H + (size_t)(row0 + ai * HALF + m * 16) * ldh + col0;
                f32x4 h0, h1;
#pragma unroll
                for (int j = 0; j < 4; ++j) { const float g0 = acc[ai][0][m][0][j], g1 = acc[ai][0][m][1][j]; h0[j] = g0 * sigm(g0) * acc[ai][1][m][0][j]; h1[j] = g1 * sigm(g1) * acc[ai][1][m][1][j]; }
                int w0 = __builtin_amdgcn_cvt_pk_fp8_f32(h0[0], h0[1], 0, false); w0 = __builtin_amdgcn_cvt_pk_fp8_f32(h0[2], h0[3], w0, true);
                int w1 = __builtin_amdgcn_cvt_pk_fp8_f32(h1[0], h1[1], 0, false); w1 = __builtin_amdgcn_cvt_pk_fp8_f32(h1[2], h1[3], w1, true);
                typedef unsigned u32x2 __attribute__((ext_vector_type(2))); *(u32x2*)rowp = (u32x2){(unsigned)w0, (unsigned)w1}; }
    }
};
struct BranchOrder {
    int G, c;
    __device__ bool next(int i, Unit& u) const {
        const long L = (long)i * G + c; if (L >= 2560) return false;
        int w = (int)L; { const int xcd = w % NXCD, off = w / NXCD; w = xcd * 320 + off; }
        const int n = w / 512, rem = w % 512, gid = rem / 64, r2 = rem % 64;
        u.pm = n * 64 + gid * 8 + (r2 % 8); u.pn = n * 8 + r2 / 8; return true;
    }
    __device__ __forceinline__ void a_ready(const Unit&) const {}
    __device__ __forceinline__ void done(const Unit&) const {}
};
struct BranchOrder5 {
    int G, c;
    __device__ bool next(int i, Unit& u) const {
        const int tt = (i / 5) * G + c; if (tt >= 512) return false; const int n = i % 5;
        const int w = (tt % NXCD) * 64 + tt / NXCD, gid = w / 64, r2 = w % 64;
        u.pm = n * 64 + gid * 8 + (r2 % 8); u.pn = n * 8 + r2 / 8; return true;
    }
    __device__ __forceinline__ void a_ready(const Unit&) const {}
    __device__ __forceinline__ void done(const Unit&) const {}
};
struct GateOrder : StaticOrder {
    __device__ bool next(int i, Unit& u) const { if (!StaticOrder::next(i, u)) return false; u.pn += 33; return true; }
};
struct GateBatchOrder {
    int grp, base, n;
    __device__ bool next(int i, Unit& u) const { if (i >= n) return false; const int r = base + i; u.pm = grp * 8 + (r & 7); u.pn = 33 + (r >> 3); return true; }
    __device__ __forceinline__ void a_ready(const Unit&) const {}
    __device__ __forceinline__ void done(const Unit&) const {}
};
struct KvOrder {
    int c, c0;
    __device__ bool next(int i, Unit& u) const { const int w = c - c0; if (i != 0 || w < 0 || w >= 32) return false; u.pm = w >> 2; u.pn = (w >> 4) * 4 + (w & 3); return true; }
    __device__ __forceinline__ void a_ready(const Unit&) const {}
    __device__ __forceinline__ void done(const Unit&) const {}
};
struct MoeOrder {
    int G, c, tpe, total; const PG8_LAS int* tb;
    __device__ bool next(int i, Unit& u) const {
        const long L = (long)i * G + c; if (L >= total) return false;
        int w = (int)L; { const int q = total / NXCD, r = total % NXCD, xcd = w % NXCD, off = w / NXCD; w = (xcd < r ? xcd * (q + 1) : r * (q + 1) + (xcd - r) * q) + off; }
        int e = 0;
#pragma unroll
        for (int k = 1; k < 8; ++k) if (w >= tb[16 + k]) e = k;
        const int loc = w - tb[16 + e], nb = tb[e];
        u.pm = tb[8 + e] + loc % nb; u.pn = e * tpe + loc / nb; return true;
    }
    __device__ __forceinline__ void a_ready(const Unit&) const {}
    __device__ __forceinline__ void done(const Unit&) const {}
};
template <class Epi, class Sched, bool ALIGN_EPI = false, bool SP2 = false>
__device__ __forceinline__ void gemm_phase(PG8_LAS unsigned char* lds, const Gemm g, const Sched& S, const Epi& E) {
    int tid = pg8_tid(); asm volatile("" : "+v"(tid));
    const int wid = __builtin_amdgcn_readfirstlane(tid >> 6), lane = tid & 63, wr = wid >> 2, wc = wid & 3, fr = lane & 15, fq = lane >> 4;
    const int K = g.K, nt = K / BK;
    unsigned voffA[2], voffB[2];
#pragma unroll
    for (int i = 0; i < 2; ++i) { int R, C; stage_rc(tid * 16 + i * 8192, R, C); const int Rb = Epi::PERM ? ((R & ~31) + perm32(R & 31)) : R;
        voffA[i] = (unsigned)(R * K + C) * 2u; voffB[i] = (unsigned)(Rb * K + C) * 2u; }
    const size_t kstep = (size_t)(BK * 2);
    const size_t hstep = (size_t)HALF * K * 2;
    const size_t tstep = 2 * hstep;
    const unsigned ldsw = (unsigned)wid * 1024u;
    const int aoff = lds_byte(wr * 64 + fr, fq * 8), boff = lds_byte(wc * 32 + fr, fq * 8);
#define PG8_SA(b, h) (((b) * 2 + (h)) * HTB)
#define PG8_SB(b, h) ((4 + (b) * 2 + (h)) * HTB)
#define PG8_STAGE(bufoff, gbase, voff) do { _Pragma("unroll") for (int _i = 0; _i < 2; ++_i) \
        __builtin_amdgcn_global_load_lds((const unsigned*)((const char*)(gbase) + (voff)[_i]), (PG8_LAS unsigned*)(lds + (bufoff) + ldsw + _i * 8192), 16, 0, 0); } while (0)
#define PG8_LDA(dst, b, h) do { _Pragma("unroll") for (int m = 0; m < 4; ++m) _Pragma("unroll") for (int k = 0; k < 2; ++k) dst[m][k] = *(const PG8_LAS bf16x8*)(lds + PG8_SA(b, h) + aoff + m * 2048 + k * 1024); } while (0)
#define PG8_LDB(dst, b, h) do { _Pragma("unroll") for (int n = 0; n < 2; ++n) _Pragma("unroll") for (int k = 0; k < 2; ++k) dst[n][k] = *(const PG8_LAS bf16x8*)(lds + PG8_SB(b, h) + boff + n * 2048 + k * 1024); } while (0)
#define PG8_MMA(ai, bj, At, Bt) do { __builtin_amdgcn_s_setprio(1); _Pragma("unroll") for (int m = 0; m < 4; ++m) _Pragma("unroll") for (int n = 0; n < 2; ++n) _Pragma("unroll") for (int k = 0; k < 2; ++k) \
        acc[ai][bj][m][n] = __builtin_amdgcn_mfma_f32_16x16x32_bf16(Bt[n][k], At[m][k], acc[ai][bj][m][n], 0, 0, 0); __builtin_amdgcn_s_setprio(0); } while (0)
#define PG8_WAIT_V(n) asm volatile("s_waitcnt vmcnt(" #n ")" ::: "memory")
#define PG8_WAIT_L(n) asm volatile("s_waitcnt lgkmcnt(" #n ")" ::: "memory")
#define PG8_BAR __builtin_amdgcn_s_barrier()
#define PG8_SCHED __builtin_amdgcn_sched_barrier(0)
    Unit cur, nxt; int ui = 0;
    if (!S.next(0, cur)) return;
    f32x4 acc[2][2][4][2];
#pragma unroll
    for (int a = 0; a < 2; ++a)
#pragma unroll
        for (int b = 0; b < 2; ++b)
#pragma unroll
            for (int m = 0; m < 4; ++m)
#pragma unroll
                for (int n = 0; n < 2; ++n) acc[a][b][m][n] = (f32x4){0.f, 0.f, 0.f, 0.f};
    bf16x8 At[4][2], B0[2][2], B1[2][2];
    const char* cA = (const char*)g.A + (size_t)cur.pm * tstep; const char* cB = (const char*)g.Bt + (size_t)cur.pn * tstep;
    S.a_ready(cur);
    if constexpr (SP2) {
        PG8_STAGE(PG8_SB(0, 0), cB, voffB); PG8_STAGE(PG8_SB(0, 1), cB + hstep, voffB); PG8_STAGE(PG8_SA(0, 0), cA, voffA); PG8_STAGE(PG8_SA(0, 1), cA + hstep, voffA);
        if (wr == 1) PG8_BAR;
        PG8_WAIT_V(2); PG8_BAR;
        PG8_STAGE(PG8_SB(1, 0), cB + kstep, voffB); PG8_STAGE(PG8_SA(1, 0), cA + kstep, voffA); PG8_STAGE(PG8_SB(1, 1), cB + hstep + kstep, voffB);
        PG8_WAIT_V(6); PG8_BAR;
    } else {
        PG8_STAGE(PG8_SB(0, 0), cB, voffB); PG8_STAGE(PG8_SA(0, 0), cA, voffA); PG8_STAGE(PG8_SB(0, 1), cB + hstep, voffB); PG8_STAGE(PG8_SA(0, 1), cA + hstep, voffA);
        if (wr == 1) PG8_BAR;
        PG8_WAIT_V(4); PG8_BAR;
        PG8_STAGE(PG8_SB(1, 0), cB + kstep, voffB); PG8_STAGE(PG8_SA(1, 0), cA + kstep, voffA); PG8_STAGE(PG8_SB(1, 1), cB + hstep + kstep, voffB);
        PG8_WAIT_V(6); PG8_BAR;
    }
    for (;;) {
        const bool has_next = S.next(ui + 1, nxt);
        const char* nA = has_next ? (const char*)g.A + (size_t)nxt.pm * tstep : cA; const char* nB = has_next ? (const char*)g.Bt + (size_t)nxt.pn * tstep : cB;
        for (int t = 0; t < nt; t += 2) {
            const bool last = (t == nt - 2);
            const char* a1 = cA + (size_t)(t + 1) * kstep;
            const char* a2 = last ? nA : cA + (size_t)(t + 2) * kstep; const char* b2 = last ? nB : cB + (size_t)(t + 2) * kstep;
            const char* a3 = a2 + kstep; const char* b3 = b2 + kstep;
            if (last && has_next) S.a_ready(nxt);
            if constexpr (SP2) {
            PG8_LDB(B0, 0, 0); PG8_LDB(B1, 0, 1); PG8_SCHED; PG8_LDA(At, 0, 0); PG8_STAGE(PG8_SA(1, 1), a1 + hstep, voffA);
            PG8_WAIT_V(8); PG8_WAIT_L(0); PG8_BAR; PG8_MMA(0, 0, At, B0); PG8_MMA(0, 1, At, B1); PG8_BAR; PG8_SCHED;
            PG8_LDA(At, 0, 1); PG8_STAGE(PG8_SB(0, 0), b2, voffB); PG8_STAGE(PG8_SB(0, 1), b2 + hstep, voffB); PG8_STAGE(PG8_SA(0, 0), a2, voffA);
            PG8_WAIT_V(8); PG8_WAIT_L(0); PG8_BAR; PG8_MMA(1, 0, At, B0); PG8_MMA(1, 1, At, B1); PG8_BAR; PG8_SCHED;
            PG8_LDB(B0, 1, 0); PG8_LDB(B1, 1, 1); PG8_SCHED; PG8_LDA(At, 1, 0); PG8_STAGE(PG8_SA(0, 1), a2 + hstep, voffA);
            PG8_WAIT_V(8); PG8_WAIT_L(0); PG8_BAR; PG8_MMA(0, 0, At, B0); PG8_MMA(0, 1, At, B1); PG8_BAR; PG8_SCHED;
            PG8_LDA(At, 1, 1); PG8_STAGE(PG8_SB(1, 0), b3, voffB); PG8_STAGE(PG8_SB(1, 1), b3 + hstep, voffB); PG8_STAGE(PG8_SA(1, 0), a3, voffA);
            PG8_WAIT_V(8); PG8_WAIT_L(0); PG8_BAR; PG8_MMA(1, 0, At, B0); PG8_MMA(1, 1, At, B1); PG8_BAR; PG8_SCHED;
            } else {
            PG8_LDB(B0, 0, 0); PG8_SCHED; PG8_LDA(At, 0, 0); PG8_STAGE(PG8_SA(1, 1), a1 + hstep, voffA);
            PG8_WAIT_L(8); PG8_BAR; PG8_WAIT_L(0); PG8_MMA(0, 0, At, B0); PG8_BAR; PG8_SCHED;
            PG8_LDB(B1, 0, 1); PG8_STAGE(PG8_SB(0, 0), b2, voffB);
            PG8_BAR; PG8_WAIT_L(0); PG8_MMA(0, 1, At, B1); PG8_BAR;
            PG8_LDA(At, 0, 1); PG8_STAGE(PG8_SA(0, 0), a2, voffA);
            PG8_BAR; PG8_WAIT_L(0); PG8_MMA(1, 0, At, B0); PG8_BAR; PG8_SCHED;
            PG8_STAGE(PG8_SB(0, 1), b2 + hstep, voffB);
            PG8_WAIT_V(6); PG8_BAR; PG8_MMA(1, 1, At, B1); PG8_BAR;
            PG8_LDB(B0, 1, 0); PG8_SCHED; PG8_LDA(At, 1, 0); PG8_STAGE(PG8_SA(0, 1), a2 + hstep, voffA);
            PG8_WAIT_L(8); PG8_BAR; PG8_WAIT_L(0); PG8_MMA(0, 0, At, B0); PG8_BAR; PG8_SCHED;
            PG8_LDB(B1, 1, 1); PG8_STAGE(PG8_SB(1, 0), b3, voffB);
            PG8_BAR; PG8_WAIT_L(0); PG8_MMA(0, 1, At, B1); PG8_BAR;
            PG8_LDA(At, 1, 1); PG8_STAGE(PG8_SA(1, 0), a3, voffA);
            PG8_BAR; PG8_WAIT_L(0); PG8_MMA(1, 0, At, B0); PG8_BAR; PG8_SCHED;
            PG8_STAGE(PG8_SB(1, 1), b3 + hstep, voffB);
            PG8_WAIT_V(6); PG8_BAR; PG8_MMA(1, 1, At, B1); PG8_BAR;
            }
        }
        if constexpr (ALIGN_EPI) { if (wr == 0) PG8_BAR; }
        if constexpr (Epi::CARRY) { int fr_ = fr, fq_ = fq; asm volatile("" : "+v"(fr_), "+v"(fq_)); E.carry(acc, cur, wr, wc, fr_, fq_); S.done(cur); }
        else if constexpr (!Epi::AFTER_DRAIN) { E(acc, cur, wr, wc, fr, fq); S.done(cur); }
        if (!has_next) break;
        if constexpr (!Epi::CARRY)
#pragma unroll
        for (int a = 0; a < 2; ++a)
#pragma unroll
            for (int b = 0; b < 2; ++b)
#pragma unroll
                for (int m = 0; m < 4; ++m)
#pragma unroll
                    for (int n = 0; n < 2; ++n) acc[a][b][m][n] = (f32x4){0.f, 0.f, 0.f, 0.f};
        cur = nxt; cA = nA; cB = nB; ++ui;
        if constexpr (ALIGN_EPI) { if (wr == 1) PG8_BAR; }
    }
    PG8_WAIT_V(0);
    if constexpr (!ALIGN_EPI) { if (wr == 0) PG8_BAR; }
    PG8_BAR;
    if constexpr (Epi::AFTER_DRAIN) { E.fused(acc, cur, wr, wc, fr, fq, lds, wid, lane); S.done(cur); }
#undef PG8_SA
#undef PG8_SB
#undef PG8_STAGE
#undef PG8_LDA
#undef PG8_LDB
#undef PG8_MMA
#undef PG8_WAIT_V
#undef PG8_WAIT_L
#undef PG8_BAR
#undef PG8_SCHED
}
typedef int i32x8 __attribute__((ext_vector_type(8)));
typedef int i32x8a __attribute__((ext_vector_type(8), aligned(16)));
template <class Epi, class Sched, bool ALIGN_EPI = false, bool SP2 = true>
__device__ __forceinline__ void gemm_phase_f8(PG8_LAS unsigned char* lds, const Gemm g, const Sched& S, const Epi& E) {
    int tid = pg8_tid(); asm volatile("" : "+v"(tid));
    const int wid = __builtin_amdgcn_readfirstlane(tid >> 6), lane = tid & 63, wr = wid >> 2, wc = wid & 3, fr = lane & 15, fq = lane >> 4;
    const int K = g.K, nt = K / BK;
    unsigned voffA[2], voffB[2];
#pragma unroll
    for (int i = 0; i < 2; ++i) { int R, C; stage_rc(tid * 16 + i * 8192, R, C); const int Rb = Epi::PERM ? ((R & ~31) + perm32(R & 31)) : R;
        voffA[i] = (unsigned)(R * K + C) * 2u; voffB[i] = (unsigned)(Rb * K + C) * 2u; }
    const size_t kstep = (size_t)(BK * 2);
    const size_t hstep = (size_t)HALF * K * 2;
    const size_t tstep = 2 * hstep;
    const unsigned ldsw = (unsigned)wid * 1024u;
    const int aoff = lds_byte(wr * 64 + fr, fq * 8), boff = lds_byte(wc * 32 + fr, fq * 8);
#define PG8_SA(b, h) (((b) * 2 + (h)) * HTB)
#define PG8_SB(b, h) ((4 + (b) * 2 + (h)) * HTB)
#define PG8_STAGE(bufoff, gbase, voff) do { _Pragma("unroll") for (int _i = 0; _i < 2; ++_i) \
        __builtin_amdgcn_global_load_lds((const unsigned*)((const char*)(gbase) + (voff)[_i]), (PG8_LAS unsigned*)(lds + (bufoff) + ldsw + _i * 8192), 16, 0, 0); } while (0)
#define PG8_LDA(dst, b, h) do { _Pragma("unroll") for (int m = 0; m < 4; ++m) { const u32x4 lo_ = *(const PG8_LAS u32x4*)(lds + PG8_SA(b, h) + aoff + m * 2048), hi_ = *(const PG8_LAS u32x4*)(lds + PG8_SA(b, h) + aoff + m * 2048 + 1024); dst[m] = (i32x8){(int)lo_.x, (int)lo_.y, (int)lo_.z, (int)lo_.w, (int)hi_.x, (int)hi_.y, (int)hi_.z, (int)hi_.w}; } } while (0)
#define PG8_LDB(dst, b, h) do { _Pragma("unroll") for (int n = 0; n < 2; ++n) { const u32x4 lo_ = *(const PG8_LAS u32x4*)(lds + PG8_SB(b, h) + boff + n * 2048), hi_ = *(const PG8_LAS u32x4*)(lds + PG8_SB(b, h) + boff + n * 2048 + 1024); dst[n] = (i32x8){(int)lo_.x, (int)lo_.y, (int)lo_.z, (int)lo_.w, (int)hi_.x, (int)hi_.y, (int)hi_.z, (int)hi_.w}; } } while (0)
#define PG8_MMA(ai, bj, At, Bt) do { __builtin_amdgcn_s_setprio(1); _Pragma("unroll") for (int m = 0; m < 4; ++m) _Pragma("unroll") for (int n = 0; n < 2; ++n) \
        asm volatile("s_nop 1\n\tv_mfma_scale_f32_16x16x128_f8f6f4 %0, %1, %2, %0, %3, %4 op_sel_hi:[0,0,0]" : "+v"(acc[ai][bj][m][n]) : "v"(Bt[n]), "v"(At[m]), "v"(sc_w), "v"(sc_a)); __builtin_amdgcn_s_setprio(0); } while (0)
#define PG8_WAIT_V(n) asm volatile("s_waitcnt vmcnt(" #n ")" ::: "memory")
#define PG8_WAIT_L(n) asm volatile("s_waitcnt lgkmcnt(" #n ")" ::: "memory")
#define PG8_BAR __builtin_amdgcn_s_barrier()
#define PG8_SCHED __builtin_amdgcn_sched_barrier(0)
    Unit cur, nxt; int ui = 0;
    if (!S.next(0, cur)) return;
    f32x4 acc[2][2][4][2];
#pragma unroll
    for (int a = 0; a < 2; ++a)
#pragma unroll
        for (int b = 0; b < 2; ++b)
#pragma unroll
            for (int m = 0; m < 4; ++m)
#pragma unroll
                for (int n = 0; n < 2; ++n) acc[a][b][m][n] = (f32x4){0.f, 0.f, 0.f, 0.f};
    i32x8 At[4], B0[2], B1[2];
    int sc_w = 0x79797979, sc_a = 0x7F7F7F7F;
    asm volatile("" : "+v"(sc_w), "+v"(sc_a));
    const char* cA = (const char*)g.A + (size_t)cur.pm * tstep; const char* cB = (const char*)g.Bt + (size_t)cur.pn * tstep;
    S.a_ready(cur);
    if constexpr (SP2) {
        PG8_STAGE(PG8_SB(0, 0), cB, voffB); PG8_STAGE(PG8_SB(0, 1), cB + hstep, voffB); PG8_STAGE(PG8_SA(0, 0), cA, voffA); PG8_STAGE(PG8_SA(0, 1), cA + hstep, voffA);
        if (wr == 1) PG8_BAR;
        PG8_WAIT_V(2); PG8_BAR;
        PG8_STAGE(PG8_SB(1, 0), cB + kstep, voffB); PG8_STAGE(PG8_SA(1, 0), cA + kstep, voffA); PG8_STAGE(PG8_SB(1, 1), cB + hstep + kstep, voffB);
        PG8_WAIT_V(6); PG8_BAR;
    } else {
        PG8_STAGE(PG8_SB(0, 0), cB, voffB); PG8_STAGE(PG8_SA(0, 0), cA, voffA); PG8_STAGE(PG8_SB(0, 1), cB + hstep, voffB); PG8_STAGE(PG8_SA(0, 1), cA + hstep, voffA);
        if (wr == 1) PG8_BAR;
        PG8_WAIT_V(4); PG8_BAR;
        PG8_STAGE(PG8_SB(1, 0), cB + kstep, voffB); PG8_STAGE(PG8_SA(1, 0), cA + kstep, voffA); PG8_STAGE(PG8_SB(1, 1), cB + hstep + kstep, voffB);
        PG8_WAIT_V(6); PG8_BAR;
    }
    for (;;) {
        const bool has_next = S.next(ui + 1, nxt);
        const char* nA = has_next ? (const char*)g.A + (size_t)nxt.pm * tstep : cA; const char* nB = has_next ? (const char*)g.Bt + (size_t)nxt.pn * tstep : cB;
        for (int t = 0; t < nt; t += 2) {
            const bool last = (t == nt - 2);
            const char* a1 = cA + (size_t)(t + 1) * kstep;
            const char* a2 = last ? nA : cA + (size_t)(t + 2) * kstep; const char* b2 = last ? nB : cB + (size_t)(t + 2) * kstep;
            const char* a3 = a2 + kstep; const char* b3 = b2 + kstep;
            if (last && has_next) S.a_ready(nxt);
            if constexpr (SP2) {
            PG8_LDB(B0, 0, 0); PG8_LDB(B1, 0, 1); PG8_SCHED; PG8_LDA(At, 0, 0); PG8_STAGE(PG8_SA(1, 1), a1 + hstep, voffA);
            PG8_WAIT_V(8); PG8_WAIT_L(0); PG8_BAR; PG8_MMA(0, 0, At, B0); PG8_MMA(0, 1, At, B1); PG8_BAR; PG8_SCHED;
            PG8_LDA(At, 0, 1); PG8_STAGE(PG8_SB(0, 0), b2, voffB); PG8_STAGE(PG8_SB(0, 1), b2 + hstep, voffB); PG8_STAGE(PG8_SA(0, 0), a2, voffA);
            PG8_WAIT_V(8); PG8_WAIT_L(0); PG8_BAR; PG8_MMA(1, 0, At, B0); PG8_MMA(1, 1, At, B1); PG8_BAR; PG8_SCHED;
            PG8_LDB(B0, 1, 0); PG8_LDB(B1, 1, 1); PG8_SCHED; PG8_LDA(At, 1, 0); PG8_STAGE(PG8_SA(0, 1), a2 + hstep, voffA);
            PG8_WAIT_V(8); PG8_WAIT_L(0); PG8_BAR; PG8_MMA(0, 0, At, B0); PG8_MMA(0, 1, At, B1); PG8_BAR; PG8_SCHED;
            PG8_LDA(At, 1, 1); PG8_STAGE(PG8_SB(1, 0), b3, voffB); PG8_STAGE(PG8_SB(1, 1), b3 + hstep, voffB); PG8_STAGE(PG8_SA(1, 0), a3, voffA);
            PG8_WAIT_V(8); PG8_WAIT_L(0); PG8_BAR; PG8_MMA(1, 0, At, B0); PG8_MMA(1, 1, At, B1); PG8_BAR; PG8_SCHED;
            } else {
            PG8_LDB(B0, 0, 0); PG8_SCHED; PG8_LDA(At, 0, 0); PG8_STAGE(PG8_SA(1, 1), a1 + hstep, voffA);
            PG8_WAIT_L(8); PG8_BAR; PG8_WAIT_L(0); PG8_MMA(0, 0, At, B0); PG8_BAR; PG8_SCHED;
            PG8_LDB(B1, 0, 1); PG8_STAGE(PG8_SB(0, 0), b2, voffB);
            PG8_BAR; PG8_WAIT_L(0); PG8_MMA(0, 1, At, B1); PG8_BAR;
            PG8_LDA(At, 0, 1); PG8_STAGE(PG8_SA(0, 0), a2, voffA);
            PG8_BAR; PG8_WAIT_L(0); PG8_MMA(1, 0, At, B0); PG8_BAR; PG8_SCHED;
            PG8_STAGE(PG8_SB(0, 1), b2 + hstep, voffB);
            PG8_WAIT_V(6); PG8_BAR; PG8_MMA(1, 1, At, B1); PG8_BAR;
            PG8_LDB(B0, 1, 0); PG8_SCHED; PG8_LDA(At, 1, 0); PG8_STAGE(PG8_SA(0, 1), a2 + hstep, voffA);
            PG8_WAIT_L(8); PG8_BAR; PG8_WAIT_L(0); PG8_MMA(0, 0, At, B0); PG8_BAR; PG8_SCHED;
            PG8_LDB(B1, 1, 1); PG8_STAGE(PG8_SB(1, 0), b3, voffB);
            PG8_BAR; PG8_WAIT_L(0); PG8_MMA(0, 1, At, B1); PG8_BAR;
            PG8_LDA(At, 1, 1); PG8_STAGE(PG8_SA(1, 0), a3, voffA);
            PG8_BAR; PG8_WAIT_L(0); PG8_MMA(1, 0, At, B0); PG8_BAR; PG8_SCHED;
            PG8_STAGE(PG8_SB(1, 1), b3 + hstep, voffB);
            PG8_WAIT_V(6); PG8_BAR; PG8_MMA(1, 1, At, B1); PG8_BAR;
            }
        }
        if constexpr (ALIGN_EPI) { if (wr == 0) PG8_BAR; }
#pragma unroll
        for (int a_ = 0; a_ < 2; ++a_)
#pragma unroll
            for (int b_ = 0; b_ < 2; ++b_) asm volatile("s_nop 15\n\ts_nop 15" : "+v"(acc[a_][b_][0][0]), "+v"(acc[a_][b_][0][1]), "+v"(acc[a_][b_][1][0]), "+v"(acc[a_][b_][1][1]), "+v"(acc[a_][b_][2][0]), "+v"(acc[a_][b_][2][1]), "+v"(acc[a_][b_][3][0]), "+v"(acc[a_][b_][3][1]));
        if constexpr (!Epi::AFTER_DRAIN) { int fr_ = fr, fq_ = fq; asm volatile("" : "+v"(fr_), "+v"(fq_));
            E(acc, cur, wr, wc, fr_, fq_); S.done(cur); }
        if (!has_next) break;
#pragma unroll
        for (int a = 0; a < 2; ++a)
#pragma unroll
            for (int b = 0; b < 2; ++b)
#pragma unroll
                for (int m = 0; m < 4; ++m)
#pragma unroll
                    for (int n = 0; n < 2; ++n) acc[a][b][m][n] = (f32x4){0.f, 0.f, 0.f, 0.f};
        cur = nxt; cA = nA; cB = nB; ++ui;
        if constexpr (ALIGN_EPI) { if (wr == 1) PG8_BAR; }
    }
    PG8_WAIT_V(0);
    if constexpr (!ALIGN_EPI) { if (wr == 0) PG8_BAR; }
    PG8_BAR;
    if constexpr (Epi::AFTER_DRAIN) { E.fused(acc, cur, wr, wc, fr, fq, lds, wid, lane); S.done(cur); }
#undef PG8_SA
#undef PG8_SB
#undef PG8_STAGE
#undef PG8_LDA
#undef PG8_LDB
#undef PG8_MMA
#undef PG8_WAIT_V
#undef PG8_WAIT_L
#undef PG8_BAR
#undef PG8_SCHED
}
}
constexpr int NT = 16384, DM = 2048, SEQ = 4096, NBATCH = 4, NLAYER = 2;
constexpr int LDP = 8448, NGATE = 10240, NIN = 18688, PIN = 18480;
constexpr int C_NAQ = 0, C_NAK = 512, C_NAV = 1024, C_GLQ = 1536, C_GLK = 1792, C_GLV = 2048, C_GLLR = 2560, C_GLOG = 2592, C_GDQKV = 3104, C_GDA = 4640, C_GDB = 4648,
              C_GDOG = 4656, C_HGQ = 5168, C_HGF = 5680, C_HGI = 6704, C_HGOG = 7216, C_MQ = 7728, C_PEND = 8240;
constexpr int DFF = 5632, DFFE = 7168, NEXP = 8, MAXSLOT = 34816;
constexpr float RMS_EPS = 1e-6f;
constexpr size_t MiB = 1u << 20;
constexpr size_t WS_CTL = 0, CTL_ZERO_BYTES = 1 * MiB;
constexpr size_t WS_ROUTE = 1 * MiB;
constexpr size_t WS_MK = 2 * MiB;
constexpr size_t WS_MVT = 4 * MiB;
constexpr size_t WS_KVRAW = 6 * MiB;
constexpr size_t WS_MEMN = 14 * MiB;
constexpr size_t WS_WIN = 24 * MiB;
constexpr size_t WS_WBR = WS_WIN + 146 * MiB;
constexpr size_t WS_WOUT = WS_WBR + 20 * MiB;
constexpr size_t WS_WMKV = WS_WOUT + 16 * MiB;
constexpr size_t WS_WGU = WS_WMKV + 8 * MiB;
constexpr size_t WS_WDN = WS_WGU + 44 * MiB;
constexpr size_t WS_MOE1 = WS_WDN + 22 * MiB;
constexpr size_t WS_MOE2 = WS_MOE1 + 448 * MiB;
constexpr size_t WS_OA = WS_MOE1 + 224 * MiB, WS_MOE2F = WS_MOE2 + 112 * MiB;
constexpr size_t WS_HM = WS_MOE2 + 224 * MiB;
constexpr size_t WS_P = WS_HM + 64 * MiB;
constexpr size_t WS_G = WS_P + 264 * MiB;
constexpr size_t WS_GLG = WS_G + 320 * MiB;
constexpr size_t WS_GQ = WS_GLG + 32 * MiB;
constexpr size_t WS_GAB = WS_GQ + 48 * MiB;
constexpr size_t WS_HQ = WS_GAB + 1 * MiB;
constexpr size_t WS_HF = WS_HQ + 16 * MiB;
constexpr size_t WS_NAVT = WS_HF + 64 * MiB;
constexpr size_t WS_SOUT = WS_NAVT + 16 * MiB;
constexpr size_t WS_BR = WS_SOUT + 96 * MiB;
constexpr size_t WS_H8 = WS_BR + 80 * MiB;
constexpr size_t WS_END = WS_H8 + 32 * MiB;
constexpr size_t WS_HID = WS_P;
constexpr size_t WS_XB = WS_P;
constexpr size_t WS_HIDM = WS_XB + 136 * MiB;
constexpr size_t WS_YB = WS_HIDM + 476 * MiB;
static_assert(WS_YB + 272 * MiB <= WS_END, "MoE overlay fits");
static_assert(WS_END <= 2085645600ull, "workspace map fits sum(inputs)");
constexpr int CW_TMO = 0, CW_CODE = 1, CW_BAR = 4096, CW_WQ = 8192, CW_CNT = 8192 + 1024, CW_CONVQ = 8192 + 2048, CW_S2DONE = 8192 + 2048 + 64, CW_GQ = 16384;
constexpr int RING_OFF = 0, RING_BYTES = 131072, LDSCTL_OFF = RING_BYTES, MISC_OFF = LDSCTL_OFF + 320, TAB_OFF = LDSCTL_OFF + 512, LDS_BYTES = 147456;
constexpr int NWAVES = 8;
#ifndef MK_SPLIT
#define MK_SPLIT 0
#endif
#define GAS __attribute__((address_space(1)))
#define LAS __attribute__((address_space(3)))
typedef unsigned short bf16;
typedef unsigned v4u __attribute__((ext_vector_type(4)));
typedef float f32x4 __attribute__((ext_vector_type(4)));
typedef short bf16x8 __attribute__((ext_vector_type(8)));
typedef GAS unsigned gu32;
typedef GAS unsigned long long gu64;
#define RLX_AGENT __ATOMIC_RELAXED, __HIP_MEMORY_SCOPE_AGENT
#define LDS_WAIT() asm volatile("s_waitcnt lgkmcnt(0)" ::: "memory")
#define VM_WAIT() asm volatile("s_waitcnt vmcnt(0)" ::: "memory")
__device__ __forceinline__ unsigned long long rt() { return __builtin_amdgcn_s_memrealtime(); }
__device__ __forceinline__ unsigned f2bf(float f) { unsigned u = __builtin_bit_cast(unsigned, f); return (u + 0x7fffu + ((u >> 16) & 1u)) >> 16; }
__device__ __forceinline__ unsigned pk2(float lo, float hi) { return f2bf(lo) | (f2bf(hi) << 16); }
constexpr int WAVETAB_OFF = 131072 + 1024;
__device__ __forceinline__ unsigned hw_slot() { return (unsigned)__builtin_amdgcn_s_getreg((5 << 11) | 4) & 63u; }
__device__ __forceinline__ int mk_lane() { return (int)__builtin_amdgcn_mbcnt_hi(~0u, __builtin_amdgcn_mbcnt_lo(~0u, 0u)); }
__device__ __forceinline__ int mk_wave() { extern __shared__ __attribute__((aligned(16))) unsigned char lds_raw_[]; const volatile LAS int* tab = (const volatile LAS int*)((LAS unsigned char*)lds_raw_ + WAVETAB_OFF); return __builtin_amdgcn_readfirstlane(tab[hw_slot()]); }
__device__ __forceinline__ int mk_tid() { return mk_wave() * 64 + mk_lane(); }
__device__ __forceinline__ int pg8_tid() { return mk_tid(); }
#define XB_TMO      128
#define XB_XCNT(j)  (256  + 64 * (j))
#define XB_XSUB(j)  (1280 + 64 * (j))
#define XB_XGEN(j)  (2304 + 64 * (j))
#define XB_TOP      3328
#define XB_TOPGEN   3392
#define XCD_BAR_WORDS 3456
#define XB_SPIN_CAP (1u << 22)

__device__ __forceinline__ unsigned xb_ld(unsigned* p)              { return __hip_atomic_load(p, __ATOMIC_RELAXED, __HIP_MEMORY_SCOPE_AGENT); }
__device__ __forceinline__ unsigned xb_add(unsigned* p, unsigned v) { return __hip_atomic_fetch_add(p, v, __ATOMIC_RELAXED, __HIP_MEMORY_SCOPE_AGENT); }
__device__ __forceinline__ unsigned xb_xcc_id() { return (unsigned)__builtin_amdgcn_s_getreg((3 << 11) | 20) & 0xFu; }
#define XB_SPIN(cond, bar) do { unsigned _sp = 0; while (cond) { __builtin_amdgcn_s_sleep(1); \
    if ((++_sp & 255u) == 0u) { if (xb_ld(&(bar)[XB_TMO])) break; if (_sp > XB_SPIN_CAP) { atomicAdd(&(bar)[XB_TMO], 1u); break; } } } } while (0)

struct XcdBarrier {
    unsigned* bar; unsigned x;
    volatile LAS unsigned* st;
};

__device__ __forceinline__ XcdBarrier xcd_barrier_post(unsigned* bar, volatile LAS unsigned* st) {
    XcdBarrier b; b.bar = bar; b.x = xb_xcc_id(); b.st = st;
    if (mk_tid() == 0) (void)xb_add(&bar[XB_XCNT(b.x)], 1u);
    return b;
}
__device__ __forceinline__ void xcd_barrier_complete(unsigned* bar, unsigned x, unsigned& nloc, unsigned& nx) {
    const unsigned G = gridDim.x * gridDim.y * gridDim.z;
    unsigned sum, cnt, mine, sp = 0u;
    for (;;) {
        sum = 0u; cnt = 0u; mine = 0u;
#pragma unroll
        for (unsigned j = 0; j < 16; ++j) { const unsigned c = xb_ld(&bar[XB_XCNT(j)]); sum += c; cnt += (c > 0u) ? 1u : 0u; mine = (j == x) ? c : mine; }
        if (sum == G) break;
        __builtin_amdgcn_s_sleep(1);
        if ((++sp & 255u) == 0u) { if (xb_ld(&bar[XB_TMO])) break; if (sp > XB_SPIN_CAP) { atomicAdd(&bar[XB_TMO], 1u); break; } }
    }
    nloc = mine > 0u ? mine : 1u; nx = cnt > 0u ? cnt : 1u;
}

__device__ __forceinline__ void xcd_barrier(const XcdBarrier& b) {
    asm volatile("s_waitcnt vmcnt(0)" ::: "memory");
    __syncthreads();
    if (mk_tid() == 0) {
        unsigned* bar = b.bar;
        __builtin_amdgcn_s_waitcnt(0);
        unsigned nloc = b.st[0], nx = b.st[1];
        if (nloc == 0u) { xcd_barrier_complete(bar, b.x, nloc, nx); b.st[0] = nloc; b.st[1] = nx; }
        const unsigned old = xb_add(&bar[XB_XSUB(b.x)], 1u);
        const unsigned gen = old / nloc;
        if (old + 1u == (gen + 1u) * nloc) {
            __builtin_amdgcn_fence(__ATOMIC_RELEASE, "agent");
            asm volatile("s_waitcnt vmcnt(0)" ::: "memory");
            const unsigned og = xb_add(&bar[XB_TOP], 1u);
            const unsigned tg = og / nx;
            if (og + 1u == (tg + 1u) * nx) xb_add(&bar[XB_TOPGEN], 1u);
            else XB_SPIN(xb_ld(&bar[XB_TOPGEN]) == tg, bar);
            __builtin_amdgcn_fence(__ATOMIC_ACQUIRE, "agent");
            xb_add(&bar[XB_XGEN(b.x)], 1u);
            asm volatile("s_waitcnt vmcnt(0)" ::: "memory");
        } else {
            XB_SPIN(xb_ld(&bar[XB_XGEN(b.x)]) == gen, bar);
            __builtin_amdgcn_fence(__ATOMIC_ACQUIRE, "agent");
            asm volatile("s_waitcnt vmcnt(0)" ::: "memory");
        }
    }
    __syncthreads();
}
typedef unsigned v2u __attribute__((ext_vector_type(2)));
typedef float f32x2v __attribute__((ext_vector_type(2)));
__device__ __forceinline__ float bflo(unsigned w) { return __uint_as_float(w << 16); }
__device__ __forceinline__ float bfhi(unsigned w) { return __uint_as_float(w & 0xffff0000u); }
__device__ __forceinline__ float bf1(bf16 h) { return __uint_as_float(((unsigned)h) << 16); }
typedef __bf16 bf16x2_t __attribute__((ext_vector_type(2)));
__device__ __forceinline__ unsigned pkbf(float lo, float hi) { const f32x2v v = {lo, hi}; return __builtin_bit_cast(unsigned, __builtin_convertvector(v, bf16x2_t)); }
__device__ __forceinline__ void unpack8(const v4u w, float (&f)[8]) { f[0] = bflo(w.x); f[1] = bfhi(w.x); f[2] = bflo(w.y); f[3] = bfhi(w.y); f[4] = bflo(w.z); f[5] = bfhi(w.z); f[6] = bflo(w.w); f[7] = bfhi(w.w); }
__device__ __forceinline__ v4u pack8(const float (&f)[8]) { v4u w; w.x = pkbf(f[0], f[1]); w.y = pkbf(f[2], f[3]); w.z = pkbf(f[4], f[5]); w.w = pkbf(f[6], f[7]); return w; }
__device__ __forceinline__ float sigmf(float x) { return __builtin_amdgcn_rcpf(1.0f + __expf(-x)); }
__device__ __forceinline__ float siluf(float x) { return x * __builtin_amdgcn_rcpf(1.0f + __expf(-x)); }
__device__ __forceinline__ float softplusf(float x) { return fmaxf(x, 0.f) + __logf(1.0f + __expf(-fabsf(x))); }
#define DPP_ADD(v, ctrl) ((v) + __int_as_float(__builtin_amdgcn_update_dpp(0, __float_as_int(v), (ctrl), 0xF, 0xF, true)))
__device__ __forceinline__ float row16_sum(float v) { v = DPP_ADD(v, 0xB1); v = DPP_ADD(v, 0x4E); v = DPP_ADD(v, 0x141); v = DPP_ADD(v, 0x140); return v; }
__device__ __forceinline__ float wave_sum(float v) { v = row16_sum(v); v += __shfl_xor(v, 16); v += __shfl_xor(v, 32); return v; }
template <int N> __device__ __forceinline__ float group_sum(float v) {
    v = DPP_ADD(v, 0xB1); v = DPP_ADD(v, 0x4E); v = DPP_ADD(v, 0x141); if (N == 16) v = DPP_ADD(v, 0x140);
    return v;
}
template <int KL> __device__ __forceinline__ float kl_sum(float v) {
    v = DPP_ADD(v, 0xB1); v = DPP_ADD(v, 0x4E); v = DPP_ADD(v, 0x141);
    if (KL == 16) v = DPP_ADD(v, 0x140);
    return v;
}
__device__ __forceinline__ unsigned pk4_f8(float a, float b, float c, float d);
__device__ __forceinline__ void rms_row(const float* xrow, const float* gain, bf16* orow, int lane, f32x4 (&v)[8], unsigned char* o8row = nullptr) {
    const f32x4* xr = (const f32x4*)xrow + lane; float s = 0.f;
#pragma unroll
    for (int j = 0; j < 8; ++j) { v[j] = xr[64 * j]; s += (v[j].x * v[j].x + v[j].y * v[j].y) + (v[j].z * v[j].z + v[j].w * v[j].w); }
    const float sc = rsqrtf(wave_sum(s) * (1.0f / DM) + RMS_EPS);
    const f32x4* gr = (const f32x4*)gain + lane; v2u* o8 = (v2u*)orow + lane;
#pragma unroll
    for (int j = 0; j < 8; ++j) { v[j] = v[j] * sc * gr[64 * j]; v2u w; w.x = pkbf(v[j].x, v[j].y); w.y = pkbf(v[j].z, v[j].w); o8[64 * j] = w;
        if (o8row) ((unsigned*)o8row)[lane + 64 * j] = pk4_f8(v[j].x, v[j].y, v[j].z, v[j].w); }
}
__device__ __forceinline__ void rms_load(const float* xrow, int lane, f32x4 (&v)[8]) { const f32x4* xr = (const f32x4*)xrow + lane;
#pragma unroll
    for (int j = 0; j < 8; ++j) v[j] = xr[64 * j]; }
__device__ __forceinline__ void rms_finish(f32x4 (&v)[8], const float* gain, bf16* orow, int lane, unsigned char* o8row) {
    float s = 0.f;
#pragma unroll
    for (int j = 0; j < 8; ++j) s += (v[j].x * v[j].x + v[j].y * v[j].y) + (v[j].z * v[j].z + v[j].w * v[j].w);
    const float sc = rsqrtf(wave_sum(s) * (1.0f / DM) + RMS_EPS);
    const f32x4* gr = (const f32x4*)gain + lane; v2u* o8 = (v2u*)orow + lane;
#pragma unroll
    for (int j = 0; j < 8; ++j) { const f32x4 y = v[j] * sc * gr[64 * j]; v2u w; w.x = pkbf(y.x, y.y); w.y = pkbf(y.z, y.w); o8[64 * j] = w;
        if (o8row) ((unsigned*)o8row)[lane + 64 * j] = pk4_f8(y.x, y.y, y.z, y.w); }
}
__device__ __forceinline__ void rms_tokens(const float* x, const float* gain, bf16* HM, unsigned char* H8, int t0, int step, int lane) {
    f32x4 va[8], vb[8]; int t = t0;
    if (t < NT) rms_load(x + (size_t)t * DM, lane, va);
#pragma unroll 1
    for (; t < NT; t += 2 * step) { const int t2 = t + step, t3 = t2 + step;
        if (t2 < NT) rms_load(x + (size_t)t2 * DM, lane, vb);
        rms_finish(va, gain, HM + (size_t)t * DM, lane, H8 ? H8 + (size_t)t * DM : nullptr);
        if (t3 < NT) rms_load(x + (size_t)t3 * DM, lane, va);
        if (t2 < NT) rms_finish(vb, gain, HM + (size_t)t2 * DM, lane, H8 ? H8 + (size_t)t2 * DM : nullptr);
    }
}
__device__ __forceinline__ unsigned pk4_f8(float a, float b, float c, float d);
__device__ __forceinline__ void rms_row_f8(const float* xrow, const float* gain, unsigned char* orow, int lane, f32x4 (&v)[8]) {
    const f32x4* xr = (const f32x4*)xrow + lane; float s = 0.f;
#pragma unroll
    for (int j = 0; j < 8; ++j) { v[j] = xr[64 * j]; s += (v[j].x * v[j].x + v[j].y * v[j].y) + (v[j].z * v[j].z + v[j].w * v[j].w); }
    const float sc = rsqrtf(wave_sum(s) * (1.0f / DM) + RMS_EPS);
    const f32x4* gr = (const f32x4*)gain + lane; unsigned* o4 = (unsigned*)orow + lane;
#pragma unroll
    for (int j = 0; j < 8; ++j) { v[j] = v[j] * sc * gr[64 * j]; o4[64 * j] = pk4_f8(v[j].x, v[j].y, v[j].z, v[j].w); }
}
__device__ __forceinline__ unsigned pk4_f8(float a, float b, float c, float d) { int w = __builtin_amdgcn_cvt_pk_fp8_f32(a, b, 0, false); w = __builtin_amdgcn_cvt_pk_fp8_f32(c, d, w, true); return (unsigned)w; }
struct RmOff { int off; __device__ __forceinline__ int operator()(int n) const { return n + off; } };
struct RmWin { __device__ __forceinline__ int operator()(int n) const { return n < C_PEND ? n : n + (LDP - C_PEND); } };
struct RmGU { int up; __device__ __forceinline__ int operator()(int n) const { return (n >> 7) * 256 + (n & 127) + up * 128; } };
__device__ __forceinline__ void tr_load(float (&v)[64], const float* W, int ldw, int N, int nblk, int it, int lane) {
    const int kb = it / nblk, nb = it % nblk; const int n = 64 * nb + lane; const bool ok = n < N; const float* p = W + (size_t)(64 * kb) * ldw + (ok ? n : 0);
#pragma unroll
    for (int kk = 0; kk < 64; ++kk) v[kk] = p[(size_t)kk * ldw];
    if (!ok) {
#pragma unroll
        for (int kk = 0; kk < 64; ++kk) v[kk] = 0.f; }
}
template <class RowMap> __device__ __forceinline__ void tr_store(const float (&v)[64], int K, int N, int nblk, int it, bf16* WT, LAS unsigned* scr, int lane, const RowMap& rm) {
    const int kb = it / nblk, nb = it % nblk;
#pragma unroll
    for (int kp = 0; kp < 32; ++kp) scr[lane * 33 + kp] = pkbf(v[2 * kp], v[2 * kp + 1]);
    LDS_WAIT(); asm volatile("" ::: "memory");
    const int c = lane & 7;
#pragma unroll
    for (int j = 0; j < 8; ++j) { const int nl = (lane >> 3) + 8 * j; const LAS unsigned* s = scr + nl * 33 + 4 * c; v4u o; o.x = s[0]; o.y = s[1]; o.z = s[2]; o.w = s[3];
        const int n = 64 * nb + nl; if (n < N) *(GAS v4u*)(WT + (size_t)rm(n) * K + 64 * kb + 8 * c) = o; }
    LDS_WAIT(); asm volatile("" ::: "memory");
}
template <class RowMap> __device__ __forceinline__ void transpose_job(const float* W, int K, int N, bf16* WT, LAS float* scr_f, int gw, int NGW, int lane, const RowMap& rm, int ldw = 0) {
    if (!ldw) ldw = N;
    LAS unsigned* scr = (LAS unsigned*)scr_f; const int nblk = (N + 63) / 64, nit = (K / 64) * nblk;
    float va[64], vb[64]; int it = gw;
    if (it < nit) tr_load(va, W, ldw, N, nblk, it, lane);
#pragma unroll 1
    for (; it < nit; it += 2 * NGW) { const int it2 = it + NGW, it3 = it2 + NGW;
        if (it2 < nit) tr_load(vb, W, ldw, N, nblk, it2, lane);
        tr_store(va, K, N, nblk, it, WT, scr, lane, rm);
        if (it3 < nit) tr_load(va, W, ldw, N, nblk, it3, lane);
        if (it2 < nit) tr_store(vb, K, N, nblk, it2, WT, scr, lane, rm);
    }
}
template <class RowMap> __device__ __forceinline__ void tr_store_f8(const float (&v)[64], float scale, int K, int N, int nblk, int it, unsigned char* WT, LAS unsigned* scr, int lane, const RowMap& rm) {
    const int kb = it / nblk, nb = it % nblk;
#pragma unroll
    for (int q = 0; q < 16; ++q) scr[lane * 17 + q] = pk4_f8(v[4 * q] * scale, v[4 * q + 1] * scale, v[4 * q + 2] * scale, v[4 * q + 3] * scale);
    LDS_WAIT(); asm volatile("" ::: "memory");
    const int c = lane & 3;
#pragma unroll
    for (int j = 0; j < 4; ++j) { const int nl = (lane >> 2) + 16 * j; const LAS unsigned* s = scr + nl * 17 + 4 * c; v4u o; o.x = s[0]; o.y = s[1]; o.z = s[2]; o.w = s[3];
        const int n = 64 * nb + nl; if (n < N) *(GAS v4u*)(WT + (size_t)rm(n) * K + 64 * kb + 16 * c) = o; }
    LDS_WAIT(); asm volatile("" ::: "memory");
}
template <class RowMap> __device__ __forceinline__ void transpose_job_f8(const float* W, float scale, int K, int N, unsigned char* WT, LAS float* scr_f, int gw, int NGW, int lane, const RowMap& rm, int ldw = 0) {
    if (!ldw) ldw = N;
    LAS unsigned* scr = (LAS unsigned*)scr_f; const int nblk = (N + 63) / 64, nit = (K / 64) * nblk;
    float va[64], vb[64]; int it = gw;
    if (it < nit) tr_load(va, W, ldw, N, nblk, it, lane);
#pragma unroll 1
    for (; it < nit; it += 2 * NGW) { const int it2 = it + NGW, it3 = it2 + NGW;
        if (it2 < nit) tr_load(vb, W, ldw, N, nblk, it2, lane);
        tr_store_f8(va, scale, K, N, nblk, it, WT, scr, lane, rm);
        if (it3 < nit) tr_load(va, W, ldw, N, nblk, it3, lane);
        if (it2 < nit) tr_store_f8(vb, scale, K, N, nblk, it2, WT, scr, lane, rm);
    }
}
__device__ __forceinline__ void moe1_convert_all(const float* wg, const float* wu, unsigned char* MOE1, LAS float* scr_f, int gw, int NGW, int lane) {
    LAS unsigned* scr = (LAS unsigned*)scr_f; constexpr int NB = DFFE / 64, TPJ = (DM / 64) * NB, NIT = 16 * TPJ;
    float va[64], vb[64]; int it = gw;
#define M1_SRC(t) (((((t) / TPJ) & 1) ? wu : wg) + (size_t)(((t) / TPJ) >> 1) * DM * DFFE)
#define M1_DST(t) (MOE1 + (size_t)(((t) / TPJ) >> 1) * 2 * DFFE * DM)
    if (it < NIT) tr_load(va, M1_SRC(it), DFFE, DFFE, NB, it % TPJ, lane);
#pragma unroll 1
    for (; it < NIT; it += 2 * NGW) { const int it2 = it + NGW, it3 = it2 + NGW;
        if (it2 < NIT) tr_load(vb, M1_SRC(it2), DFFE, DFFE, NB, it2 % TPJ, lane);
        tr_store_f8(va, 64.0f, DM, DFFE, NB, it % TPJ, M1_DST(it), scr, lane, RmGU{(it / TPJ) & 1});
        if (it3 < NIT) tr_load(va, M1_SRC(it3), DFFE, DFFE, NB, it3 % TPJ, lane);
        if (it2 < NIT) tr_store_f8(vb, 64.0f, DM, DFFE, NB, it2 % TPJ, M1_DST(it2), scr, lane, RmGU{(it2 / TPJ) & 1});
    }
#undef M1_SRC
#undef M1_DST
}
struct RmGen { int kind, off; __device__ __forceinline__ int operator()(int n) const { return kind ? (n >> 7) * 256 + (n & 127) + off * 128 : n + off; } };
struct P0Job { const float* W; int ldw, N, K, nblk, loc, f8; unsigned char* WT; RmGen rm; };
__device__ __forceinline__ P0Job p0_job(int t, const float* w_in, const float* w_br, const float* w_out, const float* w_kv, const float* f_gate, const float* f_up, const float* f_down, unsigned char* ws) {
    P0Job j; j.f8 = 0; j.rm = RmGen{0, 0};
    constexpr int T_P = 32 * 129, T_G = 32 * 160, T_B = 8 * 32, T_O = 32 * 32, T_K = 32 * 16, T_L = T_P + T_G + 5 * T_B + T_O + T_K, T_D = 32 * 88;
    if (t < 2 * T_L) { const int L = t / T_L; int r = t % T_L;
        if (r < T_P) { j.W = w_in + (size_t)L * DM * PIN; j.ldw = PIN; j.N = C_PEND; j.K = DM; j.nblk = 129; j.loc = r; j.WT = ws + WS_WIN + (size_t)L * NIN * DM * 2; return j; } r -= T_P;
        if (r < T_G) { j.W = w_in + (size_t)L * DM * PIN + C_PEND; j.ldw = PIN; j.N = NGATE; j.K = DM; j.nblk = 160; j.loc = r; j.f8 = 1; j.WT = ws + WS_WIN + ((size_t)L * NIN + LDP) * DM * 2; return j; } r -= T_G;
        if (r < 5 * T_B) { const int n = r / T_B; j.W = w_br + (size_t)(L * 5 + n) * 512 * DM; j.ldw = DM; j.N = DM; j.K = 512; j.nblk = 32; j.loc = r % T_B; j.WT = ws + WS_WBR + (size_t)(L * 5 + n) * DM * 512 * 2; return j; } r -= 5 * T_B;
        if (r < T_O) { j.W = w_out + (size_t)L * DM * DM; j.ldw = DM; j.N = DM; j.K = DM; j.nblk = 32; j.loc = r; j.WT = ws + WS_WOUT + (size_t)L * DM * DM * 2; return j; } r -= T_O;
        j.W = w_kv + (size_t)L * DM * 1024; j.ldw = 1024; j.N = 1024; j.K = DM; j.nblk = 16; j.loc = r; j.WT = ws + WS_WMKV + (size_t)L * 1024 * DM * 2; return j; }
    int r = t - 2 * T_L;
    if (r < 2 * T_D) { const int up = r / T_D; j.W = up ? f_up : f_gate; j.ldw = DFF; j.N = DFF; j.K = DM; j.nblk = 88; j.loc = r % T_D; j.WT = ws + WS_WGU; j.rm = RmGen{1, up}; return j; } r -= 2 * T_D;
    j.W = f_down; j.ldw = DM; j.N = DM; j.K = DFF; j.nblk = 32; j.loc = r; j.WT = ws + WS_WDN; return j;
}
constexpr int P0_TILES = 2 * (32 * 129 + 32 * 160 + 5 * 8 * 32 + 32 * 32 + 32 * 16) + 3 * 32 * 88;
__device__ __forceinline__ void p0_store(const float (&v)[64], const P0Job& j, LAS unsigned* scr, int lane) {
    if (j.f8) tr_store_f8(v, 64.0f, j.K, j.N, j.nblk, j.loc, j.WT, scr, lane, j.rm); else tr_store(v, j.K, j.N, j.nblk, j.loc, (bf16*)j.WT, scr, lane, j.rm);
}
__device__ __forceinline__ void phase0_convert_all(const float* w_in, const float* w_br, const float* w_out, const float* w_kv, const float* f_gate, const float* f_up, const float* f_down, unsigned char* ws, LAS float* scr_f, int gw, int NGW, int lane) {
    LAS unsigned* scr = (LAS unsigned*)scr_f; float va[64], vb[64]; int it = gw;
    P0Job ja = p0_job(it < P0_TILES ? it : 0, w_in, w_br, w_out, w_kv, f_gate, f_up, f_down, ws), jb = ja;
    if (it < P0_TILES) tr_load(va, ja.W, ja.ldw, ja.N, ja.nblk, ja.loc, lane);
#pragma unroll 1
    for (; it < P0_TILES; it += 2 * NGW) { const int it2 = it + NGW, it3 = it2 + NGW;
        if (it2 < P0_TILES) { jb = p0_job(it2, w_in, w_br, w_out, w_kv, f_gate, f_up, f_down, ws); tr_load(vb, jb.W, jb.ldw, jb.N, jb.nblk, jb.loc, lane); }
        p0_store(va, ja, scr, lane);
        if (it3 < P0_TILES) { ja = p0_job(it3, w_in, w_br, w_out, w_kv, f_gate, f_up, f_down, ws); tr_load(va, ja.W, ja.ldw, ja.N, ja.nblk, ja.loc, lane); }
        if (it2 < P0_TILES) p0_store(vb, jb, scr, lane);
    }
}
constexpr int MQ_GU = 16 * 32 * 112, MQ_TILES = MQ_GU + 2 * 112 * 32, MQ_GRAB = 16;
__device__ __forceinline__ P0Job moe_job(int t, const float* wg, const float* wu, const float* wd, unsigned char* ws) {
    P0Job j; j.f8 = 1; constexpr int TPJ = 32 * 112;
    if (t < MQ_GU) { const int jb = t / TPJ, e = jb >> 1, up = jb & 1; j.W = (up ? wu : wg) + (size_t)e * DM * DFFE; j.ldw = DFFE; j.N = DFFE; j.K = DM; j.nblk = 112; j.loc = t % TPJ; j.WT = ws + WS_MOE1 + (size_t)e * 2 * DFFE * DM; j.rm = RmGen{1, up}; return j; }
    const int r = t - MQ_GU, e = 6 + r / TPJ; j.W = wd + (size_t)e * DFFE * DM; j.ldw = DM; j.N = DM; j.K = DFFE; j.nblk = 32; j.loc = r % TPJ; j.WT = ws + WS_MOE2F + (size_t)e * DM * DFFE; j.rm = RmGen{0, 0}; return j;
}
__device__ __forceinline__ unsigned mq_grab(gu32* q, const gu32* stop, unsigned stop_val) {
    if (stop && __hip_atomic_load(stop, RLX_AGENT) >= stop_val) return 0x7fffffffu;
    return __hip_atomic_fetch_add(q, (unsigned)MQ_GRAB, RLX_AGENT);
}
__device__ __forceinline__ void moe_drain(const float* wg, const float* wu, const float* wd, unsigned char* ws, gu32* q, const gu32* stop, unsigned stop_val, volatile LAS unsigned* slot, LAS float* scr_f, int wave, int lane, int tid) {
    LAS unsigned* scr = (LAS unsigned*)scr_f; float va[64], vb[64];
    __syncthreads();
    if (tid == 0) slot[0] = mq_grab(q, stop, stop_val);
    __syncthreads();
    unsigned t = slot[0]; int i = 0; P0Job ja, jb;
    if (t < (unsigned)MQ_TILES) { ja = moe_job((int)t + 2 * wave, wg, wu, wd, ws); tr_load(va, ja.W, ja.ldw, ja.N, ja.nblk, ja.loc, lane); jb = moe_job((int)t + 2 * wave + 1, wg, wu, wd, ws); tr_load(vb, jb.W, jb.ldw, jb.N, jb.nblk, jb.loc, lane); }
#pragma unroll 1
    while (t < (unsigned)MQ_TILES) {
        if (tid == 0) slot[(i + 1) & 1] = mq_grab(q, stop, stop_val);
        tr_store_f8(va, 64.0f, ja.K, ja.N, ja.nblk, ja.loc, ja.WT, scr, lane, ja.rm);
        __syncthreads();
        const unsigned tn = slot[(i + 1) & 1];
        if (tn < (unsigned)MQ_TILES) { ja = moe_job((int)tn + 2 * wave, wg, wu, wd, ws); tr_load(va, ja.W, ja.ldw, ja.N, ja.nblk, ja.loc, lane); }
        tr_store_f8(vb, 64.0f, jb.K, jb.N, jb.nblk, jb.loc, jb.WT, scr, lane, jb.rm);
        if (tn < (unsigned)MQ_TILES) { jb = moe_job((int)tn + 2 * wave + 1, wg, wu, wd, ws); tr_load(vb, jb.W, jb.ldw, jb.N, jb.nblk, jb.loc, lane); }
        t = tn; ++i;
    }
}
struct LayerPtrs {
    const float *g_mix, *na_q_gain, *na_k_gain, *na_rel_bias, *gla_w_up, *gla_b, *gla_norm, *conv_w, *a_log, *dt_bias, *gdn_norm, *lb_raw0, *lb_raw1, *hg_norm, *mem_q_gain, *g_ffn;
};
__device__ __forceinline__ void prep_unit(int L, const LayerPtrs& lp, const LAS float* glaw, bf16* P, float* GLG, bf16* GQ, float* GAB, bf16* HQ, float* HF, bf16* NAVT, int t0, int lane) {
    const int b = t0 >> 12, s0 = t0 & 4095;
    const float* bb_ = lp.gla_b + (lane >> 5) * 256 + (lane & 31) * 8; const f32x4 glb0 = *(const f32x4*)bb_, glb1 = *(const f32x4*)(bb_ + 4);
    const float ealog = __expf(lp.a_log[lane & 7]), dtb = lp.dt_bias[lane & 7];
    float lbv[2][8];
#pragma unroll
    for (int d = 0; d < 2; ++d)
#pragma unroll
        for (int i = 0; i < 8; ++i) { const int c = d * 512 + lane * 8 + i; lbv[d][i] = L ? sigmf(lp.lb_raw1[c] - lp.lb_raw0[c]) : 0.f; }
#pragma unroll 1
    for (int tt = 0; tt < 8; ++tt) { bf16* pr = P + (size_t)(t0 + tt) * LDP;
        const v4u rq = *(const v4u*)(pr + C_NAQ + lane * 8), rk = *(const v4u*)(pr + C_NAK + lane * 8), rm = *(const v4u*)(pr + C_MQ + lane * 8), rh = *(const v4u*)(pr + C_HGQ + lane * 8),
                  rf0 = *(const v4u*)(pr + C_HGF + lane * 8), rf1 = *(const v4u*)(pr + C_HGF + 512 + lane * 8), rl0 = *(const v4u*)(pr + C_GLLR + (lane >> 5) * 16), rl1 = *(const v4u*)(pr + C_GLLR + (lane >> 5) * 16 + 8);
        const bf16 ra = pr[C_GDA + (lane & 15)];
#pragma unroll
        for (int qk = 0; qk < 2; ++qk) { bf16* p = pr + (qk ? C_NAK : C_NAQ) + lane * 8; float f[8]; unpack8(qk ? rk : rq, f);
            float ss = 0.f;
#pragma unroll
            for (int i = 0; i < 8; ++i) ss += f[i] * f[i];
            ss = group_sum<8>(ss); const float sc = rsqrtf(ss * (1.0f / 64.0f) + RMS_EPS) * (qk ? 1.0f : 0.125f);
            const float* gn = (qk ? lp.na_k_gain : lp.na_q_gain) + (lane & 7) * 8;
#pragma unroll
            for (int i = 0; i < 8; ++i) f[i] = f[i] * sc * gn[i];
            *(v4u*)p = pack8(f); }
        { bf16* p = pr + C_MQ + lane * 8; float f[8]; unpack8(rm, f); float ss = 0.f;
#pragma unroll
            for (int i = 0; i < 8; ++i) ss += f[i] * f[i];
            ss = group_sum<16>(ss); const float sc = rsqrtf(ss * (1.0f / 128.0f) + RMS_EPS) * 0.08838834764831845f; const float* gn = lp.mem_q_gain + (lane & 15) * 8;
#pragma unroll
            for (int i = 0; i < 8; ++i) f[i] = f[i] * sc * gn[i];
            *(v4u*)p = pack8(f); }
        { float f[8]; unpack8(rh, f);
#pragma unroll
            for (int i = 0; i < 8; ++i) f[i] = siluf(f[i]);
            *(v4u*)(HQ + (size_t)(t0 + tt) * 512 + lane * 8) = pack8(f);
#pragma unroll
            for (int d = 0; d < 2; ++d) { float z[8]; unpack8(d ? rf1 : rf0, z); float o[8];
#pragma unroll
                for (int i = 0; i < 8; ++i) { if (L) { const float lb = lbv[d][i]; o[i] = __logf(lb + (1.0f - lb) * sigmf(z[i])); } else o[i] = -softplusf(-z[i]); }
                float* hf = HF + (size_t)(t0 + tt) * 1024 + d * 512 + lane * 8;
                *(f32x4*)hf = (f32x4){o[0], o[1], o[2], o[3]}; *(f32x4*)(hf + 4) = (f32x4){o[4], o[5], o[6], o[7]}; } }
        { const int dir = lane >> 5, c8 = (lane & 31) * 8; float lr[16];
            { float t8[8]; unpack8(rl0, t8);
#pragma unroll
              for (int i = 0; i < 8; ++i) lr[i] = t8[i];
              unpack8(rl1, t8);
#pragma unroll
              for (int i = 0; i < 8; ++i) lr[8 + i] = t8[i]; }
            f32x4 a0 = glb0, a1 = glb1;
            int c8l = c8; asm volatile("" : "+v"(c8l));
#pragma unroll
            for (int r = 0; r < 16; ++r) { const LAS float* wp = glaw + (dir * 16 + r) * 256 + c8l; a0 = a0 + lr[r] * *(const LAS f32x4*)wp; a1 = a1 + lr[r] * *(const LAS f32x4*)(wp + 4); }
            f32x4 g0, g1;
#pragma unroll
            for (int i = 0; i < 4; ++i) { g0[i] = -softplusf(-a0[i]) * 0.0625f; g1[i] = -softplusf(-a1[i]) * 0.0625f; }
            float* gp = GLG + (size_t)(t0 + tt) * 512 + dir * 256 + c8; *(f32x4*)gp = g0; *(f32x4*)(gp + 4) = g1; }
        if (lane < 16) { const float val = bf1(ra); float o;
            if (lane < 8) o = -ealog * softplusf(val + dtb); else o = sigmf(val);
            GAB[(size_t)(t0 + tt) * 16 + lane] = o; }
    }
#pragma unroll 1
    for (int j = 0; j < 3; ++j) { const int col = j * 512 + lane * 8; float w[5][8];
#pragma unroll
        for (int tap = 0; tap < 5; ++tap) { const float* wp = lp.conv_w + tap * 1536 + col; const f32x4 w0 = *(const f32x4*)wp, w1 = *(const f32x4*)(wp + 4);
            w[tap][0] = w0[0]; w[tap][1] = w0[1]; w[tap][2] = w0[2]; w[tap][3] = w0[3]; w[tap][4] = w1[0]; w[tap][5] = w1[1]; w[tap][6] = w1[2]; w[tap][7] = w1[3]; }
#pragma unroll 1
        for (int hf = 0; hf < 2; ++hf) {
        v4u xr[8];
#pragma unroll
        for (int r = 0; r < 8; ++r) { const int s = s0 + hf * 4 + r - 2; xr[r] = (v4u){0u, 0u, 0u, 0u}; if (s >= 0 && s < SEQ) xr[r] = *(const v4u*)(P + (size_t)((b << 12) + s) * LDP + C_GDQKV + col); }
#pragma unroll
        for (int t4 = 0; t4 < 4; ++t4) { const int tt = hf * 4 + t4; float acc[8]; __builtin_amdgcn_sched_barrier(0);
#pragma unroll
            for (int i = 0; i < 8; ++i) acc[i] = 0.f;
#pragma unroll
            for (int tap = 0; tap < 5; ++tap) { float x[8]; unpack8(xr[t4 + tap], x);
#pragma unroll
                for (int i = 0; i < 8; ++i) acc[i] += w[tap][i] * x[i]; }
#pragma unroll
            for (int i = 0; i < 8; ++i) acc[i] = siluf(acc[i]);
            if (j < 2) { float ss = 0.f;
#pragma unroll
                for (int i = 0; i < 8; ++i) ss += acc[i] * acc[i];
                ss = group_sum<16>(ss); const float sc = rsqrtf(ss + 1e-6f) * (j == 0 ? 0.08838834764831845f : 1.0f);
#pragma unroll
                for (int i = 0; i < 8; ++i) acc[i] *= sc; }
            *(v4u*)(GQ + (size_t)(t0 + tt) * 1536 + col) = pack8(acc); } } }
    { unsigned vw[8][4];
#pragma unroll
        for (int tt = 0; tt < 8; ++tt) { const v4u x = *(const v4u*)(P + (size_t)(t0 + tt) * LDP + C_NAV + lane * 8); vw[tt][0] = x.x; vw[tt][1] = x.y; vw[tt][2] = x.z; vw[tt][3] = x.w; }
#pragma unroll
        for (int i = 0; i < 8; ++i) { unsigned e[8];
#pragma unroll
            for (int tt = 0; tt < 8; ++tt) e[tt] = (i & 1) ? (vw[tt][i >> 1] >> 16) : (vw[tt][i >> 1] & 0xffffu);
            v4u o; o.x = e[0] | (e[1] << 16); o.y = e[2] | (e[3] << 16); o.z = e[4] | (e[5] << 16); o.w = e[6] | (e[7] << 16);
            *(v4u*)(NAVT + ((size_t)((b * 8 + (lane >> 3)) * 64 + (lane & 7) * 8 + i)) * SEQ + s0) = o; } }
}
__device__ __forceinline__ void post_token(const LayerPtrs& lp, const bf16* P, const bf16* SOUT, bf16* BR, int t, int lane) {
    const bf16* pr = P + (size_t)t * LDP;
#pragma unroll
    for (int br = 0; br < 3; ++br) {
        float a[8], c[8], og[8];
        unpack8(*(const v4u*)(SOUT + ((size_t)(br * 2 + 0) * NT + t) * 512 + lane * 8), a);
        unpack8(*(const v4u*)(SOUT + ((size_t)(br * 2 + 1) * NT + t) * 512 + lane * 8), c);
        unpack8(*(const v4u*)(pr + (br == 0 ? C_GLOG : br == 1 ? C_GDOG : C_HGOG) + lane * 8), og);
        const float qs = br == 0 ? 0.125f : 1.0f; float ss = 0.f;
#pragma unroll
        for (int i = 0; i < 8; ++i) { a[i] = (a[i] + c[i]) * qs; ss += a[i] * a[i]; }
        ss = group_sum<16>(ss); const float sc = rsqrtf(ss * (1.0f / 128.0f) + RMS_EPS);
        const float* gn = (br == 0 ? lp.gla_norm : br == 1 ? lp.gdn_norm : lp.hg_norm) + (lane & 15) * 8;
#pragma unroll
        for (int i = 0; i < 8; ++i) a[i] = a[i] * sc * gn[i] * (br == 2 ? sigmf(og[i]) : siluf(og[i]));
        *(v4u*)(BR + ((size_t)(1 + br) * NT + t) * 512 + lane * 8) = pack8(a);
    }
}
typedef short bf16x8 __attribute__((ext_vector_type(8)));
__device__ __forceinline__ bf16x8 as_bf16x8(v4u w) { return __builtin_bit_cast(bf16x8, w); }
#define MFMA16(a, b, c) __builtin_amdgcn_mfma_f32_16x16x32_bf16((a), (b), (c), 0, 0, 0)
typedef short bf16x4 __attribute__((ext_vector_type(4)));
__device__ __forceinline__ bf16x4 as_bf16x4(v2u w) { return __builtin_bit_cast(bf16x4, w); }
#define MFMA16K16(a, b, c) __builtin_amdgcn_mfma_f32_16x16x16bf16_1k((a), (b), (c), 0, 0, 0)
__device__ __forceinline__ void na_wave_unit(const bf16* P, const bf16* NAVT, const float* rel_bias, bf16* BR0, int b, int h, int r, int qc, int lane) {
    const int fr = lane & 15, g = lane >> 4; const int c = qc * 16 + fr;
    const int kc_lo = qc == 0 ? 0 : qc == 1 ? 8 : qc == 2 ? 24 : 32;
    const int cs = min(max(c - 8, 0), 48), rbase = min(max(r - 4, 0), 56);
    const size_t tq = (size_t)(b << 12) + r * 64 + c;
    bf16x8 qf[2];
#pragma unroll
    for (int ks = 0; ks < 2; ++ks) qf[ks] = as_bf16x8(*(const v4u*)(P + tq * LDP + C_NAQ + h * 64 + ks * 32 + g * 8));
    f32x4 s[8][2]; float mx = -3.0e38f;
    v4u kf[8][2][2];
#pragma unroll
    for (int i = 0; i < 8; ++i)
#pragma unroll
        for (int kt = 0; kt < 2; ++kt) { const bf16* kp = P + ((size_t)(b << 12) + (rbase + i) * 64 + kc_lo + (fr >> 2) * 8 + kt * 4 + (fr & 3)) * LDP + C_NAK + h * 64 + g * 8; kf[i][kt][0] = *(const v4u*)kp; kf[i][kt][1] = *(const v4u*)(kp + 32); }
#pragma unroll
    for (int i = 0; i < 8; ++i) { const float* bp = rel_bias + (h * 15 + (rbase + i - r + 7)) * 31;
#pragma unroll
        for (int kt = 0; kt < 2; ++kt) {
            f32x4 a = {0.f, 0.f, 0.f, 0.f}; a = MFMA16(as_bf16x8(kf[i][kt][0]), qf[0], a); a = MFMA16(as_bf16x8(kf[i][kt][1]), qf[1], a);
            const int ck0 = kc_lo + 8 * g + 4 * kt, dc0 = ck0 - c + 15, dcl = min(max(dc0, 0), 27); const f32x4 b4 = *(const f32x4*)(bp + dcl);
#pragma unroll
            for (int jj = 0; jj < 4; ++jj) { const int ck = ck0 + jj; const bool inw = (ck >= cs) && (ck < cs + 16); const int sh = dc0 + jj - dcl;
                const float bv = sh == 0 ? b4[0] : sh == 1 ? b4[1] : sh == 2 ? b4[2] : b4[3];
                a[jj] = inw ? a[jj] + bv : -1.0e30f; mx = fmaxf(mx, a[jj]); }
            s[i][kt] = a; } }
    mx = fmaxf(mx, __shfl_xor(mx, 16)); mx = fmaxf(mx, __shfl_xor(mx, 32));
    float l = 0.f;
#pragma unroll
    for (int i = 0; i < 8; ++i)
#pragma unroll
        for (int kt = 0; kt < 2; ++kt)
#pragma unroll
            for (int jj = 0; jj < 4; ++jj) { const float p = __expf(s[i][kt][jj] - mx); s[i][kt][jj] = p; l += p; }
    l += __shfl_xor(l, 16); l += __shfl_xor(l, 32);
    f32x4 o[4];
#pragma unroll
    for (int dt = 0; dt < 4; ++dt) o[dt] = (f32x4){0.f, 0.f, 0.f, 0.f};
#pragma unroll
    for (int hh = 0; hh < 2; ++hh) { v4u vv[4][4];
#pragma unroll
        for (int i4 = 0; i4 < 4; ++i4)
#pragma unroll
            for (int dt = 0; dt < 4; ++dt) { const bf16* vp = NAVT + ((size_t)((b * 8 + h) * 64 + dt * 16 + fr)) * SEQ + (rbase + hh * 4 + i4) * 64 + kc_lo + 8 * g; vv[i4][dt] = *(const v4u*)vp; }
#pragma unroll
        for (int i4 = 0; i4 < 4; ++i4) { const int i = hh * 4 + i4; v4u pw; pw.x = pkbf(s[i][0][0], s[i][0][1]); pw.y = pkbf(s[i][0][2], s[i][0][3]); pw.z = pkbf(s[i][1][0], s[i][1][1]); pw.w = pkbf(s[i][1][2], s[i][1][3]);
            const bf16x8 pf = as_bf16x8(pw);
#pragma unroll
            for (int dt = 0; dt < 4; ++dt) o[dt] = MFMA16(as_bf16x8(vv[i4][dt]), pf, o[dt]); } }
    const float inv = 1.0f / l;
#pragma unroll
    for (int dt = 0; dt < 4; ++dt) { v2u w; w.x = pkbf(o[dt][0] * inv, o[dt][1] * inv); w.y = pkbf(o[dt][2] * inv, o[dt][3] * inv);
        *(v2u*)(BR0 + tq * 512 + h * 64 + dt * 16 + 4 * g) = w; }
}
__device__ __forceinline__ void mem_wave_unit(const bf16* P, const bf16* MK, const bf16* MVT, bf16* BR4, int t0, int h, int lane) {
    const int fr = lane & 15, g = lane >> 4, b = t0 >> 12; const size_t tq = (size_t)t0 + fr;
    bf16x8 qf[4];
#pragma unroll
    for (int ks = 0; ks < 4; ++ks) qf[ks] = as_bf16x8(*(const v4u*)(P + tq * LDP + C_MQ + h * 128 + ks * 32 + g * 8));
    f32x4 s[16]; float mx = -3.0e38f;
#pragma unroll
    for (int m4 = 0; m4 < 2; ++m4) { v4u kf[8][4];
#pragma unroll
        for (int mm = 0; mm < 8; ++mm)
#pragma unroll
            for (int ks = 0; ks < 4; ++ks) kf[mm][ks] = *(const v4u*)(MK + ((size_t)(b * 256 + (m4 * 8 + mm) * 16 + fr)) * 512 + h * 128 + g * 8 + ks * 32);
#pragma unroll
        for (int mm = 0; mm < 8; ++mm) { f32x4 a = {0.f, 0.f, 0.f, 0.f};
#pragma unroll
            for (int ks = 0; ks < 4; ++ks) a = MFMA16(as_bf16x8(kf[mm][ks]), qf[ks], a);
#pragma unroll
            for (int jj = 0; jj < 4; ++jj) mx = fmaxf(mx, a[jj]);
            s[m4 * 8 + mm] = a; } }
    mx = fmaxf(mx, __shfl_xor(mx, 16)); mx = fmaxf(mx, __shfl_xor(mx, 32));
    float l = 0.f;
#pragma unroll
    for (int mt = 0; mt < 16; ++mt)
#pragma unroll
        for (int jj = 0; jj < 4; ++jj) { const float p = __expf(s[mt][jj] - mx); s[mt][jj] = p; l += p; }
    l += __shfl_xor(l, 16); l += __shfl_xor(l, 32);
    f32x4 o[8];
#pragma unroll
    for (int dt = 0; dt < 8; ++dt) o[dt] = (f32x4){0.f, 0.f, 0.f, 0.f};
#pragma unroll
    for (int k4 = 0; k4 < 4; ++k4) { v2u vv[2][8][2];
#pragma unroll
        for (int k2 = 0; k2 < 2; ++k2)
#pragma unroll
            for (int dt = 0; dt < 8; ++dt) { const bf16* vp = MVT + ((size_t)((b * 4 + h) * 128 + dt * 16 + fr)) * 256 + (k4 * 2 + k2) * 32 + 4 * g; vv[k2][dt][0] = *(const v2u*)vp; vv[k2][dt][1] = *(const v2u*)(vp + 16); }
#pragma unroll
        for (int k2 = 0; k2 < 2; ++k2) { const int kb = k4 * 2 + k2; v4u pw; pw.x = pkbf(s[2 * kb][0], s[2 * kb][1]); pw.y = pkbf(s[2 * kb][2], s[2 * kb][3]); pw.z = pkbf(s[2 * kb + 1][0], s[2 * kb + 1][1]); pw.w = pkbf(s[2 * kb + 1][2], s[2 * kb + 1][3]);
            const bf16x8 pf = as_bf16x8(pw);
#pragma unroll
            for (int dt = 0; dt < 8; ++dt) { v4u vw; vw.x = vv[k2][dt][0].x; vw.y = vv[k2][dt][0].y; vw.z = vv[k2][dt][1].x; vw.w = vv[k2][dt][1].y; o[dt] = MFMA16(as_bf16x8(vw), pf, o[dt]); } } }
    const float inv = 1.0f / l;
#pragma unroll
    for (int dt = 0; dt < 8; ++dt) { v2u w; w.x = pkbf(o[dt][0] * inv, o[dt][1] * inv); w.y = pkbf(o[dt][2] * inv, o[dt][3] * inv);
        *(v2u*)(BR4 + tq * 512 + h * 128 + dt * 16 + 4 * g) = w; }
}
__device__ __forceinline__ void mem_wg_unit(LAS unsigned char* ring, const bf16* P, const bf16* MK, const bf16* MVT, bf16* BR4, int t0, int h, int wave, int lane, int tid) {
    const int fr = lane & 15, g = lane >> 4, b = t0 >> 12;
    { const bf16* ksrc = MK + (size_t)(b * 256) * 512 + h * 128;
#pragma unroll
      for (int i = 0; i < 8; ++i) { const int idx = i * 512 + tid, key = idx >> 4, c = idx & 15; const v4u w = *(const v4u*)(ksrc + (size_t)key * 512 + c * 8); *(LAS v4u*)(ring + key * 256 + ((c ^ (key & 15)) << 4)) = w; }
      const bf16* vsrc = MVT + (size_t)((b * 4 + h) * 128) * 256;
#pragma unroll
      for (int i = 0; i < 2; ++i) { const int idx = i * 512 + tid, d = idx >> 3, kb = idx & 7; const v4u* p = (const v4u*)(vsrc + (size_t)d * 256 + kb * 32); const v4u u0 = p[0], u1 = p[1], u2 = p[2], u3 = p[3];
          LAS unsigned char* row = ring + 65536 + d * 512; const int sw = d & 15;
          v4u c0, c1, c2, c3; c0.x = u0.x; c0.y = u0.y; c0.z = u2.x; c0.w = u2.y; c1.x = u0.z; c1.y = u0.w; c1.z = u2.z; c1.w = u2.w; c2.x = u1.x; c2.y = u1.y; c2.z = u3.x; c2.w = u3.y; c3.x = u1.z; c3.y = u1.w; c3.z = u3.z; c3.w = u3.w;
          *(LAS v4u*)(row + (((kb * 4 + 0) ^ sw) << 4)) = c0; *(LAS v4u*)(row + (((kb * 4 + 1) ^ sw) << 4)) = c1; *(LAS v4u*)(row + (((kb * 4 + 2) ^ sw) << 4)) = c2; *(LAS v4u*)(row + (((kb * 4 + 3) ^ sw) << 4)) = c3; } }
    __syncthreads();
#pragma unroll 1
    for (int sub = 0; sub < 2; ++sub) { const size_t tq = (size_t)t0 + sub * 128 + wave * 16 + fr;
        int fo = fr; asm volatile("" : "+v"(fo));
        bf16x8 qf[4];
#pragma unroll
        for (int ks = 0; ks < 4; ++ks) qf[ks] = as_bf16x8(*(const v4u*)(P + tq * LDP + C_MQ + h * 128 + ks * 32 + g * 8));
        f32x4 s[16]; float mx = -3.0e38f;
#pragma unroll
        for (int mt = 0; mt < 16; ++mt) { f32x4 a = {0.f, 0.f, 0.f, 0.f}; const LAS unsigned char* kr = ring + (mt * 16 + fo) * 256;
#pragma unroll
            for (int ks = 0; ks < 4; ++ks) a = MFMA16(as_bf16x8(*(const LAS v4u*)(kr + (((ks * 4 + g) ^ fo) << 4))), qf[ks], a);
#pragma unroll
            for (int jj = 0; jj < 4; ++jj) mx = fmaxf(mx, a[jj]);
            s[mt] = a; }
        mx = fmaxf(mx, __shfl_xor(mx, 16)); mx = fmaxf(mx, __shfl_xor(mx, 32));
        float l = 0.f;
#pragma unroll
        for (int mt = 0; mt < 16; ++mt)
#pragma unroll
            for (int jj = 0; jj < 4; ++jj) { const float p = __expf(s[mt][jj] - mx); s[mt][jj] = p; l += p; }
        l += __shfl_xor(l, 16); l += __shfl_xor(l, 32);
        f32x4 o[8];
#pragma unroll
        for (int dt = 0; dt < 8; ++dt) o[dt] = (f32x4){0.f, 0.f, 0.f, 0.f};
#pragma unroll
        for (int kb = 0; kb < 8; ++kb) { v4u pw; pw.x = pkbf(s[2 * kb][0], s[2 * kb][1]); pw.y = pkbf(s[2 * kb][2], s[2 * kb][3]); pw.z = pkbf(s[2 * kb + 1][0], s[2 * kb + 1][1]); pw.w = pkbf(s[2 * kb + 1][2], s[2 * kb + 1][3]);
            const bf16x8 pf = as_bf16x8(pw);
#pragma unroll
            for (int dt = 0; dt < 8; ++dt) o[dt] = MFMA16(as_bf16x8(*(const LAS v4u*)(ring + 65536 + (dt * 16 + fo) * 512 + (((kb * 4 + g) ^ fo) << 4))), pf, o[dt]); }
        const float inv = 1.0f / l;
#pragma unroll
        for (int dt = 0; dt < 8; ++dt) { v2u w; w.x = pkbf(o[dt][0] * inv, o[dt][1] * inv); w.y = pkbf(o[dt][2] * inv, o[dt][3] * inv);
            *(v2u*)(BR4 + tq * 512 + h * 128 + dt * 16 + 4 * g) = w; }
    }
}
#define CH_TOK(n, i) ((size_t)(dir ? (SEQ - 1 - ((n) * 16 + (i))) : ((n) * 16 + (i))))
__device__ __forceinline__ bf16 tobf(float x) { return (bf16)(pkbf(x, 0.f) & 0xffffu); }
constexpr size_t OA_GW = 0, OA_GU = 32 * MiB, OA_GKT = 64 * MiB, OA_GP = 96 * MiB, OA_GS = 100 * MiB, OA_HQD = 104 * MiB, OA_HKDT = 136 * MiB, OA_HP = 168 * MiB, OA_HV = 172 * MiB,
                 OA_LQD = 184 * MiB, OA_LKDT = 200 * MiB, OA_LP = 216 * MiB, OA_LV = 220 * MiB, OA_END = 226 * MiB;
struct DiagSrc { const bf16* q; int qp; const bf16* k; int kp; const float* lg; int lgp; const bf16* v; int vp; };
template <int K, int HG> __device__ __forceinline__ void s1_diag(LAS unsigned char* scr, const DiagSrc& S, int dir, int n, bf16* QD, bf16* KDT, bf16* PP, float* EB, int lane) {
    constexpr int NK = K / 64, LPI = K + 8;
    LAS bf16* QDs = (LAS bf16*)scr; LAS bf16* KDs = QDs + 16 * LPI;
#pragma unroll
    for (int c = 0; c < NK; ++c) { const int k = lane + 64 * c; float bi[16], lgv[16]; float b = 0.f;
#pragma unroll
        for (int i = 0; i < 16; ++i) { lgv[i] = S.lg[CH_TOK(n, i) * S.lgp + k]; b += lgv[i]; bi[i] = b; }
        unsigned kdw[8];
#pragma unroll
        for (int i = 0; i < 16; ++i) { const size_t tok = CH_TOK(n, i); const float qv = bf1(S.q[tok * S.qp + k]); float kv;
            if (HG) kv = 1.0f - __expf(lgv[i]); else kv = bf1(S.k[tok * S.kp + k]);
            const bf16 qh = tobf(qv * __expf(bi[i])), kh = tobf(kv * __expf(-bi[i]));
            QD[i * K + k] = qh; QDs[i * LPI + k] = qh; KDs[i * LPI + k] = kh;
            if (i & 1) kdw[i >> 1] |= ((unsigned)kh) << 16; else kdw[i >> 1] = kh; }
        *(v4u*)(KDT + k * 16) = (v4u){kdw[0], kdw[1], kdw[2], kdw[3]}; *(v4u*)(KDT + k * 16 + 8) = (v4u){kdw[4], kdw[5], kdw[6], kdw[7]};
        EB[k] = __expf(bi[15]); }
    LDS_WAIT(); asm volatile("" ::: "memory");
    const int fr = lane & 15, g = lane >> 4; f32x4 acc = {0.f, 0.f, 0.f, 0.f};
#pragma unroll
    for (int ks = 0; ks < K / 32; ++ks) { const bf16x8 qf = as_bf16x8(*(const LAS v4u*)(QDs + fr * LPI + 32 * ks + 8 * g)), kf = as_bf16x8(*(const LAS v4u*)(KDs + fr * LPI + 32 * ks + 8 * g)); acc = MFMA16(qf, kf, acc); }
#pragma unroll
    for (int jj = 0; jj < 4; ++jj) { const int i = 4 * g + jj; PP[i * 16 + fr] = tobf(fr <= i ? acc[jj] : 0.f); }
    LDS_WAIT(); asm volatile("" ::: "memory");
}
#define S2_BAR() do { asm volatile("s_waitcnt lgkmcnt(0)" ::: "memory"); __builtin_amdgcn_s_barrier(); asm volatile("" ::: "memory"); } while (0)
template <int K> struct DiagStage { v4u qd[K / 64], kdt[K / 64], v[2], p, eb; };
template <int K> struct DiagLds { static constexpr int QP = 2 * K + 16, LQD = 0, LKDT = 64 * QP, LV = LKDT + 4 * K * 32, LP = LV + 64 * 256, LEB = LP + 2048, BYTES = LEB + 4 * K * 4; };
template <int K> __device__ __forceinline__ void s2d_load(DiagStage<K>& R, const bf16* QD0, const bf16* KDT0, const bf16* PP0, const float* EB0, const bf16* vsrc, int vp, int dir, int grp, int tid) {
    const size_t c0 = (size_t)grp * 4;
#pragma unroll
    for (int j = 0; j < K / 64; ++j) { const int e = tid + 512 * j; R.qd[j] = *(const v4u*)(QD0 + c0 * 16 * K + (size_t)e * 8); R.kdt[j] = *(const v4u*)(KDT0 + c0 * 16 * K + (size_t)e * 8); }
#pragma unroll
    for (int j = 0; j < 2; ++j) { const int e = tid + 512 * j, row = e >> 4, col = e & 15; R.v[j] = *(const v4u*)(vsrc + CH_TOK(grp * 4 + (row >> 4), row & 15) * vp + col * 8); }
    if (tid < 128) R.p = *(const v4u*)(PP0 + c0 * 256 + tid * 8);
    else if (tid < 128 + K) R.eb = *(const v4u*)(EB0 + c0 * K + (tid - 128) * 4);
}
template <int K> __device__ __forceinline__ void s2d_store(const DiagStage<K>& R, LAS unsigned char* lds, int tid) {
    typedef DiagLds<K> L;
#pragma unroll
    for (int j = 0; j < K / 64; ++j) { const int e = tid + 512 * j, row = e / (K / 8), col = e % (K / 8); *(LAS v4u*)(lds + L::LQD + row * L::QP + col * 16) = R.qd[j]; *(LAS v4u*)(lds + L::LKDT + e * 16) = R.kdt[j]; }
#pragma unroll
    for (int j = 0; j < 2; ++j) { const int e = tid + 512 * j; *(LAS v4u*)(lds + L::LV + e * 16) = R.v[j]; }
    if (tid < 128) *(LAS v4u*)(lds + L::LP + tid * 16) = R.p;
    else if (tid < 128 + K) *(LAS v4u*)(lds + L::LEB + (tid - 128) * 16) = R.eb;
}
template <int K> __device__ __forceinline__ void s2d_chunk(LAS unsigned char* lds, int c, f32x4 (&S)[K / 16], bf16* osrc, int op, int dir, int n, int vt, int lane) {
    typedef DiagLds<K> L; const int fr = lane & 15, g = lane >> 4;
    f32x4 o = {0.f, 0.f, 0.f, 0.f};
#pragma unroll
    for (int ks = 0; ks < K / 32; ++ks) { const LAS unsigned char* qp = lds + L::LQD + (c * 16 + fr) * L::QP + (32 * ks + 4 * g) * 2; const v2u a = *(const LAS v2u*)qp, b = *(const LAS v2u*)(qp + 32);
        v4u sb; sb.x = pkbf(S[2 * ks][0], S[2 * ks][1]); sb.y = pkbf(S[2 * ks][2], S[2 * ks][3]); sb.z = pkbf(S[2 * ks + 1][0], S[2 * ks + 1][1]); sb.w = pkbf(S[2 * ks + 1][2], S[2 * ks + 1][3]);
        o = MFMA16(as_bf16x8((v4u){a.x, a.y, b.x, b.y}), as_bf16x8(sb), o); }
    unsigned vr[4];
#pragma unroll
    for (int jj = 0; jj < 4; ++jj) vr[jj] = *(const LAS unsigned short*)(lds + L::LV + ((c * 16 + 4 * g + jj) * 128 + vt * 16 + fr) * 2);
    const bf16x8 vf = as_bf16x8((v4u){vr[0] | (vr[1] << 16), vr[2] | (vr[3] << 16), 0u, 0u});
    { const v2u pp = *(const LAS v2u*)(lds + L::LP + (c * 256 + fr * 16 + 4 * g) * 2); o = MFMA16(as_bf16x8((v4u){pp.x, pp.y, 0u, 0u}), vf, o); }
#pragma unroll
    for (int kt = 0; kt < K / 16; ++kt) { const v2u kd = *(const LAS v2u*)(lds + L::LKDT + ((c * K + kt * 16 + fr) * 16 + 4 * g) * 2); const f32x4 eb = *(const LAS f32x4*)(lds + L::LEB + (c * K + kt * 16 + 4 * g) * 4);
        S[kt] = MFMA16(as_bf16x8((v4u){kd.x, kd.y, 0u, 0u}), vf, S[kt]); S[kt] = S[kt] * eb; }
#pragma unroll
    for (int jj = 0; jj < 4; ++jj) osrc[CH_TOK(n, 4 * g + jj) * op + vt * 16 + fr] = tobf(o[jj]);
}
template <int K> __device__ __forceinline__ void s2_diag(LAS unsigned char* lds, const bf16* QD0, const bf16* KDT0, const bf16* PP0, const float* EB0, const bf16* vsrc, int vp, bf16* osrc, int op, int dir, int vt, int lane, int tid) {
    static_assert(DiagLds<K>::BYTES <= RING_BYTES, "S2 LDS");
    f32x4 S[K / 16];
#pragma unroll
    for (int kt = 0; kt < K / 16; ++kt) S[kt] = (f32x4){0.f, 0.f, 0.f, 0.f};
    DiagStage<K> Ra, Rb;
    s2d_load<K>(Ra, QD0, KDT0, PP0, EB0, vsrc, vp, dir, 0, tid); s2d_load<K>(Rb, QD0, KDT0, PP0, EB0, vsrc, vp, dir, 1, tid);
#pragma unroll 1
    for (int grp = 0; grp < SEQ / 64; grp += 2) {
        S2_BAR(); s2d_store<K>(Ra, lds, tid); S2_BAR();
        s2d_load<K>(Ra, QD0, KDT0, PP0, EB0, vsrc, vp, dir, grp + 2 < SEQ / 64 ? grp + 2 : grp, tid);
#pragma unroll 2
        for (int c = 0; c < 4; ++c) s2d_chunk<K>(lds, c, S, osrc, op, dir, grp * 4 + c, vt, lane);
        S2_BAR(); s2d_store<K>(Rb, lds, tid); S2_BAR();
        s2d_load<K>(Rb, QD0, KDT0, PP0, EB0, vsrc, vp, dir, grp + 3 < SEQ / 64 ? grp + 3 : grp + 1, tid);
#pragma unroll 2
        for (int c = 0; c < 4; ++c) s2d_chunk<K>(lds, c, S, osrc, op, dir, (grp + 1) * 4 + c, vt, lane);
    }
    S2_BAR();
}
__device__ __forceinline__ void s1_gdn(LAS unsigned char* scr, const bf16* GQb, const float* GABb, int h, int dir, int n, bf16* GW, bf16* GU, bf16* GKT, bf16* GP, float* GS, int lane) {
    const int fr = lane & 15, g = lane >> 4;
    LAS float* AT = (LAS float*)scr;
    float c[16], be[16]; float cs = 0.f;
#pragma unroll
    for (int i = 0; i < 16; ++i) { const size_t tok = CH_TOK(n, i); cs += GABb[tok * 16]; c[i] = cs; be[i] = GABb[tok * 16 + 8]; }
    const size_t tr = CH_TOK(n, fr);
    f32x4 kk = {0.f, 0.f, 0.f, 0.f}, qk = {0.f, 0.f, 0.f, 0.f};
#pragma unroll
    for (int ks = 0; ks < 4; ++ks) { const bf16x8 kf = as_bf16x8(*(const v4u*)(GQb + tr * 1536 + 512 + h * 128 + 32 * ks + 8 * g)), qf = as_bf16x8(*(const v4u*)(GQb + tr * 1536 + h * 128 + 32 * ks + 8 * g));
        kk = MFMA16(kf, kf, kk); qk = MFMA16(qf, kf, qk); }
    float cj = 0.f;
#pragma unroll
    for (int i = 0; i < 16; ++i) cj = (fr == i) ? c[i] : cj;
    f32x4 av;
#pragma unroll
    for (int jj = 0; jj < 4; ++jj) { float ci = 0.f, bi = 0.f;
#pragma unroll
        for (int gg = 0; gg < 4; ++gg) { ci = (g == gg) ? c[4 * gg + jj] : ci; bi = (g == gg) ? be[4 * gg + jj] : bi; }
        const int i = 4 * g + jj; const float dec = __expf(ci - cj);
        av[jj] = (fr < i) ? bi * kk[jj] * dec : 0.f;
        GP[i * 16 + fr] = tobf(fr <= i ? qk[jj] * dec : 0.f); }
    *(LAS f32x4*)(AT + fr * 16 + 4 * g) = av;
    if (lane < 16) { GS[lane] = __expf(cj); GS[16 + lane] = __expf(c[15] - cj); } if (lane == 16) GS[32] = __expf(c[15]);
    LDS_WAIT(); asm volatile("" ::: "memory");
    float t[16];
#pragma unroll
    for (int j = 15; j >= 0; --j) { float a = (fr == j) ? 1.f : 0.f;
        if (j < 15) { f32x4 col[4];
#pragma unroll
            for (int q4 = 0; q4 < 4; ++q4) col[q4] = *(const LAS f32x4*)(AT + j * 16 + 4 * q4);
#pragma unroll
            for (int i = j + 1; i < 16; ++i) a -= t[i] * col[i >> 2][i & 3]; }
        t[j] = a; }
    float tf[4];
#pragma unroll
    for (int e = 0; e < 4; ++e) { float x = 0.f;
#pragma unroll
        for (int gg = 0; gg < 4; ++gg) x = (g == gg) ? t[4 * gg + e] : x;
        tf[e] = x; }
    const bf16x8 tfrag = as_bf16x8((v4u){pkbf(tf[0], tf[1]), pkbf(tf[2], tf[3]), 0u, 0u});
    float bj[4], bgj[4]; size_t tj[4];
#pragma unroll
    for (int e = 0; e < 4; ++e) { float cc = 0.f, bb = 0.f;
#pragma unroll
        for (int gg = 0; gg < 4; ++gg) { cc = (g == gg) ? c[4 * gg + e] : cc; bb = (g == gg) ? be[4 * gg + e] : bb; }
        bj[e] = bb; bgj[e] = bb * __expf(cc); tj[e] = CH_TOK(n, 4 * g + e); }
#pragma unroll 2
    for (int ct = 0; ct < 8; ++ct) {
        float vv[4], kv[4];
#pragma unroll
        for (int e = 0; e < 4; ++e) { vv[e] = bf1(GQb[tj[e] * 1536 + 1024 + h * 128 + ct * 16 + fr]); kv[e] = bf1(GQb[tj[e] * 1536 + 512 + h * 128 + ct * 16 + fr]); }
        const bf16x8 vb = as_bf16x8((v4u){pkbf(vv[0] * bj[0], vv[1] * bj[1]), pkbf(vv[2] * bj[2], vv[3] * bj[3]), 0u, 0u});
        const bf16x8 kb = as_bf16x8((v4u){pkbf(kv[0] * bgj[0], kv[1] * bgj[1]), pkbf(kv[2] * bgj[2], kv[3] * bgj[3]), 0u, 0u});
        const f32x4 z = {0.f, 0.f, 0.f, 0.f}; const f32x4 u = MFMA16(tfrag, vb, z), w = MFMA16(tfrag, kb, z);
#pragma unroll
        for (int jj = 0; jj < 4; ++jj) { GU[(4 * g + jj) * 128 + ct * 16 + fr] = tobf(u[jj]); GW[(4 * g + jj) * 128 + ct * 16 + fr] = tobf(w[jj]); }
        *(v2u*)(GKT + (ct * 16 + fr) * 16 + 4 * g) = (v2u){pkbf(kv[0], kv[1]), pkbf(kv[2], kv[3])};
    }
    LDS_WAIT(); asm volatile("" ::: "memory");
}
struct GdnStage { v4u w[2], q[2], kt[2], u[2], p, s; };
struct GdnLds { static constexpr int WP = 272, LW = 0, LQ = 64 * WP, LKT = 2 * 64 * WP, LU = LKT + 16384, LP = LU + 16384, LS = LP + 2048, BYTES = LS + 1024; };
__device__ __forceinline__ void s2g_load(GdnStage& R, const bf16* GW0, const bf16* GU0, const bf16* GKT0, const bf16* GP0, const float* GS0, const bf16* qsrc, int dir, int grp, int tid) {
    const size_t c0 = (size_t)grp * 4;
#pragma unroll
    for (int j = 0; j < 2; ++j) { const int e = tid + 512 * j, row = e >> 4, col = e & 15;
        R.w[j] = *(const v4u*)(GW0 + c0 * 2048 + (size_t)e * 8); R.kt[j] = *(const v4u*)(GKT0 + c0 * 2048 + (size_t)e * 8); R.u[j] = *(const v4u*)(GU0 + c0 * 2048 + (size_t)e * 8);
        R.q[j] = *(const v4u*)(qsrc + CH_TOK(grp * 4 + (row >> 4), row & 15) * 1536 + col * 8); }
    if (tid < 128) R.p = *(const v4u*)(GP0 + c0 * 256 + tid * 8);
    else if (tid < 192) R.s = *(const v4u*)(GS0 + c0 * 64 + (tid - 128) * 4);
}
__device__ __forceinline__ void s2g_store(const GdnStage& R, LAS unsigned char* lds, int tid) {
    typedef GdnLds L;
#pragma unroll
    for (int j = 0; j < 2; ++j) { const int e = tid + 512 * j, row = e >> 4, col = e & 15;
        *(LAS v4u*)(lds + L::LW + row * L::WP + col * 16) = R.w[j]; *(LAS v4u*)(lds + L::LQ + row * L::WP + col * 16) = R.q[j]; *(LAS v4u*)(lds + L::LKT + e * 16) = R.kt[j]; *(LAS v4u*)(lds + L::LU + e * 16) = R.u[j]; }
    if (tid < 128) *(LAS v4u*)(lds + L::LP + tid * 16) = R.p;
    else if (tid < 192) *(LAS v4u*)(lds + L::LS + (tid - 128) * 16) = R.s;
}
__device__ __forceinline__ void s2g_chunk(LAS unsigned char* lds, int c, f32x4 (&S)[8], bf16* osrc, int dir, int n, int vt, int lane) {
    typedef GdnLds L; const int fr = lane & 15, g = lane >> 4;
    f32x4 ws = {0.f, 0.f, 0.f, 0.f}, qs = {0.f, 0.f, 0.f, 0.f};
#pragma unroll
    for (int ks = 0; ks < 4; ++ks) { const int off = (c * 16 + fr) * L::WP + (32 * ks + 4 * g) * 2;
        const v2u a = *(const LAS v2u*)(lds + L::LW + off), b = *(const LAS v2u*)(lds + L::LW + off + 32), qa = *(const LAS v2u*)(lds + L::LQ + off), qb = *(const LAS v2u*)(lds + L::LQ + off + 32);
        v4u sb; sb.x = pkbf(S[2 * ks][0], S[2 * ks][1]); sb.y = pkbf(S[2 * ks][2], S[2 * ks][3]); sb.z = pkbf(S[2 * ks + 1][0], S[2 * ks + 1][1]); sb.w = pkbf(S[2 * ks + 1][2], S[2 * ks + 1][3]);
        const bf16x8 sbf = as_bf16x8(sb); ws = MFMA16(as_bf16x8((v4u){a.x, a.y, b.x, b.y}), sbf, ws); qs = MFMA16(as_bf16x8((v4u){qa.x, qa.y, qb.x, qb.y}), sbf, qs); }
    f32x4 vn;
#pragma unroll
    for (int jj = 0; jj < 4; ++jj) vn[jj] = bf1(*(const LAS unsigned short*)(lds + L::LU + ((c * 16 + 4 * g + jj) * 128 + vt * 16 + fr) * 2)) - ws[jj];
    const f32x4 gam = *(const LAS f32x4*)(lds + L::LS + (c * 64 + 4 * g) * 4), gdec = *(const LAS f32x4*)(lds + L::LS + (c * 64 + 16 + 4 * g) * 4); const float Gam = *(const LAS float*)(lds + L::LS + (c * 64 + 32) * 4);
    const bf16x8 vnf = as_bf16x8((v4u){pkbf(vn[0], vn[1]), pkbf(vn[2], vn[3]), 0u, 0u});
    f32x4 o = qs * gam; { const v2u pp = *(const LAS v2u*)(lds + L::LP + (c * 256 + fr * 16 + 4 * g) * 2); o = MFMA16(as_bf16x8((v4u){pp.x, pp.y, 0u, 0u}), vnf, o); }
    const f32x4 vd = vn * gdec; const bf16x8 vdf = as_bf16x8((v4u){pkbf(vd[0], vd[1]), pkbf(vd[2], vd[3]), 0u, 0u});
#pragma unroll
    for (int kt = 0; kt < 8; ++kt) { const v2u kk = *(const LAS v2u*)(lds + L::LKT + ((c * 128 + kt * 16 + fr) * 16 + 4 * g) * 2); S[kt] = S[kt] * Gam; S[kt] = MFMA16(as_bf16x8((v4u){kk.x, kk.y, 0u, 0u}), vdf, S[kt]); }
#pragma unroll
    for (int jj = 0; jj < 4; ++jj) osrc[CH_TOK(n, 4 * g + jj) * 512 + vt * 16 + fr] = tobf(o[jj]);
}
__device__ __forceinline__ void s2_gdn(LAS unsigned char* lds, const bf16* GW0, const bf16* GU0, const bf16* GKT0, const bf16* GP0, const float* GS0, const bf16* qsrc, bf16* osrc, int dir, int vt, int lane, int tid) {
    static_assert(GdnLds::BYTES <= RING_BYTES, "S2 LDS");
    f32x4 S[8];
#pragma unroll
    for (int kt = 0; kt < 8; ++kt) S[kt] = (f32x4){0.f, 0.f, 0.f, 0.f};
    GdnStage Ra, Rb;
    s2g_load(Ra, GW0, GU0, GKT0, GP0, GS0, qsrc, dir, 0, tid); s2g_load(Rb, GW0, GU0, GKT0, GP0, GS0, qsrc, dir, 1, tid);
#pragma unroll 1
    for (int grp = 0; grp < SEQ / 64; grp += 2) {
        S2_BAR(); s2g_store(Ra, lds, tid); S2_BAR();
        s2g_load(Ra, GW0, GU0, GKT0, GP0, GS0, qsrc, dir, grp + 2 < SEQ / 64 ? grp + 2 : grp, tid);
#pragma unroll 2
        for (int c = 0; c < 4; ++c) s2g_chunk(lds, c, S, osrc, dir, grp * 4 + c, vt, lane);
        S2_BAR(); s2g_store(Rb, lds, tid); S2_BAR();
        s2g_load(Rb, GW0, GU0, GKT0, GP0, GS0, qsrc, dir, grp + 3 < SEQ / 64 ? grp + 3 : grp + 1, tid);
#pragma unroll 2
        for (int c = 0; c < 4; ++c) s2g_chunk(lds, c, S, osrc, dir, (grp + 1) * 4 + c, vt, lane);
    }
    S2_BAR();
}
struct Args { const float* in[31]; float* out; unsigned char* ws; int ph_lo, ph_hi; };
static_assert(sizeof(Args) == 31 * 8 + 8 + 8 + 8, "Args has no padding");
typedef const __attribute__((address_space(4))) unsigned char* kptr_t;
typedef const float* cfptr_t; typedef float* fptr_t; typedef unsigned char* ucptr_t;
__device__ __forceinline__ kptr_t kargs() { kptr_t p = (kptr_t)__builtin_amdgcn_kernarg_segment_ptr(); asm volatile("" : "+s"(p)); return p; }
#define KIN(p, i) (*(const __attribute__((address_space(4))) cfptr_t*)((p) + 8 * (i)))
#define KOUT(p) (*(const __attribute__((address_space(4))) fptr_t*)((p) + 248))
#define KWS(p) (*(const __attribute__((address_space(4))) ucptr_t*)((p) + 256))

#ifndef STAGGER_TICKS
#define STAGGER_TICKS 0
#endif
#define GEMM_STAGGER() do { if (STAGGER_TICKS) { const unsigned long long t0_ = __builtin_amdgcn_s_memrealtime(); const unsigned long long dl_ = (unsigned long long)((bx & 15) * STAGGER_TICKS); while (__builtin_amdgcn_s_memrealtime() - t0_ < dl_) __builtin_amdgcn_s_sleep(4); } } while (0)
#ifndef FILL_TAIL
#define FILL_TAIL 1
#endif
#ifndef GATE_BATCH
#define GATE_BATCH 4
#endif
#ifndef F8_SP2
#define F8_SP2 true
#endif
#ifndef EN_MASK
#define EN_MASK 0xffffffffu
#endif
#define EN_PH(k) ((EN_MASK >> (k)) & 1u)
#ifndef REP_MASK
#define REP_MASK 0u
#endif
#define REPS(k) (((REP_MASK >> (k)) & 1u) ? 2 : 1)
#ifndef REP_S2
#define REP_S2 1
#define REP_ATT 1
#endif
__global__ void __launch_bounds__(NWAVES * 64, 2) mega_fwd(Args args) {
    extern __shared__ __attribute__((aligned(16))) unsigned char lds_raw[];
    LAS unsigned char* lds = (LAS unsigned char*)lds_raw;
    volatile LAS unsigned* MISC = (volatile LAS unsigned*)(lds + MISC_OFF);
    LAS int* TAB = (LAS int*)(lds + TAB_OFF);
    for (int u = threadIdx.x; u < (LDS_BYTES - LDSCTL_OFF) / 4; u += NWAVES * 64) ((LAS unsigned*)(lds + LDSCTL_OFF))[u] = 0u;
    __syncthreads();
    if ((threadIdx.x & 63) == 0) ((volatile LAS int*)(lds + WAVETAB_OFF))[hw_slot()] = (int)(threadIdx.x >> 6);
    __syncthreads();
    XcdBarrier bar; bar.bar = (unsigned*)(args.ws + WS_CTL) + CW_BAR; bar.x = 0; bar.st = nullptr;
    if (!MK_SPLIT) bar = xcd_barrier_post((unsigned*)(args.ws + WS_CTL) + CW_BAR, MISC + 8);
    const int lo = args.ph_lo, hi = args.ph_hi;
#define IN(k) (lo <= (k) && (k) < hi)
#define SEAM(k) do { if ((k) + 1 < hi) { if (MK_SPLIT) { if (mk_tid() == 0) __hip_atomic_store((gu32*)(args.ws + WS_CTL) + CW_TMO, 0xBADBA0u, RLX_AGENT); } else xcd_barrier(bar); } } while (0)
#define PHASE_VARS \
    const kptr_t kp = kargs(); unsigned char* const ws = KWS(kp); float* const out = KOUT(kp); (void)out; \
    int tid_ = mk_tid(); asm volatile("" : "+v"(tid_)); const int tid = tid_, lane = tid & 63, wave = __builtin_amdgcn_readfirstlane(tid >> 6); (void)lane; (void)wave; \
    int G_ = gridDim.x, bx_ = blockIdx.x; asm volatile("" : "+s"(G_), "+s"(bx_)); const int G = G_, bx = bx_; const int vcu = (G % 8 == 0) ? (bx % 8) * (G / 8) + bx / 8 : bx; const int gw = vcu * NWAVES + wave, NGW = G * NWAVES; (void)gw; (void)NGW; \
    gu32* const ctl = (gu32*)(ws + WS_CTL); (void)ctl
#define LAYER_PTRS(lp) LayerPtrs lp; \
        lp.g_mix = KIN(kp, 2) + L * DM; lp.na_q_gain = KIN(kp, 4) + L * 64; lp.na_k_gain = KIN(kp, 5) + L * 64; lp.na_rel_bias = KIN(kp, 6) + L * 8 * 15 * 31; \
        lp.gla_w_up = KIN(kp, 7) + L * 2 * 16 * 256; lp.gla_b = KIN(kp, 8) + L * 512; lp.gla_norm = KIN(kp, 9) + L * 128; lp.conv_w = KIN(kp, 10) + L * 5 * 1536; \
        lp.a_log = KIN(kp, 11) + L * 8; lp.dt_bias = KIN(kp, 12) + L * 8; lp.gdn_norm = KIN(kp, 13) + L * 128; lp.lb_raw0 = KIN(kp, 14); lp.lb_raw1 = KIN(kp, 14) + 1024; \
        lp.hg_norm = KIN(kp, 15) + L * 128; lp.mem_q_gain = KIN(kp, 18) + L * 128; lp.g_ffn = KIN(kp, 22) + L * DM
#define WSP(T, off) ((T*)(ws + (off)))

    if (EN_PH(31) && IN(0)) for (int rep_ = 0; rep_ < REPS(31); ++rep_) { PHASE_VARS;
        bf16* WIN = WSP(bf16, WS_WIN); bf16* WBR = WSP(bf16, WS_WBR); bf16* WOUT = WSP(bf16, WS_WOUT); bf16* WMKV = WSP(bf16, WS_WMKV);
        bf16* WGU = WSP(bf16, WS_WGU); bf16* WDN = WSP(bf16, WS_WDN); bf16* MOE1 = WSP(bf16, WS_MOE1); bf16* MOE2 = WSP(bf16, WS_MOE2F);
        LAS float* scr = (LAS float*)(lds + RING_OFF + wave * 16384);
        phase0_convert_all(KIN(kp, 3), KIN(kp, 20), KIN(kp, 21), KIN(kp, 17), KIN(kp, 23), KIN(kp, 24), KIN(kp, 25), ws, scr, gw, NGW, lane);
        for (int i = gw * 64 + lane; i < 2 * (LDP - C_PEND) * DM / 8; i += NGW * 64) { const int L = i / ((LDP - C_PEND) * DM / 8), r = i % ((LDP - C_PEND) * DM / 8);
            *(v4u*)(WIN + ((size_t)L * NIN + C_PEND) * DM + (size_t)r * 8) = (v4u){0u, 0u, 0u, 0u}; }
        const float* mem = KIN(kp, 1); bf16* MEMN = WSP(bf16, WS_MEMN);
        for (int row = gw; row < 2 * 1024; row += NGW) { const int L = row >> 10, m = row & 1023; f32x4 v[8]; rms_row(mem + (size_t)m * DM, KIN(kp, 16) + L * DM, MEMN + (size_t)row * DM, lane, v); }
    }

#pragma unroll 1
    for (int L = 0; L < NLAYER; ++L) {
        const int pb = 1 + 16 * L;
        if (EN_PH(0) && IN(pb + 0)) for (int rep_ = 0; rep_ < REPS(0); ++rep_) { PHASE_VARS; const float* xres = L ? (const float*)out : KIN(kp, 0); const float* gm = KIN(kp, 2) + L * DM; bf16* HM = WSP(bf16, WS_HM);
            rms_tokens(xres, gm, HM, WSP(unsigned char, WS_H8), gw, NGW, lane); }
        SEAM(pb + 0);
        if (EN_PH(1) && IN(pb + 1)) for (int rep_ = 0; rep_ < REPS(1); ++rep_) {
            { PHASE_VARS; pg8::Gemm g{WSP(bf16, WS_HM), WSP(bf16, WS_WIN) + (size_t)L * NIN * DM, NT, LDP, DM}; pg8::StaticOrder S; S.init(NT, LDP, G, bx); pg8::EpiInProj E{WSP(bf16, WS_P), WSP(bf16, WS_G)};
#if defined(PROBE_NULL_EPI)
              if (rep_) { pg8::EpiNull EN; pg8::gemm_phase<pg8::EpiNull, pg8::StaticOrder, true, true>(lds + RING_OFF, g, S, EN); } else
#endif
              { GEMM_STAGGER(); pg8::gemm_phase<pg8::EpiInProj, pg8::StaticOrder, true, true>(lds + RING_OFF, g, S, E); } }
            if (L == 0) { PHASE_VARS; pg8::Gemm g{WSP(bf16, WS_MEMN), WSP(bf16, WS_WMKV), 2048, 2048, DM}; pg8::KvOrder S{bx, G >= 96 ? 64 : 0}; pg8::EpiResF32 E{nullptr, WSP(float, WS_KVRAW), 1024, 4};
              pg8::gemm_phase<pg8::EpiResF32, pg8::KvOrder, false, true>(lds + RING_OFF, g, S, E); }
            { PHASE_VARS; const int f0 = L ? 64 : 96;
              if (FILL_TAIL && G >= 128 && bx >= f0 && rep_ == 0) { LAS float* scr = (LAS float*)(lds + RING_OFF + wave * 16384); const int gwf = (bx - f0) * NWAVES + wave, ngwf = (G - f0) * NWAVES;
#pragma unroll 1
                  for (int e = 3 * L; e < 3 * L + 3; ++e) transpose_job_f8(KIN(kp, 30) + (size_t)e * DFFE * DM, 64.0f, DFFE, DM, WSP(unsigned char, WS_MOE2F) + (size_t)e * DM * DFFE, scr, gwf, ngwf, lane, RmOff{0}); } }
        }
        SEAM(pb + 1);
        if (EN_PH(2) && IN(pb + 2)) { PHASE_VARS; LAYER_PTRS(lp);
            { LAS float* glaw = (LAS float*)(lds + RING_OFF); __syncthreads();
#pragma unroll
              for (int i = 0; i < 4; ++i) { const int e = (i * 512 + tid) * 4; *(LAS f32x4*)(glaw + e) = *(const f32x4*)(lp.gla_w_up + e); }
              __syncthreads(); }
            for (int u = gw; u < NT / 8; u += NGW) prep_unit(L, lp, (const LAS float*)(lds + RING_OFF), WSP(bf16, WS_P), WSP(float, WS_GLG), WSP(bf16, WS_GQ), WSP(float, WS_GAB), WSP(bf16, WS_HQ), WSP(float, WS_HF), WSP(bf16, WS_NAVT), u * 8, lane);
            if (L == 0) { const float* KVRAW = WSP(float, WS_KVRAW); bf16* MK = WSP(bf16, WS_MK); bf16* MVT = WSP(bf16, WS_MVT); const float* mkg = KIN(kp, 19);
                for (int row = gw; row < 2048; row += NGW) {
                    const int LL = row >> 10; const float* kr = KVRAW + (size_t)row * 1024;
                    const f32x4 k0 = *(const f32x4*)(kr + lane * 8), k1 = *(const f32x4*)(kr + lane * 8 + 4);
                    float f[8] = {k0[0], k0[1], k0[2], k0[3], k1[0], k1[1], k1[2], k1[3]}; float ss = 0.f;
#pragma unroll
                    for (int i = 0; i < 8; ++i) ss += f[i] * f[i];
                    ss = group_sum<16>(ss); const float sc = rsqrtf(ss * (1.0f / 128.0f) + RMS_EPS); const float* gn = mkg + LL * 128 + (lane & 15) * 8;
#pragma unroll
                    for (int i = 0; i < 8; ++i) f[i] = f[i] * sc * gn[i];
                    *(v4u*)(MK + (size_t)row * 512 + lane * 8) = pack8(f);
                    const int b = (row >> 8) & 3, m = row & 255; const float* vr = kr + 512;
#pragma unroll
                    for (int i = 0; i < 8; ++i) { const int cidx = lane * 8 + i; const int h = cidx >> 7, d = cidx & 127;
                        MVT[((size_t)((LL * 4 + b) * 4 + h) * 128 + d) * 256 + m] = (bf16)(pkbf(vr[cidx], 0.f) & 0xffffu); }
                }
            }
        }
        SEAM(pb + 2);
        if (EN_PH(13) && IN(pb + 13)) for (int rep_ = 0; rep_ < REPS(13); ++rep_) { PHASE_VARS;
            LAS unsigned char* scr = lds + RING_OFF + wave * 16384; unsigned char* oa = ws + WS_OA; bf16* P = WSP(bf16, WS_P);
#pragma unroll 1
            for (int u = gw; u < 3 * 8192; u += NGW) { const int br = u >> 13, cu = u & 8191, seq = cu >> 8, n = cu & 255, b = seq >> 3, h = (seq >> 1) & 3, dir = seq & 1; const size_t r0 = (size_t)b << 12;
                if (br == 0) s1_gdn(scr, WSP(bf16, WS_GQ) + r0 * 1536, WSP(float, WS_GAB) + r0 * 16 + dir * 4 + h, h, dir, n, (bf16*)(oa + OA_GW) + (size_t)cu * 2048, (bf16*)(oa + OA_GU) + (size_t)cu * 2048,
                                    (bf16*)(oa + OA_GKT) + (size_t)cu * 2048, (bf16*)(oa + OA_GP) + (size_t)cu * 256, (float*)(oa + OA_GS) + (size_t)cu * 64, lane);
                else if (br == 1) { DiagSrc S{WSP(bf16, WS_HQ) + r0 * 512 + h * 128, 512, nullptr, 0, WSP(float, WS_HF) + r0 * 1024 + dir * 512 + h * 128, 1024, nullptr, 0};
                    s1_diag<128, 1>(scr, S, dir, n, (bf16*)(oa + OA_HQD) + (size_t)cu * 2048, (bf16*)(oa + OA_HKDT) + (size_t)cu * 2048, (bf16*)(oa + OA_HP) + (size_t)cu * 256, (float*)(oa + OA_HV) + (size_t)cu * 128, lane); }
                else { DiagSrc S{P + r0 * LDP + C_GLQ + h * 64, LDP, P + r0 * LDP + C_GLK + h * 64, LDP, WSP(float, WS_GLG) + r0 * 512 + dir * 256 + h * 64, 512, nullptr, 0};
                    s1_diag<64, 0>(scr, S, dir, n, (bf16*)(oa + OA_LQD) + (size_t)cu * 1024, (bf16*)(oa + OA_LKDT) + (size_t)cu * 1024, (bf16*)(oa + OA_LP) + (size_t)cu * 256, (float*)(oa + OA_LV) + (size_t)cu * 64, lane); }
            }
        }
        SEAM(pb + 13);
        if (EN_PH(3) && IN(pb + 3)) for (int rep_ = 0; rep_ < REPS(3); ++rep_) { PHASE_VARS;
            gu32* wq = ctl + CW_WQ + 64 * (L + 2 * rep_); gu32* gq = ctl + CW_GQ + 64 * 8 * (L + 2 * rep_);
            bf16* P = WSP(bf16, WS_P); bf16* SOUT = WSP(bf16, WS_SOUT); bf16* BR = WSP(bf16, WS_BR); unsigned char* oa = ws + WS_OA;
            if (!rep_ || REP_S2) {
#pragma unroll 1
                for (int seq = bx; seq < 32; seq += G) { const int b = seq >> 3, h = (seq >> 1) & 3, dir = seq & 1; const size_t r0 = (size_t)b << 12, c0 = (size_t)seq * 256;
                    s2_gdn(lds + RING_OFF, (const bf16*)(oa + OA_GW) + c0 * 2048, (const bf16*)(oa + OA_GU) + c0 * 2048, (const bf16*)(oa + OA_GKT) + c0 * 2048, (const bf16*)(oa + OA_GP) + c0 * 256, (const float*)(oa + OA_GS) + c0 * 64,
                           WSP(bf16, WS_GQ) + r0 * 1536 + h * 128, SOUT + ((size_t)(1 * 2 + dir) * NT + r0) * 512 + h * 128, dir, wave, lane, tid); }
#pragma unroll 1
                for (int i2 = bx; i2 < 64; i2 += G) if (i2 >= 32) { const int seq = i2 - 32, b = seq >> 3, h = (seq >> 1) & 3, dir = seq & 1; const size_t r0 = (size_t)b << 12, c0 = (size_t)seq * 256;
                    s2_diag<128>(lds + RING_OFF, (const bf16*)(oa + OA_HQD) + c0 * 2048, (const bf16*)(oa + OA_HKDT) + c0 * 2048, (const bf16*)(oa + OA_HP) + c0 * 256, (const float*)(oa + OA_HV) + c0 * 128,
                                 P + r0 * LDP + C_HGI + h * 128, LDP, SOUT + ((size_t)(2 * 2 + dir) * NT + r0) * 512 + h * 128, 512, dir, wave, lane, tid); }
#pragma unroll 1
                for (int i2 = bx; i2 < 96; i2 += G) if (i2 >= 64) { const int seq = i2 - 64, b = seq >> 3, h = (seq >> 1) & 3, dir = seq & 1; const size_t r0 = (size_t)b << 12, c0 = (size_t)seq * 256;
                    s2_diag<64>(lds + RING_OFF, (const bf16*)(oa + OA_LQD) + c0 * 1024, (const bf16*)(oa + OA_LKDT) + c0 * 1024, (const bf16*)(oa + OA_LP) + c0 * 256, (const float*)(oa + OA_LV) + c0 * 64,
                                P + r0 * LDP + C_GLV + h * 128, LDP, SOUT + ((size_t)(0 * 2 + dir) * NT + r0) * 512 + h * 128, 512, dir, wave, lane, tid); }
            }
            if (bx < 96 && rep_ == 0) { __syncthreads(); if (tid == 0) __hip_atomic_fetch_add(ctl + CW_S2DONE + 64 * L, 1u, RLX_AGENT); }
            if (!rep_ || REP_ATT) {
            bool gates_left = true;
            for (;;) {
                __syncthreads();
                if (tid == 0) { unsigned v = 0xffffffffu;
                    if (gates_left) for (int k8 = 0; k8 < 8; ++k8) { const int x = (bx + k8) & 7; const unsigned b0 = __hip_atomic_fetch_add(gq + 64 * x, 1u, RLX_AGENT); if (b0 < (unsigned)(320 / GATE_BATCH)) { v = (unsigned)x * 4096u + b0; break; } }
                    MISC[17] = v; if (v == 0xffffffffu) MISC[16] = __hip_atomic_fetch_add(wq, 1u, RLX_AGENT); }
                __syncthreads();
                const unsigned gsel = MISC[17];
                if (gsel != 0xffffffffu) {
                    const unsigned char* g8b = (const unsigned char*)(WSP(bf16, WS_WIN) + ((size_t)L * NIN + LDP) * DM) - (size_t)33 * 256 * DM;
                    pg8::Gemm g8{WSP(bf16, WS_H8), (const bf16*)g8b, NT, NIN, DM / 2}; pg8::GateBatchOrder S8{(int)(gsel >> 12), (int)(gsel & 4095u) * GATE_BATCH, GATE_BATCH}; pg8::EpiInProj E8{WSP(bf16, WS_P), WSP(bf16, WS_G)};
                    pg8::gemm_phase_f8<pg8::EpiInProj, pg8::GateBatchOrder, true, F8_SP2>(lds + RING_OFF, g8, S8, E8);
                    continue; }
                gates_left = false;
                int it = (int)MISC[16];
                if (it >= 768) break;
                int lane_ = lane, tid_q = tid; asm volatile("" : "+v"(lane_), "+v"(tid_q));
                if (it < 512) {
                    const int b = it >> 7, h = (it >> 4) & 7, rq = it & 15;
                    na_wave_unit(P, WSP(bf16, WS_NAVT), KIN(kp, 6) + L * 8 * 15 * 31, BR, b, h, 4 * rq + (wave >> 2), wave & 3, lane_);
                    na_wave_unit(P, WSP(bf16, WS_NAVT), KIN(kp, 6) + L * 8 * 15 * 31, BR, b, h, 4 * rq + 2 + (wave >> 2), wave & 3, lane_);
                } else {
                    const int i2 = it - 512, tb = i2 >> 2, h = i2 & 3;
                    mem_wg_unit(lds + RING_OFF, P, WSP(bf16, WS_MK) + (size_t)L * 1024 * 512, WSP(bf16, WS_MVT) + (size_t)L * 4 * 4 * 128 * 256, BR + (size_t)4 * NT * 512, tb * 256, h, wave, lane_, tid_q);
                }
            }
            }
            if (FILL_TAIL && G >= 128 && rep_ == 0 && bx >= 144) { LAS float* scr = (LAS float*)(lds + RING_OFF + wave * 16384);
                moe_drain(KIN(kp, 28), KIN(kp, 29), KIN(kp, 30), ws, ctl + CW_CONVQ, ctl + CW_S2DONE + 64 * L, 96u, MISC + 20, scr, wave, lane, tid); }
        }
        SEAM(pb + 3);
        if (EN_PH(4) && IN(pb + 4)) for (int rep_ = 0; rep_ < REPS(4); ++rep_) { PHASE_VARS; LAYER_PTRS(lp); for (int t = gw; t < NT; t += NGW) post_token(lp, WSP(bf16, WS_P), WSP(bf16, WS_SOUT), WSP(bf16, WS_BR), t, lane);
            if (L == 1 && rep_ == 0) {
                bf16* MOE1 = WSP(bf16, WS_MOE1); bf16* MOE2 = WSP(bf16, WS_MOE2F); LAS float* scr = (LAS float*)(lds + RING_OFF + wave * 16384);
                if (FILL_TAIL && G >= 128) moe_drain(KIN(kp, 28), KIN(kp, 29), KIN(kp, 30), ws, ctl + CW_CONVQ, nullptr, 0u, MISC + 20, scr, wave, lane, tid);
                else { moe1_convert_all(KIN(kp, 28), KIN(kp, 29), (unsigned char*)MOE1, scr, gw, NGW, lane);
#pragma unroll 1
                    for (int e = 0; e < NEXP; ++e) transpose_job_f8(KIN(kp, 30) + (size_t)e * DFFE * DM, 64.0f, DFFE, DM, (unsigned char*)MOE2 + (size_t)e * DM * DFFE, scr, gw, NGW, lane, RmOff{0}); }
            }
        }
        SEAM(pb + 4);
        if (EN_PH(5) && IN(pb + 5)) { PHASE_VARS; pg8::Gemm g{WSP(bf16, WS_BR), WSP(bf16, WS_WBR) + (size_t)L * 5 * DM * 512, 5 * NT, 5 * DM, 512}; pg8::BranchOrder5 S{G, bx}; pg8::EpiBranchAcc E{WSP(bf16, WS_G), WSP(bf16, WS_HM)};
            pg8::gemm_phase<pg8::EpiBranchAcc, pg8::BranchOrder5, true, true>(lds + RING_OFF, g, S, E); }
        SEAM(pb + 5);
        if (EN_PH(7) && IN(pb + 7)) { PHASE_VARS; const float* xres = L ? (const float*)out : KIN(kp, 0);
            pg8::Gemm g{WSP(bf16, WS_HM), WSP(bf16, WS_WOUT) + (size_t)L * DM * DM, NT, DM, DM}; pg8::StaticOrder S; S.init(NT, DM, G, bx); pg8::EpiResF32 E{xres, out, DM, 1 << 20};
            pg8::gemm_phase<pg8::EpiResF32, pg8::StaticOrder, true, true>(lds + RING_OFF, g, S, E); }
        SEAM(pb + 7);
        if (L == 0) {
            if (EN_PH(8) && IN(pb + 8)) for (int rep_ = 0; rep_ < REPS(8); ++rep_) { PHASE_VARS; const float* gf = KIN(kp, 22) + L * DM; bf16* HM = WSP(bf16, WS_HM);
                rms_tokens(out, gf, HM, nullptr, gw, NGW, lane); }
            SEAM(pb + 8);
            if (EN_PH(9) && IN(pb + 9)) for (int rep_ = 0; rep_ < REPS(9); ++rep_) { PHASE_VARS; pg8::Gemm g{WSP(bf16, WS_HM), WSP(bf16, WS_WGU), NT, 2 * DFF, DM}; pg8::StaticOrder S; S.init(NT, 2 * DFF, G, bx); pg8::EpiSwiGLU E{WSP(bf16, WS_HID), DFF, 1 << 20};
                GEMM_STAGGER(); pg8::gemm_phase<pg8::EpiSwiGLU, pg8::StaticOrder, true, true>(lds + RING_OFF, g, S, E); }
            SEAM(pb + 9);
            if (EN_PH(10) && IN(pb + 10)) { PHASE_VARS; pg8::Gemm g{WSP(bf16, WS_HID), WSP(bf16, WS_WDN), NT, DM, DFF}; pg8::StaticOrder S; S.init(NT, DM, G, bx); pg8::EpiResF32 E{out, out, DM, 1 << 20};
                pg8::gemm_phase<pg8::EpiResF32, pg8::StaticOrder, true, true>(lds + RING_OFF, g, S, E); }
            SEAM(pb + 10);
        } else {
            if (EN_PH(8) && IN(pb + 8)) { PHASE_VARS; gu32* cnt = ctl + CW_CNT; unsigned* ROUTE = WSP(unsigned, WS_ROUTE); bf16* HM = WSP(bf16, WS_HM);
                const float* wr = KIN(kp, 26); const float* brt = KIN(kp, 27); const float* gf = KIN(kp, 22) + L * DM;
                LAS unsigned* lcnt = (LAS unsigned*)(lds + RING_OFF); LAS unsigned* gbase = lcnt + 8;
                LAS f32x4* wl = (LAS f32x4*)(lds + RING_OFF + 4096);
                __syncthreads();
#pragma unroll
                for (int i = 0; i < 8; ++i) { const int idx = i * 512 + tid, ln = idx & 63, r = idx >> 6, half = r & 1, q = (r >> 1) & 3, j = r >> 3; wl[idx] = *(const f32x4*)(wr + (size_t)(4 * (ln + 64 * j) + q) * 8 + half * 4); }
                for (int blk = bx; blk < NT / 64; blk += G) {
                    __syncthreads(); if (tid < 8) lcnt[tid] = 0u; __syncthreads();
                    unsigned re0 = 0, re1 = 0, rp0 = 0, rp1 = 0; float rw0 = 0.f, rw1 = 0.f;
#pragma unroll 1
                    for (int tt = 0; tt < 8; ++tt) { const int t = blk * 64 + wave * 8 + tt; f32x4 v[8]; rms_row_f8(out + (size_t)t * DM, gf, (unsigned char*)HM + (size_t)t * DM, lane, v);
                        float lg[8]; int ll = lane; asm volatile("" : "+v"(ll));
#pragma unroll
                        for (int e = 0; e < 8; ++e) lg[e] = 0.f;
#pragma unroll
                        for (int j = 0; j < 8; ++j)
#pragma unroll
                            for (int q = 0; q < 4; ++q) { const f32x4 w0 = wl[((j * 4 + q) * 2 + 0) * 64 + ll], w1 = wl[((j * 4 + q) * 2 + 1) * 64 + ll]; const float hv = v[j][q];
                                lg[0] += hv * w0[0]; lg[1] += hv * w0[1]; lg[2] += hv * w0[2]; lg[3] += hv * w0[3]; lg[4] += hv * w1[0]; lg[5] += hv * w1[1]; lg[6] += hv * w1[2]; lg[7] += hv * w1[3]; }
#pragma unroll
                        for (int e = 0; e < 8; ++e) lg[e] = wave_sum(lg[e]) + brt[e];
                        int e0 = 0; float m0 = lg[0];
#pragma unroll
                        for (int e = 1; e < 8; ++e) if (lg[e] > m0) { m0 = lg[e]; e0 = e; }
                        int e1 = 0; float m1 = -3.0e38f;
#pragma unroll
                        for (int e = 0; e < 8; ++e) if (e != e0 && lg[e] > m1) { m1 = lg[e]; e1 = e; }
                        const float w0 = 1.0f / (1.0f + __expf(m1 - m0));
                        if (lane == tt) { re0 = e0; re1 = e1; rw0 = w0; rw1 = 1.0f - w0;
                            rp0 = __hip_atomic_fetch_add(&lcnt[e0], 1u, __ATOMIC_RELAXED, __HIP_MEMORY_SCOPE_WORKGROUP); rp1 = __hip_atomic_fetch_add(&lcnt[e1], 1u, __ATOMIC_RELAXED, __HIP_MEMORY_SCOPE_WORKGROUP); }
                    }
                    __syncthreads();
                    if (tid < 8) gbase[tid] = __hip_atomic_fetch_add(cnt + 64 * tid, lcnt[tid], RLX_AGENT);
                    __syncthreads();
                    if (lane < 8) { const int t = blk * 64 + wave * 8 + lane; unsigned* rr = ROUTE + (size_t)t * 8;
                        rr[0] = re0; rr[1] = re1; rr[2] = gbase[re0] + rp0; rr[3] = gbase[re1] + rp1; rr[4] = __float_as_uint(rw0); rr[5] = __float_as_uint(rw1); }
                }
            }
            SEAM(pb + 8);
            if (hi > pb + 9) { PHASE_VARS; gu32* cnt = ctl + CW_CNT;
                __syncthreads();
                if (tid == 0) { int acc = 0; for (int e = 0; e < 8; ++e) { const int c = (int)__hip_atomic_load(cnt + 64 * e, RLX_AGENT); const int nb = (c + 255) >> 8; TAB[e] = nb; TAB[8 + e] = acc; TAB[32 + e] = acc * 256; acc += nb; } TAB[40] = acc; }
                __syncthreads();
            }
            if (EN_PH(9) && IN(pb + 9)) for (int rep_ = 0; rep_ < REPS(9); ++rep_) { PHASE_VARS; bf16* XB = WSP(bf16, WS_XB); unsigned* ROUTE = WSP(unsigned, WS_ROUTE); const bf16* HM = WSP(bf16, WS_HM);
                for (int t = gw; t < NT; t += NGW) { unsigned* rr = ROUTE + (size_t)t * 8; const unsigned e0 = rr[0], e1 = rr[1]; const unsigned s0 = (unsigned)TAB[32 + e0] + rr[2], s1 = (unsigned)TAB[32 + e1] + rr[3];
                    if (lane == 0) { rr[6] = s0; rr[7] = s1; }
                    const v4u* src = (const v4u*)((const unsigned char*)HM + (size_t)t * DM) + lane; v4u* d0 = (v4u*)((unsigned char*)XB + (size_t)s0 * DM) + lane; v4u* d1 = (v4u*)((unsigned char*)XB + (size_t)s1 * DM) + lane;
#pragma unroll
                    for (int j = 0; j < 2; ++j) { const v4u x = src[64 * j]; d0[64 * j] = x; d1[64 * j] = x; } } }
            SEAM(pb + 9);
            if (EN_PH(10) && IN(pb + 10)) for (int rep_ = 0; rep_ < REPS(20); ++rep_) { PHASE_VARS; __syncthreads(); if (tid == 0) { for (int e = 0; e <= 8; ++e) TAB[16 + e] = (e < 8 ? TAB[8 + e] : TAB[40]) * 56; } __syncthreads();
                pg8::Gemm g{WSP(bf16, WS_XB), WSP(bf16, WS_MOE1), MAXSLOT, 8 * 2 * DFFE, DM / 2}; pg8::MoeOrder S{G, bx, 56, TAB[40] * 56, TAB}; pg8::EpiSwiGLU8 E{WSP(unsigned char, WS_HIDM), DFFE, 56};
                GEMM_STAGGER(); pg8::gemm_phase_f8<pg8::EpiSwiGLU8, pg8::MoeOrder, true, F8_SP2>(lds + RING_OFF, g, S, E); }
            SEAM(pb + 10);
            if (EN_PH(11) && IN(pb + 11)) for (int rep_ = 0; rep_ < REPS(11); ++rep_) { PHASE_VARS; __syncthreads(); if (tid == 0) { for (int e = 0; e <= 8; ++e) TAB[16 + e] = (e < 8 ? TAB[8 + e] : TAB[40]) * 8; } __syncthreads();
                pg8::Gemm g{WSP(bf16, WS_HIDM), WSP(bf16, WS_MOE2F), MAXSLOT, 8 * DM, DFFE / 2}; pg8::MoeOrder S{G, bx, 8, TAB[40] * 8, TAB}; pg8::EpiBf16Out E{WSP(bf16, WS_YB), DM, 8};
                GEMM_STAGGER(); pg8::gemm_phase_f8<pg8::EpiBf16Out, pg8::MoeOrder, true, F8_SP2>(lds + RING_OFF, g, S, E); }
            SEAM(pb + 11);
            if (EN_PH(12) && IN(pb + 12)) { PHASE_VARS; const bf16* YB = WSP(bf16, WS_YB); const unsigned* ROUTE = WSP(unsigned, WS_ROUTE);
                for (int t = gw; t < NT; t += NGW) { const unsigned* rr = ROUTE + (size_t)t * 8; const float w0 = __uint_as_float(rr[4]), w1 = __uint_as_float(rr[5]); const size_t s0 = rr[6], s1 = rr[7];
                    f32x4* o = (f32x4*)(out + (size_t)t * DM) + lane; const v2u* y0 = (const v2u*)(YB + s0 * DM) + lane; const v2u* y1 = (const v2u*)(YB + s1 * DM) + lane;
#pragma unroll
                    for (int j = 0; j < 8; ++j) { const v2u a = y0[64 * j], b = y1[64 * j];
                        o[64 * j] = o[64 * j] + w0 * (f32x4){bflo(a.x), bfhi(a.x), bflo(a.y), bfhi(a.y)} + w1 * (f32x4){bflo(b.x), bfhi(b.x), bflo(b.y), bfhi(b.y)}; } } }
        }
    }
#undef IN
#undef SEAM
}
extern "C" void kernel_launch(void* const* d_in, const int* in_sizes, int n_in, void* d_out, int out_size, void* d_ws, size_t ws_size, hipStream_t stream) {
    static int grid = 0;
    if (grid == 0) {
        if (n_in != 31 || in_sizes[0] != NT * DM || out_size != NT * DM || ws_size < WS_END) { fprintf(stderr, "kernel_launch: unexpected shapes (n_in %d, in0 %d, out %d, ws %zu < %zu); nothing launched\n", n_in, n_in > 0 ? in_sizes[0] : -1, out_size, ws_size, (size_t)WS_END); grid = -1; return; }
        int dev = 0, cus = 0, per_cu = 0;
        if (hipGetDevice(&dev) != hipSuccess || hipDeviceGetAttribute(&cus, hipDeviceAttributeMultiprocessorCount, dev) != hipSuccess) { grid = -1; return; }
        if (hipFuncSetAttribute((const void*)mega_fwd, hipFuncAttributeMaxDynamicSharedMemorySize, LDS_BYTES) != hipSuccess) { fprintf(stderr, "kernel_launch: hipFuncSetAttribute failed\n"); grid = -1; return; }
        if (hipOccupancyMaxActiveBlocksPerMultiprocessor(&per_cu, (const void*)mega_fwd, NWAVES * 64, LDS_BYTES) != hipSuccess || per_cu < 1) fprintf(stderr, "kernel_launch: occupancy query reports %d\n", per_cu);
        (void)hipGetLastError();
        grid = cus;
    }
    if (grid < 0) return;
    if (hipMemsetAsync((char*)d_ws + WS_CTL, 0, CTL_ZERO_BYTES, stream) != hipSuccess) return;
    Args a{};
    for (int i = 0; i < 31; ++i) a.in[i] = (const float*)d_in[i];
    a.out = (float*)d_out; a.ws = (unsigned char*)d_ws;
#if MK_SPLIT
    int ids[40]; int n = 0; ids[n++] = 0;
    for (int L = 0; L < 2; ++L) for (int k = 0; k < (L ? 13 : 11); ++k) { ids[n++] = 1 + 16 * L + k; if (k == 2) ids[n++] = 1 + 16 * L + 13; }
    for (int i = 0; i < n; ++i) { a.ph_lo = ids[i]; a.ph_hi = ids[i] + 1; hipLaunchKernelGGL(mega_fwd, dim3(grid), dim3(NWAVES * 64), LDS_BYTES, stream, a); }
#else
    a.ph_lo = 0; a.ph_hi = 64;
    hipLaunchKernelGGL(mega_fwd, dim3(grid), dim3(NWAVES * 64), LDS_BYTES, stream, a);
#endif
    const hipError_t le = hipPeekAtLastError();
    if (le != hipSuccess) fprintf(stderr, "kernel_launch: launch failed: %s\n", hipGetErrorName(le));
}
```
